# Optimizing an MI355X kernel written in HIP

```python
import jax, jax.numpy as jnp
from jax import lax
import numpy as np

D_MODEL = 1024
BATCH = 4
SEQ = 4096
DEPTH = 4
DEC_BATCH = 32
DEC_SEQ = 8
PAST_LEN = 8192
PAGE_SIZE = 128

HEAD_DIM = 64
HEADS_PER_GROUP = 4
ATTN_GROUPS = ((128, 1), (512, 4), (2048, 16))
N_HEADS = HEADS_PER_GROUP * len(ATTN_GROUPS)
ATTN_WIDTH = N_HEADS * HEAD_DIM
MERGED_WIDTH = HEADS_PER_GROUP * HEAD_DIM
ROT_DIM = HEAD_DIM // 4
ROPE_THETA = 500000.0
POOL_WINDOWS = (2, 4, 8, 16)
POOL_GROUP_DIM = D_MODEL // 8
POOL_WIDTH = len(POOL_WINDOWS) * POOL_GROUP_DIM
POOL_PAD = max(POOL_WINDOWS) - 1
D_FF = 4 * D_MODEL
IN_WIDTH = 3 * ATTN_WIDTH + POOL_WIDTH + 2 * D_MODEL
Q_BLOCK = 128
RMS_EPS = 1e-6

kernel_name = "hybrid_dilated_pool_decoder_step"


def rmsnorm(x, g):
    xf = x.astype(jnp.float32)
    y = xf * lax.rsqrt(jnp.mean(xf * xf, axis=-1, keepdims=True) + RMS_EPS) * g.astype(jnp.float32)
    return y.astype(x.dtype)


def rope(x, pos):
    half = ROT_DIM // 2
    inv = ROPE_THETA ** (-jnp.arange(0, ROT_DIM, 2, dtype=jnp.float32) / ROT_DIM)
    ang = pos.astype(jnp.float32)[:, None] * inv[None, :]
    cos = jnp.cos(ang)[None, :, None, :]
    sin = jnp.sin(ang)[None, :, None, :]
    xr = x[..., :ROT_DIM].astype(jnp.float32)
    x1, x2 = xr[..., :half], xr[..., half:]
    rot = jnp.concatenate([x1 * cos - x2 * sin, x2 * cos + x1 * sin], axis=-1)
    return jnp.concatenate([rot.astype(x.dtype), x[..., ROT_DIM:]], axis=-1)


def dilated_group(q, k_all, v_all, q_idx, window, dilation):
    n_keys = window // dilation + 1
    idx = q_idx[:, None] - jnp.arange(n_keys)[None, :] * dilation
    valid = idx >= 0
    idx_c = jnp.maximum(idx, 0)
    kg = k_all[:, idx_c]
    vg = v_all[:, idx_c]
    s = jnp.einsum('bthd,btjhd->bhtj', q, kg).astype(jnp.float32) * (HEAD_DIM ** -0.5)
    s = jnp.where(valid[None, None], s, -jnp.inf)
    m = jnp.max(s, axis=-1, keepdims=True)
    p = jnp.exp(s - m)
    den = jnp.sum(p, axis=-1, keepdims=True)
    o = jnp.einsum('bhtj,btjhd->bthd', p / den, vg.astype(jnp.float32))
    lse = jnp.transpose((m + jnp.log(den))[..., 0], (0, 2, 1))
    return o, lse


def dilated_mixture(q, ks, vs, q_idxs):
    outs, lses = [], []
    for g, (w, d) in enumerate(ATTN_GROUPS):
        qg = q[:, :, g * HEADS_PER_GROUP:(g + 1) * HEADS_PER_GROUP]
        o, lse = dilated_group(qg, ks[g], vs[g], q_idxs[g], w, d)
        outs.append(o)
        lses.append(lse)
    wts = jax.nn.softmax(jnp.stack(lses, axis=0), axis=0)
    return jnp.sum(wts[..., None] * jnp.stack(outs, axis=0), axis=0)


def attention_branch(q, ks, vs, offsets):
    B, T = q.shape[0], q.shape[1]
    if T > Q_BLOCK and T % Q_BLOCK == 0:
        nb = T // Q_BLOCK
        qb = jnp.transpose(q.reshape(B, nb, Q_BLOCK, N_HEADS, HEAD_DIM), (1, 0, 2, 3, 4))
        ib = jnp.arange(T, dtype=jnp.int32).reshape(nb, Q_BLOCK)
        ob = lax.map(lambda a: dilated_mixture(a[0], ks, vs, [off + a[1] for off in offsets]), (qb, ib))
        o = jnp.transpose(ob, (1, 0, 2, 3, 4)).reshape(B, T, HEADS_PER_GROUP, HEAD_DIM)
    else:
        t = jnp.arange(T, dtype=jnp.int32)
        o = dilated_mixture(q, ks, vs, [off + t for off in offsets])
    return o.reshape(B, T, MERGED_WIDTH)


def pool_branch(u_ext, pos0, lin, scale):
    B = u_ext.shape[0]
    T = u_ext.shape[1] - POOL_PAD
    uf = u_ext.astype(jnp.float32)
    c = jnp.concatenate([jnp.zeros((B, 1, POOL_WIDTH), jnp.float32), jnp.cumsum(uf, axis=1)], axis=1)
    pos = pos0 + jnp.arange(T, dtype=jnp.int32)
    u_new = uf[:, POOL_PAD:]
    outs = []
    for g, w in enumerate(POOL_WINDOWS):
        sl = slice(g * POOL_GROUP_DIM, (g + 1) * POOL_GROUP_DIM)
        s = c[:, POOL_PAD + 1:POOL_PAD + 1 + T, sl] - c[:, POOL_PAD + 1 - w:POOL_PAD + 1 - w + T, sl]
        cnt = jnp.minimum(w, pos + 1).astype(jnp.float32)[None, :, None]
        outs.append(s / cnt - u_new[..., sl])
    p = jnp.stack(outs, axis=2)
    y = jnp.einsum('btgc,gcd->btgd', p, lin.astype(jnp.float32)).reshape(B, T, POOL_WIDTH)
    return (y * scale.astype(jnp.float32)).astype(u_ext.dtype)


def layer(x, pos, pos0, kv_bufs, pool_buf, norm1, w_in, w_pa, w_pb, pool_lin, pool_scale, w_o, norm2, w_up, w_down):
    B, T, _ = x.shape
    h = rmsnorm(x, norm1)
    proj = h @ w_in
    c1, c2, c3 = ATTN_WIDTH, 2 * ATTN_WIDTH, 3 * ATTN_WIDTH
    c4 = c3 + POOL_WIDTH
    c5 = c4 + D_MODEL
    q, k, v, u, ga, gb = jnp.split(proj, [c1, c2, c3, c4, c5], axis=-1)
    q = rope(q.reshape(B, T, N_HEADS, HEAD_DIM), pos)
    k = rope(k.reshape(B, T, N_HEADS, HEAD_DIM), pos)
    v = v.reshape(B, T, N_HEADS, HEAD_DIM)
    ks, vs, offs, new_kv = [], [], [], []
    for g, (w, d) in enumerate(ATTN_GROUPS):
        kg = k[:, :, g * HEADS_PER_GROUP:(g + 1) * HEADS_PER_GROUP]
        vg = v[:, :, g * HEADS_PER_GROUP:(g + 1) * HEADS_PER_GROUP]
        if kv_bufs is None:
            k_all, v_all, off, keep = kg, vg, 0, min(w, T)
        else:
            buf = kv_bufs[g]
            L = buf.shape[1]
            k_all = jnp.concatenate([buf[:, :, 0], kg], axis=1)
            v_all = jnp.concatenate([buf[:, :, 1], vg], axis=1)
            off, keep = L, L
        ks.append(k_all)
        vs.append(v_all)
        offs.append(off)
        new_kv.append(jnp.stack([k_all[:, -keep:], v_all[:, -keep:]], axis=2))
    o_a = attention_branch(q, ks, vs, offs).astype(x.dtype)
    if pool_buf is None:
        pool_buf = jnp.zeros((B, POOL_PAD, POOL_WIDTH), u.dtype)
    u_ext = jnp.concatenate([pool_buf, u], axis=1)
    new_pool = u_ext[:, -POOL_PAD:]
    o_b = pool_branch(u_ext, pos0, pool_lin, pool_scale)
    mixed = jax.nn.sigmoid(ga) * (o_a @ w_pa) + jax.nn.sigmoid(gb) * (o_b @ w_pb)
    x = x + mixed @ w_o
    h2 = rmsnorm(x, norm2)
    x = x + jnp.square(jax.nn.relu(h2 @ w_up)) @ w_down
    return x, new_kv, new_pool


def setup_inputs(seed: int = 0) -> dict:
    key = jax.random.key(seed)
    ks = jax.random.split(key, 20)
    f32 = jnp.float32
    nrm = lambda k, shape, s: jax.random.normal(k, shape, f32) * s
    win = [min(w, PAST_LEN) for (w, _) in ATTN_GROUPS]
    return {
        "x_prompt": nrm(ks[0], (BATCH, SEQ, D_MODEL), 1.0),
        "x_sample": nrm(ks[1], (DEC_BATCH, DEC_SEQ, D_MODEL), 1.0),
        "cache_kv_w128": nrm(ks[2], (DEPTH, DEC_BATCH, win[0], 2, HEADS_PER_GROUP, HEAD_DIM), 1.0),
        "cache_kv_w512": nrm(ks[3], (DEPTH, DEC_BATCH, win[1], 2, HEADS_PER_GROUP, HEAD_DIM), 1.0),
        "cache_kv_w2048": nrm(ks[4], (DEPTH, DEC_BATCH, win[2], 2, HEADS_PER_GROUP, HEAD_DIM), 1.0),
        "state_pool": nrm(ks[5], (DEPTH, DEC_BATCH, POOL_PAD, POOL_WIDTH), 1.0),
        "norm1": 1.0 + nrm(ks[6], (DEPTH, D_MODEL), 0.05),
        "w_in": nrm(ks[7], (DEPTH, D_MODEL, IN_WIDTH), D_MODEL ** -0.5),
        "w_pa": nrm(ks[8], (DEPTH, MERGED_WIDTH, D_MODEL), MERGED_WIDTH ** -0.5),
        "w_pb": nrm(ks[9], (DEPTH, POOL_WIDTH, D_MODEL), POOL_WIDTH ** -0.5),
        "pool_lin": nrm(ks[10], (DEPTH, len(POOL_WINDOWS), POOL_GROUP_DIM, POOL_GROUP_DIM), POOL_GROUP_DIM ** -0.5),
        "pool_scale": 1.0 + nrm(ks[11], (DEPTH, POOL_WIDTH), 0.05),
        "w_o": nrm(ks[12], (DEPTH, D_MODEL, D_MODEL), D_MODEL ** -0.5),
        "norm2": 1.0 + nrm(ks[13], (DEPTH, D_MODEL), 0.05),
        "w_up": nrm(ks[14], (DEPTH, D_MODEL, D_FF), D_MODEL ** -0.5),
        "w_down": nrm(ks[15], (DEPTH, D_FF, D_MODEL), D_FF ** -0.5),
        "final_norm": 1.0 + nrm(ks[16], (D_MODEL,), 0.05),
    }


def reference(x_prompt, x_sample, cache_kv_w128, cache_kv_w512, cache_kv_w2048, state_pool,
              norm1, w_in, w_pa, w_pb, pool_lin, pool_scale, w_o, norm2, w_up, w_down, final_norm):
    pos_p = jnp.arange(SEQ, dtype=jnp.int32)
    pos_s = PAST_LEN + jnp.arange(DEC_SEQ, dtype=jnp.int32)
    xp, xs = x_prompt, x_sample
    kvp = [[], [], []]
    kvs = [[], [], []]
    poolp, pools = [], []
    for l in range(DEPTH):
        wl = (norm1[l], w_in[l], w_pa[l], w_pb[l], pool_lin[l], pool_scale[l], w_o[l], norm2[l], w_up[l], w_down[l])
        xp, nkv_p, npool_p = layer(xp, pos_p, 0, None, None, *wl)
        bufs = [cache_kv_w128[l], cache_kv_w512[l], cache_kv_w2048[l]]
        xs, nkv_s, npool_s = layer(xs, pos_s, PAST_LEN, bufs, state_pool[l], *wl)
        for g in range(3):
            kvp[g].append(nkv_p[g])
            kvs[g].append(nkv_s[g])
        poolp.append(npool_p)
        pools.append(npool_s)
    y_prompt = rmsnorm(xp, final_norm)
    y_sample = rmsnorm(xs, final_norm)
    kv_w128_prompt = jnp.stack(kvp[0], axis=0)
    kv_w512_prompt = jnp.stack(kvp[1], axis=0)
    kv_w2048_prompt = jnp.stack(kvp[2], axis=0)
    pool_prompt = jnp.stack(poolp, axis=0)
    kv_w128_sample = jnp.stack(kvs[0], axis=0)
    kv_w512_sample = jnp.stack(kvs[1], axis=0)
    kv_w2048_sample = jnp.stack(kvs[2], axis=0)
    pool_sample = jnp.stack(pools, axis=0)
    return (y_prompt, y_sample, kv_w128_prompt, kv_w512_prompt, kv_w2048_prompt, pool_prompt,
            kv_w128_sample, kv_w512_sample, kv_w2048_sample, pool_sample)
```

```cpp
#include <hip/hip_runtime.h>
#include <hip/hip_cooperative_groups.h>
#include <cstdio>
#include <cstdint>
namespace cg = cooperative_groups;

namespace pg8 {
#define PG8_LAS __attribute__((address_space(3)))
typedef unsigned short bf16_t;
typedef short bf16x8 __attribute__((ext_vector_type(8)));
typedef float f32x4 __attribute__((ext_vector_type(4)));
typedef unsigned u32x4 __attribute__((ext_vector_type(4)));
typedef unsigned u32x2 __attribute__((ext_vector_type(2)));
constexpr int BM = 256, BK = 64, HALF = 128, HTB = HALF * BK * 2, STAGE_BYTES = 8 * HTB, NXCD = 8, WGM = 8;

__host__ __device__ __forceinline__ int lds_byte(int r, int c) { const int st = (r >> 4) * 2 + (c >> 5), rr = r & 15, cc = c & 31, ob = rr * 64 + cc * 2; return st * 1024 + (ob ^ (((ob >> 9) & 1) << 5)); }
__host__ __device__ __forceinline__ void stage_rc(int b, int& R, int& C) { const int st = b / 1024, sb = b % 1024, swz = sb ^ (((sb >> 9) & 1) << 5); R = (st >> 1) * 16 + swz / 64; C = (st & 1) * 32 + (swz % 64) / 2; }
__host__ __device__ __forceinline__ int perm32(int rho) { const int n = rho >> 4, i = rho & 15; return 8 * (i >> 2) + 4 * n + (i & 3); }

struct Unit { int pm, pn; };
struct Gemm { const bf16_t* A; const bf16_t* Bt; int M, N, K; };

struct StaticOrder {
    int nM, nN, nwg, G, c;
    __host__ __device__ void init(int M, int N, int G_, int c_) { nM = M / BM; nN = N / BM; nwg = nM * nN; G = G_; c = c_; }
    __host__ __device__ bool next(int i, Unit& u) const {
        const long L = (long)i * G + c; if (L >= nwg) return false;
        int wgid = (int)L; { const int q = nwg / NXCD, r = nwg % NXCD, xcd = wgid % NXCD, off = wgid / NXCD; wgid = (xcd < r ? xcd * (q + 1) : r * (q + 1) + (xcd - r) * q) + off; }
        const int nig = WGM * nN, gid = wgid / nig, fm = gid * WGM, gsz = (nM - fm) < WGM ? (nM - fm) : WGM;
        u.pm = fm + ((wgid % nig) % gsz); u.pn = (wgid % nig) / gsz; return true;
    }
    __device__ __forceinline__ void a_ready(const Unit&) const {}
    __device__ __forceinline__ void done(const Unit&) const {}
};

__device__ __forceinline__ unsigned cvt_pk_bf16(float lo, float hi) { unsigned r; asm volatile("v_cvt_pk_bf16_f32 %0, %1, %2" : "=v"(r) : "v"(lo), "v"(hi)); return r; }

template <class Epi, class Sched, bool ALIGN_EPI = false, bool SP2 = false>
__device__ __forceinline__ void gemm_phase(PG8_LAS unsigned char* lds, const Gemm g, const Sched& S, const Epi& E) {
    int tid = threadIdx.x; asm volatile("" : "+v"(tid));
    const int wid = __builtin_amdgcn_readfirstlane(tid >> 6), lane = tid & 63, wr = wid >> 2, wc = wid & 3, fr = lane & 15, fq = lane >> 4;
    const int K = g.K, nt = K / BK;
    unsigned voffA[2], voffB[2];
#pragma unroll
    for (int i = 0; i < 2; ++i) { int R, C; stage_rc(tid * 16 + i * 8192, R, C); const int Rb = Epi::PERM ? ((R & ~31) + perm32(R & 31)) : R;
        voffA[i] = (unsigned)(R * K + C) * 2u; voffB[i] = (unsigned)(Rb * K + C) * 2u; }
    const size_t kstep = (size_t)(BK * 2);
    const size_t hstep = (size_t)HALF * K * 2;
    const size_t tstep = 2 * hstep;
    const unsigned ldsw = (unsigned)wid * 1024u;
    const int aoff = lds_byte(wr * 64 + fr, fq * 8), boff = lds_byte(wc * 32 + fr, fq * 8);
#define PG8_SA(b, h) (((b) * 2 + (h)) * HTB)
#define PG8_SB(b, h) ((4 + (b) * 2 + (h)) * HTB)
#define PG8_STAGE(bufoff, gbase, voff) do { _Pragma("unroll") for (int _i = 0; _i < 2; ++_i) \
        __builtin_amdgcn_global_load_lds((const unsigned*)((const char*)(gbase) + (voff)[_i]), (PG8_LAS unsigned*)(lds + (bufoff) + ldsw + _i * 8192), 16, 0, 0); } while (0)
#define PG8_LDA(dst, b, h) do { _Pragma("unroll") for (int m = 0; m < 4; ++m) _Pragma("unroll") for (int k = 0; k < 2; ++k) dst[m][k] = *(const PG8_LAS bf16x8*)(lds + PG8_SA(b, h) + aoff + m * 2048 + k * 1024); } while (0)
#define PG8_LDB(dst, b, h) do { _Pragma("unroll") for (int n = 0; n < 2; ++n) _Pragma("unroll") for (int k = 0; k < 2; ++k) dst[n][k] = *(const PG8_LAS bf16x8*)(lds + PG8_SB(b, h) + boff + n * 2048 + k * 1024); } while (0)
#define PG8_MMA(ai, bj, At, Bt) do { __builtin_amdgcn_s_setprio(1); _Pragma("unroll") for (int m = 0; m < 4; ++m) _Pragma("unroll") for (int n = 0; n < 2; ++n) _Pragma("unroll") for (int k = 0; k < 2; ++k) \
        acc[ai][bj][m][n] = __builtin_amdgcn_mfma_f32_16x16x32_bf16(Bt[n][k], At[m][k], acc[ai][bj][m][n], 0, 0, 0); __builtin_amdgcn_s_setprio(0); } while (0)
#define PG8_WAIT_V(n) asm volatile("s_waitcnt vmcnt(" #n ")" ::: "memory")
#define PG8_WAIT_L(n) asm volatile("s_waitcnt lgkmcnt(" #n ")" ::: "memory")
#define PG8_BAR __builtin_amdgcn_s_barrier()
#define PG8_SCHED __builtin_amdgcn_sched_barrier(0)
    Unit cur, nxt; int ui = 0;
    if (!S.next(0, cur)) return;
    f32x4 acc[2][2][4][2];
#pragma unroll
    for (int a = 0; a < 2; ++a)
#pragma unroll
        for (int b = 0; b < 2; ++b)
#pragma unroll
            for (int m = 0; m < 4; ++m)
#pragma unroll
                for (int n = 0; n < 2; ++n) acc[a][b][m][n] = (f32x4){0.f, 0.f, 0.f, 0.f};
    bf16x8 At[4][2], B0[2][2], B1[2][2];
    const char* cA = (const char*)g.A + (size_t)cur.pm * tstep; const char* cB = (const char*)g.Bt + (size_t)cur.pn * tstep;
    S.a_ready(cur);
    if constexpr (SP2) {
        PG8_STAGE(PG8_SB(0, 0), cB, voffB); PG8_STAGE(PG8_SB(0, 1), cB + hstep, voffB); PG8_STAGE(PG8_SA(0, 0), cA, voffA); PG8_STAGE(PG8_SA(0, 1), cA + hstep, voffA);
        if (wr == 1) PG8_BAR;
        PG8_WAIT_V(2); PG8_BAR;
        PG8_STAGE(PG8_SB(1, 0), cB + kstep, voffB); PG8_STAGE(PG8_SA(1, 0), cA + kstep, voffA); PG8_STAGE(PG8_SB(1, 1), cB + hstep + kstep, voffB);
        PG8_WAIT_V(6); PG8_BAR;
    } else {
        PG8_STAGE(PG8_SB(0, 0), cB, voffB); PG8_STAGE(PG8_SA(0, 0), cA, voffA); PG8_STAGE(PG8_SB(0, 1), cB + hstep, voffB); PG8_STAGE(PG8_SA(0, 1), cA + hstep, voffA);
        if (wr == 1) PG8_BAR;
        PG8_WAIT_V(4); PG8_BAR;
        PG8_STAGE(PG8_SB(1, 0), cB + kstep, voffB); PG8_STAGE(PG8_SA(1, 0), cA + kstep, voffA); PG8_STAGE(PG8_SB(1, 1), cB + hstep + kstep, voffB);
        PG8_WAIT_V(6); PG8_BAR;
    }
    for (;;) {
        const bool has_next = S.next(ui + 1, nxt);
        const char* nA = has_next ? (const char*)g.A + (size_t)nxt.pm * tstep : cA; const char* nB = has_next ? (const char*)g.Bt + (size_t)nxt.pn * tstep : cB;
        for (int t = 0; t < nt; t += 2) {
            const bool last = (t == nt - 2);
            const char* a1 = cA + (size_t)(t + 1) * kstep;
            const char* a2 = last ? nA : cA + (size_t)(t + 2) * kstep; const char* b2 = last ? nB : cB + (size_t)(t + 2) * kstep;
            const char* a3 = a2 + kstep; const char* b3 = b2 + kstep;
            if (last && has_next) S.a_ready(nxt);
            if constexpr (SP2) {
            PG8_LDB(B0, 0, 0); PG8_LDB(B1, 0, 1); PG8_SCHED; PG8_LDA(At, 0, 0); PG8_STAGE(PG8_SA(1, 1), a1 + hstep, voffA);
            PG8_WAIT_V(8); PG8_WAIT_L(0); PG8_BAR; PG8_MMA(0, 0, At, B0); PG8_MMA(0, 1, At, B1); PG8_BAR; PG8_SCHED;
            PG8_LDA(At, 0, 1); PG8_STAGE(PG8_SB(0, 0), b2, voffB); PG8_STAGE(PG8_SB(0, 1), b2 + hstep, voffB); PG8_STAGE(PG8_SA(0, 0), a2, voffA);
            PG8_WAIT_V(8); PG8_WAIT_L(0); PG8_BAR; PG8_MMA(1, 0, At, B0); PG8_MMA(1, 1, At, B1); PG8_BAR; PG8_SCHED;
            PG8_LDB(B0, 1, 0); PG8_LDB(B1, 1, 1); PG8_SCHED; PG8_LDA(At, 1, 0); PG8_STAGE(PG8_SA(0, 1), a2 + hstep, voffA);
            PG8_WAIT_V(8); PG8_WAIT_L(0); PG8_BAR; PG8_MMA(0, 0, At, B0); PG8_MMA(0, 1, At, B1); PG8_BAR; PG8_SCHED;
            PG8_LDA(At, 1, 1); PG8_STAGE(PG8_SB(1, 0), b3, voffB); PG8_STAGE(PG8_SB(1, 1), b3 + hstep, voffB); PG8_STAGE(PG8_SA(1, 0), a3, voffA);
            PG8_WAIT_V(8); PG8_WAIT_L(0); PG8_BAR; PG8_MMA(1, 0, At, B0); PG8_MMA(1, 1, At, B1); PG8_BAR; PG8_SCHED;
            } else {
            PG8_LDB(B0, 0, 0); PG8_SCHED; PG8_LDA(At, 0, 0); PG8_STAGE(PG8_SA(1, 1), a1 + hstep, voffA);
            PG8_WAIT_L(8); PG8_BAR; PG8_WAIT_L(0); PG8_MMA(0, 0, At, B0); PG8_BAR; PG8_SCHED;
            PG8_LDB(B1, 0, 1); PG8_STAGE(PG8_SB(0, 0), b2, voffB);
            PG8_BAR; PG8_WAIT_L(0); PG8_MMA(0, 1, At, B1); PG8_BAR;
            PG8_LDA(At, 0, 1); PG8_STAGE(PG8_SA(0, 0), a2, voffA);
            PG8_BAR; PG8_WAIT_L(0); PG8_MMA(1, 0, At, B0); PG8_BAR; PG8_SCHED;
            PG8_STAGE(PG8_SB(0, 1), b2 + hstep, voffB);
            PG8_WAIT_V(6); PG8_BAR; PG8_MMA(1, 1, At, B1); PG8_BAR;
            PG8_LDB(B0, 1, 0); PG8_SCHED; PG8_LDA(At, 1, 0); PG8_STAGE(PG8_SA(0, 1), a2 + hstep, voffA);
            PG8_WAIT_L(8); PG8_BAR; PG8_WAIT_L(0); PG8_MMA(0, 0, At, B0); PG8_BAR; PG8_SCHED;
            PG8_LDB(B1, 1, 1); PG8_STAGE(PG8_SB(1, 0), b3, voffB);
            PG8_BAR; PG8_WAIT_L(0); PG8_MMA(0, 1, At, B1); PG8_BAR;
            PG8_LDA(At, 1, 1); PG8_STAGE(PG8_SA(1, 0), a3, voffA);
            PG8_BAR; PG8_WAIT_L(0); PG8_MMA(1, 0, At, B0); PG8_BAR; PG8_SCHED;
            PG8_STAGE(PG8_SB(1, 1), b3 + hstep, voffB);
            PG8_WAIT_V(6); PG8_BAR; PG8_MMA(1, 1, At, B1); PG8_BAR;
            }
        }
        if constexpr (ALIGN_EPI) { if (wr == 0) PG8_BAR; }
        E(acc, cur, wr, wc, fr, fq); S.done(cur);
        if (!has_next) break;
#pragma unroll
        for (int a = 0; a < 2; ++a)
#pragma unroll
            for (int b = 0; b < 2; ++b)
#pragma unroll
                for (int m = 0; m < 4; ++m)
#pragma unroll
                    for (int n = 0; n < 2; ++n) acc[a][b][m][n] = (f32x4){0.f, 0.f, 0.f, 0.f};
        cur = nxt; cA = nA; cB = nB; ++ui;
        if constexpr (ALIGN_EPI) { if (wr == 1) PG8_BAR; }
    }
    PG8_WAIT_V(0);
    if constexpr (!ALIGN_EPI) { if (wr == 0) PG8_BAR; }
    PG8_BAR;
#undef PG8_SA
#undef PG8_SB
#undef PG8_STAGE
#undef PG8_LDA
#undef PG8_LDB
#undef PG8_MMA
#undef PG8_WAIT_V
#undef PG8_WAIT_L
#undef PG8_BAR
#undef PG8_SCHED
}
}

using pg8::bf16_t; using pg8::f32x4; using pg8::u32x4; using pg8::u32x2; using pg8::Unit; using pg8::cvt_pk_bf16;
#define LAS __attribute__((address_space(3)))

constexpr int DM = 1024, TP = 4096, NTP = 16384, NTS = 256, NTOK = 16640, DEPTH = 4, NIN = 4864, DFF = 4096;
constexpr int NTHREADS = 512, LDS_BYTES = 147456;
constexpr size_t O_YP = 0, O_YS = 16777216, O_KVP0 = 17039360, O_KVP1 = 18087936, O_KVP2 = 22282240, O_POOLP = 39059456,
                 O_KVS0 = 39182336, O_KVS1 = 47570944, O_KVS2 = 81125376, O_POOLS = 215343104;
constexpr size_t WS_WIN = 0;
constexpr size_t WS_WPA = WS_WIN + (size_t)DEPTH * NIN * DM * 2;
constexpr size_t WS_WPB = WS_WPA + (size_t)DEPTH * DM * 256 * 2;
constexpr size_t WS_WO  = WS_WPB + (size_t)DEPTH * DM * 512 * 2;
constexpr size_t WS_WUP = WS_WO  + (size_t)DEPTH * DM * DM * 2;
constexpr size_t WS_WDN = WS_WUP + (size_t)DEPTH * DFF * DM * 2;
constexpr size_t WS_X   = WS_WDN + (size_t)DEPTH * DM * DFF * 2;
constexpr size_t WS_XB  = WS_X   + (size_t)NTOK * DM * 4;
constexpr size_t WS_QKV = WS_XB  + (size_t)NTOK * DM * 2;
constexpr size_t WS_U   = WS_QKV + (size_t)NTOK * 2304 * 2;
constexpr size_t WS_G   = WS_U   + (size_t)NTOK * 512 * 2;
constexpr size_t WS_OA  = WS_G   + (size_t)NTOK * 2048 * 2;
constexpr size_t WS_P   = WS_OA  + (size_t)NTOK * 256 * 2;
constexpr size_t WS_TMP = WS_P   + (size_t)NTOK * 512 * 2;
constexpr size_t WS_MIX = WS_TMP + (size_t)NTOK * DM * 4;
constexpr size_t WS_H   = WS_MIX + (size_t)NTOK * DM * 2;
constexpr size_t WS_SS  = WS_H   + (size_t)NTOK * DFF * 2;
constexpr size_t WS_ROPE = WS_SS + (size_t)9 * NTOK * 4;
constexpr size_t WS_BAR = WS_ROPE + (size_t)4104 * 16 * 4;
constexpr size_t WS_END = WS_BAR + (size_t)4096 * 4;

struct Params { const float* in[17]; float* out; unsigned char* ws; };

__device__ __forceinline__ void unpack8(const u32x4 w, float (&f)[8]) {
    f[0] = __uint_as_float(w.x << 16); f[1] = __uint_as_float(w.x & 0xffff0000u);
    f[2] = __uint_as_float(w.y << 16); f[3] = __uint_as_float(w.y & 0xffff0000u);
    f[4] = __uint_as_float(w.z << 16); f[5] = __uint_as_float(w.z & 0xffff0000u);
    f[6] = __uint_as_float(w.w << 16); f[7] = __uint_as_float(w.w & 0xffff0000u);
}
__device__ __forceinline__ u32x4 pack8(const float (&f)[8]) {
    u32x4 w; w.x = cvt_pk_bf16(f[0], f[1]); w.y = cvt_pk_bf16(f[2], f[3]); w.z = cvt_pk_bf16(f[4], f[5]); w.w = cvt_pk_bf16(f[6], f[7]); return w;
}
__device__ __forceinline__ float sigmoidf_(float x) { return 1.0f / (1.0f + __expf(-x)); }

struct EpiAll {
    static constexpr bool PERM = true, AFTER_DRAIN = false;
    int mode, layer, ssi, ssn; unsigned char* ws; float* out;

    struct Pre { u32x4 g; f32x4 a, b; float rs; };

    template <int MODE> __device__ __forceinline__ Pre pre(unsigned char* ws, int row, int c) const {
        Pre p;
        if constexpr (MODE == 0 || MODE == 4) p.rs = ((const float*)(ws + WS_SS) + (size_t)ssi * NTOK)[row];
        if constexpr (MODE == 1) p.g = *(const u32x4*)((const bf16_t*)(ws + WS_G) + (size_t)row * 2048 + c);
        if constexpr (MODE == 2) { p.g = *(const u32x4*)((const bf16_t*)(ws + WS_G) + (size_t)row * 2048 + 1024 + c);
            const float* tp = (const float*)(ws + WS_TMP) + (size_t)row * DM + c; p.a = *(const f32x4*)tp; p.b = *(const f32x4*)(tp + 4); }
        if constexpr (MODE == 3) { const float* xp = (const float*)(ws + WS_X) + (size_t)row * DM + c; p.a = *(const f32x4*)xp; p.b = *(const f32x4*)(xp + 4); }
        return p;
    }
    __device__ __forceinline__ void fin_proj(unsigned char* ws, int row, int c32, int fq, float (&v)[8], const Pre& p) const {
        const int pn = c32 >> 8, cl = (c32 & 255) + 8 * fq;
        const float rs = rsqrtf(p.rs * (1.0f / 1024.0f) + 1e-6f);
        const bool samp = row >= NTP;
        const int b = samp ? ((row - NTP) >> 3) : (row >> 12);
        const int t = samp ? (row & 7) : (row & 4095);
#pragma unroll
        for (int i = 0; i < 8; ++i) v[i] *= rs;
        if (pn < 6 && ((c32 >> 5) & 1) == 0) {
            float pv[8];
#pragma unroll
            for (int i = 0; i < 8; ++i) pv[i] = __shfl_xor(v[i], 16);
            if (fq < 2) {
                const int pi = samp ? (4096 + t) : t;
                const f32x4* rp = (const f32x4*)((const float*)(ws + WS_ROPE) + (size_t)pi * 16);
                const f32x4 c0 = rp[0], c1 = rp[1], s0 = rp[2], s1 = rp[3];
                const float sg = (fq == 0) ? -1.0f : 1.0f;
#pragma unroll
                for (int i = 0; i < 4; ++i) { v[i] = v[i] * c0[i] + sg * pv[i] * s0[i]; v[4 + i] = v[4 + i] * c1[i] + sg * pv[4 + i] * s1[i]; }
            }
        }
        if (pn >= 11) {
#pragma unroll
            for (int i = 0; i < 8; ++i) v[i] = sigmoidf_(v[i]);
        }
        bf16_t* dst; int ld, cbase;
        if (pn < 9) { dst = (bf16_t*)(ws + WS_QKV); ld = 2304; cbase = pn * 256; }
        else if (pn < 11) { dst = (bf16_t*)(ws + WS_U); ld = 512; cbase = (pn - 9) * 256; }
        else { dst = (bf16_t*)(ws + WS_G); ld = 2048; cbase = (pn - 11) * 256; }
        *(u32x4*)(dst + (size_t)row * ld + cbase + cl) = pack8(v);
        if (pn >= 3 && pn < 9) {
            const int kvi = pn - 3; const int g = (kvi >= 3) ? kvi - 3 : kvi; const int kv = (kvi >= 3) ? 1 : 0;
            const int W = 128 << (2 * g);
            const size_t okp = (g == 0) ? O_KVP0 : (g == 1 ? O_KVP1 : O_KVP2);
            const size_t oks = (g == 0) ? O_KVS0 : (g == 1 ? O_KVS1 : O_KVS2);
            float* op = nullptr;
            if (samp) op = out + oks + ((size_t)((layer * 32 + b) * W + (W - 8 + t)) * 2 + kv) * 256 + cl;
            else if (t >= TP - W) op = out + okp + ((size_t)((layer * 4 + b) * W + (t - (TP - W))) * 2 + kv) * 256 + cl;
            if (op) { *(f32x4*)op = (f32x4){v[0], v[1], v[2], v[3]}; *(f32x4*)(op + 4) = (f32x4){v[4], v[5], v[6], v[7]}; }
        } else if (pn >= 9 && pn < 11) {
            float* op = nullptr; const int c = cbase + cl;
            if (samp) op = out + O_POOLS + (size_t)((layer * 32 + b) * 15 + 7 + t) * 512 + c;
            else if (t >= TP - 15) op = out + O_POOLP + (size_t)((layer * 4 + b) * 15 + (t - (TP - 15))) * 512 + c;
            if (op) { *(f32x4*)op = (f32x4){v[0], v[1], v[2], v[3]}; *(f32x4*)(op + 4) = (f32x4){v[4], v[5], v[6], v[7]}; }
        }
    }
    template <int MODE> __device__ __forceinline__ void fin(unsigned char* ws, int row, int c32, int fq, float (&v)[8], const Pre& p) const {
        const int c = c32 + 8 * fq;
        if constexpr (MODE == 0) fin_proj(ws, row, c32, fq, v, p);
        if constexpr (MODE == 1) {
            float gg[8]; unpack8(p.g, gg);
            float* tp = (float*)(ws + WS_TMP) + (size_t)row * DM + c;
            *(f32x4*)tp = (f32x4){gg[0] * v[0], gg[1] * v[1], gg[2] * v[2], gg[3] * v[3]};
            *(f32x4*)(tp + 4) = (f32x4){gg[4] * v[4], gg[5] * v[5], gg[6] * v[6], gg[7] * v[7]};
        }
        if constexpr (MODE == 2) {
            float gg[8]; unpack8(p.g, gg);
#pragma unroll
            for (int i = 0; i < 4; ++i) { v[i] = p.a[i] + gg[i] * v[i]; v[4 + i] = p.b[i] + gg[4 + i] * v[4 + i]; }
            *(u32x4*)((bf16_t*)(ws + WS_MIX) + (size_t)row * DM + c) = pack8(v);
        }
        if constexpr (MODE == 3) {
            float* xp = (float*)(ws + WS_X) + (size_t)row * DM + c;
            float sq = 0.f;
#pragma unroll
            for (int i = 0; i < 4; ++i) { v[i] += p.a[i]; v[4 + i] += p.b[i]; }
#pragma unroll
            for (int i = 0; i < 8; ++i) sq += v[i] * v[i];
            *(f32x4*)xp = (f32x4){v[0], v[1], v[2], v[3]}; *(f32x4*)(xp + 4) = (f32x4){v[4], v[5], v[6], v[7]};
            *(u32x4*)((bf16_t*)(ws + WS_XB) + (size_t)row * DM + c) = pack8(v);
            sq += __shfl_xor(sq, 16); sq += __shfl_xor(sq, 32);
            if (fq == 0) atomicAdd((float*)(ws + WS_SS) + (size_t)ssn * NTOK + row, sq);
        }
        if constexpr (MODE == 4) {
            const float rs = rsqrtf(p.rs * (1.0f / 1024.0f) + 1e-6f);
#pragma unroll
            for (int i = 0; i < 8; ++i) { const float a = fmaxf(v[i] * rs, 0.f); v[i] = a * a; }
            *(u32x4*)((bf16_t*)(ws + WS_H) + (size_t)row * DFF + c) = pack8(v);
        }
    }
    __device__ __forceinline__ void chunk(unsigned char* ws, int row, int c32, int fq, float (&v)[8]) const {
        const int c = c32 + 8 * fq;
        switch (mode) {
            case 0: { const Pre p = pre<0>(ws, row, c); fin<0>(ws, row, c32, fq, v, p); } break;
            case 1: { const Pre p = pre<1>(ws, row, c); fin<1>(ws, row, c32, fq, v, p); } break;
            case 2: { const Pre p = pre<2>(ws, row, c); fin<2>(ws, row, c32, fq, v, p); } break;
            case 3: { const Pre p = pre<3>(ws, row, c); fin<3>(ws, row, c32, fq, v, p); } break;
            default: { const Pre p = pre<4>(ws, row, c); fin<4>(ws, row, c32, fq, v, p); } break;
        }
    }
    template <int MODE> __device__ __forceinline__ void tile(unsigned char* ws, const f32x4 (&acc)[2][2][4][2], const Unit& u, int wr, int wc, int fr, int fq) const {
        constexpr int MB = (MODE == 2 || MODE == 3) ? 2 : 4;
#pragma unroll
        for (int ai = 0; ai < 2; ++ai)
#pragma unroll
            for (int m0 = 0; m0 < 4; m0 += MB) {
                Pre p[MB][2];
#pragma unroll
                for (int mm = 0; mm < MB; ++mm)
#pragma unroll
                    for (int bj = 0; bj < 2; ++bj) p[mm][bj] = pre<MODE>(ws, u.pm * 256 + ai * 128 + wr * 64 + (m0 + mm) * 16 + fr, u.pn * 256 + bj * 128 + wc * 32 + 8 * fq);
#pragma unroll
                for (int mm = 0; mm < MB; ++mm)
#pragma unroll
                    for (int bj = 0; bj < 2; ++bj) {
                        float v[8];
#pragma unroll
                        for (int i = 0; i < 4; ++i) { v[i] = acc[ai][bj][m0 + mm][0][i]; v[4 + i] = acc[ai][bj][m0 + mm][1][i]; }
                        fin<MODE>(ws, u.pm * 256 + ai * 128 + wr * 64 + (m0 + mm) * 16 + fr, u.pn * 256 + bj * 128 + wc * 32, fq, v, p[mm][bj]);
                    }
                asm volatile("" ::: "memory");
            }
    }
    __device__ __forceinline__ void operator()(const f32x4 (&acc)[2][2][4][2], const Unit& u, int wr, int wc, int fr, int fq) const {
        asm volatile("" : "+v"(fr), "+v"(fq));
        unsigned char* ws = this->ws; asm volatile("" : "+s"(ws));
        switch (mode) {
            case 0: tile<0>(ws, acc, u, wr, wc, fr, fq); break;
            case 1: tile<1>(ws, acc, u, wr, wc, fr, fq); break;
            case 2: tile<2>(ws, acc, u, wr, wc, fr, fq); break;
            case 3: tile<3>(ws, acc, u, wr, wc, fr, fq); break;
            default: tile<4>(ws, acc, u, wr, wc, fr, fq); break;
        }
    }
};

__device__ __forceinline__ void skinny_gemm(LAS unsigned char* lds, const bf16_t* __restrict__ A, const bf16_t* __restrict__ Bt, int N, int K, const EpiAll& E, int first, int G) {
    using pg8::bf16x8;
    int tid = threadIdx.x; asm volatile("" : "+v"(tid));
    const int lane = tid & 63, w = __builtin_amdgcn_readfirstlane(tid >> 6), kg = lane >> 4, qn = lane & 15;
    const int half = w & 1, kq = w >> 1, Kq = K >> 2, nsteps = Kq >> 5;
    unsigned char* ws = E.ws; asm volatile("" : "+s"(ws));
    LAS float* red = (LAS float*)lds;
    const int units = 4 * (N >> 5);
#pragma unroll 1
    for (int u = first; u < units; u += G) {
        const int rb = u & 3, c32 = (u >> 2) << 5;
        const int row0 = rb * 64 + half * 32;
        const bf16_t* ap = A + (size_t)(row0 + qn) * K + kq * Kq + kg * 8;
        const bf16_t* bp = Bt + (size_t)(c32 + 8 * (qn >> 2) + (qn & 3)) * K + kq * Kq + kg * 8;
        f32x4 acc[2][2];
#pragma unroll
        for (int a = 0; a < 2; ++a)
#pragma unroll
            for (int b = 0; b < 2; ++b) acc[a][b] = (f32x4){0.f, 0.f, 0.f, 0.f};
#pragma unroll 8
        for (int ks = 0; ks < nsteps; ++ks) {
            const bf16x8 x0 = *(const bf16x8*)(ap + ks * 32), x1 = *(const bf16x8*)(ap + (size_t)16 * K + ks * 32);
            const bf16x8 w0 = *(const bf16x8*)(bp + ks * 32), w1 = *(const bf16x8*)(bp + (size_t)4 * K + ks * 32);
            acc[0][0] = __builtin_amdgcn_mfma_f32_16x16x32_bf16(w0, x0, acc[0][0], 0, 0, 0);
            acc[0][1] = __builtin_amdgcn_mfma_f32_16x16x32_bf16(w1, x0, acc[0][1], 0, 0, 0);
            acc[1][0] = __builtin_amdgcn_mfma_f32_16x16x32_bf16(w0, x1, acc[1][0], 0, 0, 0);
            acc[1][1] = __builtin_amdgcn_mfma_f32_16x16x32_bf16(w1, x1, acc[1][1], 0, 0, 0);
        }
        __syncthreads();
        if (kq != 0) {
#pragma unroll
            for (int a = 0; a < 2; ++a)
#pragma unroll
                for (int b = 0; b < 2; ++b)
#pragma unroll
                    for (int i = 0; i < 4; ++i) red[(w * 16 + a * 8 + b * 4 + i) * 64 + lane] = acc[a][b][i];
        }
        __syncthreads();
        if (kq == 0) {
#pragma unroll
            for (int q = 1; q < 4; ++q)
#pragma unroll
                for (int a = 0; a < 2; ++a)
#pragma unroll
                    for (int b = 0; b < 2; ++b)
#pragma unroll
                        for (int i = 0; i < 4; ++i) acc[a][b][i] += red[((w + 2 * q) * 16 + a * 8 + b * 4 + i) * 64 + lane];
#pragma unroll
            for (int a = 0; a < 2; ++a) {
                float v[8];
#pragma unroll
                for (int i = 0; i < 4; ++i) { v[i] = acc[a][0][i]; v[4 + i] = acc[a][1][i]; }
                E.chunk(ws, NTP + row0 + a * 16 + qn, c32, kg, v);
            }
        }
    }
    __syncthreads();
}

__device__ __forceinline__ void lds_wait() { asm volatile("s_waitcnt lgkmcnt(0)" ::: "memory"); }
__device__ __forceinline__ void transpose_item(const float* __restrict__ W, const float* __restrict__ gsc, int K, int N, bf16_t* __restrict__ WT, LAS float* scr, int item, int lane) {
    const int nblk = N / 64, kb = item / nblk, nb = item % nblk, k0 = 64 * kb, n0 = 64 * nb;
    f32x4 v[16];
#pragma unroll
    for (int i = 0; i < 16; ++i) v[i] = *(const f32x4*)(W + (size_t)(k0 + 4 * i + (lane >> 4)) * N + n0 + 4 * (lane & 15));
#pragma unroll
    for (int i = 0; i < 16; ++i) { const int kk = 4 * i + (lane >> 4); const float sc = gsc ? gsc[k0 + kk] : 1.0f; LAS float* d = scr + kk * 65 + 4 * (lane & 15);
        d[0] = v[i][0] * sc; d[1] = v[i][1] * sc; d[2] = v[i][2] * sc; d[3] = v[i][3] * sc; }
    lds_wait();
    const int c = lane & 7;
#pragma unroll
    for (int j = 0; j < 8; ++j) { const int n = (lane >> 3) + 8 * j; const LAS float* sp = scr + (8 * c) * 65 + n;
        u32x4 o; o.x = cvt_pk_bf16(sp[0 * 65], sp[1 * 65]); o.y = cvt_pk_bf16(sp[2 * 65], sp[3 * 65]); o.z = cvt_pk_bf16(sp[4 * 65], sp[5 * 65]); o.w = cvt_pk_bf16(sp[6 * 65], sp[7 * 65]);
        *(u32x4*)(WT + (size_t)(n0 + n) * K + k0 + 8 * c) = o; }
    lds_wait();
}

template <int L>
__device__ __forceinline__ void copy_shift(const float* __restrict__ src, float* __restrict__ dst, int layer, size_t gtid, size_t nth) {
    constexpr size_t per = (size_t)(L - 8) * 128;
    constexpr size_t total = (size_t)32 * per;
    constexpr int U = 8;
    const f32x4* s4 = (const f32x4*)src + (size_t)layer * 32 * L * 128; f32x4* d4 = (f32x4*)dst + (size_t)layer * 32 * L * 128;
    for (size_t i = gtid; i < total; i += nth * U) {
        f32x4 v[U];
#pragma unroll
        for (int u = 0; u < U; ++u) { const size_t idx = i + u * nth; const size_t ii = idx < total ? idx : 0; const size_t lb = ii / per, r = ii - lb * per;
            v[u] = __builtin_nontemporal_load(s4 + lb * (size_t)L * 128 + r + 8 * 128); }
#pragma unroll
        for (int u = 0; u < U; ++u) { const size_t idx = i + u * nth; if (idx < total) { const size_t lb = idx / per, r = idx - lb * per; __builtin_nontemporal_store(v[u], d4 + lb * (size_t)L * 128 + r); } }
    }
}

#define ATT_DOT(S, Q, KF) do { float _s = 0.f; _Pragma("unroll") for (int _i = 0; _i < 8; ++_i) _s += Q[_i] * KF[_i]; \
    _s += __shfl_xor(_s, 1); _s += __shfl_xor(_s, 2); _s += __shfl_xor(_s, 4); S = _s; } while (0)

__device__ __forceinline__ void attn_finish(float m, float l, float (&o)[8], bf16_t* dstp, int kg) {
    float M = m; M = fmaxf(M, __shfl_xor(M, 8)); M = fmaxf(M, __shfl_xor(M, 16)); M = fmaxf(M, __shfl_xor(M, 32));
    const float f = __expf(m - M); l *= f;
#pragma unroll
    for (int i = 0; i < 8; ++i) o[i] *= f;
    l += __shfl_xor(l, 8); l += __shfl_xor(l, 16); l += __shfl_xor(l, 32);
#pragma unroll
    for (int i = 0; i < 8; ++i) { o[i] += __shfl_xor(o[i], 8); o[i] += __shfl_xor(o[i], 16); o[i] += __shfl_xor(o[i], 32); }
    const float inv = 1.0f / l;
#pragma unroll
    for (int i = 0; i < 8; ++i) o[i] *= inv;
    if (kg == 0) *(u32x4*)dstp = pack8(o);
}

__device__ __forceinline__ void attn_prompt_item(const bf16_t* __restrict__ qkv, bf16_t* __restrict__ oa, int token, int h, int lane) {
    const int kg = lane >> 3, dl = lane & 7;
    const int b = token >> 12, t = token & 4095;
    const bf16_t* qrow = qkv + (size_t)token * 2304 + h * 64 + dl * 8;
    const bf16_t* kbase = qkv + (size_t)(b << 12) * 2304 + 768 + h * 64 + dl * 8;
    float m = -1e30f, l = 0.f; float o[8];
#pragma unroll
    for (int i = 0; i < 8; ++i) o[i] = 0.f;
#pragma unroll 1
    for (int g = 0; g < 3; ++g) {
        const int d = 1 << (2 * g);
        float q[8]; unpack8(*(const u32x4*)(qrow + g * 256), q);
#pragma unroll
        for (int i = 0; i < 8; ++i) q[i] *= 0.125f;
        const bf16_t* kb = kbase + g * 256;
#pragma unroll 1
        for (int it = 0; it < 16; it += 4) {
            u32x4 kr[4], vr[4]; bool val[4];
#pragma unroll
            for (int u = 0; u < 4; ++u) { const int j = (it + u) * 8 + kg; const int pos = t - j * d; val[u] = pos >= 0; const bf16_t* r = kb + (size_t)(pos < 0 ? 0 : pos) * 2304;
                kr[u] = *(const u32x4*)r; vr[u] = *(const u32x4*)(r + 768); }
            float s[4];
#pragma unroll
            for (int u = 0; u < 4; ++u) { float kf[8]; unpack8(kr[u], kf); ATT_DOT(s[u], q, kf); if (!val[u]) s[u] = -1e30f; }
            const float mb = fmaxf(fmaxf(m, fmaxf(s[0], s[1])), fmaxf(s[2], s[3]));
            const float corr = __expf(m - mb);
            l *= corr;
#pragma unroll
            for (int i = 0; i < 8; ++i) o[i] *= corr;
#pragma unroll
            for (int u = 0; u < 4; ++u) { const float p = val[u] ? __expf(s[u] - mb) : 0.f; l += p; float vf[8]; unpack8(vr[u], vf);
#pragma unroll
                for (int i = 0; i < 8; ++i) o[i] += p * vf[i]; }
            m = mb;
        }
    }
    {
        const int g = kg < 2 ? kg : 2; const int d = 1 << (2 * g);
        const int pos = t - 128 * d; const bool val = (kg < 3) && (pos >= 0);
        float q[8]; unpack8(*(const u32x4*)(qrow + g * 256), q);
        const bf16_t* r = kbase + g * 256 + (size_t)(pos < 0 ? 0 : pos) * 2304;
        float kf[8], vf[8]; unpack8(*(const u32x4*)r, kf); unpack8(*(const u32x4*)(r + 768), vf);
        float s; ATT_DOT(s, q, kf); s *= 0.125f;
        if (!val) s = -1e30f;
        const float mb = fmaxf(m, s); const float corr = __expf(m - mb); const float p = val ? __expf(s - mb) : 0.f;
        l = l * corr + p;
#pragma unroll
        for (int i = 0; i < 8; ++i) o[i] = o[i] * corr + p * vf[i];
        m = mb;
    }
    attn_finish(m, l, o, oa + (size_t)token * 256 + h * 64 + dl * 8, kg);
}

__device__ __forceinline__ void sample_kv(const bf16_t* __restrict__ newb, const float* __restrict__ cb, int W, int idx, float (&kf)[8], float (&vf)[8]) {
    if (idx >= W) { const bf16_t* r = newb + (size_t)(idx - W) * 2304; unpack8(*(const u32x4*)r, kf); unpack8(*(const u32x4*)(r + 768), vf); }
    else { const float* r = cb + (size_t)idx * 512; const f32x4 a = *(const f32x4*)r, b2 = *(const f32x4*)(r + 4), c = *(const f32x4*)(r + 256), d2 = *(const f32x4*)(r + 260);
#pragma unroll
        for (int i = 0; i < 4; ++i) { kf[i] = a[i]; kf[4 + i] = b2[i]; vf[i] = c[i]; vf[4 + i] = d2[i]; } }
}
__device__ __forceinline__ void attn_sample_sub(const bf16_t* __restrict__ qkv, const float* __restrict__ cg_, bf16_t* __restrict__ PO, float* __restrict__ LSE,
                                                int layer, int stok, int h, int g, int lane) {
    const int kg = lane >> 3, dl = lane & 7;
    const int b = stok >> 3, t = stok & 7;
    const int token = NTP + stok;
    const int d = 1 << (2 * g), W = 128 << (2 * g);
    const bf16_t* nb = qkv + (size_t)(NTP + b * 8) * 2304 + 768 + g * 256 + h * 64 + dl * 8;
    const float* cb = cg_ + (size_t)(layer * 32 + b) * W * 512 + h * 64 + dl * 8;
    float q[8]; unpack8(*(const u32x4*)(qkv + (size_t)token * 2304 + g * 256 + h * 64 + dl * 8), q);
#pragma unroll
    for (int i = 0; i < 8; ++i) q[i] *= 0.125f;
    float m = -1e30f, l = 0.f; float o[8];
#pragma unroll
    for (int i = 0; i < 8; ++i) o[i] = 0.f;
#pragma unroll 1
    for (int it = 0; it < 16; it += 8) {
        float kf[8][8], vf[8][8], s[8];
#pragma unroll
        for (int u = 0; u < 8; ++u) { const int j = (it + u) * 8 + kg; sample_kv(nb, cb, W, W + t - j * d, kf[u], vf[u]); }
        float mb = m;
#pragma unroll
        for (int u = 0; u < 8; ++u) { ATT_DOT(s[u], q, kf[u]); mb = fmaxf(mb, s[u]); }
        const float corr = __expf(m - mb);
        l *= corr;
#pragma unroll
        for (int i = 0; i < 8; ++i) o[i] *= corr;
#pragma unroll
        for (int u = 0; u < 8; ++u) { const float p = __expf(s[u] - mb); l += p;
#pragma unroll
            for (int i = 0; i < 8; ++i) o[i] += p * vf[u][i]; }
        m = mb;
    }
    {
        const bool val = kg == 0;
        float kf[8], vf[8]; sample_kv(nb, cb, W, W + t - 128 * d, kf, vf);
        float s; ATT_DOT(s, q, kf);
        if (!val) s = -1e30f;
        const float mb = fmaxf(m, s); const float corr = __expf(m - mb); const float p = val ? __expf(s - mb) : 0.f;
        l = l * corr + p;
#pragma unroll
        for (int i = 0; i < 8; ++i) o[i] = o[i] * corr + p * vf[i];
        m = mb;
    }
    float M = m; M = fmaxf(M, __shfl_xor(M, 8)); M = fmaxf(M, __shfl_xor(M, 16)); M = fmaxf(M, __shfl_xor(M, 32));
    const float f = __expf(m - M); l *= f;
#pragma unroll
    for (int i = 0; i < 8; ++i) o[i] *= f;
    l += __shfl_xor(l, 8); l += __shfl_xor(l, 16); l += __shfl_xor(l, 32);
#pragma unroll
    for (int i = 0; i < 8; ++i) { o[i] += __shfl_xor(o[i], 8); o[i] += __shfl_xor(o[i], 16); o[i] += __shfl_xor(o[i], 32); }
    const float inv = 1.0f / l;
#pragma unroll
    for (int i = 0; i < 8; ++i) o[i] *= inv;
    if (kg == 0) *(u32x4*)(PO + ((size_t)g * NTOK + token) * 256 + h * 64 + dl * 8) = pack8(o);
    if (lane == 0) LSE[((size_t)g * NTOK + token) * 4 + h] = M + __logf(l);
}

constexpr int ATT_PITCH = 144, ATT_ROWS = 272, ATT_VOFF = ATT_ROWS * ATT_PITCH;
typedef short s16x4 __attribute__((ext_vector_type(4)));
template <int OFF> __device__ __forceinline__ s16x4 tr_read(unsigned addr) { s16x4 r; asm volatile("ds_read_b64_tr_b16 %0, %1 offset:%2" : "=v"(r) : "v"(addr), "n"(OFF) : "memory"); return r; }
__device__ __forceinline__ void tr_wait8(s16x4& a, s16x4& b, s16x4& c, s16x4& d, s16x4& e, s16x4& f, s16x4& g, s16x4& h) {
    asm volatile("s_waitcnt lgkmcnt(0)" : "+v"(a), "+v"(b), "+v"(c), "+v"(d), "+v"(e), "+v"(f), "+v"(g), "+v"(h) :: "memory"); }

__device__ __forceinline__ void attn_mfma_phase(LAS unsigned char* lds, const bf16_t* __restrict__ QKV, bf16_t* __restrict__ PO, float* __restrict__ LSE, int bid, int G, int tid) {
    using pg8::bf16x8;
    const int lane = tid & 63, w = __builtin_amdgcn_readfirstlane(tid >> 6), kg = lane >> 4, qn = lane & 15;
    for (int i = tid; i < 2 * 144; i += NTHREADS) { const int kv = i / 144, rem = i - kv * 144; *(LAS u32x4*)(lds + kv * ATT_VOFF + 256 * ATT_PITCH + rem * 16) = (u32x4){0u, 0u, 0u, 0u}; }
    const unsigned vaddr = (unsigned)(uintptr_t)(lds + ATT_VOFF + (16 * w + 4 * kg + (qn >> 2)) * ATT_PITCH + (lane & 3) * 8);
    const float csc = 0.125f * 1.44269504089f;
#define ATT_DECODE(U, b_, h_, g_, r_, I0_) do { const int _bh = (U) / 96, _rest = (U) - _bh * 96; b_ = _bh >> 2; h_ = _bh & 3; \
        if (_rest < 32) { g_ = 0; r_ = 0; I0_ = 128 * _rest; } else if (_rest < 64) { g_ = 1; r_ = (_rest - 32) >> 3; I0_ = 128 * ((_rest - 32) & 7); } else { g_ = 2; r_ = (_rest - 64) >> 1; I0_ = 128 * ((_rest - 64) & 1); } } while (0)
#define ATT_FETCH(U) do { int _b, _h, _g, _r, _I0; ATT_DECODE(U, _b, _h, _g, _r, _I0); const int _d = 1 << (2 * _g); \
        _Pragma("unroll") for (int i = 0; i < 8; ++i) { const int kv = i >> 2, row = (tid >> 3) + 64 * (i & 3), ch = tid & 7; const int I = _I0 - 128 + row; \
            pf[i] = (u32x4){0u, 0u, 0u, 0u}; \
            if (I >= 0) pf[i] = *(const u32x4*)(QKV + (size_t)(_b * 4096 + _r + _d * I) * 2304 + 768 + kv * 768 + _g * 256 + _h * 64 + ch * 8); } \
        const bf16_t* _qp = QKV + ((size_t)_b * 4096 + _r + _d * (_I0 + 16 * w + qn)) * 2304 + _g * 256 + _h * 64 + kg * 8; \
        qf0 = *(const bf16x8*)_qp; qf1 = *(const bf16x8*)(_qp + 32); } while (0)
    u32x4 pf[8]; bf16x8 qf0, qf1;
    if (bid < 1536) ATT_FETCH(bid);
#pragma unroll 1
    for (int u = bid; u < 1536; u += G) {
        int b, h, g, r, I0; ATT_DECODE(u, b, h, g, r, I0);
        const int d = 1 << (2 * g);
        __syncthreads();
#pragma unroll
        for (int i = 0; i < 8; ++i) { const int kv = i >> 2, row = (tid >> 3) + 64 * (i & 3), ch = tid & 7; *(LAS u32x4*)(lds + kv * ATT_VOFF + row * ATT_PITCH + ch * 16) = pf[i]; }
        const bf16x8 q0 = qf0, q1 = qf1;
        __syncthreads();
        if (u + G < 1536) ATT_FETCH(u + G);
        const int Iq = I0 + 16 * w + qn; const size_t tokq = (size_t)b * 4096 + r + d * Iq;
        f32x4 sc[9];
        const LAS unsigned char* kb = lds + (16 * w + qn) * ATT_PITCH + kg * 16;
#pragma unroll
        for (int kt = 0; kt < 9; ++kt) { const bf16x8 k0 = *(const LAS bf16x8*)(kb + kt * 16 * ATT_PITCH), k1 = *(const LAS bf16x8*)(kb + kt * 16 * ATT_PITCH + 64);
            f32x4 z = (f32x4){0.f, 0.f, 0.f, 0.f}; z = __builtin_amdgcn_mfma_f32_16x16x32_bf16(k0, q0, z, 0, 0, 0); sc[kt] = __builtin_amdgcn_mfma_f32_16x16x32_bf16(k1, q1, z, 0, 0, 0); }
        const int jb = 128 + qn - 4 * kg, ikb = I0 - 128 + 16 * w + 4 * kg;
        float m = -1e30f;
#pragma unroll
        for (int kt = 0; kt < 9; ++kt)
#pragma unroll
            for (int i = 0; i < 4; ++i) { const int j = jb - 16 * kt - i; const bool val = (j >= 0) && (j <= 128) && (ikb + 16 * kt + i >= 0); sc[kt][i] = val ? sc[kt][i] : -1e30f; m = fmaxf(m, sc[kt][i]); }
        m = fmaxf(m, __shfl_xor(m, 16)); m = fmaxf(m, __shfl_xor(m, 32));
        const float mc = m * csc; float l = 0.f;
        unsigned pk[10][2];
#pragma unroll
        for (int kt = 0; kt < 9; ++kt) { float p[4];
#pragma unroll
            for (int i = 0; i < 4; ++i) { p[i] = (sc[kt][i] > -1e29f) ? __builtin_amdgcn_exp2f(sc[kt][i] * csc - mc) : 0.f; l += p[i]; }
            pk[kt][0] = cvt_pk_bf16(p[0], p[1]); pk[kt][1] = cvt_pk_bf16(p[2], p[3]); }
        pk[9][0] = 0u; pk[9][1] = 0u;
        l += __shfl_xor(l, 16); l += __shfl_xor(l, 32);
        f32x4 o[4];
#pragma unroll
        for (int dt = 0; dt < 4; ++dt) o[dt] = (f32x4){0.f, 0.f, 0.f, 0.f};
#define ATT_PV(KK) do { s16x4 a0 = tr_read<(KK) * 32 * ATT_PITCH + 0>(vaddr), a1 = tr_read<(KK) * 32 * ATT_PITCH + 32>(vaddr), a2 = tr_read<(KK) * 32 * ATT_PITCH + 64>(vaddr), a3 = tr_read<(KK) * 32 * ATT_PITCH + 96>(vaddr); \
            s16x4 c0 = tr_read<(KK) * 32 * ATT_PITCH + 16 * ATT_PITCH + 0>(vaddr), c1 = tr_read<(KK) * 32 * ATT_PITCH + 16 * ATT_PITCH + 32>(vaddr), c2 = tr_read<(KK) * 32 * ATT_PITCH + 16 * ATT_PITCH + 64>(vaddr), c3 = tr_read<(KK) * 32 * ATT_PITCH + 16 * ATT_PITCH + 96>(vaddr); \
            tr_wait8(a0, a1, a2, a3, c0, c1, c2, c3); \
            u32x4 pw; pw.x = pk[2 * (KK)][0]; pw.y = pk[2 * (KK)][1]; pw.z = pk[2 * (KK) + 1][0]; pw.w = pk[2 * (KK) + 1][1]; \
            const bf16x8 pf = __builtin_bit_cast(bf16x8, pw); \
            o[0] = __builtin_amdgcn_mfma_f32_16x16x32_bf16(__builtin_shufflevector(a0, c0, 0, 1, 2, 3, 4, 5, 6, 7), pf, o[0], 0, 0, 0); \
            o[1] = __builtin_amdgcn_mfma_f32_16x16x32_bf16(__builtin_shufflevector(a1, c1, 0, 1, 2, 3, 4, 5, 6, 7), pf, o[1], 0, 0, 0); \
            o[2] = __builtin_amdgcn_mfma_f32_16x16x32_bf16(__builtin_shufflevector(a2, c2, 0, 1, 2, 3, 4, 5, 6, 7), pf, o[2], 0, 0, 0); \
            o[3] = __builtin_amdgcn_mfma_f32_16x16x32_bf16(__builtin_shufflevector(a3, c3, 0, 1, 2, 3, 4, 5, 6, 7), pf, o[3], 0, 0, 0); } while (0)
        ATT_PV(0); ATT_PV(1); ATT_PV(2); ATT_PV(3); ATT_PV(4);
        const float il = 1.0f / l;
        bf16_t* op = PO + ((size_t)g * NTOK + tokq) * 256 + h * 64 + 4 * kg;
#pragma unroll
        for (int dt = 0; dt < 4; ++dt) { u32x2 wv; wv.x = cvt_pk_bf16(o[dt][0] * il, o[dt][1] * il); wv.y = cvt_pk_bf16(o[dt][2] * il, o[dt][3] * il); *(u32x2*)(op + 16 * dt) = wv; }
        if (kg == 0) LSE[((size_t)g * NTOK + tokq) * 4 + h] = m * 0.125f + __logf(l);
    }
#undef ATT_PV
#undef ATT_FETCH
#undef ATT_DECODE
}

#define XB_TMO      128
#define XB_XCNT(j)  (256  + 64 * (j))
#define XB_XSUB(j)  (1280 + 64 * (j))
#define XB_XGEN(j)  (2304 + 64 * (j))
#define XB_TOP      3328
#define XB_TOPGEN   3392
#define XCD_BAR_WORDS 3456
#define XB_SPIN_CAP (1u << 20)
__device__ __forceinline__ unsigned xb_ld(unsigned* p)              { return __hip_atomic_load(p, __ATOMIC_RELAXED, __HIP_MEMORY_SCOPE_AGENT); }
__device__ __forceinline__ unsigned xb_add(unsigned* p, unsigned v) { return __hip_atomic_fetch_add(p, v, __ATOMIC_RELAXED, __HIP_MEMORY_SCOPE_AGENT); }
__device__ __forceinline__ unsigned xb_xcc_id() { return (unsigned)__builtin_amdgcn_s_getreg((3 << 11) | 20) & 0xFu; }
#define XB_SPIN(cond, bar) do { unsigned _sp = 0; while (cond) { __builtin_amdgcn_s_sleep(1); \
    if ((++_sp & 255u) == 0u) { if (xb_ld(&(bar)[XB_TMO])) break; if (_sp > XB_SPIN_CAP) { atomicAdd(&(bar)[XB_TMO], 1u); break; } } } } while (0)
struct XcdBarrier { unsigned* bar; unsigned x; volatile LAS unsigned* st; };
__device__ __forceinline__ XcdBarrier xcd_barrier_post(unsigned* bar, volatile LAS unsigned* st) {
    XcdBarrier b; b.bar = bar; b.x = xb_xcc_id(); b.st = st;
    if (threadIdx.x == 0) (void)xb_add(&bar[XB_XCNT(b.x)], 1u);
    return b;
}
__device__ __forceinline__ void xcd_barrier_complete(unsigned* bar, unsigned x, unsigned& nloc, unsigned& nx) {
    const unsigned G = gridDim.x * gridDim.y * gridDim.z;
    unsigned sum, cnt, mine, sp = 0u;
    for (;;) {
        sum = 0u; cnt = 0u; mine = 0u;
#pragma unroll
        for (unsigned j = 0; j < 16; ++j) { const unsigned c = xb_ld(&bar[XB_XCNT(j)]); sum += c; cnt += (c > 0u) ? 1u : 0u; mine = (j == x) ? c : mine; }
        if (sum == G) break;
        __builtin_amdgcn_s_sleep(1);
        if ((++sp & 255u) == 0u) { if (xb_ld(&bar[XB_TMO])) break; if (sp > XB_SPIN_CAP) { atomicAdd(&bar[XB_TMO], 1u); break; } }
    }
    nloc = mine > 0u ? mine : 1u; nx = cnt > 0u ? cnt : 1u;
}
__device__ __forceinline__ void xcd_barrier(const XcdBarrier& b) {
    asm volatile("s_waitcnt vmcnt(0)" ::: "memory");
    __syncthreads();
    if (threadIdx.x == 0) {
        unsigned* bar = b.bar;
        __builtin_amdgcn_s_waitcnt(0);
        unsigned nloc = b.st[0], nx = b.st[1];
        if (nloc == 0u) { xcd_barrier_complete(bar, b.x, nloc, nx); b.st[0] = nloc; b.st[1] = nx; }
        const unsigned old = xb_add(&bar[XB_XSUB(b.x)], 1u);
        const unsigned gen = old / nloc;
        if (old + 1u == (gen + 1u) * nloc) {
            __builtin_amdgcn_fence(__ATOMIC_RELEASE, "agent");
            asm volatile("s_waitcnt vmcnt(0)" ::: "memory");
            const unsigned og = xb_add(&bar[XB_TOP], 1u);
            const unsigned tg = og / nx;
            if (og + 1u == (tg + 1u) * nx) xb_add(&bar[XB_TOPGEN], 1u);
            else XB_SPIN(xb_ld(&bar[XB_TOPGEN]) == tg, bar);
            __builtin_amdgcn_fence(__ATOMIC_ACQUIRE, "agent");
            xb_add(&bar[XB_XGEN(b.x)], 1u);
            asm volatile("s_waitcnt vmcnt(0)" ::: "memory");
        } else {
            XB_SPIN(xb_ld(&bar[XB_XGEN(b.x)]) == gen, bar);
            __builtin_amdgcn_fence(__ATOMIC_ACQUIRE, "agent");
            asm volatile("s_waitcnt vmcnt(0)" ::: "memory");
        }
    }
    __syncthreads();
}

__global__ void __launch_bounds__(NTHREADS, 2) fwd_megakernel(Params P) {
    extern __shared__ __attribute__((aligned(16))) unsigned char lds_raw[];
    LAS unsigned char* lds = (LAS unsigned char*)lds_raw;
    cg::grid_group grid = cg::this_grid();
    const int tid = threadIdx.x, lane = tid & 63, wave = __builtin_amdgcn_readfirstlane(tid >> 6);
    const int G = gridDim.x, bid = blockIdx.x;
    const int gw = bid * 8 + wave, NGW = G * 8;
    const size_t gtid = (size_t)bid * NTHREADS + tid, nth = (size_t)G * NTHREADS;
    unsigned char* ws = P.ws;
    bf16_t* Wt_in = (bf16_t*)(ws + WS_WIN); bf16_t* Wt_pa = (bf16_t*)(ws + WS_WPA); bf16_t* Wt_pb = (bf16_t*)(ws + WS_WPB);
    bf16_t* Wt_o = (bf16_t*)(ws + WS_WO); bf16_t* Wt_up = (bf16_t*)(ws + WS_WUP); bf16_t* Wt_dn = (bf16_t*)(ws + WS_WDN);
    float* X = (float*)(ws + WS_X); bf16_t* XB = (bf16_t*)(ws + WS_XB); bf16_t* QKV = (bf16_t*)(ws + WS_QKV); bf16_t* UB = (bf16_t*)(ws + WS_U);
    bf16_t* GT = (bf16_t*)(ws + WS_G); bf16_t* OA = (bf16_t*)(ws + WS_OA); bf16_t* PB = (bf16_t*)(ws + WS_P); float* TMP = (float*)(ws + WS_TMP);
    bf16_t* MIX = (bf16_t*)(ws + WS_MIX); bf16_t* HID = (bf16_t*)(ws + WS_H); float* SS = (float*)(ws + WS_SS); float* ROPE = (float*)(ws + WS_ROPE);
    float* out = P.out;
    volatile LAS unsigned* bst = (volatile LAS unsigned*)(lds + LDS_BYTES - 16);
    if (tid == 0) { bst[0] = 0u; bst[1] = 0u; }
    __syncthreads();
    const XcdBarrier xb = xcd_barrier_post((unsigned*)(ws + WS_BAR), bst);

    {
        LAS float* LsT = (LAS float*)lds;
        LAS float* Ws = LsT + 128 * 128;
        for (int item = bid; item < DEPTH * 4 * 16; item += G) {
            const int l = item >> 6, g = (item >> 4) & 3, n0 = (item & 15) * 64;
            const float* lin = P.in[10] + (size_t)(l * 4 + g) * 128 * 128;
            const float* sc = P.in[11] + l * 512 + g * 128;
            const float* wpb = P.in[9] + (size_t)l * 512 * 1024 + (size_t)g * 128 * 1024;
            for (int i = tid; i < 128 * 128; i += NTHREADS) { const int c = i >> 7, d = i & 127; LsT[d * 128 + c] = lin[i] * sc[d]; }
            for (int i = tid; i < 128 * 64; i += NTHREADS) { const int d = i >> 6, n = i & 63; Ws[i] = wpb[(size_t)d * 1024 + n0 + n]; }
            __syncthreads();
            const int n = tid & 63, cgp = tid >> 6;
            float a[16];
#pragma unroll
            for (int i = 0; i < 16; ++i) a[i] = 0.f;
            for (int d = 0; d < 128; ++d) {
                const float w = Ws[d * 64 + n];
                const LAS f32x4* lp = (const LAS f32x4*)(LsT + d * 128 + cgp * 16);
#pragma unroll
                for (int q4 = 0; q4 < 4; ++q4) { const f32x4 lv = lp[q4];
#pragma unroll
                    for (int i = 0; i < 4; ++i) a[q4 * 4 + i] += lv[i] * w; }
            }
            bf16_t* op = Wt_pb + ((size_t)l * 1024 + n0 + n) * 512 + g * 128 + cgp * 16;
            u32x4 o0, o1; o0.x = cvt_pk_bf16(a[0], a[1]); o0.y = cvt_pk_bf16(a[2], a[3]); o0.z = cvt_pk_bf16(a[4], a[5]); o0.w = cvt_pk_bf16(a[6], a[7]);
            o1.x = cvt_pk_bf16(a[8], a[9]); o1.y = cvt_pk_bf16(a[10], a[11]); o1.z = cvt_pk_bf16(a[12], a[13]); o1.w = cvt_pk_bf16(a[14], a[15]);
            *(u32x4*)op = o0; *(u32x4*)(op + 8) = o1;
            __syncthreads();
        }
        {
            LAS float* scr = (LAS float*)(lds + wave * 16640);
            constexpr int I_IN = 16 * 76, I_PA = 4 * 16, I_O = 16 * 16, I_UP = 16 * 64, I_DN = 64 * 16, I_L = I_IN + I_PA + I_O + I_UP + I_DN;
            for (int it = gw; it < DEPTH * I_L; it += NGW) {
                const int l = it / I_L; int r = it - l * I_L;
                if (r < I_IN) { transpose_item(P.in[7] + (size_t)l * DM * NIN, P.in[6] + l * DM, DM, NIN, Wt_in + (size_t)l * NIN * DM, scr, r, lane); continue; } r -= I_IN;
                if (r < I_PA) { transpose_item(P.in[8] + (size_t)l * 256 * DM, nullptr, 256, DM, Wt_pa + (size_t)l * DM * 256, scr, r, lane); continue; } r -= I_PA;
                if (r < I_O) { transpose_item(P.in[12] + (size_t)l * DM * DM, nullptr, DM, DM, Wt_o + (size_t)l * DM * DM, scr, r, lane); continue; } r -= I_O;
                if (r < I_UP) { transpose_item(P.in[14] + (size_t)l * DM * DFF, P.in[13] + l * DM, DM, DFF, Wt_up + (size_t)l * DFF * DM, scr, r, lane); continue; } r -= I_UP;
                transpose_item(P.in[15] + (size_t)l * DFF * DM, nullptr, DFF, DM, Wt_dn + (size_t)l * DM * DFF, scr, r, lane);
            }
        }
        for (int row = gw; row < NTOK; row += NGW) {
            const float* src = row < NTP ? P.in[0] + (size_t)row * DM : P.in[1] + (size_t)(row - NTP) * DM;
            float s = 0.f;
#pragma unroll
            for (int j = 0; j < 4; ++j) { const f32x4 v = *(const f32x4*)(src + 4 * lane + 256 * j); s += v[0] * v[0] + v[1] * v[1] + v[2] * v[2] + v[3] * v[3];
                *(f32x4*)(X + (size_t)row * DM + 4 * lane + 256 * j) = v;
                u32x2 w; w.x = cvt_pk_bf16(v[0], v[1]); w.y = cvt_pk_bf16(v[2], v[3]); *(u32x2*)(XB + (size_t)row * DM + 4 * lane + 256 * j) = w; }
#pragma unroll
            for (int o = 1; o < 64; o <<= 1) s += __shfl_xor(s, o);
            if (lane == 0) SS[row] = s;
        }
        for (size_t i = gtid; i < 4104 * 8; i += nth) { const int pi = (int)(i >> 3), k = (int)(i & 7); const float pos = (float)(pi < 4096 ? pi : 8192 + pi - 4096);
            const float inv = powf(500000.0f, -(float)(2 * k) / 16.0f); const float ang = pos * inv; ROPE[pi * 16 + k] = cosf(ang); ROPE[pi * 16 + 8 + k] = sinf(ang); }
        for (size_t i = gtid; i < (size_t)8 * NTOK; i += nth) SS[NTOK + i] = 0.f;
        for (size_t i = gtid; i < (size_t)DEPTH * 32 * 7 * 128; i += nth) { const size_t lb = i / (7 * 128), r = i - lb * (7 * 128);
            *(f32x4*)(out + O_POOLS + lb * 15 * 512 + r * 4) = *(const f32x4*)(P.in[5] + lb * 15 * 512 + 8 * 512 + r * 4); }
    }
    grid.sync();

    pg8::StaticOrder S;
#pragma unroll 1
    for (int step = 0; step < DEPTH * 7; ++step) {
        const int layer = step / 7, st = step - layer * 7;
        if (st == 1) {
            int tid_l = threadIdx.x; asm volatile("" : "+v"(tid_l));
            const int lane = tid_l & 63, gw = bid * 8 + (tid_l >> 6);
            const size_t gtid = (size_t)bid * NTHREADS + tid_l;
            unsigned char* wsl = ws; asm volatile("" : "+s"(wsl));
            bf16_t* QKV = (bf16_t*)(wsl + WS_QKV); bf16_t* UB = (bf16_t*)(wsl + WS_U); bf16_t* OA = (bf16_t*)(wsl + WS_OA); bf16_t* PB = (bf16_t*)(wsl + WS_P);
            bf16_t* PO = (bf16_t*)(wsl + WS_TMP); float* LSE = (float*)(wsl + WS_TMP + (size_t)3 * NTOK * 256 * 2);
            for (int it = gw; it < NTS * 12; it += NGW) { const int g = it % 3, r = it / 3; attn_sample_sub(QKV, g == 0 ? P.in[2] : (g == 1 ? P.in[3] : P.in[4]), PO, LSE, layer, r >> 2, r & 3, g, lane); }
            attn_mfma_phase(lds, QKV, PO, LSE, bid, G, tid_l);
            copy_shift<128>(P.in[2], out + O_KVS0, layer, gtid, nth);
            copy_shift<512>(P.in[3], out + O_KVS1, layer, gtid, nth);
            copy_shift<2048>(P.in[4], out + O_KVS2, layer, gtid, nth);
            xcd_barrier(xb);
            for (size_t idx = gtid; idx < (size_t)NTOK * 32; idx += nth) {
                const size_t token = idx >> 5; const int c = (int)(idx & 31) * 8, h = c >> 6;
                const float l0 = LSE[(0 * (size_t)NTOK + token) * 4 + h], l1 = LSE[(1 * (size_t)NTOK + token) * 4 + h], l2 = LSE[(2 * (size_t)NTOK + token) * 4 + h];
                const float mx = fmaxf(l0, fmaxf(l1, l2)); float w0 = __expf(l0 - mx), w1 = __expf(l1 - mx), w2 = __expf(l2 - mx); const float iw = 1.0f / (w0 + w1 + w2); w0 *= iw; w1 *= iw; w2 *= iw;
                float a0[8], a1[8], a2[8], o[8];
                unpack8(*(const u32x4*)(PO + (0 * (size_t)NTOK + token) * 256 + c), a0); unpack8(*(const u32x4*)(PO + (1 * (size_t)NTOK + token) * 256 + c), a1); unpack8(*(const u32x4*)(PO + (2 * (size_t)NTOK + token) * 256 + c), a2);
#pragma unroll
                for (int k = 0; k < 8; ++k) o[k] = w0 * a0[k] + w1 * a1[k] + w2 * a2[k];
                *(u32x4*)(OA + token * 256 + c) = pack8(o);
            }
            const float* sp = P.in[5] + (size_t)layer * 32 * 15 * 512;
            for (size_t idx = gtid; idx < (size_t)NTOK * 64; idx += nth) {
                const int token = (int)(idx >> 6), c = (int)(idx & 63) * 8; const int w = 2 << (c >> 7);
                const bool samp = token >= NTP; const int t = samp ? (token & 7) : (token & 4095); const int b = (token - NTP) >> 3;
                float sum[8], ut[8];
                unpack8(*(const u32x4*)(UB + (size_t)token * 512 + c), ut);
#pragma unroll
                for (int i = 0; i < 8; ++i) sum[i] = ut[i];
                for (int i = 1; i < w; ++i) {
                    const int tt = t - i; float f[8];
                    if (tt >= 0) unpack8(*(const u32x4*)(UB + (size_t)(token - i) * 512 + c), f);
                    else if (samp) { const float* r = sp + (size_t)(b * 15 + 15 + tt) * 512 + c; const f32x4 a = *(const f32x4*)r, b2 = *(const f32x4*)(r + 4);
#pragma unroll
                        for (int k = 0; k < 4; ++k) { f[k] = a[k]; f[4 + k] = b2[k]; } }
                    else {
#pragma unroll
                        for (int k = 0; k < 8; ++k) f[k] = 0.f; }
#pragma unroll
                    for (int k = 0; k < 8; ++k) sum[k] += f[k];
                }
                const float cnt = samp ? (float)w : (float)(w < t + 1 ? w : t + 1); const float ic = 1.0f / cnt;
                float p[8];
#pragma unroll
                for (int k = 0; k < 8; ++k) p[k] = sum[k] * ic - ut[k];
                *(u32x4*)(PB + (size_t)token * 512 + c) = pack8(p);
            }
            xcd_barrier(xb);
            continue;
        }
        pg8::Gemm g; EpiAll E; E.ws = ws; E.out = out; E.layer = layer; E.ssi = 0; E.ssn = 0;
        g.M = NTP;
        if (st == 0)      { g.A = XB;  g.Bt = Wt_in + (size_t)layer * NIN * DM; g.N = NIN; g.K = DM;  E.mode = 0; E.ssi = 2 * layer; }
        else if (st == 2) { g.A = OA;  g.Bt = Wt_pa + (size_t)layer * DM * 256; g.N = DM;  g.K = 256; E.mode = 1; }
        else if (st == 3) { g.A = PB;  g.Bt = Wt_pb + (size_t)layer * DM * 512; g.N = DM;  g.K = 512; E.mode = 2; }
        else if (st == 4) { g.A = MIX; g.Bt = Wt_o + (size_t)layer * DM * DM;   g.N = DM;  g.K = DM;  E.mode = 3; E.ssn = 2 * layer + 1; }
        else if (st == 5) { g.A = XB;  g.Bt = Wt_up + (size_t)layer * DFF * DM; g.N = DFF; g.K = DM;  E.mode = 4; E.ssi = 2 * layer + 1; }
        else              { g.A = HID; g.Bt = Wt_dn + (size_t)layer * DM * DFF; g.N = DM;  g.K = DFF; E.mode = 3; E.ssn = 2 * layer + 2; }
        S.init(NTP, g.N, G, bid);
        pg8::gemm_phase<EpiAll, pg8::StaticOrder, true, true>(lds, g, S, E);
        skinny_gemm(lds, g.A + (size_t)NTP * g.K, g.Bt, g.N, g.K, E, G - 1 - bid, G);
        if (st != 2) xcd_barrier(xb);
    }
    {
        int tid_l = threadIdx.x; asm volatile("" : "+v"(tid_l));
        const int lane = tid_l & 63, gw = bid * 8 + (tid_l >> 6);
        unsigned char* wsl = ws; asm volatile("" : "+s"(wsl));
        float* X = (float*)(wsl + WS_X);
        const float* fn = P.in[16]; const float* ssf = (const float*)(wsl + WS_SS) + (size_t)8 * NTOK;
        for (int row = gw; row < NTOK; row += NGW) {
            const float rs = rsqrtf(ssf[row] * (1.0f / 1024.0f) + 1e-6f);
#pragma unroll
            for (int j = 0; j < 4; ++j) { const int c = 4 * lane + 256 * j; const f32x4 v = *(const f32x4*)(X + (size_t)row * DM + c); const f32x4 gn = *(const f32x4*)(fn + c);
                *(f32x4*)(out + (size_t)row * DM + c) = (f32x4){v[0] * rs * gn[0], v[1] * rs * gn[1], v[2] * rs * gn[2], v[3] * rs * gn[3]}; }
        }
    }
}

extern "C" void kernel_launch(void* const* d_in, const int* in_sizes, int n_in, void* d_out, int out_size, void* d_ws, size_t ws_size, hipStream_t stream) {
    static int grid_blocks = 0;
    if (grid_blocks == 0) {
        if (n_in != 17 || ws_size < WS_END) { fprintf(stderr, "kernel_launch: unexpected n_in %d / ws %zu (need %zu)\n", n_in, ws_size, (size_t)WS_END); grid_blocks = -1; return; }
        int dev = 0, cus = 0, per_cu = 0;
        (void)hipGetDevice(&dev);
        (void)hipDeviceGetAttribute(&cus, hipDeviceAttributeMultiprocessorCount, dev);
        if (hipFuncSetAttribute((const void*)fwd_megakernel, hipFuncAttributeMaxDynamicSharedMemorySize, LDS_BYTES) != hipSuccess) { fprintf(stderr, "kernel_launch: hipFuncSetAttribute failed\n"); grid_blocks = -1; return; }
        (void)hipOccupancyMaxActiveBlocksPerMultiprocessor(&per_cu, (const void*)fwd_megakernel, NTHREADS, LDS_BYTES);
        if (per_cu < 1) { fprintf(stderr, "kernel_launch: occupancy query says %d blocks/CU\n", per_cu); grid_blocks = -1; return; }
        grid_blocks = cus * 1;
    }
    if (grid_blocks < 0) return;
    if (hipMemsetAsync((unsigned char*)d_ws + WS_BAR, 0, 4096 * 4, stream) != hipSuccess) { fprintf(stderr, "kernel_launch: memset of barrier words failed\n"); return; }
    Params p{};
    for (int i = 0; i < 17; ++i) p.in[i] = (const float*)d_in[i];
    p.out = (float*)d_out; p.ws = (unsigned char*)d_ws;
    void* args[] = {&p};
    hipError_t e = hipLaunchCooperativeKernel((const void*)fwd_megakernel, dim3(grid_blocks), dim3(NTHREADS), args, LDS_BYTES, stream);
    if (e != hipSuccess) fprintf(stderr, "cooperative launch failed: %s (grid %d)\n", hipGetErrorString(e), grid_blocks);
}
```

```cpp
#include <hip/hip_runtime.h>
#include <hip/hip_cooperative_groups.h>
#include <cstdio>
#include <cstdint>
namespace cg = cooperative_groups;

namespace pg8 {
#define PG8_LAS __attribute__((address_space(3)))
typedef unsigned short bf16_t;
typedef short bf16x8 __attribute__((ext_vector_type(8)));
typedef float f32x4 __attribute__((ext_vector_type(4)));
typedef unsigned u32x4 __attribute__((ext_vector_type(4)));
typedef unsigned u32x2 __attribute__((ext_vector_type(2)));
constexpr int BM = 256, BK = 64, HALF = 128, HTB = HALF * BK * 2, STAGE_BYTES = 8 * HTB, NXCD = 8, WGM = 8;

__host__ __device__ __forceinline__ int lds_byte(int r, int c) { const int st = (r >> 4) * 2 + (c >> 5), rr = r & 15, cc = c & 31, ob = rr * 64 + cc * 2; return st * 1024 + (ob ^ (((ob >> 9) & 1) << 5)); }
__host__ __device__ __forceinline__ void stage_rc(int b, int& R, int& C) { const int st = b / 1024, sb = b % 1024, swz = sb ^ (((sb >> 9) & 1) << 5); R = (st >> 1) * 16 + swz / 64; C = (st & 1) * 32 + (swz % 64) / 2; }
__host__ __device__ __forceinline__ int perm32(int rho) { const int n = rho >> 4, i = rho & 15; return 8 * (i >> 2) + 4 * n + (i & 3); }

struct Unit { int pm, pn; };
struct Gemm { const bf16_t* A; const bf16_t* Bt; int M, N, K; };

struct StaticOrder {
    int nM, nN, nwg, G, c;
    __host__ __device__ void init(int M, int N, int G_, int c_) { nM = M / BM; nN = N / BM; nwg = nM * nN; G = G_; c = c_; }
    __host__ __device__ bool next(int i, Unit& u) const {
        const long L = (long)i * G + c; if (L >= nwg) return false;
        int wgid = (int)L; { const int q = nwg / NXCD, r = nwg % NXCD, xcd = wgid % NXCD, off = wgid / NXCD; wgid = (xcd < r ? xcd * (q + 1) : r * (q + 1) + (xcd - r) * q) + off; }
        const int nig = WGM * nN, gid = wgid / nig, fm = gid * WGM, gsz = (nM - fm) < WGM ? (nM - fm) : WGM;
        u.pm = fm + ((wgid % nig) % gsz); u.pn = (wgid % nig) / gsz; return true;
    }
    __device__ __forceinline__ void a_ready(const Unit&) const {}
    __device__ __forceinline__ void done(const Unit&) const {}
};

__device__ __forceinline__ unsigned cvt_pk_bf16(float lo, float hi) { unsigned r; asm volatile("v_cvt_pk_bf16_f32 %0, %1, %2" : "=v"(r) : "v"(lo), "v"(hi)); return r; }

template <class Epi, class Sched, bool ALIGN_EPI = false, bool SP2 = false>
__device__ __forceinline__ void gemm_phase(PG8_LAS unsigned char* lds, const Gemm g, const Sched& S, const Epi& E) {
    int tid = threadIdx.x; asm volatile("" : "+v"(tid));
    const int wid = __builtin_amdgcn_readfirstlane(tid >> 6), lane = tid & 63, wr = wid >> 2, wc = wid & 3, fr = lane & 15, fq = lane >> 4;
    const int K = g.K, nt = K / BK;
    unsigned voffA[2], voffB[2];
#pragma unroll
    for (int i = 0; i < 2; ++i) { int R, C; stage_rc(tid * 16 + i * 8192, R, C); const int Rb = Epi::PERM ? ((R & ~31) + perm32(R & 31)) : R;
        voffA[i] = (unsigned)(R * K + C) * 2u; voffB[i] = (unsigned)(Rb * K + C) * 2u; }
    const size_t kstep = (size_t)(BK * 2);
    const size_t hstep = (size_t)HALF * K * 2;
    const size_t tstep = 2 * hstep;
    const unsigned ldsw = (unsigned)wid * 1024u;
    const int aoff = lds_byte(wr * 64 + fr, fq * 8), boff = lds_byte(wc * 32 + fr, fq * 8);
#define PG8_SA(b, h) (((b) * 2 + (h)) * HTB)
#define PG8_SB(b, h) ((4 + (b) * 2 + (h)) * HTB)
#define PG8_STAGE(bufoff, gbase, voff) do { _Pragma("unroll") for (int _i = 0; _i < 2; ++_i) \
        __builtin_amdgcn_global_load_lds((const unsigned*)((const char*)(gbase) + (voff)[_i]), (PG8_LAS unsigned*)(lds + (bufoff) + ldsw + _i * 8192), 16, 0, 0); } while (0)
#define PG8_LDA(dst, b, h) do { _Pragma("unroll") for (int m = 0; m < 4; ++m) _Pragma("unroll") for (int k = 0; k < 2; ++k) dst[m][k] = *(const PG8_LAS bf16x8*)(lds + PG8_SA(b, h) + aoff + m * 2048 + k * 1024); } while (0)
#define PG8_LDB(dst, b, h) do { _Pragma("unroll") for (int n = 0; n < 2; ++n) _Pragma("unroll") for (int k = 0; k < 2; ++k) dst[n][k] = *(const PG8_LAS bf16x8*)(lds + PG8_SB(b, h) + boff + n * 2048 + k * 1024); } while (0)
#define PG8_MMA(ai, bj, At, Bt) do { __builtin_amdgcn_s_setprio(1); _Pragma("unroll") for (int m = 0; m < 4; ++m) _Pragma("unroll") for (int n = 0; n < 2; ++n) _Pragma("unroll") for (int k = 0; k < 2; ++k) \
        acc[ai][bj][m][n] = __builtin_amdgcn_mfma_f32_16x16x32_bf16(Bt[n][k], At[m][k], acc[ai][bj][m][n], 0, 0, 0); __builtin_amdgcn_s_setprio(0); } while (0)
#define PG8_WAIT_V(n) asm volatile("s_waitcnt vmcnt(" #n ")" ::: "memory")
#define PG8_WAIT_L(n) asm volatile("s_waitcnt lgkmcnt(" #n ")" ::: "memory")
#define PG8_BAR __builtin_amdgcn_s_barrier()
#define PG8_SCHED __builtin_amdgcn_sched_barrier(0)
    Unit cur, nxt; int ui = 0;
    if (!S.next(0, cur)) return;
    f32x4 acc[2][2][4][2];
#pragma unroll
    for (int a = 0; a < 2; ++a)
#pragma unroll
        for (int b = 0; b < 2; ++b)
#pragma unroll
            for (int m = 0; m < 4; ++m)
#pragma unroll
                for (int n = 0; n < 2; ++n) acc[a][b][m][n] = (f32x4){0.f, 0.f, 0.f, 0.f};
    bf16x8 At[4][2], B0[2][2], B1[2][2];
    const char* cA = (const char*)g.A + (size_t)cur.pm * tstep; const char* cB = (const char*)g.Bt + (size_t)cur.pn * tstep;
    S.a_ready(cur);
    if constexpr (SP2) {
        PG8_STAGE(PG8_SB(0, 0), cB, voffB); PG8_STAGE(PG8_SB(0, 1), cB + hstep, voffB); PG8_STAGE(PG8_SA(0, 0), cA, voffA); PG8_STAGE(PG8_SA(0, 1), cA + hstep, voffA);
        if (wr == 1) PG8_BAR;
        PG8_WAIT_V(2); PG8_BAR;
        PG8_STAGE(PG8_SB(1, 0), cB + kstep, voffB); PG8_STAGE(PG8_SA(1, 0), cA + kstep, voffA); PG8_STAGE(PG8_SB(1, 1), cB + hstep + kstep, voffB);
        PG8_WAIT_V(6); PG8_BAR;
    } else {
        PG8_STAGE(PG8_SB(0, 0), cB, voffB); PG8_STAGE(PG8_SA(0, 0), cA, voffA); PG8_STAGE(PG8_SB(0, 1), cB + hstep, voffB); PG8_STAGE(PG8_SA(0, 1), cA + hstep, voffA);
        if (wr == 1) PG8_BAR;
        PG8_WAIT_V(4); PG8_BAR;
        PG8_STAGE(PG8_SB(1, 0), cB + kstep, voffB); PG8_STAGE(PG8_SA(1, 0), cA + kstep, voffA); PG8_STAGE(PG8_SB(1, 1), cB + hstep + kstep, voffB);
        PG8_WAIT_V(6); PG8_BAR;
    }
    for (;;) {
        const bool has_next = S.next(ui + 1, nxt);
        const char* nA = has_next ? (const char*)g.A + (size_t)nxt.pm * tstep : cA; const char* nB = has_next ? (const char*)g.Bt + (size_t)nxt.pn * tstep : cB;
        for (int t = 0; t < nt; t += 2) {
            const bool last = (t == nt - 2);
            const char* a1 = cA + (size_t)(t + 1) * kstep;
            const char* a2 = last ? nA : cA + (size_t)(t + 2) * kstep; const char* b2 = last ? nB : cB + (size_t)(t + 2) * kstep;
            const char* a3 = a2 + kstep; const char* b3 = b2 + kstep;
            if (last && has_next) S.a_ready(nxt);
            if constexpr (SP2) {
            PG8_LDB(B0, 0, 0); PG8_LDB(B1, 0, 1); PG8_SCHED; PG8_LDA(At, 0, 0); PG8_STAGE(PG8_SA(1, 1), a1 + hstep, voffA);
            PG8_WAIT_V(8); PG8_WAIT_L(0); PG8_BAR; PG8_MMA(0, 0, At, B0); PG8_MMA(0, 1, At, B1); PG8_BAR; PG8_SCHED;
            PG8_LDA(At, 0, 1); PG8_STAGE(PG8_SB(0, 0), b2, voffB); PG8_STAGE(PG8_SB(0, 1), b2 + hstep, voffB); PG8_STAGE(PG8_SA(0, 0), a2, voffA);
            PG8_WAIT_V(8); PG8_WAIT_L(0); PG8_BAR; PG8_MMA(1, 0, At, B0); PG8_MMA(1, 1, At, B1); PG8_BAR; PG8_SCHED;
            PG8_LDB(B0, 1, 0); PG8_LDB(B1, 1, 1); PG8_SCHED; PG8_LDA(At, 1, 0); PG8_STAGE(PG8_SA(0, 1), a2 + hstep, voffA);
            PG8_WAIT_V(8); PG8_WAIT_L(0); PG8_BAR; PG8_MMA(0, 0, At, B0); PG8_MMA(0, 1, At, B1); PG8_BAR; PG8_SCHED;
            PG8_LDA(At, 1, 1); PG8_STAGE(PG8_SB(1, 0), b3, voffB); PG8_STAGE(PG8_SB(1, 1), b3 + hstep, voffB); PG8_STAGE(PG8_SA(1, 0), a3, voffA);
            PG8_WAIT_V(8); PG8_WAIT_L(0); PG8_BAR; PG8_MMA(1, 0, At, B0); PG8_MMA(1, 1, At, B1); PG8_BAR; PG8_SCHED;
            } else {
            PG8_LDB(B0, 0, 0); PG8_SCHED; PG8_LDA(At, 0, 0); PG8_STAGE(PG8_SA(1, 1), a1 + hstep, voffA);
            PG8_WAIT_L(8); PG8_BAR; PG8_WAIT_L(0); PG8_MMA(0, 0, At, B0); PG8_BAR; PG8_SCHED;
            PG8_LDB(B1, 0, 1); PG8_STAGE(PG8_SB(0, 0), b2, voffB);
            PG8_BAR; PG8_WAIT_L(0); PG8_MMA(0, 1, At, B1); PG8_BAR;
            PG8_LDA(At, 0, 1); PG8_STAGE(PG8_SA(0, 0), a2, voffA);
            PG8_BAR; PG8_WAIT_L(0); PG8_MMA(1, 0, At, B0); PG8_BAR; PG8_SCHED;
            PG8_STAGE(PG8_SB(0, 1), b2 + hstep, voffB);
            PG8_WAIT_V(6); PG8_BAR; PG8_MMA(1, 1, At, B1); PG8_BAR;
            PG8_LDB(B0, 1, 0); PG8_SCHED; PG8_LDA(At, 1, 0); PG8_STAGE(PG8_SA(0, 1), a2 + hstep, voffA);
            PG8_WAIT_L(8); PG8_BAR; PG8_WAIT_L(0); PG8_MMA(0, 0, At, B0); PG8_BAR; PG8_SCHED;
            PG8_LDB(B1, 1, 1); PG8_STAGE(PG8_SB(1, 0), b3, voffB);
            PG8_BAR; PG8_WAIT_L(0); PG8_MMA(0, 1, At, B1); PG8_BAR;
            PG8_LDA(At, 1, 1); PG8_STAGE(PG8_SA(1, 0), a3, voffA);
            PG8_BAR; PG8_WAIT_L(0); PG8_MMA(1, 0, At, B0); PG8_BAR; PG8_SCHED;
            PG8_STAGE(PG8_SB(1, 1), b3 + hstep, voffB);
            PG8_WAIT_V(6); PG8_BAR; PG8_MMA(1, 1, At, B1); PG8_BAR;
            }
        }
        if constexpr (ALIGN_EPI) { if (wr == 0) PG8_BAR; }
        E(acc, cur, wr, wc, fr, fq); S.done(cur);
        if (!has_next) break;
#pragma unroll
        for (int a = 0; a < 2; ++a)
#pragma unroll
            for (int b = 0; b < 2; ++b)
#pragma unroll
                for (int m = 0; m < 4; ++m)
#pragma unroll
                    for (int n = 0; n < 2; ++n) acc[a][b][m][n] = (f32x4){0.f, 0.f, 0.f, 0.f};
        cur = nxt; cA = nA; cB = nB; ++ui;
        if constexpr (ALIGN_EPI) { if (wr == 1) PG8_BAR; }
    }
    PG8_WAIT_V(0);
    if constexpr (!ALIGN_EPI) { if (wr == 0) PG8_BAR; }
    PG8_BAR;
#undef PG8_SA
#undef PG8_SB
#undef PG8_STAGE
#undef PG8_LDA
#undef PG8_LDB
#undef PG8_MMA
#undef PG8_WAIT_V
#undef PG8_WAIT_L
#undef PG8_BAR
#undef PG8_SCHED
}
}

using pg8::bf16_t; using pg8::f32x4; using pg8::u32x4; using pg8::u32x2; using pg8::Unit; using pg8::cvt_pk_bf16;
#define LAS __attribute__((address_space(3)))

constexpr int DM = 1024, TP = 4096, NTP = 16384, NTS = 256, NTOK = 16640, DEPTH = 4, NIN = 4864, DFF = 4096;
constexpr int NTHREADS = 512, LDS_BYTES = 147456;
constexpr size_t O_YP = 0, O_YS = 16777216, O_KVP0 = 17039360, O_KVP1 = 18087936, O_KVP2 = 22282240, O_POOLP = 39059456,
                 O_KVS0 = 39182336, O_KVS1 = 47570944, O_KVS2 = 81125376, O_POOLS = 215343104;
constexpr size_t WS_WIN = 0;
constexpr size_t WS_WPA = WS_WIN + (size_t)DEPTH * NIN * DM * 2;
constexpr size_t WS_WPB = WS_WPA + (size_t)DEPTH * DM * 256 * 2;
constexpr size_t WS_WO  = WS_WPB + (size_t)DEPTH * DM * 512 * 2;
constexpr size_t WS_WUP = WS_WO  + (size_t)DEPTH * DM * DM * 2;
constexpr size_t WS_WDN = WS_WUP + (size_t)DEPTH * DFF * DM * 2;
constexpr size_t WS_X   = WS_WDN + (size_t)DEPTH * DM * DFF * 2;
constexpr size_t WS_XB  = WS_X   + (size_t)NTOK * DM * 4;
constexpr size_t WS_QKV = WS_XB  + (size_t)NTOK * DM * 2;
constexpr size_t WS_U   = WS_QKV + (size_t)NTOK * 2304 * 2;
constexpr size_t WS_G   = WS_U   + (size_t)NTOK * 512 * 2;
constexpr size_t WS_OA  = WS_G   + (size_t)NTOK * 2048 * 2;
constexpr size_t WS_P   = WS_OA  + (size_t)NTOK * 256 * 2;
constexpr size_t WS_TMP = WS_P   + (size_t)NTOK * 512 * 2;
constexpr size_t WS_MIX = WS_TMP + (size_t)NTOK * DM * 4;
constexpr size_t WS_H   = WS_MIX + (size_t)NTOK * DM * 2;
constexpr size_t WS_SS  = WS_H   + (size_t)NTOK * DFF * 2;
constexpr size_t WS_ROPE = WS_SS + (size_t)9 * NTOK * 4;
constexpr size_t WS_BAR = WS_ROPE + (size_t)4104 * 16 * 4;
constexpr size_t WS_END = WS_BAR + (size_t)4096 * 4;

struct Params { const float* in[17]; float* out; unsigned char* ws; };

__device__ __forceinline__ void unpack8(const u32x4 w, float (&f)[8]) {
    f[0] = __uint_as_float(w.x << 16); f[1] = __uint_as_float(w.x & 0xffff0000u);
    f[2] = __uint_as_float(w.y << 16); f[3] = __uint_as_float(w.y & 0xffff0000u);
    f[4] = __uint_as_float(w.z << 16); f[5] = __uint_as_float(w.z & 0xffff0000u);
    f[6] = __uint_as_float(w.w << 16); f[7] = __uint_as_float(w.w & 0xffff0000u);
}
__device__ __forceinline__ u32x4 pack8(const float (&f)[8]) {
    u32x4 w; w.x = cvt_pk_bf16(f[0], f[1]); w.y = cvt_pk_bf16(f[2], f[3]); w.z = cvt_pk_bf16(f[4], f[5]); w.w = cvt_pk_bf16(f[6], f[7]); return w;
}
__device__ __forceinline__ float sigmoidf_(float x) { return 1.0f / (1.0f + __expf(-x)); }

struct EpiAll {
    static constexpr bool PERM = true, AFTER_DRAIN = false;
    int mode, layer, ssi, ssn; unsigned char* ws; float* out;

    struct Pre { u32x4 g; f32x4 a, b; float rs; };

    template <int MODE> __device__ __forceinline__ Pre pre(unsigned char* ws, int row, int c) const {
        Pre p;
        if constexpr (MODE == 0 || MODE == 4) p.rs = ((const float*)(ws + WS_SS) + (size_t)ssi * NTOK)[row];
        if constexpr (MODE == 1) p.g = *(const u32x4*)((const bf16_t*)(ws + WS_G) + (size_t)row * 2048 + c);
        if constexpr (MODE == 2) { p.g = *(const u32x4*)((const bf16_t*)(ws + WS_G) + (size_t)row * 2048 + 1024 + c);
            const float* tp = (const float*)(ws + WS_TMP) + (size_t)row * DM + c; p.a = *(const f32x4*)tp; p.b = *(const f32x4*)(tp + 4); }
        if constexpr (MODE == 3) { const float* xp = (const float*)(ws + WS_X) + (size_t)row * DM + c; p.a = *(const f32x4*)xp; p.b = *(const f32x4*)(xp + 4); }
        return p;
    }
    __device__ __forceinline__ void fin_proj(unsigned char* ws, int row, int c32, int fq, float (&v)[8], const Pre& p) const {
        const int pn = c32 >> 8, cl = (c32 & 255) + 8 * fq;
        const float rs = rsqrtf(p.rs * (1.0f / 1024.0f) + 1e-6f);
        const bool samp = row >= NTP;
        const int b = samp ? ((row - NTP) >> 3) : (row >> 12);
        const int t = samp ? (row & 7) : (row & 4095);
#pragma unroll
        for (int i = 0; i < 8; ++i) v[i] *= rs;
        if (pn < 6 && ((c32 >> 5) & 1) == 0) {
            float pv[8];
#pragma unroll
            for (int i = 0; i < 8; ++i) pv[i] = __shfl_xor(v[i], 16);
            if (fq < 2) {
                const int pi = samp ? (4096 + t) : t;
                const f32x4* rp = (const f32x4*)((const float*)(ws + WS_ROPE) + (size_t)pi * 16);
                const f32x4 c0 = rp[0], c1 = rp[1], s0 = rp[2], s1 = rp[3];
                const float sg = (fq == 0) ? -1.0f : 1.0f;
#pragma unroll
                for (int i = 0; i < 4; ++i) { v[i] = v[i] * c0[i] + sg * pv[i] * s0[i]; v[4 + i] = v[4 + i] * c1[i] + sg * pv[4 + i] * s1[i]; }
            }
        }
        if (pn >= 11) {
#pragma unroll
            for (int i = 0; i < 8; ++i) v[i] = sigmoidf_(v[i]);
        }
        bf16_t* dst; int ld, cbase;
        if (pn < 9) { dst = (bf16_t*)(ws + WS_QKV); ld = 2304; cbase = pn * 256; }
        else if (pn < 11) { dst = (bf16_t*)(ws + WS_U); ld = 512; cbase = (pn - 9) * 256; }
        else { dst = (bf16_t*)(ws + WS_G); ld = 2048; cbase = (pn - 11) * 256; }
        *(u32x4*)(dst + (size_t)row * ld + cbase + cl) = pack8(v);
        if (pn >= 3 && pn < 9) {
            const int kvi = pn - 3; const int g = (kvi >= 3) ? kvi - 3 : kvi; const int kv = (kvi >= 3) ? 1 : 0;
            const int W = 128 << (2 * g);
            const size_t okp = (g == 0) ? O_KVP0 : (g == 1 ? O_KVP1 : O_KVP2);
            const size_t oks = (g == 0) ? O_KVS0 : (g == 1 ? O_KVS1 : O_KVS2);
            float* op = nullptr;
            if (samp) op = out + oks + ((size_t)((layer * 32 + b) * W + (W - 8 + t)) * 2 + kv) * 256 + cl;
            else if (t >= TP - W) op = out + okp + ((size_t)((layer * 4 + b) * W + (t - (TP - W))) * 2 + kv) * 256 + cl;
            if (op) { *(f32x4*)op = (f32x4){v[0], v[1], v[2], v[3]}; *(f32x4*)(op + 4) = (f32x4){v[4], v[5], v[6], v[7]}; }
        } else if (pn >= 9 && pn < 11) {
            float* op = nullptr; const int c = cbase + cl;
            if (samp) op = out + O_POOLS + (size_t)((layer * 32 + b) * 15 + 7 + t) * 512 + c;
            else if (t >= TP - 15) op = out + O_POOLP + (size_t)((layer * 4 + b) * 15 + (t - (TP - 15))) * 512 + c;
            if (op) { *(f32x4*)op = (f32x4){v[0], v[1], v[2], v[3]}; *(f32x4*)(op + 4) = (f32x4){v[4], v[5], v[6], v[7]}; }
        }
    }
    template <int MODE> __device__ __forceinline__ void fin(unsigned char* ws, int row, int c32, int fq, float (&v)[8], const Pre& p) const {
        const int c = c32 + 8 * fq;
        if constexpr (MODE == 0) fin_proj(ws, row, c32, fq, v, p);
        if constexpr (MODE == 1) {
            float gg[8]; unpack8(p.g, gg);
            float* tp = (float*)(ws + WS_TMP) + (size_t)row * DM + c;
            *(f32x4*)tp = (f32x4){gg[0] * v[0], gg[1] * v[1], gg[2] * v[2], gg[3] * v[3]};
            *(f32x4*)(tp + 4) = (f32x4){gg[4] * v[4], gg[5] * v[5], gg[6] * v[6], gg[7] * v[7]};
        }
        if constexpr (MODE == 2) {
            float gg[8]; unpack8(p.g, gg);
#pragma unroll
            for (int i = 0; i < 4; ++i) { v[i] = p.a[i] + gg[i] * v[i]; v[4 + i] = p.b[i] + gg[4 + i] * v[4 + i]; }
            *(u32x4*)((bf16_t*)(ws + WS_MIX) + (size_t)row * DM + c) = pack8(v);
        }
        if constexpr (MODE == 3) {
            float* xp = (float*)(ws + WS_X) + (size_t)row * DM + c;
            float sq = 0.f;
#pragma unroll
            for (int i = 0; i < 4; ++i) { v[i] += p.a[i]; v[4 + i] += p.b[i]; }
#pragma unroll
            for (int i = 0; i < 8; ++i) sq += v[i] * v[i];
            *(f32x4*)xp = (f32x4){v[0], v[1], v[2], v[3]}; *(f32x4*)(xp + 4) = (f32x4){v[4], v[5], v[6], v[7]};
            *(u32x4*)((bf16_t*)(ws + WS_XB) + (size_t)row * DM + c) = pack8(v);
            sq += __shfl_xor(sq, 16); sq += __shfl_xor(sq, 32);
            if (fq == 0) atomicAdd((float*)(ws + WS_SS) + (size_t)ssn * NTOK + row, sq);
        }
        if constexpr (MODE == 4) {
            const float rs = rsqrtf(p.rs * (1.0f / 1024.0f) + 1e-6f);
#pragma unroll
            for (int i = 0; i < 8; ++i) { const float a = fmaxf(v[i] * rs, 0.f); v[i] = a * a; }
            *(u32x4*)((bf16_t*)(ws + WS_H) + (size_t)row * DFF + c) = pack8(v);
        }
    }
    __device__ __forceinline__ void chunk(unsigned char* ws, int row, int c32, int fq, float (&v)[8]) const {
        const int c = c32 + 8 * fq;
        switch (mode) {
            case 0: { const Pre p = pre<0>(ws, row, c); fin<0>(ws, row, c32, fq, v, p); } break;
            case 1: { const Pre p = pre<1>(ws, row, c); fin<1>(ws, row, c32, fq, v, p); } break;
            case 2: { const Pre p = pre<2>(ws, row, c); fin<2>(ws, row, c32, fq, v, p); } break;
            case 3: { const Pre p = pre<3>(ws, row, c); fin<3>(ws, row, c32, fq, v, p); } break;
            default: { const Pre p = pre<4>(ws, row, c); fin<4>(ws, row, c32, fq, v, p); } break;
        }
    }
    template <int MODE> __device__ __forceinline__ void tile(unsigned char* ws, const f32x4 (&acc)[2][2][4][2], const Unit& u, int wr, int wc, int fr, int fq) const {
        constexpr int MB = (MODE == 2 || MODE == 3) ? 2 : 4;
#pragma unroll
        for (int ai = 0; ai < 2; ++ai)
#pragma unroll
            for (int m0 = 0; m0 < 4; m0 += MB) {
                Pre p[MB][2];
#pragma unroll
                for (int mm = 0; mm < MB; ++mm)
#pragma unroll
                    for (int bj = 0; bj < 2; ++bj) p[mm][bj] = pre<MODE>(ws, u.pm * 256 + ai * 128 + wr * 64 + (m0 + mm) * 16 + fr, u.pn * 256 + bj * 128 + wc * 32 + 8 * fq);
#pragma unroll
                for (int mm = 0; mm < MB; ++mm)
#pragma unroll
                    for (int bj = 0; bj < 2; ++bj) {
                        float v[8];
#pragma unroll
                        for (int i = 0; i < 4; ++i) { v[i] = acc[ai][bj][m0 + mm][0][i]; v[4 + i] = acc[ai][bj][m0 + mm][1][i]; }
                        fin<MODE>(ws, u.pm * 256 + ai * 128 + wr * 64 + (m0 + mm) * 16 + fr, u.pn * 256 + bj * 128 + wc * 32, fq, v, p[mm][bj]);
                    }
                asm volatile("" ::: "memory");
            }
    }
    __device__ __forceinline__ void operator()(const f32x4 (&acc)[2][2][4][2], const Unit& u, int wr, int wc, int fr, int fq) const {
        asm volatile("" : "+v"(fr), "+v"(fq));
        unsigned char* ws = this->ws; asm volatile("" : "+s"(ws));
        switch (mode) {
            case 0: tile<0>(ws, acc, u, wr, wc, fr, fq); break;
            case 1: tile<1>(ws, acc, u, wr, wc, fr, fq); break;
            case 2: tile<2>(ws, acc, u, wr, wc, fr, fq); break;
            case 3: tile<3>(ws, acc, u, wr, wc, fr, fq); break;
            default: tile<4>(ws, acc, u, wr, wc, fr, fq); break;
        }
    }
};

__device__ __forceinline__ void skinny_gemm(LAS unsigned char* lds, const bf16_t* __restrict__ A, const bf16_t* __restrict__ Bt, int N, int K, const EpiAll& E, int first, int G) {
    using pg8::bf16x8;
    int tid = threadIdx.x; asm volatile("" : "+v"(tid));
    const int lane = tid & 63, w = __builtin_amdgcn_readfirstlane(tid >> 6), kg = lane >> 4, qn = lane & 15;
    const int nh = (N == 1024) ? 1 : 2, ksplit = 8 / nh;
    const int half = w % nh, kq = w / nh, Kq = K / ksplit, nsteps = Kq >> 5;
    unsigned char* ws = E.ws; asm volatile("" : "+s"(ws));
    LAS float* red = (LAS float*)lds;
    const int RB = 8 / nh, units = RB * (N >> 5);
#pragma unroll 1
    for (int u = first; u < units; u += G) {
        const int rb = u % RB, c32 = (u / RB) << 5;
        const int row0 = rb * 32 * nh + half * 32;
        const bf16_t* ap = A + (size_t)(row0 + qn) * K + kq * Kq + kg * 8;
        const bf16_t* bp = Bt + (size_t)(c32 + 8 * (qn >> 2) + (qn & 3)) * K + kq * Kq + kg * 8;
        f32x4 acc[2][2];
#pragma unroll
        for (int a = 0; a < 2; ++a)
#pragma unroll
            for (int b = 0; b < 2; ++b) acc[a][b] = (f32x4){0.f, 0.f, 0.f, 0.f};
#pragma unroll 8
        for (int ks = 0; ks < nsteps; ++ks) {
            const bf16x8 x0 = *(const bf16x8*)(ap + ks * 32), x1 = *(const bf16x8*)(ap + (size_t)16 * K + ks * 32);
            const bf16x8 w0 = *(const bf16x8*)(bp + ks * 32), w1 = *(const bf16x8*)(bp + (size_t)4 * K + ks * 32);
            acc[0][0] = __builtin_amdgcn_mfma_f32_16x16x32_bf16(w0, x0, acc[0][0], 0, 0, 0);
            acc[0][1] = __builtin_amdgcn_mfma_f32_16x16x32_bf16(w1, x0, acc[0][1], 0, 0, 0);
            acc[1][0] = __builtin_amdgcn_mfma_f32_16x16x32_bf16(w0, x1, acc[1][0], 0, 0, 0);
            acc[1][1] = __builtin_amdgcn_mfma_f32_16x16x32_bf16(w1, x1, acc[1][1], 0, 0, 0);
        }
        __syncthreads();
        if (kq != 0) {
#pragma unroll
            for (int a = 0; a < 2; ++a)
#pragma unroll
                for (int b = 0; b < 2; ++b)
#pragma unroll
                    for (int i = 0; i < 4; ++i) red[(w * 16 + a * 8 + b * 4 + i) * 64 + lane] = acc[a][b][i];
        }
        __syncthreads();
        if (kq == 0) {
#pragma unroll 1
            for (int q = 1; q < ksplit; ++q)
#pragma unroll
                for (int a = 0; a < 2; ++a)
#pragma unroll
                    for (int b = 0; b < 2; ++b)
#pragma unroll
                        for (int i = 0; i < 4; ++i) acc[a][b][i] += red[((w + nh * q) * 16 + a * 8 + b * 4 + i) * 64 + lane];
#pragma unroll
            for (int a = 0; a < 2; ++a) {
                float v[8];
#pragma unroll
                for (int i = 0; i < 4; ++i) { v[i] = acc[a][0][i]; v[4 + i] = acc[a][1][i]; }
                E.chunk(ws, NTP + row0 + a * 16 + qn, c32, kg, v);
            }
        }
    }
    __syncthreads();
}

__device__ __forceinline__ void lds_wait() { asm volatile("s_waitcnt lgkmcnt(0)" ::: "memory"); }
__device__ __forceinline__ void transpose_item(const float* __restrict__ W, const float* __restrict__ gsc, int K, int N, bf16_t* __restrict__ WT, LAS float* scr, int item, int lane) {
    const int nblk = N / 64, kb = item / nblk, nb = item % nblk, k0 = 64 * kb, n0 = 64 * nb;
    f32x4 v[16];
#pragma unroll
    for (int i = 0; i < 16; ++i) v[i] = *(const f32x4*)(W + (size_t)(k0 + 4 * i + (lane >> 4)) * N + n0 + 4 * (lane & 15));
#pragma unroll
    for (int i = 0; i < 16; ++i) { const int kk = 4 * i + (lane >> 4); const float sc = gsc ? gsc[k0 + kk] : 1.0f; LAS float* d = scr + kk * 65 + 4 * (lane & 15);
        d[0] = v[i][0] * sc; d[1] = v[i][1] * sc; d[2] = v[i][2] * sc; d[3] = v[i][3] * sc; }
    lds_wait();
    const int c = lane & 7;
#pragma unroll
    for (int j = 0; j < 8; ++j) { const int n = (lane >> 3) + 8 * j; const LAS float* sp = scr + (8 * c) * 65 + n;
        u32x4 o; o.x = cvt_pk_bf16(sp[0 * 65], sp[1 * 65]); o.y = cvt_pk_bf16(sp[2 * 65], sp[3 * 65]); o.z = cvt_pk_bf16(sp[4 * 65], sp[5 * 65]); o.w = cvt_pk_bf16(sp[6 * 65], sp[7 * 65]);
        *(u32x4*)(WT + (size_t)(n0 + n) * K + k0 + 8 * c) = o; }
    lds_wait();
}

template <int L>
__device__ __forceinline__ void copy_shift(const float* __restrict__ src, float* __restrict__ dst, int layer, size_t gtid, size_t nth) {
    constexpr size_t per = (size_t)(L - 8) * 128;
    constexpr size_t total = (size_t)32 * per;
    constexpr int U = 8;
    const f32x4* s4 = (const f32x4*)src + (size_t)layer * 32 * L * 128; f32x4* d4 = (f32x4*)dst + (size_t)layer * 32 * L * 128;
    for (size_t i = gtid; i < total; i += nth * U) {
        f32x4 v[U];
#pragma unroll
        for (int u = 0; u < U; ++u) { const size_t idx = i + u * nth; const size_t ii = idx < total ? idx : 0; const size_t lb = ii / per, r = ii - lb * per;
            v[u] = __builtin_nontemporal_load(s4 + lb * (size_t)L * 128 + r + 8 * 128); }
#pragma unroll
        for (int u = 0; u < U; ++u) { const size_t idx = i + u * nth; if (idx < total) { const size_t lb = idx / per, r = idx - lb * per; __builtin_nontemporal_store(v[u], d4 + lb * (size_t)L * 128 + r); } }
    }
}

#define ATT_DOT(S, Q, KF) do { float _s = 0.f; _Pragma("unroll") for (int _i = 0; _i < 8; ++_i) _s += Q[_i] * KF[_i]; \
    _s += __shfl_xor(_s, 1); _s += __shfl_xor(_s, 2); _s += __shfl_xor(_s, 4); S = _s; } while (0)

__device__ __forceinline__ void attn_finish(float m, float l, float (&o)[8], bf16_t* dstp, int kg) {
    float M = m; M = fmaxf(M, __shfl_xor(M, 8)); M = fmaxf(M, __shfl_xor(M, 16)); M = fmaxf(M, __shfl_xor(M, 32));
    const float f = __expf(m - M); l *= f;
#pragma unroll
    for (int i = 0; i < 8; ++i) o[i] *= f;
    l += __shfl_xor(l, 8); l += __shfl_xor(l, 16); l += __shfl_xor(l, 32);
#pragma unroll
    for (int i = 0; i < 8; ++i) { o[i] += __shfl_xor(o[i], 8); o[i] += __shfl_xor(o[i], 16); o[i] += __shfl_xor(o[i], 32); }
    const float inv = 1.0f / l;
#pragma unroll
    for (int i = 0; i < 8; ++i) o[i] *= inv;
    if (kg == 0) *(u32x4*)dstp = pack8(o);
}

__device__ __forceinline__ void attn_prompt_item(const bf16_t* __restrict__ qkv, bf16_t* __restrict__ oa, int token, int h, int lane) {
    const int kg = lane >> 3, dl = lane & 7;
    const int b = token >> 12, t = token & 4095;
    const bf16_t* qrow = qkv + (size_t)token * 2304 + h * 64 + dl * 8;
    const bf16_t* kbase = qkv + (size_t)(b << 12) * 2304 + 768 + h * 64 + dl * 8;
    float m = -1e30f, l = 0.f; float o[8];
#pragma unroll
    for (int i = 0; i < 8; ++i) o[i] = 0.f;
#pragma unroll 1
    for (int g = 0; g < 3; ++g) {
        const int d = 1 << (2 * g);
        float q[8]; unpack8(*(const u32x4*)(qrow + g * 256), q);
#pragma unroll
        for (int i = 0; i < 8; ++i) q[i] *= 0.125f;
        const bf16_t* kb = kbase + g * 256;
#pragma unroll 1
        for (int it = 0; it < 16; it += 4) {
            u32x4 kr[4], vr[4]; bool val[4];
#pragma unroll
            for (int u = 0; u < 4; ++u) { const int j = (it + u) * 8 + kg; const int pos = t - j * d; val[u] = pos >= 0; const bf16_t* r = kb + (size_t)(pos < 0 ? 0 : pos) * 2304;
                kr[u] = *(const u32x4*)r; vr[u] = *(const u32x4*)(r + 768); }
            float s[4];
#pragma unroll
            for (int u = 0; u < 4; ++u) { float kf[8]; unpack8(kr[u], kf); ATT_DOT(s[u], q, kf); if (!val[u]) s[u] = -1e30f; }
            const float mb = fmaxf(fmaxf(m, fmaxf(s[0], s[1])), fmaxf(s[2], s[3]));
            const float corr = __expf(m - mb);
            l *= corr;
#pragma unroll
            for (int i = 0; i < 8; ++i) o[i] *= corr;
#pragma unroll
            for (int u = 0; u < 4; ++u) { const float p = val[u] ? __expf(s[u] - mb) : 0.f; l += p; float vf[8]; unpack8(vr[u], vf);
#pragma unroll
                for (int i = 0; i < 8; ++i) o[i] += p * vf[i]; }
            m = mb;
        }
    }
    {
        const int g = kg < 2 ? kg : 2; const int d = 1 << (2 * g);
        const int pos = t - 128 * d; const bool val = (kg < 3) && (pos >= 0);
        float q[8]; unpack8(*(const u32x4*)(qrow + g * 256), q);
        const bf16_t* r = kbase + g * 256 + (size_t)(pos < 0 ? 0 : pos) * 2304;
        float kf[8], vf[8]; unpack8(*(const u32x4*)r, kf); unpack8(*(const u32x4*)(r + 768), vf);
        float s; ATT_DOT(s, q, kf); s *= 0.125f;
        if (!val) s = -1e30f;
        const float mb = fmaxf(m, s); const float corr = __expf(m - mb); const float p = val ? __expf(s - mb) : 0.f;
        l = l * corr + p;
#pragma unroll
        for (int i = 0; i < 8; ++i) o[i] = o[i] * corr + p * vf[i];
        m = mb;
    }
    attn_finish(m, l, o, oa + (size_t)token * 256 + h * 64 + dl * 8, kg);
}

__device__ __forceinline__ void sample_kv(const bf16_t* __restrict__ newb, const float* __restrict__ cb, int W, int idx, float (&kf)[8], float (&vf)[8]) {
    if (idx >= W) { const bf16_t* r = newb + (size_t)(idx - W) * 2304; unpack8(*(const u32x4*)r, kf); unpack8(*(const u32x4*)(r + 768), vf); }
    else { const float* r = cb + (size_t)idx * 512; const f32x4 a = *(const f32x4*)r, b2 = *(const f32x4*)(r + 4), c = *(const f32x4*)(r + 256), d2 = *(const f32x4*)(r + 260);
#pragma unroll
        for (int i = 0; i < 4; ++i) { kf[i] = a[i]; kf[4 + i] = b2[i]; vf[i] = c[i]; vf[4 + i] = d2[i]; } }
}
__device__ __forceinline__ void attn_sample_sub(const bf16_t* __restrict__ qkv, const float* __restrict__ cg_, bf16_t* __restrict__ PO, float* __restrict__ LSE,
                                                int layer, int stok, int h, int g, int lane) {
    const int kg = lane >> 3, dl = lane & 7;
    const int b = stok >> 3, t = stok & 7;
    const int token = NTP + stok;
    const int d = 1 << (2 * g), W = 128 << (2 * g);
    const bf16_t* nb = qkv + (size_t)(NTP + b * 8) * 2304 + 768 + g * 256 + h * 64 + dl * 8;
    const float* cb = cg_ + (size_t)(layer * 32 + b) * W * 512 + h * 64 + dl * 8;
    float q[8]; unpack8(*(const u32x4*)(qkv + (size_t)token * 2304 + g * 256 + h * 64 + dl * 8), q);
#pragma unroll
    for (int i = 0; i < 8; ++i) q[i] *= 0.125f;
    float m = -1e30f, l = 0.f; float o[8];
#pragma unroll
    for (int i = 0; i < 8; ++i) o[i] = 0.f;
#pragma unroll 1
    for (int it = 0; it < 16; it += 8) {
        float kf[8][8], vf[8][8], s[8];
#pragma unroll
        for (int u = 0; u < 8; ++u) { const int j = (it + u) * 8 + kg; sample_kv(nb, cb, W, W + t - j * d, kf[u], vf[u]); }
        float mb = m;
#pragma unroll
        for (int u = 0; u < 8; ++u) { ATT_DOT(s[u], q, kf[u]); mb = fmaxf(mb, s[u]); }
        const float corr = __expf(m - mb);
        l *= corr;
#pragma unroll
        for (int i = 0; i < 8; ++i) o[i] *= corr;
#pragma unroll
        for (int u = 0; u < 8; ++u) { const float p = __expf(s[u] - mb); l += p;
#pragma unroll
            for (int i = 0; i < 8; ++i) o[i] += p * vf[u][i]; }
        m = mb;
    }
    {
        const bool val = kg == 0;
        float kf[8], vf[8]; sample_kv(nb, cb, W, W + t - 128 * d, kf, vf);
        float s; ATT_DOT(s, q, kf);
        if (!val) s = -1e30f;
        const float mb = fmaxf(m, s); const float corr = __expf(m - mb); const float p = val ? __expf(s - mb) : 0.f;
        l = l * corr + p;
#pragma unroll
        for (int i = 0; i < 8; ++i) o[i] = o[i] * corr + p * vf[i];
        m = mb;
    }
    float M = m; M = fmaxf(M, __shfl_xor(M, 8)); M = fmaxf(M, __shfl_xor(M, 16)); M = fmaxf(M, __shfl_xor(M, 32));
    const float f = __expf(m - M); l *= f;
#pragma unroll
    for (int i = 0; i < 8; ++i) o[i] *= f;
    l += __shfl_xor(l, 8); l += __shfl_xor(l, 16); l += __shfl_xor(l, 32);
#pragma unroll
    for (int i = 0; i < 8; ++i) { o[i] += __shfl_xor(o[i], 8); o[i] += __shfl_xor(o[i], 16); o[i] += __shfl_xor(o[i], 32); }
    const float inv = 1.0f / l;
#pragma unroll
    for (int i = 0; i < 8; ++i) o[i] *= inv;
    if (kg == 0) *(u32x4*)(PO + ((size_t)g * NTOK + token) * 256 + h * 64 + dl * 8) = pack8(o);
    if (lane == 0) LSE[((size_t)g * NTOK + token) * 4 + h] = M + __logf(l);
}

constexpr int ATT_PITCH = 144, ATT_ROWS = 272, ATT_VOFF = ATT_ROWS * ATT_PITCH;
typedef short s16x4 __attribute__((ext_vector_type(4)));
template <int OFF> __device__ __forceinline__ s16x4 tr_read(unsigned addr) { s16x4 r; asm volatile("ds_read_b64_tr_b16 %0, %1 offset:%2" : "=v"(r) : "v"(addr), "n"(OFF) : "memory"); return r; }
__device__ __forceinline__ void tr_wait8(s16x4& a, s16x4& b, s16x4& c, s16x4& d, s16x4& e, s16x4& f, s16x4& g, s16x4& h) {
    asm volatile("s_waitcnt lgkmcnt(0)" : "+v"(a), "+v"(b), "+v"(c), "+v"(d), "+v"(e), "+v"(f), "+v"(g), "+v"(h) :: "memory"); }

__device__ __forceinline__ void attn_mfma_phase(LAS unsigned char* lds, const bf16_t* __restrict__ QKV, bf16_t* __restrict__ PO, float* __restrict__ LSE, int bid, int G, int tid) {
    using pg8::bf16x8;
    const int lane = tid & 63, w = __builtin_amdgcn_readfirstlane(tid >> 6), kg = lane >> 4, qn = lane & 15;
    for (int i = tid; i < 2 * 144; i += NTHREADS) { const int kv = i / 144, rem = i - kv * 144; *(LAS u32x4*)(lds + kv * ATT_VOFF + 256 * ATT_PITCH + rem * 16) = (u32x4){0u, 0u, 0u, 0u}; }
    const unsigned vaddr = (unsigned)(uintptr_t)(lds + ATT_VOFF + (16 * w + 4 * kg + (qn >> 2)) * ATT_PITCH + (lane & 3) * 8);
    const float csc = 0.125f * 1.44269504089f;
#define ATT_DECODE(U, b_, h_, g_, r_, I0_) do { const int _bh = (U) / 96, _rest = (U) - _bh * 96; b_ = _bh >> 2; h_ = _bh & 3; \
        if (_rest < 32) { g_ = 0; r_ = 0; I0_ = 128 * _rest; } else if (_rest < 64) { g_ = 1; r_ = (_rest - 32) >> 3; I0_ = 128 * ((_rest - 32) & 7); } else { g_ = 2; r_ = (_rest - 64) >> 1; I0_ = 128 * ((_rest - 64) & 1); } } while (0)
#define ATT_FETCH(U) do { int _b, _h, _g, _r, _I0; ATT_DECODE(U, _b, _h, _g, _r, _I0); const int _d = 1 << (2 * _g); \
        _Pragma("unroll") for (int i = 0; i < 8; ++i) { const int kv = i >> 2, row = (tid >> 3) + 64 * (i & 3), ch = tid & 7; const int I = _I0 - 128 + row; \
            pf[i] = (u32x4){0u, 0u, 0u, 0u}; \
            if (I >= 0) pf[i] = *(const u32x4*)(QKV + (size_t)(_b * 4096 + _r + _d * I) * 2304 + 768 + kv * 768 + _g * 256 + _h * 64 + ch * 8); } \
        const bf16_t* _qp = QKV + ((size_t)_b * 4096 + _r + _d * (_I0 + 16 * w + qn)) * 2304 + _g * 256 + _h * 64 + kg * 8; \
        qf0 = *(const bf16x8*)_qp; qf1 = *(const bf16x8*)(_qp + 32); } while (0)
    u32x4 pf[8]; bf16x8 qf0, qf1;
    if (bid < 1536) ATT_FETCH(bid);
#pragma unroll 1
    for (int u = bid; u < 1536; u += G) {
        int b, h, g, r, I0; ATT_DECODE(u, b, h, g, r, I0);
        const int d = 1 << (2 * g);
        __syncthreads();
#pragma unroll
        for (int i = 0; i < 8; ++i) { const int kv = i >> 2, row = (tid >> 3) + 64 * (i & 3), ch = tid & 7; *(LAS u32x4*)(lds + kv * ATT_VOFF + row * ATT_PITCH + ch * 16) = pf[i]; }
        const bf16x8 q0 = qf0, q1 = qf1;
        __syncthreads();
        if (u + G < 1536) ATT_FETCH(u + G);
        const int Iq = I0 + 16 * w + qn; const size_t tokq = (size_t)b * 4096 + r + d * Iq;
        f32x4 sc[9];
        const LAS unsigned char* kb = lds + (16 * w + qn) * ATT_PITCH + kg * 16;
#pragma unroll
        for (int kt = 0; kt < 9; ++kt) { const bf16x8 k0 = *(const LAS bf16x8*)(kb + kt * 16 * ATT_PITCH), k1 = *(const LAS bf16x8*)(kb + kt * 16 * ATT_PITCH + 64);
            f32x4 z = (f32x4){0.f, 0.f, 0.f, 0.f}; z = __builtin_amdgcn_mfma_f32_16x16x32_bf16(k0, q0, z, 0, 0, 0); sc[kt] = __builtin_amdgcn_mfma_f32_16x16x32_bf16(k1, q1, z, 0, 0, 0); }
        const int jb = 128 + qn - 4 * kg, ikb = I0 - 128 + 16 * w + 4 * kg;
        float m = -1e30f;
#pragma unroll
        for (int kt = 0; kt < 9; ++kt)
#pragma unroll
            for (int i = 0; i < 4; ++i) { const int j = jb - 16 * kt - i; const bool val = (j >= 0) && (j <= 128) && (ikb + 16 * kt + i >= 0); sc[kt][i] = val ? sc[kt][i] : -1e30f; m = fmaxf(m, sc[kt][i]); }
        m = fmaxf(m, __shfl_xor(m, 16)); m = fmaxf(m, __shfl_xor(m, 32));
        const float mc = m * csc; float l = 0.f;
        unsigned pk[10][2];
#pragma unroll
        for (int kt = 0; kt < 9; ++kt) { float p[4];
#pragma unroll
            for (int i = 0; i < 4; ++i) { p[i] = (sc[kt][i] > -1e29f) ? __builtin_amdgcn_exp2f(sc[kt][i] * csc - mc) : 0.f; l += p[i]; }
            pk[kt][0] = cvt_pk_bf16(p[0], p[1]); pk[kt][1] = cvt_pk_bf16(p[2], p[3]); }
        pk[9][0] = 0u; pk[9][1] = 0u;
        l += __shfl_xor(l, 16); l += __shfl_xor(l, 32);
        f32x4 o[4];
#pragma unroll
        for (int dt = 0; dt < 4; ++dt) o[dt] = (f32x4){0.f, 0.f, 0.f, 0.f};
#define ATT_PV(KK) do { s16x4 a0 = tr_read<(KK) * 32 * ATT_PITCH + 0>(vaddr), a1 = tr_read<(KK) * 32 * ATT_PITCH + 32>(vaddr), a2 = tr_read<(KK) * 32 * ATT_PITCH + 64>(vaddr), a3 = tr_read<(KK) * 32 * ATT_PITCH + 96>(vaddr); \
            s16x4 c0 = tr_read<(KK) * 32 * ATT_PITCH + 16 * ATT_PITCH + 0>(vaddr), c1 = tr_read<(KK) * 32 * ATT_PITCH + 16 * ATT_PITCH + 32>(vaddr), c2 = tr_read<(KK) * 32 * ATT_PITCH + 16 * ATT_PITCH + 64>(vaddr), c3 = tr_read<(KK) * 32 * ATT_PITCH + 16 * ATT_PITCH + 96>(vaddr); \
            tr_wait8(a0, a1, a2, a3, c0, c1, c2, c3); \
            u32x4 pw; pw.x = pk[2 * (KK)][0]; pw.y = pk[2 * (KK)][1]; pw.z = pk[2 * (KK) + 1][0]; pw.w = pk[2 * (KK) + 1][1]; \
            const bf16x8 pf = __builtin_bit_cast(bf16x8, pw); \
            o[0] = __builtin_amdgcn_mfma_f32_16x16x32_bf16(__builtin_shufflevector(a0, c0, 0, 1, 2, 3, 4, 5, 6, 7), pf, o[0], 0, 0, 0); \
            o[1] = __builtin_amdgcn_mfma_f32_16x16x32_bf16(__builtin_shufflevector(a1, c1, 0, 1, 2, 3, 4, 5, 6, 7), pf, o[1], 0, 0, 0); \
            o[2] = __builtin_amdgcn_mfma_f32_16x16x32_bf16(__builtin_shufflevector(a2, c2, 0, 1, 2, 3, 4, 5, 6, 7), pf, o[2], 0, 0, 0); \
            o[3] = __builtin_amdgcn_mfma_f32_16x16x32_bf16(__builtin_shufflevector(a3, c3, 0, 1, 2, 3, 4, 5, 6, 7), pf, o[3], 0, 0, 0); } while (0)
        ATT_PV(0); ATT_PV(1); ATT_PV(2); ATT_PV(3); ATT_PV(4);
        const float il = 1.0f / l;
        bf16_t* op = PO + ((size_t)g * NTOK + tokq) * 256 + h * 64 + 4 * kg;
#pragma unroll
        for (int dt = 0; dt < 4; ++dt) { u32x2 wv; wv.x = cvt_pk_bf16(o[dt][0] * il, o[dt][1] * il); wv.y = cvt_pk_bf16(o[dt][2] * il, o[dt][3] * il); *(u32x2*)(op + 16 * dt) = wv; }
        if (kg == 0) LSE[((size_t)g * NTOK + tokq) * 4 + h] = m * 0.125f + __logf(l);
    }
#undef ATT_PV
#undef ATT_FETCH
#undef ATT_DECODE
}

#define XB_TMO      128
#define XB_XCNT(j)  (256  + 64 * (j))
#define XB_XSUB(j)  (1280 + 64 * (j))
#define XB_XGEN(j)  (2304 + 64 * (j))
#define XB_TOP      3328
#define XB_TOPGEN   3392
#define XCD_BAR_WORDS 3456
#define XB_SPIN_CAP (1u << 20)
__device__ __forceinline__ unsigned xb_ld(unsigned* p)              { return __hip_atomic_load(p, __ATOMIC_RELAXED, __HIP_MEMORY_SCOPE_AGENT); }
__device__ __forceinline__ unsigned xb_add(unsigned* p, unsigned v) { return __hip_atomic_fetch_add(p, v, __ATOMIC_RELAXED, __HIP_MEMORY_SCOPE_AGENT); }
__device__ __forceinline__ unsigned xb_xcc_id() { return (unsigned)__builtin_amdgcn_s_getreg((3 << 11) | 20) & 0xFu; }
#define XB_SPIN(cond, bar) do { unsigned _sp = 0; while (cond) { __builtin_amdgcn_s_sleep(1); \
    if ((++_sp & 255u) == 0u) { if (xb_ld(&(bar)[XB_TMO])) break; if (_sp > XB_SPIN_CAP) { atomicAdd(&(bar)[XB_TMO], 1u); break; } } } } while (0)
struct XcdBarrier { unsigned* bar; unsigned x; volatile LAS unsigned* st; };
__device__ __forceinline__ XcdBarrier xcd_barrier_post(unsigned* bar, volatile LAS unsigned* st) {
    XcdBarrier b; b.bar = bar; b.x = xb_xcc_id(); b.st = st;
    if (threadIdx.x == 0) (void)xb_add(&bar[XB_XCNT(b.x)], 1u);
    return b;
}
__device__ __forceinline__ void xcd_barrier_complete(unsigned* bar, unsigned x, unsigned& nloc, unsigned& nx) {
    const unsigned G = gridDim.x * gridDim.y * gridDim.z;
    unsigned sum, cnt, mine, sp = 0u;
    for (;;) {
        sum = 0u; cnt = 0u; mine = 0u;
#pragma unroll
        for (unsigned j = 0; j < 16; ++j) { const unsigned c = xb_ld(&bar[XB_XCNT(j)]); sum += c; cnt += (c > 0u) ? 1u : 0u; mine = (j == x) ? c : mine; }
        if (sum == G) break;
        __builtin_amdgcn_s_sleep(1);
        if ((++sp & 255u) == 0u) { if (xb_ld(&bar[XB_TMO])) break; if (sp > XB_SPIN_CAP) { atomicAdd(&bar[XB_TMO], 1u); break; } }
    }
    nloc = mine > 0u ? mine : 1u; nx = cnt > 0u ? cnt : 1u;
}
__device__ __forceinline__ void xcd_barrier(const XcdBarrier& b) {
    asm volatile("s_waitcnt vmcnt(0)" ::: "memory");
    __syncthreads();
    if (threadIdx.x == 0) {
        unsigned* bar = b.bar;
        __builtin_amdgcn_s_waitcnt(0);
        unsigned nloc = b.st[0], nx = b.st[1];
        if (nloc == 0u) { xcd_barrier_complete(bar, b.x, nloc, nx); b.st[0] = nloc; b.st[1] = nx; }
        const unsigned old = xb_add(&bar[XB_XSUB(b.x)], 1u);
        const unsigned gen = old / nloc;
        if (old + 1u == (gen + 1u) * nloc) {
            __builtin_amdgcn_fence(__ATOMIC_RELEASE, "agent");
            asm volatile("s_waitcnt vmcnt(0)" ::: "memory");
            const unsigned og = xb_add(&bar[XB_TOP], 1u);
            const unsigned tg = og / nx;
            if (og + 1u == (tg + 1u) * nx) xb_add(&bar[XB_TOPGEN], 1u);
            else XB_SPIN(xb_ld(&bar[XB_TOPGEN]) == tg, bar);
            __builtin_amdgcn_fence(__ATOMIC_ACQUIRE, "agent");
            xb_add(&bar[XB_XGEN(b.x)], 1u);
            asm volatile("s_waitcnt vmcnt(0)" ::: "memory");
        } else {
            XB_SPIN(xb_ld(&bar[XB_XGEN(b.x)]) == gen, bar);
            __builtin_amdgcn_fence(__ATOMIC_ACQUIRE, "agent");
            asm volatile("s_waitcnt vmcnt(0)" ::: "memory");
        }
    }
    __syncthreads();
}

__global__ void __launch_bounds__(NTHREADS, 2) fwd_megakernel(Params P) {
    extern __shared__ __attribute__((aligned(16))) unsigned char lds_raw[];
    LAS unsigned char* lds = (LAS unsigned char*)lds_raw;
    cg::grid_group grid = cg::this_grid();
    const int tid = threadIdx.x, lane = tid & 63, wave = __builtin_amdgcn_readfirstlane(tid >> 6);
    const int G = gridDim.x, bid = blockIdx.x;
    const int gw = bid * 8 + wave, NGW = G * 8;
    const size_t gtid = (size_t)bid * NTHREADS + tid, nth = (size_t)G * NTHREADS;
    unsigned char* ws = P.ws;
    bf16_t* Wt_in = (bf16_t*)(ws + WS_WIN); bf16_t* Wt_pa = (bf16_t*)(ws + WS_WPA); bf16_t* Wt_pb = (bf16_t*)(ws + WS_WPB);
    bf16_t* Wt_o = (bf16_t*)(ws + WS_WO); bf16_t* Wt_up = (bf16_t*)(ws + WS_WUP); bf16_t* Wt_dn = (bf16_t*)(ws + WS_WDN);
    float* X = (float*)(ws + WS_X); bf16_t* XB = (bf16_t*)(ws + WS_XB); bf16_t* QKV = (bf16_t*)(ws + WS_QKV); bf16_t* UB = (bf16_t*)(ws + WS_U);
    bf16_t* GT = (bf16_t*)(ws + WS_G); bf16_t* OA = (bf16_t*)(ws + WS_OA); bf16_t* PB = (bf16_t*)(ws + WS_P); float* TMP = (float*)(ws + WS_TMP);
    bf16_t* MIX = (bf16_t*)(ws + WS_MIX); bf16_t* HID = (bf16_t*)(ws + WS_H); float* SS = (float*)(ws + WS_SS); float* ROPE = (float*)(ws + WS_ROPE);
    float* out = P.out;
    volatile LAS unsigned* bst = (volatile LAS unsigned*)(lds + LDS_BYTES - 16);
    if (tid == 0) { bst[0] = 0u; bst[1] = 0u; }
    __syncthreads();
    const XcdBarrier xb = xcd_barrier_post((unsigned*)(ws + WS_BAR), bst);

    {
        LAS float* LsT = (LAS float*)lds;
        LAS float* Ws = LsT + 128 * 128;
        for (int item = bid; item < DEPTH * 4 * 16; item += G) {
            const int l = item >> 6, g = (item >> 4) & 3, n0 = (item & 15) * 64;
            const float* lin = P.in[10] + (size_t)(l * 4 + g) * 128 * 128;
            const float* sc = P.in[11] + l * 512 + g * 128;
            const float* wpb = P.in[9] + (size_t)l * 512 * 1024 + (size_t)g * 128 * 1024;
            for (int i = tid; i < 128 * 128; i += NTHREADS) { const int c = i >> 7, d = i & 127; LsT[d * 128 + c] = lin[i] * sc[d]; }
            for (int i = tid; i < 128 * 64; i += NTHREADS) { const int d = i >> 6, n = i & 63; Ws[i] = wpb[(size_t)d * 1024 + n0 + n]; }
            __syncthreads();
            const int n = tid & 63, cgp = tid >> 6;
            float a[16];
#pragma unroll
            for (int i = 0; i < 16; ++i) a[i] = 0.f;
            for (int d = 0; d < 128; ++d) {
                const float w = Ws[d * 64 + n];
                const LAS f32x4* lp = (const LAS f32x4*)(LsT + d * 128 + cgp * 16);
#pragma unroll
                for (int q4 = 0; q4 < 4; ++q4) { const f32x4 lv = lp[q4];
#pragma unroll
                    for (int i = 0; i < 4; ++i) a[q4 * 4 + i] += lv[i] * w; }
            }
            bf16_t* op = Wt_pb + ((size_t)l * 1024 + n0 + n) * 512 + g * 128 + cgp * 16;
            u32x4 o0, o1; o0.x = cvt_pk_bf16(a[0], a[1]); o0.y = cvt_pk_bf16(a[2], a[3]); o0.z = cvt_pk_bf16(a[4], a[5]); o0.w = cvt_pk_bf16(a[6], a[7]);
            o1.x = cvt_pk_bf16(a[8], a[9]); o1.y = cvt_pk_bf16(a[10], a[11]); o1.z = cvt_pk_bf16(a[12], a[13]); o1.w = cvt_pk_bf16(a[14], a[15]);
            *(u32x4*)op = o0; *(u32x4*)(op + 8) = o1;
            __syncthreads();
        }
        {
            LAS float* scr = (LAS float*)(lds + wave * 16640);
            constexpr int I_IN = 16 * 76, I_PA = 4 * 16, I_O = 16 * 16, I_UP = 16 * 64, I_DN = 64 * 16, I_L = I_IN + I_PA + I_O + I_UP + I_DN;
            for (int it = gw; it < DEPTH * I_L; it += NGW) {
                const int l = it / I_L; int r = it - l * I_L;
                if (r < I_IN) { transpose_item(P.in[7] + (size_t)l * DM * NIN, P.in[6] + l * DM, DM, NIN, Wt_in + (size_t)l * NIN * DM, scr, r, lane); continue; } r -= I_IN;
                if (r < I_PA) { transpose_item(P.in[8] + (size_t)l * 256 * DM, nullptr, 256, DM, Wt_pa + (size_t)l * DM * 256, scr, r, lane); continue; } r -= I_PA;
                if (r < I_O) { transpose_item(P.in[12] + (size_t)l * DM * DM, nullptr, DM, DM, Wt_o + (size_t)l * DM * DM, scr, r, lane); continue; } r -= I_O;
                if (r < I_UP) { transpose_item(P.in[14] + (size_t)l * DM * DFF, P.in[13] + l * DM, DM, DFF, Wt_up + (size_t)l * DFF * DM, scr, r, lane); continue; } r -= I_UP;
                transpose_item(P.in[15] + (size_t)l * DFF * DM, nullptr, DFF, DM, Wt_dn + (size_t)l * DM * DFF, scr, r, lane);
            }
        }
        for (int row = gw; row < NTOK; row += NGW) {
            const float* src = row < NTP ? P.in[0] + (size_t)row * DM : P.in[1] + (size_t)(row - NTP) * DM;
            float s = 0.f;
#pragma unroll
            for (int j = 0; j < 4; ++j) { const f32x4 v = *(const f32x4*)(src + 4 * lane + 256 * j); s += v[0] * v[0] + v[1] * v[1] + v[2] * v[2] + v[3] * v[3];
                *(f32x4*)(X + (size_t)row * DM + 4 * lane + 256 * j) = v;
                u32x2 w; w.x = cvt_pk_bf16(v[0], v[1]); w.y = cvt_pk_bf16(v[2], v[3]); *(u32x2*)(XB + (size_t)row * DM + 4 * lane + 256 * j) = w; }
#pragma unroll
            for (int o = 1; o < 64; o <<= 1) s += __shfl_xor(s, o);
            if (lane == 0) SS[row] = s;
        }
        for (size_t i = gtid; i < 4104 * 8; i += nth) { const int pi = (int)(i >> 3), k = (int)(i & 7); const float pos = (float)(pi < 4096 ? pi : 8192 + pi - 4096);
            const float inv = powf(500000.0f, -(float)(2 * k) / 16.0f); const float ang = pos * inv; ROPE[pi * 16 + k] = cosf(ang); ROPE[pi * 16 + 8 + k] = sinf(ang); }
        for (size_t i = gtid; i < (size_t)8 * NTOK; i += nth) SS[NTOK + i] = 0.f;
        for (size_t i = gtid; i < (size_t)DEPTH * 32 * 7 * 128; i += nth) { const size_t lb = i / (7 * 128), r = i - lb * (7 * 128);
            *(f32x4*)(out + O_POOLS + lb * 15 * 512 + r * 4) = *(const f32x4*)(P.in[5] + lb * 15 * 512 + 8 * 512 + r * 4); }
    }
    grid.sync();

    pg8::StaticOrder S;
#pragma unroll 1
    for (int step = 0; step < DEPTH * 7; ++step) {
        const int layer = step / 7, st = step - layer * 7;
        if (st == 1) {
            int tid_l = threadIdx.x; asm volatile("" : "+v"(tid_l));
            const int lane = tid_l & 63, gw = bid * 8 + (tid_l >> 6);
            const size_t gtid = (size_t)bid * NTHREADS + tid_l;
            unsigned char* wsl = ws; asm volatile("" : "+s"(wsl));
            bf16_t* QKV = (bf16_t*)(wsl + WS_QKV); bf16_t* UB = (bf16_t*)(wsl + WS_U); bf16_t* OA = (bf16_t*)(wsl + WS_OA); bf16_t* PB = (bf16_t*)(wsl + WS_P);
            bf16_t* PO = (bf16_t*)(wsl + WS_TMP); float* LSE = (float*)(wsl + WS_TMP + (size_t)3 * NTOK * 256 * 2);
            for (int it = gw; it < NTS * 12; it += NGW) { const int g = it % 3, r = it / 3; attn_sample_sub(QKV, g == 0 ? P.in[2] : (g == 1 ? P.in[3] : P.in[4]), PO, LSE, layer, r >> 2, r & 3, g, lane); }
            attn_mfma_phase(lds, QKV, PO, LSE, bid, G, tid_l);
            copy_shift<128>(P.in[2], out + O_KVS0, layer, gtid, nth);
            copy_shift<512>(P.in[3], out + O_KVS1, layer, gtid, nth);
            copy_shift<2048>(P.in[4], out + O_KVS2, layer, gtid, nth);
            xcd_barrier(xb);
            for (size_t idx = gtid; idx < (size_t)NTOK * 32; idx += nth) {
                const size_t token = idx >> 5; const int c = (int)(idx & 31) * 8, h = c >> 6;
                const float l0 = LSE[(0 * (size_t)NTOK + token) * 4 + h], l1 = LSE[(1 * (size_t)NTOK + token) * 4 + h], l2 = LSE[(2 * (size_t)NTOK + token) * 4 + h];
                const float mx = fmaxf(l0, fmaxf(l1, l2)); float w0 = __expf(l0 - mx), w1 = __expf(l1 - mx), w2 = __expf(l2 - mx); const float iw = 1.0f / (w0 + w1 + w2); w0 *= iw; w1 *= iw; w2 *= iw;
                float a0[8], a1[8], a2[8], o[8];
                unpack8(*(const u32x4*)(PO + (0 * (size_t)NTOK + token) * 256 + c), a0); unpack8(*(const u32x4*)(PO + (1 * (size_t)NTOK + token) * 256 + c), a1); unpack8(*(const u32x4*)(PO + (2 * (size_t)NTOK + token) * 256 + c), a2);
#pragma unroll
                for (int k = 0; k < 8; ++k) o[k] = w0 * a0[k] + w1 * a1[k] + w2 * a2[k];
                *(u32x4*)(OA + token * 256 + c) = pack8(o);
            }
            const float* sp = P.in[5] + (size_t)layer * 32 * 15 * 512;
            for (size_t idx = gtid; idx < (size_t)NTOK * 64; idx += nth) {
                const int token = (int)(idx >> 6), c = (int)(idx & 63) * 8; const int w = 2 << (c >> 7);
                const bool samp = token >= NTP; const int t = samp ? (token & 7) : (token & 4095); const int b = (token - NTP) >> 3;
                float sum[8], ut[8];
                unpack8(*(const u32x4*)(UB + (size_t)token * 512 + c), ut);
#pragma unroll
                for (int i = 0; i < 8; ++i) sum[i] = ut[i];
                for (int i = 1; i < w; ++i) {
                    const int tt = t - i; float f[8];
                    if (tt >= 0) unpack8(*(const u32x4*)(UB + (size_t)(token - i) * 512 + c), f);
                    else if (samp) { const float* r = sp + (size_t)(b * 15 + 15 + tt) * 512 + c; const f32x4 a = *(const f32x4*)r, b2 = *(const f32x4*)(r + 4);
#pragma unroll
                        for (int k = 0; k < 4; ++k) { f[k] = a[k]; f[4 + k] = b2[k]; } }
                    else {
#pragma unroll
                        for (int k = 0; k < 8; ++k) f[k] = 0.f; }
#pragma unroll
                    for (int k = 0; k < 8; ++k) sum[k] += f[k];
                }
                const float cnt = samp ? (float)w : (float)(w < t + 1 ? w : t + 1); const float ic = 1.0f / cnt;
                float p[8];
#pragma unroll
                for (int k = 0; k < 8; ++k) p[k] = sum[k] * ic - ut[k];
                *(u32x4*)(PB + (size_t)token * 512 + c) = pack8(p);
            }
            xcd_barrier(xb);
            continue;
        }
        pg8::Gemm g; EpiAll E; E.ws = ws; E.out = out; E.layer = layer; E.ssi = 0; E.ssn = 0;
        const int Mg = (st == 0) ? NTOK : NTP;
        g.M = Mg;
        if (st == 0)      { g.A = XB;  g.Bt = Wt_in + (size_t)layer * NIN * DM; g.N = NIN; g.K = DM;  E.mode = 0; E.ssi = 2 * layer; }
        else if (st == 2) { g.A = OA;  g.Bt = Wt_pa + (size_t)layer * DM * 256; g.N = DM;  g.K = 256; E.mode = 1; }
        else if (st == 3) { g.A = PB;  g.Bt = Wt_pb + (size_t)layer * DM * 512; g.N = DM;  g.K = 512; E.mode = 2; }
        else if (st == 4) { g.A = MIX; g.Bt = Wt_o + (size_t)layer * DM * DM;   g.N = DM;  g.K = DM;  E.mode = 3; E.ssn = 2 * layer + 1; }
        else if (st == 5) { g.A = XB;  g.Bt = Wt_up + (size_t)layer * DFF * DM; g.N = DFF; g.K = DM;  E.mode = 4; E.ssi = 2 * layer + 1; }
        else              { g.A = HID; g.Bt = Wt_dn + (size_t)layer * DM * DFF; g.N = DM;  g.K = DFF; E.mode = 3; E.ssn = 2 * layer + 2; }
        S.init(Mg, g.N, G, bid);
        pg8::gemm_phase<EpiAll, pg8::StaticOrder, true, true>(lds, g, S, E);
        if (st != 0) skinny_gemm(lds, g.A + (size_t)NTP * g.K, g.Bt, g.N, g.K, E, G - 1 - bid, G);
        if (st != 2) xcd_barrier(xb);
    }
    {
        int tid_l = threadIdx.x; asm volatile("" : "+v"(tid_l));
        const int lane = tid_l & 63, gw = bid * 8 + (tid_l >> 6);
        unsigned char* wsl = ws; asm volatile("" : "+s"(wsl));
        float* X = (float*)(wsl + WS_X);
        const float* fn = P.in[16]; const float* ssf = (const float*)(wsl + WS_SS) + (size_t)8 * NTOK;
        for (int row = gw; row < NTOK; row += NGW) {
            const float rs = rsqrtf(ssf[row] * (1.0f / 1024.0f) + 1e-6f);
#pragma unroll
            for (int j = 0; j < 4; ++j) { const int c = 4 * lane + 256 * j; const f32x4 v = *(const f32x4*)(X + (size_t)row * DM + c); const f32x4 gn = *(const f32x4*)(fn + c);
                *(f32x4*)(out + (size_t)row * DM + c) = (f32x4){v[0] * rs * gn[0], v[1] * rs * gn[1], v[2] * rs * gn[2], v[3] * rs * gn[3]}; }
        }
    }
}

extern "C" void kernel_launch(void* const* d_in, const int* in_sizes, int n_in, void* d_out, int out_size, void* d_ws, size_t ws_size, hipStream_t stream) {
    static int grid_blocks = 0;
    if (grid_blocks == 0) {
        if (n_in != 17 || ws_size < WS_END) { fprintf(stderr, "kernel_launch: unexpected n_in %d / ws %zu (need %zu)\n", n_in, ws_size, (size_t)WS_END); grid_blocks = -1; return; }
        int dev = 0, cus = 0, per_cu = 0;
        (void)hipGetDevice(&dev);
        (void)hipDeviceGetAttribute(&cus, hipDeviceAttributeMultiprocessorCount, dev);
        if (hipFuncSetAttribute((const void*)fwd_megakernel, hipFuncAttributeMaxDynamicSharedMemorySize, LDS_BYTES) != hipSuccess) { fprintf(stderr, "kernel_launch: hipFuncSetAttribute failed\n"); grid_blocks = -1; return; }
        (void)hipOccupancyMaxActiveBlocksPerMultiprocessor(&per_cu, (const void*)fwd_megakernel, NTHREADS, LDS_BYTES);
        if (per_cu < 1) { fprintf(stderr, "kernel_launch: occupancy query says %d blocks/CU\n", per_cu); grid_blocks = -1; return; }
        grid_blocks = cus * 1;
    }
    if (grid_blocks < 0) return;
    if (hipMemsetAsync((unsigned char*)d_ws + WS_BAR, 0, 4096 * 4, stream) != hipSuccess) { fprintf(stderr, "kernel_launch: memset of barrier words failed\n"); return; }
    Params p{};
    for (int i = 0; i < 17; ++i) p.in[i] = (const float*)d_in[i];
    p.out = (float*)d_out; p.ws = (unsigned char*)d_ws;
    void* args[] = {&p};
    hipError_t e = hipLaunchCooperativeKernel((const void*)fwd_megakernel, dim3(grid_blocks), dim3(NTHREADS), args, LDS_BYTES, stream);
    if (e != hipSuccess) fprintf(stderr, "cooperative launch failed: %s (grid %d)\n", hipGetErrorString(e), grid_blocks);
}
```

```cpp
#include <hip/hip_runtime.h>
#include <hip/hip_cooperative_groups.h>
#include <cstdio>
#include <cstdint>
namespace cg = cooperative_groups;

namespace pg8 {
#define PG8_LAS __attribute__((address_space(3)))
typedef unsigned short bf16_t;
typedef short bf16x8 __attribute__((ext_vector_type(8)));
typedef float f32x4 __attribute__((ext_vector_type(4)));
typedef unsigned u32x4 __attribute__((ext_vector_type(4)));
typedef unsigned u32x2 __attribute__((ext_vector_type(2)));
constexpr int BM = 256, BK = 64, HALF = 128, HTB = HALF * BK * 2, STAGE_BYTES = 8 * HTB, NXCD = 8, WGM = 8;

__host__ __device__ __forceinline__ int lds_byte(int r, int c) { const int st = (r >> 4) * 2 + (c >> 5), rr = r & 15, cc = c & 31, ob = rr * 64 + cc * 2; return st * 1024 + (ob ^ (((ob >> 9) & 1) << 5)); }
__host__ __device__ __forceinline__ void stage_rc(int b, int& R, int& C) { const int st = b / 1024, sb = b % 1024, swz = sb ^ (((sb >> 9) & 1) << 5); R = (st >> 1) * 16 + swz / 64; C = (st & 1) * 32 + (swz % 64) / 2; }
__host__ __device__ __forceinline__ int perm32(int rho) { const int n = rho >> 4, i = rho & 15; return 8 * (i >> 2) + 4 * n + (i & 3); }

struct Unit { int pm, pn; };
struct Gemm { const bf16_t* A; const bf16_t* Bt; int M, N, K; };

struct StaticOrder {
    int nM, nN, nwg, G, c;
    __host__ __device__ void init(int M, int N, int G_, int c_) { nM = M / BM; nN = N / BM; nwg = nM * nN; G = G_; c = c_; }
    __host__ __device__ bool next(int i, Unit& u) const {
        const long L = (long)i * G + c; if (L >= nwg) return false;
        int wgid = (int)L; { const int q = nwg / NXCD, r = nwg % NXCD, xcd = wgid % NXCD, off = wgid / NXCD; wgid = (xcd < r ? xcd * (q + 1) : r * (q + 1) + (xcd - r) * q) + off; }
        const int nig = WGM * nN, gid = wgid / nig, fm = gid * WGM, gsz = (nM - fm) < WGM ? (nM - fm) : WGM;
        u.pm = fm + ((wgid % nig) % gsz); u.pn = (wgid % nig) / gsz; return true;
    }
    __device__ __forceinline__ void a_ready(const Unit&) const {}
    __device__ __forceinline__ void done(const Unit&) const {}
};

__device__ __forceinline__ unsigned cvt_pk_bf16(float lo, float hi) { unsigned r; asm volatile("v_cvt_pk_bf16_f32 %0, %1, %2" : "=v"(r) : "v"(lo), "v"(hi)); return r; }

template <class Epi, class Sched, bool ALIGN_EPI = false, bool SP2 = false>
__device__ __forceinline__ void gemm_phase(PG8_LAS unsigned char* lds, const Gemm g, const Sched& S, const Epi& E) {
    int tid = threadIdx.x; asm volatile("" : "+v"(tid));
    const int wid = __builtin_amdgcn_readfirstlane(tid >> 6), lane = tid & 63, wr = wid >> 2, wc = wid & 3, fr = lane & 15, fq = lane >> 4;
    const int K = g.K, nt = K / BK;
    unsigned voffA[2], voffB[2];
#pragma unroll
    for (int i = 0; i < 2; ++i) { int R, C; stage_rc(tid * 16 + i * 8192, R, C); const int Rb = Epi::PERM ? ((R & ~31) + perm32(R & 31)) : R;
        voffA[i] = (unsigned)(R * K + C) * 2u; voffB[i] = (unsigned)(Rb * K + C) * 2u; }
    const size_t kstep = (size_t)(BK * 2);
    const size_t hstep = (size_t)HALF * K * 2;
    const size_t tstep = 2 * hstep;
    const unsigned ldsw = (unsigned)wid * 1024u;
    const int aoff = lds_byte(wr * 64 + fr, fq * 8), boff = lds_byte(wc * 32 + fr, fq * 8);
#define PG8_SA(b, h) (((b) * 2 + (h)) * HTB)
#define PG8_SB(b, h) ((4 + (b) * 2 + (h)) * HTB)
#define PG8_STAGE(bufoff, gbase, voff) do { _Pragma("unroll") for (int _i = 0; _i < 2; ++_i) \
        __builtin_amdgcn_global_load_lds((const unsigned*)((const char*)(gbase) + (voff)[_i]), (PG8_LAS unsigned*)(lds + (bufoff) + ldsw + _i * 8192), 16, 0, 0); } while (0)
#define PG8_LDA(dst, b, h) do { _Pragma("unroll") for (int m = 0; m < 4; ++m) _Pragma("unroll") for (int k = 0; k < 2; ++k) dst[m][k] = *(const PG8_LAS bf16x8*)(lds + PG8_SA(b, h) + aoff + m * 2048 + k * 1024); } while (0)
#define PG8_LDB(dst, b, h) do { _Pragma("unroll") for (int n = 0; n < 2; ++n) _Pragma("unroll") for (int k = 0; k < 2; ++k) dst[n][k] = *(const PG8_LAS bf16x8*)(lds + PG8_SB(b, h) + boff + n * 2048 + k * 1024); } while (0)
#define PG8_MMA(ai, bj, At, Bt) do { __builtin_amdgcn_s_setprio(1); _Pragma("unroll") for (int m = 0; m < 4; ++m) _Pragma("unroll") for (int n = 0; n < 2; ++n) _Pragma("unroll") for (int k = 0; k < 2; ++k) \
        acc[ai][bj][m][n] = __builtin_amdgcn_mfma_f32_16x16x32_bf16(Bt[n][k], At[m][k], acc[ai][bj][m][n], 0, 0, 0); __builtin_amdgcn_s_setprio(0); } while (0)
#define PG8_WAIT_V(n) asm volatile("s_waitcnt vmcnt(" #n ")" ::: "memory")
#define PG8_WAIT_L(n) asm volatile("s_waitcnt lgkmcnt(" #n ")" ::: "memory")
#define PG8_BAR __builtin_amdgcn_s_barrier()
#define PG8_SCHED __builtin_amdgcn_sched_barrier(0)
    Unit cur, nxt; int ui = 0;
    if (!S.next(0, cur)) return;
    f32x4 acc[2][2][4][2];
#pragma unroll
    for (int a = 0; a < 2; ++a)
#pragma unroll
        for (int b = 0; b < 2; ++b)
#pragma unroll
            for (int m = 0; m < 4; ++m)
#pragma unroll
                for (int n = 0; n < 2; ++n) acc[a][b][m][n] = (f32x4){0.f, 0.f, 0.f, 0.f};
    bf16x8 At[4][2], B0[2][2], B1[2][2];
    const char* cA = (const char*)g.A + (size_t)cur.pm * tstep; const char* cB = (const char*)g.Bt + (size_t)cur.pn * tstep;
    S.a_ready(cur);
    if constexpr (SP2) {
        PG8_STAGE(PG8_SB(0, 0), cB, voffB); PG8_STAGE(PG8_SB(0, 1), cB + hstep, voffB); PG8_STAGE(PG8_SA(0, 0), cA, voffA); PG8_STAGE(PG8_SA(0, 1), cA + hstep, voffA);
        if (wr == 1) PG8_BAR;
        PG8_WAIT_V(2); PG8_BAR;
        PG8_STAGE(PG8_SB(1, 0), cB + kstep, voffB); PG8_STAGE(PG8_SA(1, 0), cA + kstep, voffA); PG8_STAGE(PG8_SB(1, 1), cB + hstep + kstep, voffB);
        PG8_WAIT_V(6); PG8_BAR;
    } else {
        PG8_STAGE(PG8_SB(0, 0), cB, voffB); PG8_STAGE(PG8_SA(0, 0), cA, voffA); PG8_STAGE(PG8_SB(0, 1), cB + hstep, voffB); PG8_STAGE(PG8_SA(0, 1), cA + hstep, voffA);
        if (wr == 1) PG8_BAR;
        PG8_WAIT_V(4); PG8_BAR;
        PG8_STAGE(PG8_SB(1, 0), cB + kstep, voffB); PG8_STAGE(PG8_SA(1, 0), cA + kstep, voffA); PG8_STAGE(PG8_SB(1, 1), cB + hstep + kstep, voffB);
        PG8_WAIT_V(6); PG8_BAR;
    }
    for (;;) {
        const bool has_next = S.next(ui + 1, nxt);
        const char* nA = has_next ? (const char*)g.A + (size_t)nxt.pm * tstep : cA; const char* nB = has_next ? (const char*)g.Bt + (size_t)nxt.pn * tstep : cB;
        for (int t = 0; t < nt; t += 2) {
            const bool last = (t == nt - 2);
            const char* a1 = cA + (size_t)(t + 1) * kstep;
            const char* a2 = last ? nA : cA + (size_t)(t + 2) * kstep; const char* b2 = last ? nB : cB + (size_t)(t + 2) * kstep;
            const char* a3 = a2 + kstep; const char* b3 = b2 + kstep;
            if (last && has_next) S.a_ready(nxt);
            if constexpr (SP2) {
            PG8_LDB(B0, 0, 0); PG8_LDB(B1, 0, 1); PG8_SCHED; PG8_LDA(At, 0, 0); PG8_STAGE(PG8_SA(1, 1), a1 + hstep, voffA);
            PG8_WAIT_V(8); PG8_WAIT_L(0); PG8_BAR; PG8_MMA(0, 0, At, B0); PG8_MMA(0, 1, At, B1); PG8_BAR; PG8_SCHED;
            PG8_LDA(At, 0, 1); PG8_STAGE(PG8_SB(0, 0), b2, voffB); PG8_STAGE(PG8_SB(0, 1), b2 + hstep, voffB); PG8_STAGE(PG8_SA(0, 0), a2, voffA);
            PG8_WAIT_V(8); PG8_WAIT_L(0); PG8_BAR; PG8_MMA(1, 0, At, B0); PG8_MMA(1, 1, At, B1); PG8_BAR; PG8_SCHED;
            PG8_LDB(B0, 1, 0); PG8_LDB(B1, 1, 1); PG8_SCHED; PG8_LDA(At, 1, 0); PG8_STAGE(PG8_SA(0, 1), a2 + hstep, voffA);
            PG8_WAIT_V(8); PG8_WAIT_L(0); PG8_BAR; PG8_MMA(0, 0, At, B0); PG8_MMA(0, 1, At, B1); PG8_BAR; PG8_SCHED;
            PG8_LDA(At, 1, 1); PG8_STAGE(PG8_SB(1, 0), b3, voffB); PG8_STAGE(PG8_SB(1, 1), b3 + hstep, voffB); PG8_STAGE(PG8_SA(1, 0), a3, voffA);
            PG8_WAIT_V(8); PG8_WAIT_L(0); PG8_BAR; PG8_MMA(1, 0, At, B0); PG8_MMA(1, 1, At, B1); PG8_BAR; PG8_SCHED;
            } else {
            PG8_LDB(B0, 0, 0); PG8_SCHED; PG8_LDA(At, 0, 0); PG8_STAGE(PG8_SA(1, 1), a1 + hstep, voffA);
            PG8_WAIT_L(8); PG8_BAR; PG8_WAIT_L(0); PG8_MMA(0, 0, At, B0); PG8_BAR; PG8_SCHED;
            PG8_LDB(B1, 0, 1); PG8_STAGE(PG8_SB(0, 0), b2, voffB);
            PG8_BAR; PG8_WAIT_L(0); PG8_MMA(0, 1, At, B1); PG8_BAR;
            PG8_LDA(At, 0, 1); PG8_STAGE(PG8_SA(0, 0), a2, voffA);
            PG8_BAR; PG8_WAIT_L(0); PG8_MMA(1, 0, At, B0); PG8_BAR; PG8_SCHED;
            PG8_STAGE(PG8_SB(0, 1), b2 + hstep, voffB);
            PG8_WAIT_V(6); PG8_BAR; PG8_MMA(1, 1, At, B1); PG8_BAR;
            PG8_LDB(B0, 1, 0); PG8_SCHED; PG8_LDA(At, 1, 0); PG8_STAGE(PG8_SA(0, 1), a2 + hstep, voffA);
            PG8_WAIT_L(8); PG8_BAR; PG8_WAIT_L(0); PG8_MMA(0, 0, At, B0); PG8_BAR; PG8_SCHED;
            PG8_LDB(B1, 1, 1); PG8_STAGE(PG8_SB(1, 0), b3, voffB);
            PG8_BAR; PG8_WAIT_L(0); PG8_MMA(0, 1, At, B1); PG8_BAR;
            PG8_LDA(At, 1, 1); PG8_STAGE(PG8_SA(1, 0), a3, voffA);
            PG8_BAR; PG8_WAIT_L(0); PG8_MMA(1, 0, At, B0); PG8_BAR; PG8_SCHED;
            PG8_STAGE(PG8_SB(1, 1), b3 + hstep, voffB);
            PG8_WAIT_V(6); PG8_BAR; PG8_MMA(1, 1, At, B1); PG8_BAR;
            }
        }
        if constexpr (ALIGN_EPI) { if (wr == 0) PG8_BAR; }
        E(acc, cur, wr, wc, fr, fq); S.done(cur);
        if (!has_next) break;
#pragma unroll
        for (int a = 0; a < 2; ++a)
#pragma unroll
            for (int b = 0; b < 2; ++b)
#pragma unroll
                for (int m = 0; m < 4; ++m)
#pragma unroll
                    for (int n = 0; n < 2; ++n) acc[a][b][m][n] = (f32x4){0.f, 0.f, 0.f, 0.f};
        cur = nxt; cA = nA; cB = nB; ++ui;
        if constexpr (ALIGN_EPI) { if (wr == 1) PG8_BAR; }
    }
    PG8_WAIT_V(0);
    if constexpr (!ALIGN_EPI) { if (wr == 0) PG8_BAR; }
    PG8_BAR;
#undef PG8_SA
#undef PG8_SB
#undef PG8_STAGE
#undef PG8_LDA
#undef PG8_LDB
#undef PG8_MMA
#undef PG8_WAIT_V
#undef PG8_WAIT_L
#undef PG8_BAR
#undef PG8_SCHED
}
}

using pg8::bf16_t; using pg8::f32x4; using pg8::u32x4; using pg8::u32x2; using pg8::Unit; using pg8::cvt_pk_bf16;
#define LAS __attribute__((address_space(3)))

constexpr int DM = 1024, TP = 4096, NTP = 16384, NTS = 256, NTOK = 16640, DEPTH = 4, NIN = 4864, DFF = 4096;
constexpr int NTHREADS = 512, LDS_BYTES = 147456;
constexpr size_t O_YP = 0, O_YS = 16777216, O_KVP0 = 17039360, O_KVP1 = 18087936, O_KVP2 = 22282240, O_POOLP = 39059456,
                 O_KVS0 = 39182336, O_KVS1 = 47570944, O_KVS2 = 81125376, O_POOLS = 215343104;
constexpr size_t WS_WIN = 0;
constexpr size_t WS_WPA = WS_WIN + (size_t)DEPTH * NIN * DM * 2;
constexpr size_t WS_WPB = WS_WPA + (size_t)DEPTH * DM * 256 * 2;
constexpr size_t WS_WO  = WS_WPB + (size_t)DEPTH * DM * 512 * 2;
constexpr size_t WS_WUP = WS_WO  + (size_t)DEPTH * DM * DM * 2;
constexpr size_t WS_WDN = WS_WUP + (size_t)DEPTH * DFF * DM * 2;
constexpr size_t WS_X   = WS_WDN + (size_t)DEPTH * DM * DFF * 2;
constexpr size_t WS_XB  = WS_X   + (size_t)NTOK * DM * 4;
constexpr size_t WS_QKV = WS_XB  + (size_t)NTOK * DM * 2;
constexpr size_t WS_U   = WS_QKV + (size_t)NTOK * 2304 * 2;
constexpr size_t WS_G   = WS_U   + (size_t)NTOK * 512 * 2;
constexpr size_t WS_OA  = WS_G   + (size_t)NTOK * 2048 * 2;
constexpr size_t WS_P   = WS_OA  + (size_t)NTOK * 256 * 2;
constexpr size_t WS_TMP = WS_P   + (size_t)NTOK * 512 * 2;
constexpr size_t WS_MIX = WS_TMP + (size_t)NTOK * DM * 4;
constexpr size_t WS_H   = WS_MIX + (size_t)NTOK * DM * 2;
constexpr size_t WS_SS  = WS_H   + (size_t)NTOK * DFF * 2;
constexpr size_t WS_ROPE = WS_SS + (size_t)9 * NTOK * 4;
constexpr size_t WS_BAR = WS_ROPE + (size_t)4104 * 16 * 4;
constexpr size_t WS_END = WS_BAR + (size_t)4096 * 4;

struct Params { const float* in[17]; float* out; unsigned char* ws; };

__device__ __forceinline__ void unpack8(const u32x4 w, float (&f)[8]) {
    f[0] = __uint_as_float(w.x << 16); f[1] = __uint_as_float(w.x & 0xffff0000u);
    f[2] = __uint_as_float(w.y << 16); f[3] = __uint_as_float(w.y & 0xffff0000u);
    f[4] = __uint_as_float(w.z << 16); f[5] = __uint_as_float(w.z & 0xffff0000u);
    f[6] = __uint_as_float(w.w << 16); f[7] = __uint_as_float(w.w & 0xffff0000u);
}
__device__ __forceinline__ u32x4 pack8(const float (&f)[8]) {
    u32x4 w; w.x = cvt_pk_bf16(f[0], f[1]); w.y = cvt_pk_bf16(f[2], f[3]); w.z = cvt_pk_bf16(f[4], f[5]); w.w = cvt_pk_bf16(f[6], f[7]); return w;
}
__device__ __forceinline__ float sigmoidf_(float x) { return 1.0f / (1.0f + __expf(-x)); }

struct EpiAll {
    static constexpr bool PERM = true, AFTER_DRAIN = false;
    int mode, layer, ssi, ssn; unsigned char* ws; float* out;

    struct Pre { u32x4 g; f32x4 a, b; float rs; };

    template <int MODE> __device__ __forceinline__ Pre pre(unsigned char* ws, int row, int c) const {
        Pre p;
        if constexpr (MODE == 0 || MODE == 4) p.rs = ((const float*)(ws + WS_SS) + (size_t)ssi * NTOK)[row];
        if constexpr (MODE == 1) p.g = *(const u32x4*)((const bf16_t*)(ws + WS_G) + (size_t)row * 2048 + c);
        if constexpr (MODE == 2) { p.g = *(const u32x4*)((const bf16_t*)(ws + WS_G) + (size_t)row * 2048 + 1024 + c);
            const float* tp = (const float*)(ws + WS_TMP) + (size_t)row * DM + c; p.a = *(const f32x4*)tp; p.b = *(const f32x4*)(tp + 4); }
        if constexpr (MODE == 3) { const float* xp = (const float*)(ws + WS_X) + (size_t)row * DM + c; p.a = *(const f32x4*)xp; p.b = *(const f32x4*)(xp + 4); }
        return p;
    }
    __device__ __forceinline__ void fin_proj(unsigned char* ws, int row, int c32, int fq, float (&v)[8], const Pre& p) const {
        const int pn = c32 >> 8, cl = (c32 & 255) + 8 * fq;
        const float rs = rsqrtf(p.rs * (1.0f / 1024.0f) + 1e-6f);
        const bool samp = row >= NTP;
        const int b = samp ? ((row - NTP) >> 3) : (row >> 12);
        const int t = samp ? (row & 7) : (row & 4095);
#pragma unroll
        for (int i = 0; i < 8; ++i) v[i] *= rs;
        if (pn < 6 && ((c32 >> 5) & 1) == 0) {
            float pv[8];
#pragma unroll
            for (int i = 0; i < 8; ++i) pv[i] = __shfl_xor(v[i], 16);
            if (fq < 2) {
                const int pi = samp ? (4096 + t) : t;
                const f32x4* rp = (const f32x4*)((const float*)(ws + WS_ROPE) + (size_t)pi * 16);
                const f32x4 c0 = rp[0], c1 = rp[1], s0 = rp[2], s1 = rp[3];
                const float sg = (fq == 0) ? -1.0f : 1.0f;
#pragma unroll
                for (int i = 0; i < 4; ++i) { v[i] = v[i] * c0[i] + sg * pv[i] * s0[i]; v[4 + i] = v[4 + i] * c1[i] + sg * pv[4 + i] * s1[i]; }
            }
        }
        if (pn >= 11) {
#pragma unroll
            for (int i = 0; i < 8; ++i) v[i] = sigmoidf_(v[i]);
        }
        bf16_t* dst; int ld, cbase;
        if (pn < 9) { dst = (bf16_t*)(ws + WS_QKV); ld = 2304; cbase = pn * 256; }
        else if (pn < 11) { dst = (bf16_t*)(ws + WS_U); ld = 512; cbase = (pn - 9) * 256; }
        else { dst = (bf16_t*)(ws + WS_G); ld = 2048; cbase = (pn - 11) * 256; }
        *(u32x4*)(dst + (size_t)row * ld + cbase + cl) = pack8(v);
        if (pn >= 3 && pn < 9) {
            const int kvi = pn - 3; const int g = (kvi >= 3) ? kvi - 3 : kvi; const int kv = (kvi >= 3) ? 1 : 0;
            const int W = 128 << (2 * g);
            const size_t okp = (g == 0) ? O_KVP0 : (g == 1 ? O_KVP1 : O_KVP2);
            const size_t oks = (g == 0) ? O_KVS0 : (g == 1 ? O_KVS1 : O_KVS2);
            float* op = nullptr;
            if (samp) op = out + oks + ((size_t)((layer * 32 + b) * W + (W - 8 + t)) * 2 + kv) * 256 + cl;
            else if (t >= TP - W) op = out + okp + ((size_t)((layer * 4 + b) * W + (t - (TP - W))) * 2 + kv) * 256 + cl;
            if (op) { *(f32x4*)op = (f32x4){v[0], v[1], v[2], v[3]}; *(f32x4*)(op + 4) = (f32x4){v[4], v[5], v[6], v[7]}; }
        } else if (pn >= 9 && pn < 11) {
            float* op = nullptr; const int c = cbase + cl;
            if (samp) op = out + O_POOLS + (size_t)((layer * 32 + b) * 15 + 7 + t) * 512 + c;
            else if (t >= TP - 15) op = out + O_POOLP + (size_t)((layer * 4 + b) * 15 + (t - (TP - 15))) * 512 + c;
            if (op) { *(f32x4*)op = (f32x4){v[0], v[1], v[2], v[3]}; *(f32x4*)(op + 4) = (f32x4){v[4], v[5], v[6], v[7]}; }
        }
    }
    template <int MODE> __device__ __forceinline__ void fin(unsigned char* ws, int row, int c32, int fq, float (&v)[8], const Pre& p) const {
        const int c = c32 + 8 * fq;
        if constexpr (MODE == 0) fin_proj(ws, row, c32, fq, v, p);
        if constexpr (MODE == 1) {
            float gg[8]; unpack8(p.g, gg);
            float* tp = (float*)(ws + WS_TMP) + (size_t)row * DM + c;
            *(f32x4*)tp = (f32x4){gg[0] * v[0], gg[1] * v[1], gg[2] * v[2], gg[3] * v[3]};
            *(f32x4*)(tp + 4) = (f32x4){gg[4] * v[4], gg[5] * v[5], gg[6] * v[6], gg[7] * v[7]};
        }
        if constexpr (MODE == 2) {
            float gg[8]; unpack8(p.g, gg);
#pragma unroll
            for (int i = 0; i < 4; ++i) { v[i] = p.a[i] + gg[i] * v[i]; v[4 + i] = p.b[i] + gg[4 + i] * v[4 + i]; }
            *(u32x4*)((bf16_t*)(ws + WS_MIX) + (size_t)row * DM + c) = pack8(v);
        }
        if constexpr (MODE == 3) {
            float* xp = (float*)(ws + WS_X) + (size_t)row * DM + c;
            float sq = 0.f;
#pragma unroll
            for (int i = 0; i < 4; ++i) { v[i] += p.a[i]; v[4 + i] += p.b[i]; }
#pragma unroll
            for (int i = 0; i < 8; ++i) sq += v[i] * v[i];
            *(f32x4*)xp = (f32x4){v[0], v[1], v[2], v[3]}; *(f32x4*)(xp + 4) = (f32x4){v[4], v[5], v[6], v[7]};
            *(u32x4*)((bf16_t*)(ws + WS_XB) + (size_t)row * DM + c) = pack8(v);
            sq += __shfl_xor(sq, 16); sq += __shfl_xor(sq, 32);
            if (fq == 0) atomicAdd((float*)(ws + WS_SS) + (size_t)ssn * NTOK + row, sq);
        }
        if constexpr (MODE == 4) {
            const float rs = rsqrtf(p.rs * (1.0f / 1024.0f) + 1e-6f);
#pragma unroll
            for (int i = 0; i < 8; ++i) { const float a = fmaxf(v[i] * rs, 0.f); v[i] = a * a; }
            *(u32x4*)((bf16_t*)(ws + WS_H) + (size_t)row * DFF + c) = pack8(v);
        }
    }
    __device__ __forceinline__ void chunk(unsigned char* ws, int row, int c32, int fq, float (&v)[8]) const {
        const int c = c32 + 8 * fq;
        switch (mode) {
            case 0: { const Pre p = pre<0>(ws, row, c); fin<0>(ws, row, c32, fq, v, p); } break;
            case 1: { const Pre p = pre<1>(ws, row, c); fin<1>(ws, row, c32, fq, v, p); } break;
            case 2: { const Pre p = pre<2>(ws, row, c); fin<2>(ws, row, c32, fq, v, p); } break;
            case 3: { const Pre p = pre<3>(ws, row, c); fin<3>(ws, row, c32, fq, v, p); } break;
            default: { const Pre p = pre<4>(ws, row, c); fin<4>(ws, row, c32, fq, v, p); } break;
        }
    }
    template <int MODE> __device__ __forceinline__ void tile(unsigned char* ws, const f32x4 (&acc)[2][2][4][2], const Unit& u, int wr, int wc, int fr, int fq) const {
        constexpr int MB = (MODE == 2 || MODE == 3) ? 2 : 4;
#pragma unroll
        for (int ai = 0; ai < 2; ++ai)
#pragma unroll
            for (int m0 = 0; m0 < 4; m0 += MB) {
                Pre p[MB][2];
#pragma unroll
                for (int mm = 0; mm < MB; ++mm)
#pragma unroll
                    for (int bj = 0; bj < 2; ++bj) p[mm][bj] = pre<MODE>(ws, u.pm * 256 + ai * 128 + wr * 64 + (m0 + mm) * 16 + fr, u.pn * 256 + bj * 128 + wc * 32 + 8 * fq);
#pragma unroll
                for (int mm = 0; mm < MB; ++mm)
#pragma unroll
                    for (int bj = 0; bj < 2; ++bj) {
                        float v[8];
#pragma unroll
                        for (int i = 0; i < 4; ++i) { v[i] = acc[ai][bj][m0 + mm][0][i]; v[4 + i] = acc[ai][bj][m0 + mm][1][i]; }
                        fin<MODE>(ws, u.pm * 256 + ai * 128 + wr * 64 + (m0 + mm) * 16 + fr, u.pn * 256 + bj * 128 + wc * 32, fq, v, p[mm][bj]);
                    }
                asm volatile("" ::: "memory");
            }
    }
    __device__ __forceinline__ void operator()(const f32x4 (&acc)[2][2][4][2], const Unit& u, int wr, int wc, int fr, int fq) const {
        asm volatile("" : "+v"(fr), "+v"(fq));
        unsigned char* ws = this->ws; asm volatile("" : "+s"(ws));
        switch (mode) {
            case 0: tile<0>(ws, acc, u, wr, wc, fr, fq); break;
            case 1: tile<1>(ws, acc, u, wr, wc, fr, fq); break;
            case 2: tile<2>(ws, acc, u, wr, wc, fr, fq); break;
            case 3: tile<3>(ws, acc, u, wr, wc, fr, fq); break;
            default: tile<4>(ws, acc, u, wr, wc, fr, fq); break;
        }
    }
};

__device__ __forceinline__ void skinny_gemm(LAS unsigned char* lds, const bf16_t* __restrict__ A, const bf16_t* __restrict__ Bt, int N, int K, const EpiAll& E, int first, int G) {
    using pg8::bf16x8;
    int tid = threadIdx.x; asm volatile("" : "+v"(tid));
    const int lane = tid & 63, w = __builtin_amdgcn_readfirstlane(tid >> 6), kg = lane >> 4, qn = lane & 15;
    const int nh = (N == 1024) ? 1 : 2, ksplit = 8 / nh;
    const int half = w % nh, kq = w / nh, Kq = K / ksplit, nsteps = Kq >> 5;
    unsigned char* ws = E.ws; asm volatile("" : "+s"(ws));
    LAS float* red = (LAS float*)lds;
    const int RB = 8 / nh, units = RB * (N >> 5);
#pragma unroll 1
    for (int u = first; u < units; u += G) {
        const int rb = u % RB, c32 = (u / RB) << 5;
        const int row0 = rb * 32 * nh + half * 32;
        const bf16_t* ap = A + (size_t)(row0 + qn) * K + kq * Kq + kg * 8;
        const bf16_t* bp = Bt + (size_t)(c32 + 8 * (qn >> 2) + (qn & 3)) * K + kq * Kq + kg * 8;
        f32x4 acc[2][2];
#pragma unroll
        for (int a = 0; a < 2; ++a)
#pragma unroll
            for (int b = 0; b < 2; ++b) acc[a][b] = (f32x4){0.f, 0.f, 0.f, 0.f};
#pragma unroll 8
        for (int ks = 0; ks < nsteps; ++ks) {
            const bf16x8 x0 = *(const bf16x8*)(ap + ks * 32), x1 = *(const bf16x8*)(ap + (size_t)16 * K + ks * 32);
            const bf16x8 w0 = *(const bf16x8*)(bp + ks * 32), w1 = *(const bf16x8*)(bp + (size_t)4 * K + ks * 32);
            acc[0][0] = __builtin_amdgcn_mfma_f32_16x16x32_bf16(w0, x0, acc[0][0], 0, 0, 0);
            acc[0][1] = __builtin_amdgcn_mfma_f32_16x16x32_bf16(w1, x0, acc[0][1], 0, 0, 0);
            acc[1][0] = __builtin_amdgcn_mfma_f32_16x16x32_bf16(w0, x1, acc[1][0], 0, 0, 0);
            acc[1][1] = __builtin_amdgcn_mfma_f32_16x16x32_bf16(w1, x1, acc[1][1], 0, 0, 0);
        }
        __syncthreads();
        if (kq != 0) {
#pragma unroll
            for (int a = 0; a < 2; ++a)
#pragma unroll
                for (int b = 0; b < 2; ++b)
#pragma unroll
                    for (int i = 0; i < 4; ++i) red[(w * 16 + a * 8 + b * 4 + i) * 64 + lane] = acc[a][b][i];
        }
        __syncthreads();
        if (kq == 0) {
#pragma unroll 1
            for (int q = 1; q < ksplit; ++q)
#pragma unroll
                for (int a = 0; a < 2; ++a)
#pragma unroll
                    for (int b = 0; b < 2; ++b)
#pragma unroll
                        for (int i = 0; i < 4; ++i) acc[a][b][i] += red[((w + nh * q) * 16 + a * 8 + b * 4 + i) * 64 + lane];
#pragma unroll
            for (int a = 0; a < 2; ++a) {
                float v[8];
#pragma unroll
                for (int i = 0; i < 4; ++i) { v[i] = acc[a][0][i]; v[4 + i] = acc[a][1][i]; }
                E.chunk(ws, NTP + row0 + a * 16 + qn, c32, kg, v);
            }
        }
    }
    __syncthreads();
}

__device__ __forceinline__ void lds_wait() { asm volatile("s_waitcnt lgkmcnt(0)" ::: "memory"); }
__device__ __forceinline__ void transpose_item(const float* __restrict__ W, const float* __restrict__ gsc, int K, int N, bf16_t* __restrict__ WT, LAS float* scr, int item, int lane) {
    const int nblk = N / 64, kb = item / nblk, nb = item % nblk, k0 = 64 * kb, n0 = 64 * nb;
    f32x4 v[16];
#pragma unroll
    for (int i = 0; i < 16; ++i) v[i] = *(const f32x4*)(W + (size_t)(k0 + 4 * i + (lane >> 4)) * N + n0 + 4 * (lane & 15));
#pragma unroll
    for (int i = 0; i < 16; ++i) { const int kk = 4 * i + (lane >> 4); const float sc = gsc ? gsc[k0 + kk] : 1.0f; LAS float* d = scr + kk * 65 + 4 * (lane & 15);
        d[0] = v[i][0] * sc; d[1] = v[i][1] * sc; d[2] = v[i][2] * sc; d[3] = v[i][3] * sc; }
    lds_wait();
    const int c = lane & 7;
#pragma unroll
    for (int j = 0; j < 8; ++j) { const int n = (lane >> 3) + 8 * j; const LAS float* sp = scr + (8 * c) * 65 + n;
        u32x4 o; o.x = cvt_pk_bf16(sp[0 * 65], sp[1 * 65]); o.y = cvt_pk_bf16(sp[2 * 65], sp[3 * 65]); o.z = cvt_pk_bf16(sp[4 * 65], sp[5 * 65]); o.w = cvt_pk_bf16(sp[6 * 65], sp[7 * 65]);
        *(u32x4*)(WT + (size_t)(n0 + n) * K + k0 + 8 * c) = o; }
    lds_wait();
}

template <int L>
__device__ __forceinline__ void copy_shift(const float* __restrict__ src, float* __restrict__ dst, int layer, size_t gtid, size_t nth) {
    constexpr size_t per = (size_t)(L - 8) * 128;
    constexpr size_t total = (size_t)32 * per;
    constexpr int U = 8;
    const f32x4* s4 = (const f32x4*)src + (size_t)layer * 32 * L * 128; f32x4* d4 = (f32x4*)dst + (size_t)layer * 32 * L * 128;
    for (size_t i = gtid; i < total; i += nth * U) {
        f32x4 v[U];
#pragma unroll
        for (int u = 0; u < U; ++u) { const size_t idx = i + u * nth; const size_t ii = idx < total ? idx : 0; const size_t lb = ii / per, r = ii - lb * per;
            v[u] = __builtin_nontemporal_load(s4 + lb * (size_t)L * 128 + r + 8 * 128); }
#pragma unroll
        for (int u = 0; u < U; ++u) { const size_t idx = i + u * nth; if (idx < total) { const size_t lb = idx / per, r = idx - lb * per; __builtin_nontemporal_store(v[u], d4 + lb * (size_t)L * 128 + r); } }
    }
}

#define ATT_DOT(S, Q, KF) do { float _s = 0.f; _Pragma("unroll") for (int _i = 0; _i < 8; ++_i) _s += Q[_i] * KF[_i]; \
    _s += __shfl_xor(_s, 1); _s += __shfl_xor(_s, 2); _s += __shfl_xor(_s, 4); S = _s; } while (0)

__device__ __forceinline__ void attn_finish(float m, float l, float (&o)[8], bf16_t* dstp, int kg) {
    float M = m; M = fmaxf(M, __shfl_xor(M, 8)); M = fmaxf(M, __shfl_xor(M, 16)); M = fmaxf(M, __shfl_xor(M, 32));
    const float f = __expf(m - M); l *= f;
#pragma unroll
    for (int i = 0; i < 8; ++i) o[i] *= f;
    l += __shfl_xor(l, 8); l += __shfl_xor(l, 16); l += __shfl_xor(l, 32);
#pragma unroll
    for (int i = 0; i < 8; ++i) { o[i] += __shfl_xor(o[i], 8); o[i] += __shfl_xor(o[i], 16); o[i] += __shfl_xor(o[i], 32); }
    const float inv = 1.0f / l;
#pragma unroll
    for (int i = 0; i < 8; ++i) o[i] *= inv;
    if (kg == 0) *(u32x4*)dstp = pack8(o);
}

__device__ __forceinline__ void attn_prompt_item(const bf16_t* __restrict__ qkv, bf16_t* __restrict__ oa, int token, int h, int lane) {
    const int kg = lane >> 3, dl = lane & 7;
    const int b = token >> 12, t = token & 4095;
    const bf16_t* qrow = qkv + (size_t)token * 2304 + h * 64 + dl * 8;
    const bf16_t* kbase = qkv + (size_t)(b << 12) * 2304 + 768 + h * 64 + dl * 8;
    float m = -1e30f, l = 0.f; float o[8];
#pragma unroll
    for (int i = 0; i < 8; ++i) o[i] = 0.f;
#pragma unroll 1
    for (int g = 0; g < 3; ++g) {
        const int d = 1 << (2 * g);
        float q[8]; unpack8(*(const u32x4*)(qrow + g * 256), q);
#pragma unroll
        for (int i = 0; i < 8; ++i) q[i] *= 0.125f;
        const bf16_t* kb = kbase + g * 256;
#pragma unroll 1
        for (int it = 0; it < 16; it += 4) {
            u32x4 kr[4], vr[4]; bool val[4];
#pragma unroll
            for (int u = 0; u < 4; ++u) { const int j = (it + u) * 8 + kg; const int pos = t - j * d; val[u] = pos >= 0; const bf16_t* r = kb + (size_t)(pos < 0 ? 0 : pos) * 2304;
                kr[u] = *(const u32x4*)r; vr[u] = *(const u32x4*)(r + 768); }
            float s[4];
#pragma unroll
            for (int u = 0; u < 4; ++u) { float kf[8]; unpack8(kr[u], kf); ATT_DOT(s[u], q, kf); if (!val[u]) s[u] = -1e30f; }
            const float mb = fmaxf(fmaxf(m, fmaxf(s[0], s[1])), fmaxf(s[2], s[3]));
            const float corr = __expf(m - mb);
            l *= corr;
#pragma unroll
            for (int i = 0; i < 8; ++i) o[i] *= corr;
#pragma unroll
            for (int u = 0; u < 4; ++u) { const float p = val[u] ? __expf(s[u] - mb) : 0.f; l += p; float vf[8]; unpack8(vr[u], vf);
#pragma unroll
                for (int i = 0; i < 8; ++i) o[i] += p * vf[i]; }
            m = mb;
        }
    }
    {
        const int g = kg < 2 ? kg : 2; const int d = 1 << (2 * g);
        const int pos = t - 128 * d; const bool val = (kg < 3) && (pos >= 0);
        float q[8]; unpack8(*(const u32x4*)(qrow + g * 256), q);
        const bf16_t* r = kbase + g * 256 + (size_t)(pos < 0 ? 0 : pos) * 2304;
        float kf[8], vf[8]; unpack8(*(const u32x4*)r, kf); unpack8(*(const u32x4*)(r + 768), vf);
        float s; ATT_DOT(s, q, kf); s *= 0.125f;
        if (!val) s = -1e30f;
        const float mb = fmaxf(m, s); const float corr = __expf(m - mb); const float p = val ? __expf(s - mb) : 0.f;
        l = l * corr + p;
#pragma unroll
        for (int i = 0; i < 8; ++i) o[i] = o[i] * corr + p * vf[i];
        m = mb;
    }
    attn_finish(m, l, o, oa + (size_t)token * 256 + h * 64 + dl * 8, kg);
}

__device__ __forceinline__ void sample_kv(const bf16_t* __restrict__ newb, const float* __restrict__ cb, int W, int idx, float (&kf)[8], float (&vf)[8]) {
    if (idx >= W) { const bf16_t* r = newb + (size_t)(idx - W) * 2304; unpack8(*(const u32x4*)r, kf); unpack8(*(const u32x4*)(r + 768), vf); }
    else { const float* r = cb + (size_t)idx * 512; const f32x4 a = *(const f32x4*)r, b2 = *(const f32x4*)(r + 4), c = *(const f32x4*)(r + 256), d2 = *(const f32x4*)(r + 260);
#pragma unroll
        for (int i = 0; i < 4; ++i) { kf[i] = a[i]; kf[4 + i] = b2[i]; vf[i] = c[i]; vf[4 + i] = d2[i]; } }
}
__device__ __forceinline__ void attn_sample_sub(const bf16_t* __restrict__ qkv, const float* __restrict__ cg_, bf16_t* __restrict__ PO, float* __restrict__ LSE,
                                                int layer, int stok, int h, int g, int lane) {
    const int kg = lane >> 3, dl = lane & 7;
    const int b = stok >> 3, t = stok & 7;
    const int token = NTP + stok;
    const int d = 1 << (2 * g), W = 128 << (2 * g);
    const bf16_t* nb = qkv + (size_t)(NTP + b * 8) * 2304 + 768 + g * 256 + h * 64 + dl * 8;
    const float* cb = cg_ + (size_t)(layer * 32 + b) * W * 512 + h * 64 + dl * 8;
    float q[8]; unpack8(*(const u32x4*)(qkv + (size_t)token * 2304 + g * 256 + h * 64 + dl * 8), q);
#pragma unroll
    for (int i = 0; i < 8; ++i) q[i] *= 0.125f;
    float m = -1e30f, l = 0.f; float o[8];
#pragma unroll
    for (int i = 0; i < 8; ++i) o[i] = 0.f;
#pragma unroll 1
    for (int it = 0; it < 16; it += 8) {
        float kf[8][8], vf[8][8], s[8];
#pragma unroll
        for (int u = 0; u < 8; ++u) { const int j = (it + u) * 8 + kg; sample_kv(nb, cb, W, W + t - j * d, kf[u], vf[u]); }
        float mb = m;
#pragma unroll
        for (int u = 0; u < 8; ++u) { ATT_DOT(s[u], q, kf[u]); mb = fmaxf(mb, s[u]); }
        const float corr = __expf(m - mb);
        l *= corr;
#pragma unroll
        for (int i = 0; i < 8; ++i) o[i] *= corr;
#pragma unroll
        for (int u = 0; u < 8; ++u) { const float p = __expf(s[u] - mb); l += p;
#pragma unroll
            for (int i = 0; i < 8; ++i) o[i] += p * vf[u][i]; }
        m = mb;
    }
    {
        const bool val = kg == 0;
        float kf[8], vf[8]; sample_kv(nb, cb, W, W + t - 128 * d, kf, vf);
        float s; ATT_DOT(s, q, kf);
        if (!val) s = -1e30f;
        const float mb = fmaxf(m, s); const float corr = __expf(m - mb); const float p = val ? __expf(s - mb) : 0.f;
        l = l * corr + p;
#pragma unroll
        for (int i = 0; i < 8; ++i) o[i] = o[i] * corr + p * vf[i];
        m = mb;
    }
    float M = m; M = fmaxf(M, __shfl_xor(M, 8)); M = fmaxf(M, __shfl_xor(M, 16)); M = fmaxf(M, __shfl_xor(M, 32));
    const float f = __expf(m - M); l *= f;
#pragma unroll
    for (int i = 0; i < 8; ++i) o[i] *= f;
    l += __shfl_xor(l, 8); l += __shfl_xor(l, 16); l += __shfl_xor(l, 32);
#pragma unroll
    for (int i = 0; i < 8; ++i) { o[i] += __shfl_xor(o[i], 8); o[i] += __shfl_xor(o[i], 16); o[i] += __shfl_xor(o[i], 32); }
    const float inv = 1.0f / l;
#pragma unroll
    for (int i = 0; i < 8; ++i) o[i] *= inv;
    if (kg == 0) *(u32x4*)(PO + ((size_t)g * NTOK + token) * 256 + h * 64 + dl * 8) = pack8(o);
    if (lane == 0) LSE[((size_t)g * NTOK + token) * 4 + h] = M + __logf(l);
}

constexpr int ATT_PITCH = 144, ATT_ROWS = 272, ATT_VOFF = ATT_ROWS * ATT_PITCH;
typedef short s16x4 __attribute__((ext_vector_type(4)));
template <int OFF> __device__ __forceinline__ s16x4 tr_read(unsigned addr) { s16x4 r; asm volatile("ds_read_b64_tr_b16 %0, %1 offset:%2" : "=v"(r) : "v"(addr), "n"(OFF) : "memory"); return r; }
__device__ __forceinline__ void tr_wait8(s16x4& a, s16x4& b, s16x4& c, s16x4& d, s16x4& e, s16x4& f, s16x4& g, s16x4& h) {
    asm volatile("s_waitcnt lgkmcnt(0)" : "+v"(a), "+v"(b), "+v"(c), "+v"(d), "+v"(e), "+v"(f), "+v"(g), "+v"(h) :: "memory"); }

__device__ __forceinline__ void attn_mfma_phase(LAS unsigned char* lds, const bf16_t* __restrict__ QKV, bf16_t* __restrict__ PO, float* __restrict__ LSE, int bid, int G, int tid) {
    using pg8::bf16x8;
    const int lane = tid & 63, w = __builtin_amdgcn_readfirstlane(tid >> 6), kg = lane >> 4, qn = lane & 15;
    for (int i = tid; i < 2 * 144; i += NTHREADS) { const int kv = i / 144, rem = i - kv * 144; *(LAS u32x4*)(lds + kv * ATT_VOFF + 256 * ATT_PITCH + rem * 16) = (u32x4){0u, 0u, 0u, 0u}; }
    const unsigned vaddr = (unsigned)(uintptr_t)(lds + ATT_VOFF + (16 * w + 4 * kg + (qn >> 2)) * ATT_PITCH + (lane & 3) * 8);
    const float csc = 0.125f * 1.44269504089f;
#define ATT_DECODE(U, b_, h_, g_, r_, I0_) do { const int _bh = (U) / 96, _rest = (U) - _bh * 96; b_ = _bh >> 2; h_ = _bh & 3; \
        if (_rest < 32) { g_ = 0; r_ = 0; I0_ = 128 * _rest; } else if (_rest < 64) { g_ = 1; r_ = (_rest - 32) >> 3; I0_ = 128 * ((_rest - 32) & 7); } else { g_ = 2; r_ = (_rest - 64) >> 1; I0_ = 128 * ((_rest - 64) & 1); } } while (0)
#define ATT_FETCH(U) do { int _b, _h, _g, _r, _I0; ATT_DECODE(U, _b, _h, _g, _r, _I0); const int _d = 1 << (2 * _g); \
        _Pragma("unroll") for (int i = 0; i < 8; ++i) { const int kv = i >> 2, row = (tid >> 3) + 64 * (i & 3), ch = tid & 7; const int I = _I0 - 128 + row; \
            pf[i] = (u32x4){0u, 0u, 0u, 0u}; \
            if (I >= 0) pf[i] = *(const u32x4*)(QKV + (size_t)(_b * 4096 + _r + _d * I) * 2304 + 768 + kv * 768 + _g * 256 + _h * 64 + ch * 8); } \
        const bf16_t* _qp = QKV + ((size_t)_b * 4096 + _r + _d * (_I0 + 16 * w + qn)) * 2304 + _g * 256 + _h * 64 + kg * 8; \
        qf0 = *(const bf16x8*)_qp; qf1 = *(const bf16x8*)(_qp + 32); } while (0)
    u32x4 pf[8]; bf16x8 qf0, qf1;
    if (bid < 1536) ATT_FETCH(bid);
#pragma unroll 1
    for (int u = bid; u < 1536; u += G) {
        int b, h, g, r, I0; ATT_DECODE(u, b, h, g, r, I0);
        const int d = 1 << (2 * g);
        __syncthreads();
#pragma unroll
        for (int i = 0; i < 8; ++i) { const int kv = i >> 2, row = (tid >> 3) + 64 * (i & 3), ch = tid & 7; *(LAS u32x4*)(lds + kv * ATT_VOFF + row * ATT_PITCH + ch * 16) = pf[i]; }
        const bf16x8 q0 = qf0, q1 = qf1;
        __syncthreads();
        if (u + G < 1536) ATT_FETCH(u + G);
        const int Iq = I0 + 16 * w + qn; const size_t tokq = (size_t)b * 4096 + r + d * Iq;
        f32x4 sc[9];
        const LAS unsigned char* kb = lds + (16 * w + qn) * ATT_PITCH + kg * 16;
#pragma unroll
        for (int kt = 0; kt < 9; ++kt) { const bf16x8 k0 = *(const LAS bf16x8*)(kb + kt * 16 * ATT_PITCH), k1 = *(const LAS bf16x8*)(kb + kt * 16 * ATT_PITCH + 64);
            f32x4 z = (f32x4){0.f, 0.f, 0.f, 0.f}; z = __builtin_amdgcn_mfma_f32_16x16x32_bf16(k0, q0, z, 0, 0, 0); sc[kt] = __builtin_amdgcn_mfma_f32_16x16x32_bf16(k1, q1, z, 0, 0, 0); }
        const int jb = 128 + qn - 4 * kg, ikb = I0 - 128 + 16 * w + 4 * kg;
        float m = -1e30f;
#pragma unroll
        for (int kt = 0; kt < 9; ++kt)
#pragma unroll
            for (int i = 0; i < 4; ++i) { const int j = jb - 16 * kt - i; const bool val = (j >= 0) && (j <= 128) && (ikb + 16 * kt + i >= 0); sc[kt][i] = val ? sc[kt][i] : -1e30f; m = fmaxf(m, sc[kt][i]); }
        m = fmaxf(m, __shfl_xor(m, 16)); m = fmaxf(m, __shfl_xor(m, 32));
        const float mc = m * csc; float l = 0.f;
        unsigned pk[10][2];
#pragma unroll
        for (int kt = 0; kt < 9; ++kt) { float p[4];
#pragma unroll
            for (int i = 0; i < 4; ++i) { p[i] = (sc[kt][i] > -1e29f) ? __builtin_amdgcn_exp2f(sc[kt][i] * csc - mc) : 0.f; l += p[i]; }
            pk[kt][0] = cvt_pk_bf16(p[0], p[1]); pk[kt][1] = cvt_pk_bf16(p[2], p[3]); }
        pk[9][0] = 0u; pk[9][1] = 0u;
        l += __shfl_xor(l, 16); l += __shfl_xor(l, 32);
        f32x4 o[4];
#pragma unroll
        for (int dt = 0; dt < 4; ++dt) o[dt] = (f32x4){0.f, 0.f, 0.f, 0.f};
#define ATT_PV(KK) do { s16x4 a0 = tr_read<(KK) * 32 * ATT_PITCH + 0>(vaddr), a1 = tr_read<(KK) * 32 * ATT_PITCH + 32>(vaddr), a2 = tr_read<(KK) * 32 * ATT_PITCH + 64>(vaddr), a3 = tr_read<(KK) * 32 * ATT_PITCH + 96>(vaddr); \
            s16x4 c0 = tr_read<(KK) * 32 * ATT_PITCH + 16 * ATT_PITCH + 0>(vaddr), c1 = tr_read<(KK) * 32 * ATT_PITCH + 16 * ATT_PITCH + 32>(vaddr), c2 = tr_read<(KK) * 32 * ATT_PITCH + 16 * ATT_PITCH + 64>(vaddr), c3 = tr_read<(KK) * 32 * ATT_PITCH + 16 * ATT_PITCH + 96>(vaddr); \
            tr_wait8(a0, a1, a2, a3, c0, c1, c2, c3); \
            u32x4 pw; pw.x = pk[2 * (KK)][0]; pw.y = pk[2 * (KK)][1]; pw.z = pk[2 * (KK) + 1][0]; pw.w = pk[2 * (KK) + 1][1]; \
            const bf16x8 pf = __builtin_bit_cast(bf16x8, pw); \
            o[0] = __builtin_amdgcn_mfma_f32_16x16x32_bf16(__builtin_shufflevector(a0, c0, 0, 1, 2, 3, 4, 5, 6, 7), pf, o[0], 0, 0, 0); \
            o[1] = __builtin_amdgcn_mfma_f32_16x16x32_bf16(__builtin_shufflevector(a1, c1, 0, 1, 2, 3, 4, 5, 6, 7), pf, o[1], 0, 0, 0); \
            o[2] = __builtin_amdgcn_mfma_f32_16x16x32_bf16(__builtin_shufflevector(a2, c2, 0, 1, 2, 3, 4, 5, 6, 7), pf, o[2], 0, 0, 0); \
            o[3] = __builtin_amdgcn_mfma_f32_16x16x32_bf16(__builtin_shufflevector(a3, c3, 0, 1, 2, 3, 4, 5, 6, 7), pf, o[3], 0, 0, 0); } while (0)
        ATT_PV(0); ATT_PV(1); ATT_PV(2); ATT_PV(3); ATT_PV(4);
        const float il = 1.0f / l;
        bf16_t* op = PO + ((size_t)g * NTOK + tokq) * 256 + h * 64 + 4 * kg;
#pragma unroll
        for (int dt = 0; dt < 4; ++dt) { u32x2 wv; wv.x = cvt_pk_bf16(o[dt][0] * il, o[dt][1] * il); wv.y = cvt_pk_bf16(o[dt][2] * il, o[dt][3] * il); *(u32x2*)(op + 16 * dt) = wv; }
        if (kg == 0) LSE[((size_t)g * NTOK + tokq) * 4 + h] = m * 0.125f + __logf(l);
    }
#undef ATT_PV
#undef ATT_FETCH
#undef ATT_DECODE
}

#define XB_TMO      128
#define XB_XCNT(j)  (256  + 64 * (j))
#define XB_XSUB(j)  (1280 + 64 * (j))
#define XB_XGEN(j)  (2304 + 64 * (j))
#define XB_TOP      3328
#define XB_TOPGEN   3392
#define XCD_BAR_WORDS 3456
#define XB_SPIN_CAP (1u << 20)
__device__ __forceinline__ unsigned xb_ld(unsigned* p)              { return __hip_atomic_load(p, __ATOMIC_RELAXED, __HIP_MEMORY_SCOPE_AGENT); }
__device__ __forceinline__ unsigned xb_add(unsigned* p, unsigned v) { return __hip_atomic_fetch_add(p, v, __ATOMIC_RELAXED, __HIP_MEMORY_SCOPE_AGENT); }
__device__ __forceinline__ unsigned xb_xcc_id() { return (unsigned)__builtin_amdgcn_s_getreg((3 << 11) | 20) & 0xFu; }
#define XB_SPIN(cond, bar) do { unsigned _sp = 0; while (cond) { __builtin_amdgcn_s_sleep(1); \
    if ((++_sp & 255u) == 0u) { if (xb_ld(&(bar)[XB_TMO])) break; if (_sp > XB_SPIN_CAP) { atomicAdd(&(bar)[XB_TMO], 1u); break; } } } } while (0)
struct XcdBarrier { unsigned* bar; unsigned x; volatile LAS unsigned* st; };
__device__ __forceinline__ XcdBarrier xcd_barrier_post(unsigned* bar, volatile LAS unsigned* st) {
    XcdBarrier b; b.bar = bar; b.x = xb_xcc_id(); b.st = st;
    if (threadIdx.x == 0) (void)xb_add(&bar[XB_XCNT(b.x)], 1u);
    return b;
}
__device__ __forceinline__ void xcd_barrier_complete(unsigned* bar, unsigned x, unsigned& nloc, unsigned& nx) {
    const unsigned G = gridDim.x * gridDim.y * gridDim.z;
    unsigned sum, cnt, mine, sp = 0u;
    for (;;) {
        sum = 0u; cnt = 0u; mine = 0u;
#pragma unroll
        for (unsigned j = 0; j < 16; ++j) { const unsigned c = xb_ld(&bar[XB_XCNT(j)]); sum += c; cnt += (c > 0u) ? 1u : 0u; mine = (j == x) ? c : mine; }
        if (sum == G) break;
        __builtin_amdgcn_s_sleep(1);
        if ((++sp & 255u) == 0u) { if (xb_ld(&bar[XB_TMO])) break; if (sp > XB_SPIN_CAP) { atomicAdd(&bar[XB_TMO], 1u); break; } }
    }
    nloc = mine > 0u ? mine : 1u; nx = cnt > 0u ? cnt : 1u;
}
__device__ __forceinline__ void xcd_barrier(const XcdBarrier& b) {
    asm volatile("s_waitcnt vmcnt(0)" ::: "memory");
    __syncthreads();
    if (threadIdx.x == 0) {
        unsigned* bar = b.bar;
        __builtin_amdgcn_s_waitcnt(0);
        unsigned nloc = b.st[0], nx = b.st[1];
        if (nloc == 0u) { xcd_barrier_complete(bar, b.x, nloc, nx); b.st[0] = nloc; b.st[1] = nx; }
        const unsigned old = xb_add(&bar[XB_XSUB(b.x)], 1u);
        const unsigned gen = old / nloc;
        if (old + 1u == (gen + 1u) * nloc) {
            __builtin_amdgcn_fence(__ATOMIC_RELEASE, "agent");
            asm volatile("s_waitcnt vmcnt(0)" ::: "memory");
            const unsigned og = xb_add(&bar[XB_TOP], 1u);
            const unsigned tg = og / nx;
            if (og + 1u == (tg + 1u) * nx) xb_add(&bar[XB_TOPGEN], 1u);
            else XB_SPIN(xb_ld(&bar[XB_TOPGEN]) == tg, bar);
            __builtin_amdgcn_fence(__ATOMIC_ACQUIRE, "agent");
            xb_add(&bar[XB_XGEN(b.x)], 1u);
            asm volatile("s_waitcnt vmcnt(0)" ::: "memory");
        } else {
            XB_SPIN(xb_ld(&bar[XB_XGEN(b.x)]) == gen, bar);
            __builtin_amdgcn_fence(__ATOMIC_ACQUIRE, "agent");
            asm volatile("s_waitcnt vmcnt(0)" ::: "memory");
        }
    }
    __syncthreads();
}

template <int GP> __device__ __forceinline__ void pool_item(const bf16_t* __restrict__ UB, bf16_t* __restrict__ PB, const float* __restrict__ sp, int tb, int cl) {
    constexpr int W = 2 << GP, NR = W + 7;
    const int c = (GP * 16 + cl) * 8;
    const int token0 = tb * 8; const bool samp = token0 >= NTP; const int t0 = samp ? 0 : (token0 & 4095); const int b = (token0 - NTP) >> 3;
    u32x4 R[NR];
#pragma unroll
    for (int r = 0; r < NR; ++r) { const int dt = r - (W - 1);
        if (dt >= 0 || t0 + dt >= 0) R[r] = *(const u32x4*)(UB + (size_t)(token0 + dt) * 512 + c);
        else if (samp) { const float* q = sp + (size_t)(b * 15 + 15 + dt) * 512 + c; const f32x4 a = *(const f32x4*)q, b2 = *(const f32x4*)(q + 4);
            R[r].x = cvt_pk_bf16(a[0], a[1]); R[r].y = cvt_pk_bf16(a[2], a[3]); R[r].z = cvt_pk_bf16(b2[0], b2[1]); R[r].w = cvt_pk_bf16(b2[2], b2[3]); }
        else R[r] = (u32x4){0u, 0u, 0u, 0u}; }
#pragma unroll
    for (int j = 0; j < 8; ++j) {
        float sum[8];
#pragma unroll
        for (int k = 0; k < 8; ++k) sum[k] = 0.f;
#pragma unroll
        for (int i = 0; i < W; ++i) { float f[8]; unpack8(R[j + (W - 1) - i], f);
#pragma unroll
            for (int k = 0; k < 8; ++k) sum[k] += f[k]; }
        float ut[8]; unpack8(R[j + W - 1], ut);
        const int t = t0 + j; const float cnt = samp ? (float)W : (float)(W < t + 1 ? W : t + 1); const float ic = 1.0f / cnt;
        float p[8];
#pragma unroll
        for (int k = 0; k < 8; ++k) p[k] = sum[k] * ic - ut[k];
        *(u32x4*)(PB + (size_t)(token0 + j) * 512 + c) = pack8(p);
    }
}

__global__ void __launch_bounds__(NTHREADS, 2) fwd_megakernel(Params P) {
    extern __shared__ __attribute__((aligned(16))) unsigned char lds_raw[];
    LAS unsigned char* lds = (LAS unsigned char*)lds_raw;
    cg::grid_group grid = cg::this_grid();
    const int tid = threadIdx.x, lane = tid & 63, wave = __builtin_amdgcn_readfirstlane(tid >> 6);
    const int G = gridDim.x, bid = blockIdx.x;
    const int gw = bid * 8 + wave, NGW = G * 8;
    const size_t gtid = (size_t)bid * NTHREADS + tid, nth = (size_t)G * NTHREADS;
    unsigned char* ws = P.ws;
    bf16_t* Wt_in = (bf16_t*)(ws + WS_WIN); bf16_t* Wt_pa = (bf16_t*)(ws + WS_WPA); bf16_t* Wt_pb = (bf16_t*)(ws + WS_WPB);
    bf16_t* Wt_o = (bf16_t*)(ws + WS_WO); bf16_t* Wt_up = (bf16_t*)(ws + WS_WUP); bf16_t* Wt_dn = (bf16_t*)(ws + WS_WDN);
    float* X = (float*)(ws + WS_X); bf16_t* XB = (bf16_t*)(ws + WS_XB); bf16_t* QKV = (bf16_t*)(ws + WS_QKV); bf16_t* UB = (bf16_t*)(ws + WS_U);
    bf16_t* GT = (bf16_t*)(ws + WS_G); bf16_t* OA = (bf16_t*)(ws + WS_OA); bf16_t* PB = (bf16_t*)(ws + WS_P); float* TMP = (float*)(ws + WS_TMP);
    bf16_t* MIX = (bf16_t*)(ws + WS_MIX); bf16_t* HID = (bf16_t*)(ws + WS_H); float* SS = (float*)(ws + WS_SS); float* ROPE = (float*)(ws + WS_ROPE);
    float* out = P.out;
    volatile LAS unsigned* bst = (volatile LAS unsigned*)(lds + LDS_BYTES - 16);
    if (tid == 0) { bst[0] = 0u; bst[1] = 0u; }
    __syncthreads();
    const XcdBarrier xb = xcd_barrier_post((unsigned*)(ws + WS_BAR), bst);

    {
        LAS float* LsT = (LAS float*)lds;
        LAS float* Ws = LsT + 128 * 128;
        for (int item = bid; item < DEPTH * 4 * 16; item += G) {
            const int l = item >> 6, g = (item >> 4) & 3, n0 = (item & 15) * 64;
            const float* lin = P.in[10] + (size_t)(l * 4 + g) * 128 * 128;
            const float* sc = P.in[11] + l * 512 + g * 128;
            const float* wpb = P.in[9] + (size_t)l * 512 * 1024 + (size_t)g * 128 * 1024;
            for (int i = tid; i < 128 * 128; i += NTHREADS) { const int c = i >> 7, d = i & 127; LsT[d * 128 + c] = lin[i] * sc[d]; }
            for (int i = tid; i < 128 * 64; i += NTHREADS) { const int d = i >> 6, n = i & 63; Ws[i] = wpb[(size_t)d * 1024 + n0 + n]; }
            __syncthreads();
            const int n = tid & 63, cgp = tid >> 6;
            float a[16];
#pragma unroll
            for (int i = 0; i < 16; ++i) a[i] = 0.f;
            for (int d = 0; d < 128; ++d) {
                const float w = Ws[d * 64 + n];
                const LAS f32x4* lp = (const LAS f32x4*)(LsT + d * 128 + cgp * 16);
#pragma unroll
                for (int q4 = 0; q4 < 4; ++q4) { const f32x4 lv = lp[q4];
#pragma unroll
                    for (int i = 0; i < 4; ++i) a[q4 * 4 + i] += lv[i] * w; }
            }
            bf16_t* op = Wt_pb + ((size_t)l * 1024 + n0 + n) * 512 + g * 128 + cgp * 16;
            u32x4 o0, o1; o0.x = cvt_pk_bf16(a[0], a[1]); o0.y = cvt_pk_bf16(a[2], a[3]); o0.z = cvt_pk_bf16(a[4], a[5]); o0.w = cvt_pk_bf16(a[6], a[7]);
            o1.x = cvt_pk_bf16(a[8], a[9]); o1.y = cvt_pk_bf16(a[10], a[11]); o1.z = cvt_pk_bf16(a[12], a[13]); o1.w = cvt_pk_bf16(a[14], a[15]);
            *(u32x4*)op = o0; *(u32x4*)(op + 8) = o1;
            __syncthreads();
        }
        {
            LAS float* scr = (LAS float*)(lds + wave * 16640);
            constexpr int I_IN = 16 * 76, I_PA = 4 * 16, I_O = 16 * 16, I_UP = 16 * 64, I_DN = 64 * 16, I_L = I_IN + I_PA + I_O + I_UP + I_DN;
            for (int it = gw; it < DEPTH * I_L; it += NGW) {
                const int l = it / I_L; int r = it - l * I_L;
                if (r < I_IN) { transpose_item(P.in[7] + (size_t)l * DM * NIN, P.in[6] + l * DM, DM, NIN, Wt_in + (size_t)l * NIN * DM, scr, r, lane); continue; } r -= I_IN;
                if (r < I_PA) { transpose_item(P.in[8] + (size_t)l * 256 * DM, nullptr, 256, DM, Wt_pa + (size_t)l * DM * 256, scr, r, lane); continue; } r -= I_PA;
                if (r < I_O) { transpose_item(P.in[12] + (size_t)l * DM * DM, nullptr, DM, DM, Wt_o + (size_t)l * DM * DM, scr, r, lane); continue; } r -= I_O;
                if (r < I_UP) { transpose_item(P.in[14] + (size_t)l * DM * DFF, P.in[13] + l * DM, DM, DFF, Wt_up + (size_t)l * DFF * DM, scr, r, lane); continue; } r -= I_UP;
                transpose_item(P.in[15] + (size_t)l * DFF * DM, nullptr, DFF, DM, Wt_dn + (size_t)l * DM * DFF, scr, r, lane);
            }
        }
        for (int row = gw; row < NTOK; row += NGW) {
            const float* src = row < NTP ? P.in[0] + (size_t)row * DM : P.in[1] + (size_t)(row - NTP) * DM;
            float s = 0.f;
#pragma unroll
            for (int j = 0; j < 4; ++j) { const f32x4 v = *(const f32x4*)(src + 4 * lane + 256 * j); s += v[0] * v[0] + v[1] * v[1] + v[2] * v[2] + v[3] * v[3];
                *(f32x4*)(X + (size_t)row * DM + 4 * lane + 256 * j) = v;
                u32x2 w; w.x = cvt_pk_bf16(v[0], v[1]); w.y = cvt_pk_bf16(v[2], v[3]); *(u32x2*)(XB + (size_t)row * DM + 4 * lane + 256 * j) = w; }
#pragma unroll
            for (int o = 1; o < 64; o <<= 1) s += __shfl_xor(s, o);
            if (lane == 0) SS[row] = s;
        }
        for (size_t i = gtid; i < 4104 * 8; i += nth) { const int pi = (int)(i >> 3), k = (int)(i & 7); const float pos = (float)(pi < 4096 ? pi : 8192 + pi - 4096);
            const float inv = powf(500000.0f, -(float)(2 * k) / 16.0f); const float ang = pos * inv; ROPE[pi * 16 + k] = cosf(ang); ROPE[pi * 16 + 8 + k] = sinf(ang); }
        for (size_t i = gtid; i < (size_t)8 * NTOK; i += nth) SS[NTOK + i] = 0.f;
        for (size_t i = gtid; i < (size_t)DEPTH * 32 * 7 * 128; i += nth) { const size_t lb = i / (7 * 128), r = i - lb * (7 * 128);
            *(f32x4*)(out + O_POOLS + lb * 15 * 512 + r * 4) = *(const f32x4*)(P.in[5] + lb * 15 * 512 + 8 * 512 + r * 4); }
    }
    grid.sync();

    pg8::StaticOrder S;
#pragma unroll 1
    for (int step = 0; step < DEPTH * 7; ++step) {
        const int layer = step / 7, st = step - layer * 7;
        if (st == 1) {
            int tid_l = threadIdx.x; asm volatile("" : "+v"(tid_l));
            const int lane = tid_l & 63, gw = bid * 8 + (tid_l >> 6);
            const size_t gtid = (size_t)bid * NTHREADS + tid_l;
            unsigned char* wsl = ws; asm volatile("" : "+s"(wsl));
            bf16_t* QKV = (bf16_t*)(wsl + WS_QKV); bf16_t* UB = (bf16_t*)(wsl + WS_U); bf16_t* OA = (bf16_t*)(wsl + WS_OA); bf16_t* PB = (bf16_t*)(wsl + WS_P);
            bf16_t* PO = (bf16_t*)(wsl + WS_TMP); float* LSE = (float*)(wsl + WS_TMP + (size_t)3 * NTOK * 256 * 2);
            for (int it = gw; it < NTS * 12; it += NGW) { const int g = it % 3, r = it / 3; attn_sample_sub(QKV, g == 0 ? P.in[2] : (g == 1 ? P.in[3] : P.in[4]), PO, LSE, layer, r >> 2, r & 3, g, lane); }
            attn_mfma_phase(lds, QKV, PO, LSE, bid, G, tid_l);
            copy_shift<128>(P.in[2], out + O_KVS0, layer, gtid, nth);
            copy_shift<512>(P.in[3], out + O_KVS1, layer, gtid, nth);
            copy_shift<2048>(P.in[4], out + O_KVS2, layer, gtid, nth);
            xcd_barrier(xb);
            for (size_t idx = gtid; idx < (size_t)NTOK * 32; idx += nth) {
                const size_t token = idx >> 5; const int c = (int)(idx & 31) * 8, h = c >> 6;
                const float l0 = LSE[(0 * (size_t)NTOK + token) * 4 + h], l1 = LSE[(1 * (size_t)NTOK + token) * 4 + h], l2 = LSE[(2 * (size_t)NTOK + token) * 4 + h];
                const float mx = fmaxf(l0, fmaxf(l1, l2)); float w0 = __expf(l0 - mx), w1 = __expf(l1 - mx), w2 = __expf(l2 - mx); const float iw = 1.0f / (w0 + w1 + w2); w0 *= iw; w1 *= iw; w2 *= iw;
                float a0[8], a1[8], a2[8], o[8];
                unpack8(*(const u32x4*)(PO + (0 * (size_t)NTOK + token) * 256 + c), a0); unpack8(*(const u32x4*)(PO + (1 * (size_t)NTOK + token) * 256 + c), a1); unpack8(*(const u32x4*)(PO + (2 * (size_t)NTOK + token) * 256 + c), a2);
#pragma unroll
                for (int k = 0; k < 8; ++k) o[k] = w0 * a0[k] + w1 * a1[k] + w2 * a2[k];
                *(u32x4*)(OA + token * 256 + c) = pack8(o);
            }
            const float* sp = P.in[5] + (size_t)layer * 32 * 15 * 512;
            for (int it = (int)gtid; it < 4 * (NTOK / 8) * 16; it += (int)nth) {
                const int cl = it & 15, q = it >> 4, g = q / (NTOK / 8), tb = q - g * (NTOK / 8);
                if (g == 0) pool_item<0>(UB, PB, sp, tb, cl); else if (g == 1) pool_item<1>(UB, PB, sp, tb, cl); else if (g == 2) pool_item<2>(UB, PB, sp, tb, cl); else pool_item<3>(UB, PB, sp, tb, cl);
            }
            xcd_barrier(xb);
            continue;
        }
        pg8::Gemm g; EpiAll E; E.ws = ws; E.out = out; E.layer = layer; E.ssi = 0; E.ssn = 0;
        const int Mg = (st == 0) ? NTOK : NTP;
        g.M = Mg;
        if (st == 0)      { g.A = XB;  g.Bt = Wt_in + (size_t)layer * NIN * DM; g.N = NIN; g.K = DM;  E.mode = 0; E.ssi = 2 * layer; }
        else if (st == 2) { g.A = OA;  g.Bt = Wt_pa + (size_t)layer * DM * 256; g.N = DM;  g.K = 256; E.mode = 1; }
        else if (st == 3) { g.A = PB;  g.Bt = Wt_pb + (size_t)layer * DM * 512; g.N = DM;  g.K = 512; E.mode = 2; }
        else if (st == 4) { g.A = MIX; g.Bt = Wt_o + (size_t)layer * DM * DM;   g.N = DM;  g.K = DM;  E.mode = 3; E.ssn = 2 * layer + 1; }
        else if (st == 5) { g.A = XB;  g.Bt = Wt_up + (size_t)layer * DFF * DM; g.N = DFF; g.K = DM;  E.mode = 4; E.ssi = 2 * layer + 1; }
        else              { g.A = HID; g.Bt = Wt_dn + (size_t)layer * DM * DFF; g.N = DM;  g.K = DFF; E.mode = 3; E.ssn = 2 * layer + 2; }
        S.init(Mg, g.N, G, bid);
        pg8::gemm_phase<EpiAll, pg8::StaticOrder, true, true>(lds, g, S, E);
        if (st != 0) skinny_gemm(lds, g.A + (size_t)NTP * g.K, g.Bt, g.N, g.K, E, G - 1 - bid, G);
        if (st != 2) xcd_barrier(xb);
    }
    {
        int tid_l = threadIdx.x; asm volatile("" : "+v"(tid_l));
        const int lane = tid_l & 63, gw = bid * 8 + (tid_l >> 6);
        unsigned char* wsl = ws; asm volatile("" : "+s"(wsl));
        float* X = (float*)(wsl + WS_X);
        const float* fn = P.in[16]; const float* ssf = (const float*)(wsl + WS_SS) + (size_t)8 * NTOK;
        for (int row = gw; row < NTOK; row += NGW) {
            const float rs = rsqrtf(ssf[row] * (1.0f / 1024.0f) + 1e-6f);
#pragma unroll
            for (int j = 0; j < 4; ++j) { const int c = 4 * lane + 256 * j; const f32x4 v = *(const f32x4*)(X + (size_t)row * DM + c); const f32x4 gn = *(const f32x4*)(fn + c);
                *(f32x4*)(out + (size_t)row * DM + c) = (f32x4){v[0] * rs * gn[0], v[1] * rs * gn[1], v[2] * rs * gn[2], v[3] * rs * gn[3]}; }
        }
    }
}

extern "C" void kernel_launch(void* const* d_in, const int* in_sizes, int n_in, void* d_out, int out_size, void* d_ws, size_t ws_size, hipStream_t stream) {
    static int grid_blocks = 0;
    if (grid_blocks == 0) {
        if (n_in != 17 || ws_size < WS_END) { fprintf(stderr, "kernel_launch: unexpected n_in %d / ws %zu (need %zu)\n", n_in, ws_size, (size_t)WS_END); grid_blocks = -1; return; }
        int dev = 0, cus = 0, per_cu = 0;
        (void)hipGetDevice(&dev);
        (void)hipDeviceGetAttribute(&cus, hipDeviceAttributeMultiprocessorCount, dev);
        if (hipFuncSetAttribute((const void*)fwd_megakernel, hipFuncAttributeMaxDynamicSharedMemorySize, LDS_BYTES) != hipSuccess) { fprintf(stderr, "kernel_launch: hipFuncSetAttribute failed\n"); grid_blocks = -1; return; }
        (void)hipOccupancyMaxActiveBlocksPerMultiprocessor(&per_cu, (const void*)fwd_megakernel, NTHREADS, LDS_BYTES);
        if (per_cu < 1) { fprintf(stderr, "kernel_launch: occupancy query says %d blocks/CU\n", per_cu); grid_blocks = -1; return; }
        grid_blocks = cus * 1;
    }
    if (grid_blocks < 0) return;
    if (hipMemsetAsync((unsigned char*)d_ws + WS_BAR, 0, 4096 * 4, stream) != hipSuccess) { fprintf(stderr, "kernel_launch: memset of barrier words failed\n"); return; }
    Params p{};
    for (int i = 0; i < 17; ++i) p.in[i] = (const float*)d_in[i];
    p.out = (float*)d_out; p.ws = (unsigned char*)d_ws;
    void* args[] = {&p};
    hipError_t e = hipLaunchCooperativeKernel((const void*)fwd_megakernel, dim3(grid_blocks), dim3(NTHREADS), args, LDS_BYTES, stream);
    if (e != hipSuccess) fprintf(stderr, "cooperative launch failed: %s (grid %d)\n", hipGetErrorString(e), grid_blocks);
}
```

```cpp
#include <hip/hip_runtime.h>
#include <hip/hip_cooperative_groups.h>
#include <cstdio>
#include <cstdint>
namespace cg = cooperative_groups;

namespace pg8 {
#define PG8_LAS __attribute__((address_space(3)))
typedef unsigned short bf16_t;
typedef short bf16x8 __attribute__((ext_vector_type(8)));
typedef float f32x4 __attribute__((ext_vector_type(4)));
typedef unsigned u32x4 __attribute__((ext_vector_type(4)));
typedef unsigned u32x2 __attribute__((ext_vector_type(2)));
constexpr int BM = 256, BK = 64, HALF = 128, HTB = HALF * BK * 2, STAGE_BYTES = 8 * HTB, NXCD = 8, WGM = 8;

__host__ __device__ __forceinline__ int lds_byte(int r, int c) { const int st = (r >> 4) * 2 + (c >> 5), rr = r & 15, cc = c & 31, ob = rr * 64 + cc * 2; return st * 1024 + (ob ^ (((ob >> 9) & 1) << 5)); }
__host__ __device__ __forceinline__ void stage_rc(int b, int& R, int& C) { const int st = b / 1024, sb = b % 1024, swz = sb ^ (((sb >> 9) & 1) << 5); R = (st >> 1) * 16 + swz / 64; C = (st & 1) * 32 + (swz % 64) / 2; }
__host__ __device__ __forceinline__ int perm32(int rho) { const int n = rho >> 4, i = rho & 15; return 8 * (i >> 2) + 4 * n + (i & 3); }

struct Unit { int pm, pn; };
struct Gemm { const bf16_t* A; const bf16_t* Bt; int M, N, K; };

struct StaticOrder {
    int nM, nN, nwg, G, c;
    __host__ __device__ void init(int M, int N, int G_, int c_) { nM = M / BM; nN = N / BM; nwg = nM * nN; G = G_; c = c_; }
    __host__ __device__ bool next(int i, Unit& u) const {
        const long L = (long)i * G + c; if (L >= nwg) return false;
        int wgid = (int)L; { const int q = nwg / NXCD, r = nwg % NXCD, xcd = wgid % NXCD, off = wgid / NXCD; wgid = (xcd < r ? xcd * (q + 1) : r * (q + 1) + (xcd - r) * q) + off; }
        const int nig = WGM * nN, gid = wgid / nig, fm = gid * WGM, gsz = (nM - fm) < WGM ? (nM - fm) : WGM;
        u.pm = fm + ((wgid % nig) % gsz); u.pn = (wgid % nig) / gsz; return true;
    }
    __device__ __forceinline__ void a_ready(const Unit&) const {}
    __device__ __forceinline__ void done(const Unit&) const {}
};

__device__ __forceinline__ unsigned cvt_pk_bf16(float lo, float hi) { unsigned r; asm volatile("v_cvt_pk_bf16_f32 %0, %1, %2" : "=v"(r) : "v"(lo), "v"(hi)); return r; }

template <class Epi, class Sched, bool ALIGN_EPI = false, bool SP2 = false>
__device__ __forceinline__ void gemm_phase(PG8_LAS unsigned char* lds, const Gemm g, const Sched& S, const Epi& E) {
    int tid = threadIdx.x; asm volatile("" : "+v"(tid));
    const int wid = __builtin_amdgcn_readfirstlane(tid >> 6), lane = tid & 63, wr = wid >> 2, wc = wid & 3, fr = lane & 15, fq = lane >> 4;
    const int K = g.K, nt = K / BK;
    unsigned voffA[2], voffB[2];
#pragma unroll
    for (int i = 0; i < 2; ++i) { int R, C; stage_rc(tid * 16 + i * 8192, R, C); const int Rb = Epi::PERM ? ((R & ~31) + perm32(R & 31)) : R;
        voffA[i] = (unsigned)(R * K + C) * 2u; voffB[i] = (unsigned)(Rb * K + C) * 2u; }
    const size_t kstep = (size_t)(BK * 2);
    const size_t hstep = (size_t)HALF * K * 2;
    const size_t tstep = 2 * hstep;
    const unsigned ldsw = (unsigned)wid * 1024u;
    const int aoff = lds_byte(wr * 64 + fr, fq * 8), boff = lds_byte(wc * 32 + fr, fq * 8);
#define PG8_SA(b, h) (((b) * 2 + (h)) * HTB)
#define PG8_SB(b, h) ((4 + (b) * 2 + (h)) * HTB)
#define PG8_STAGE(bufoff, gbase, voff) do { _Pragma("unroll") for (int _i = 0; _i < 2; ++_i) \
        __builtin_amdgcn_global_load_lds((const unsigned*)((const char*)(gbase) + (voff)[_i]), (PG8_LAS unsigned*)(lds + (bufoff) + ldsw + _i * 8192), 16, 0, 0); } while (0)
#define PG8_LDA(dst, b, h) do { _Pragma("unroll") for (int m = 0; m < 4; ++m) _Pragma("unroll") for (int k = 0; k < 2; ++k) dst[m][k] = *(const PG8_LAS bf16x8*)(lds + PG8_SA(b, h) + aoff + m * 2048 + k * 1024); } while (0)
#define PG8_LDB(dst, b, h) do { _Pragma("unroll") for (int n = 0; n < 2; ++n) _Pragma("unroll") for (int k = 0; k < 2; ++k) dst[n][k] = *(const PG8_LAS bf16x8*)(lds + PG8_SB(b, h) + boff + n * 2048 + k * 1024); } while (0)
#define PG8_MMA(ai, bj, At, Bt) do { __builtin_amdgcn_s_setprio(1); _Pragma("unroll") for (int m = 0; m < 4; ++m) _Pragma("unroll") for (int n = 0; n < 2; ++n) _Pragma("unroll") for (int k = 0; k < 2; ++k) \
        acc[ai][bj][m][n] = __builtin_amdgcn_mfma_f32_16x16x32_bf16(Bt[n][k], At[m][k], acc[ai][bj][m][n], 0, 0, 0); __builtin_amdgcn_s_setprio(0); } while (0)
#define PG8_WAIT_V(n) asm volatile("s_waitcnt vmcnt(" #n ")" ::: "memory")
#define PG8_WAIT_L(n) asm volatile("s_waitcnt lgkmcnt(" #n ")" ::: "memory")
#define PG8_BAR __builtin_amdgcn_s_barrier()
#define PG8_SCHED __builtin_amdgcn_sched_barrier(0)
    Unit cur, nxt; int ui = 0;
    if (!S.next(0, cur)) return;
    f32x4 acc[2][2][4][2];
#pragma unroll
    for (int a = 0; a < 2; ++a)
#pragma unroll
        for (int b = 0; b < 2; ++b)
#pragma unroll
            for (int m = 0; m < 4; ++m)
#pragma unroll
                for (int n = 0; n < 2; ++n) acc[a][b][m][n] = (f32x4){0.f, 0.f, 0.f, 0.f};
    bf16x8 At[4][2], B0[2][2], B1[2][2];
    const char* cA = (const char*)g.A + (size_t)cur.pm * tstep; const char* cB = (const char*)g.Bt + (size_t)cur.pn * tstep;
    S.a_ready(cur);
    if constexpr (SP2) {
        PG8_STAGE(PG8_SB(0, 0), cB, voffB); PG8_STAGE(PG8_SB(0, 1), cB + hstep, voffB); PG8_STAGE(PG8_SA(0, 0), cA, voffA); PG8_STAGE(PG8_SA(0, 1), cA + hstep, voffA);
        if (wr == 1) PG8_BAR;
        PG8_WAIT_V(2); PG8_BAR;
        PG8_STAGE(PG8_SB(1, 0), cB + kstep, voffB); PG8_STAGE(PG8_SA(1, 0), cA + kstep, voffA); PG8_STAGE(PG8_SB(1, 1), cB + hstep + kstep, voffB);
        PG8_WAIT_V(6); PG8_BAR;
    } else {
        PG8_STAGE(PG8_SB(0, 0), cB, voffB); PG8_STAGE(PG8_SA(0, 0), cA, voffA); PG8_STAGE(PG8_SB(0, 1), cB + hstep, voffB); PG8_STAGE(PG8_SA(0, 1), cA + hstep, voffA);
        if (wr == 1) PG8_BAR;
        PG8_WAIT_V(4); PG8_BAR;
        PG8_STAGE(PG8_SB(1, 0), cB + kstep, voffB); PG8_STAGE(PG8_SA(1, 0), cA + kstep, voffA); PG8_STAGE(PG8_SB(1, 1), cB + hstep + kstep, voffB);
        PG8_WAIT_V(6); PG8_BAR;
    }
    for (;;) {
        const bool has_next = S.next(ui + 1, nxt);
        const char* nA = has_next ? (const char*)g.A + (size_t)nxt.pm * tstep : cA; const char* nB = has_next ? (const char*)g.Bt + (size_t)nxt.pn * tstep : cB;
        for (int t = 0; t < nt; t += 2) {
            const bool last = (t == nt - 2);
            const char* a1 = cA + (size_t)(t + 1) * kstep;
            const char* a2 = last ? nA : cA + (size_t)(t + 2) * kstep; const char* b2 = last ? nB : cB + (size_t)(t + 2) * kstep;
            const char* a3 = a2 + kstep; const char* b3 = b2 + kstep;
            if (last && has_next) S.a_ready(nxt);
            if constexpr (SP2) {
            PG8_LDB(B0, 0, 0); PG8_LDB(B1, 0, 1); PG8_SCHED; PG8_LDA(At, 0, 0); PG8_STAGE(PG8_SA(1, 1), a1 + hstep, voffA);
            PG8_WAIT_V(8); PG8_WAIT_L(0); PG8_BAR; PG8_MMA(0, 0, At, B0); PG8_MMA(0, 1, At, B1); PG8_BAR; PG8_SCHED;
            PG8_LDA(At, 0, 1); PG8_STAGE(PG8_SB(0, 0), b2, voffB); PG8_STAGE(PG8_SB(0, 1), b2 + hstep, voffB); PG8_STAGE(PG8_SA(0, 0), a2, voffA);
            PG8_WAIT_V(8); PG8_WAIT_L(0); PG8_BAR; PG8_MMA(1, 0, At, B0); PG8_MMA(1, 1, At, B1); PG8_BAR; PG8_SCHED;
            PG8_LDB(B0, 1, 0); PG8_LDB(B1, 1, 1); PG8_SCHED; PG8_LDA(At, 1, 0); PG8_STAGE(PG8_SA(0, 1), a2 + hstep, voffA);
            PG8_WAIT_V(8); PG8_WAIT_L(0); PG8_BAR; PG8_MMA(0, 0, At, B0); PG8_MMA(0, 1, At, B1); PG8_BAR; PG8_SCHED;
            PG8_LDA(At, 1, 1); PG8_STAGE(PG8_SB(1, 0), b3, voffB); PG8_STAGE(PG8_SB(1, 1), b3 + hstep, voffB); PG8_STAGE(PG8_SA(1, 0), a3, voffA);
            PG8_WAIT_V(8); PG8_WAIT_L(0); PG8_BAR; PG8_MMA(1, 0, At, B0); PG8_MMA(1, 1, At, B1); PG8_BAR; PG8_SCHED;
            } else {
            PG8_LDB(B0, 0, 0); PG8_SCHED; PG8_LDA(At, 0, 0); PG8_STAGE(PG8_SA(1, 1), a1 + hstep, voffA);
            PG8_WAIT_L(8); PG8_BAR; PG8_WAIT_L(0); PG8_MMA(0, 0, At, B0); PG8_BAR; PG8_SCHED;
            PG8_LDB(B1, 0, 1); PG8_STAGE(PG8_SB(0, 0), b2, voffB);
            PG8_BAR; PG8_WAIT_L(0); PG8_MMA(0, 1, At, B1); PG8_BAR;
            PG8_LDA(At, 0, 1); PG8_STAGE(PG8_SA(0, 0), a2, voffA);
            PG8_BAR; PG8_WAIT_L(0); PG8_MMA(1, 0, At, B0); PG8_BAR; PG8_SCHED;
            PG8_STAGE(PG8_SB(0, 1), b2 + hstep, voffB);
            PG8_WAIT_V(6); PG8_BAR; PG8_MMA(1, 1, At, B1); PG8_BAR;
            PG8_LDB(B0, 1, 0); PG8_SCHED; PG8_LDA(At, 1, 0); PG8_STAGE(PG8_SA(0, 1), a2 + hstep, voffA);
            PG8_WAIT_L(8); PG8_BAR; PG8_WAIT_L(0); PG8_MMA(0, 0, At, B0); PG8_BAR; PG8_SCHED;
            PG8_LDB(B1, 1, 1); PG8_STAGE(PG8_SB(1, 0), b3, voffB);
            PG8_BAR; PG8_WAIT_L(0); PG8_MMA(0, 1, At, B1); PG8_BAR;
            PG8_LDA(At, 1, 1); PG8_STAGE(PG8_SA(1, 0), a3, voffA);
            PG8_BAR; PG8_WAIT_L(0); PG8_MMA(1, 0, At, B0); PG8_BAR; PG8_SCHED;
            PG8_STAGE(PG8_SB(1, 1), b3 + hstep, voffB);
            PG8_WAIT_V(6); PG8_BAR; PG8_MMA(1, 1, At, B1); PG8_BAR;
            }
        }
        if constexpr (ALIGN_EPI) { if (wr == 0) PG8_BAR; }
        E(acc, cur, wr, wc, fr, fq); S.done(cur);
        if (!has_next) break;
#pragma unroll
        for (int a = 0; a < 2; ++a)
#pragma unroll
            for (int b = 0; b < 2; ++b)
#pragma unroll
                for (int m = 0; m < 4; ++m)
#pragma unroll
                    for (int n = 0; n < 2; ++n) acc[a][b][m][n] = (f32x4){0.f, 0.f, 0.f, 0.f};
        cur = nxt; cA = nA; cB = nB; ++ui;
        if constexpr (ALIGN_EPI) { if (wr == 1) PG8_BAR; }
    }
    PG8_WAIT_V(0);
    if constexpr (!ALIGN_EPI) { if (wr == 0) PG8_BAR; }
    PG8_BAR;
#undef PG8_SA
#undef PG8_SB
#undef PG8_STAGE
#undef PG8_LDA
#undef PG8_LDB
#undef PG8_MMA
#undef PG8_WAIT_V
#undef PG8_WAIT_L
#undef PG8_BAR
#undef PG8_SCHED
}
}

using pg8::bf16_t; using pg8::f32x4; using pg8::u32x4; using pg8::u32x2; using pg8::Unit; using pg8::cvt_pk_bf16;
#define LAS __attribute__((address_space(3)))

constexpr int DM = 1024, TP = 4096, NTP = 16384, NTS = 256, NTOK = 16640, DEPTH = 4, NIN = 4864, DFF = 4096;
constexpr int NTHREADS = 512, LDS_BYTES = 147456;
constexpr size_t O_YP = 0, O_YS = 16777216, O_KVP0 = 17039360, O_KVP1 = 18087936, O_KVP2 = 22282240, O_POOLP = 39059456,
                 O_KVS0 = 39182336, O_KVS1 = 47570944, O_KVS2 = 81125376, O_POOLS = 215343104;
constexpr size_t WS_WIN = 0;
constexpr size_t WS_WPA = WS_WIN + (size_t)DEPTH * NIN * DM * 2;
constexpr size_t WS_WPB = WS_WPA + (size_t)DEPTH * DM * 256 * 2;
constexpr size_t WS_WO  = WS_WPB + (size_t)DEPTH * DM * 512 * 2;
constexpr size_t WS_WUP = WS_WO  + (size_t)DEPTH * DM * DM * 2;
constexpr size_t WS_WDN = WS_WUP + (size_t)DEPTH * DFF * DM * 2;
constexpr size_t WS_X   = WS_WDN + (size_t)DEPTH * DM * DFF * 2;
constexpr size_t WS_XB  = WS_X   + (size_t)NTOK * DM * 4;
constexpr size_t WS_QKV = WS_XB  + (size_t)NTOK * DM * 2;
constexpr size_t WS_U   = WS_QKV + (size_t)NTOK * 2304 * 2;
constexpr size_t WS_G   = WS_U   + (size_t)NTOK * 512 * 2;
constexpr size_t WS_OA  = WS_G   + (size_t)NTOK * 2048 * 2;
constexpr size_t WS_P   = WS_OA  + (size_t)NTOK * 256 * 2;
constexpr size_t WS_TMP = WS_P   + (size_t)NTOK * 512 * 2;
constexpr size_t WS_MIX = WS_TMP + (size_t)NTOK * DM * 4;
constexpr size_t WS_H   = WS_MIX + (size_t)NTOK * DM * 2;
constexpr size_t WS_SS  = WS_H   + (size_t)NTOK * DFF * 2;
constexpr size_t WS_ROPE = WS_SS + (size_t)9 * NTOK * 4;
constexpr size_t WS_BAR = WS_ROPE + (size_t)4104 * 16 * 4;
constexpr size_t WS_END = WS_BAR + (size_t)4096 * 4;

struct Params { const float* in[17]; float* out; unsigned char* ws; };

__device__ __forceinline__ void unpack8(const u32x4 w, float (&f)[8]) {
    f[0] = __uint_as_float(w.x << 16); f[1] = __uint_as_float(w.x & 0xffff0000u);
    f[2] = __uint_as_float(w.y << 16); f[3] = __uint_as_float(w.y & 0xffff0000u);
    f[4] = __uint_as_float(w.z << 16); f[5] = __uint_as_float(w.z & 0xffff0000u);
    f[6] = __uint_as_float(w.w << 16); f[7] = __uint_as_float(w.w & 0xffff0000u);
}
__device__ __forceinline__ u32x4 pack8(const float (&f)[8]) {
    u32x4 w; w.x = cvt_pk_bf16(f[0], f[1]); w.y = cvt_pk_bf16(f[2], f[3]); w.z = cvt_pk_bf16(f[4], f[5]); w.w = cvt_pk_bf16(f[6], f[7]); return w;
}
__device__ __forceinline__ float sigmoidf_(float x) { return 1.0f / (1.0f + __expf(-x)); }

struct EpiAll {
    static constexpr bool PERM = true, AFTER_DRAIN = false;
    int mode, layer, ssi, ssn; unsigned char* ws; float* out;

    struct Pre { u32x4 g; f32x4 a, b; float rs; };

    template <int MODE> __device__ __forceinline__ Pre pre(unsigned char* ws, int row, int c) const {
        Pre p;
        if constexpr (MODE == 0 || MODE == 4) p.rs = ((const float*)(ws + WS_SS) + (size_t)ssi * NTOK)[row];
        if constexpr (MODE == 1) p.g = *(const u32x4*)((const bf16_t*)(ws + WS_G) + (size_t)row * 2048 + c);
        if constexpr (MODE == 2) { p.g = *(const u32x4*)((const bf16_t*)(ws + WS_G) + (size_t)row * 2048 + 1024 + c);
            const float* tp = (const float*)(ws + WS_TMP) + (size_t)row * DM + c; p.a = *(const f32x4*)tp; p.b = *(const f32x4*)(tp + 4); }
        if constexpr (MODE == 3) { const float* xp = (const float*)(ws + WS_X) + (size_t)row * DM + c; p.a = *(const f32x4*)xp; p.b = *(const f32x4*)(xp + 4); }
        return p;
    }
    __device__ __forceinline__ void fin_proj(unsigned char* ws, int row, int c32, int fq, float (&v)[8], const Pre& p) const {
        const int pn = c32 >> 8, cl = (c32 & 255) + 8 * fq;
        const float rs = rsqrtf(p.rs * (1.0f / 1024.0f) + 1e-6f);
        const bool samp = row >= NTP;
        const int b = samp ? ((row - NTP) >> 3) : (row >> 12);
        const int t = samp ? (row & 7) : (row & 4095);
#pragma unroll
        for (int i = 0; i < 8; ++i) v[i] *= rs;
        if (pn < 6 && ((c32 >> 5) & 1) == 0) {
            float pv[8];
#pragma unroll
            for (int i = 0; i < 8; ++i) pv[i] = __shfl_xor(v[i], 16);
            if (fq < 2) {
                const int pi = samp ? (4096 + t) : t;
                const f32x4* rp = (const f32x4*)((const float*)(ws + WS_ROPE) + (size_t)pi * 16);
                const f32x4 c0 = rp[0], c1 = rp[1], s0 = rp[2], s1 = rp[3];
                const float sg = (fq == 0) ? -1.0f : 1.0f;
#pragma unroll
                for (int i = 0; i < 4; ++i) { v[i] = v[i] * c0[i] + sg * pv[i] * s0[i]; v[4 + i] = v[4 + i] * c1[i] + sg * pv[4 + i] * s1[i]; }
            }
        }
        if (pn >= 11) {
#pragma unroll
            for (int i = 0; i < 8; ++i) v[i] = sigmoidf_(v[i]);
        }
        bf16_t* dst; int ld, cbase;
        if (pn < 9) { dst = (bf16_t*)(ws + WS_QKV); ld = 2304; cbase = pn * 256; }
        else if (pn < 11) { dst = (bf16_t*)(ws + WS_U); ld = 512; cbase = (pn - 9) * 256; }
        else { dst = (bf16_t*)(ws + WS_G); ld = 2048; cbase = (pn - 11) * 256; }
        *(u32x4*)(dst + (size_t)row * ld + cbase + cl) = pack8(v);
        if (pn >= 3 && pn < 9) {
            const int kvi = pn - 3; const int g = (kvi >= 3) ? kvi - 3 : kvi; const int kv = (kvi >= 3) ? 1 : 0;
            const int W = 128 << (2 * g);
            const size_t okp = (g == 0) ? O_KVP0 : (g == 1 ? O_KVP1 : O_KVP2);
            const size_t oks = (g == 0) ? O_KVS0 : (g == 1 ? O_KVS1 : O_KVS2);
            float* op = nullptr;
            if (samp) op = out + oks + ((size_t)((layer * 32 + b) * W + (W - 8 + t)) * 2 + kv) * 256 + cl;
            else if (t >= TP - W) op = out + okp + ((size_t)((layer * 4 + b) * W + (t - (TP - W))) * 2 + kv) * 256 + cl;
            if (op) { *(f32x4*)op = (f32x4){v[0], v[1], v[2], v[3]}; *(f32x4*)(op + 4) = (f32x4){v[4], v[5], v[6], v[7]}; }
        } else if (pn >= 9 && pn < 11) {
            float* op = nullptr; const int c = cbase + cl;
            if (samp) op = out + O_POOLS + (size_t)((layer * 32 + b) * 15 + 7 + t) * 512 + c;
            else if (t >= TP - 15) op = out + O_POOLP + (size_t)((layer * 4 + b) * 15 + (t - (TP - 15))) * 512 + c;
            if (op) { *(f32x4*)op = (f32x4){v[0], v[1], v[2], v[3]}; *(f32x4*)(op + 4) = (f32x4){v[4], v[5], v[6], v[7]}; }
        }
    }
    template <int MODE> __device__ __forceinline__ void fin(unsigned char* ws, int row, int c32, int fq, float (&v)[8], const Pre& p) const {
        const int c = c32 + 8 * fq;
        if constexpr (MODE == 0) fin_proj(ws, row, c32, fq, v, p);
        if constexpr (MODE == 1) {
            float gg[8]; unpack8(p.g, gg);
            float* tp = (float*)(ws + WS_TMP) + (size_t)row * DM + c;
            *(f32x4*)tp = (f32x4){gg[0] * v[0], gg[1] * v[1], gg[2] * v[2], gg[3] * v[3]};
            *(f32x4*)(tp + 4) = (f32x4){gg[4] * v[4], gg[5] * v[5], gg[6] * v[6], gg[7] * v[7]};
        }
        if constexpr (MODE == 2) {
            float gg[8]; unpack8(p.g, gg);
#pragma unroll
            for (int i = 0; i < 4; ++i) { v[i] = p.a[i] + gg[i] * v[i]; v[4 + i] = p.b[i] + gg[4 + i] * v[4 + i]; }
            *(u32x4*)((bf16_t*)(ws + WS_MIX) + (size_t)row * DM + c) = pack8(v);
        }
        if constexpr (MODE == 3) {
            float* xp = (float*)(ws + WS_X) + (size_t)row * DM + c;
            float sq = 0.f;
#pragma unroll
            for (int i = 0; i < 4; ++i) { v[i] += p.a[i]; v[4 + i] += p.b[i]; }
#pragma unroll
            for (int i = 0; i < 8; ++i) sq += v[i] * v[i];
            *(f32x4*)xp = (f32x4){v[0], v[1], v[2], v[3]}; *(f32x4*)(xp + 4) = (f32x4){v[4], v[5], v[6], v[7]};
            *(u32x4*)((bf16_t*)(ws + WS_XB) + (size_t)row * DM + c) = pack8(v);
            sq += __shfl_xor(sq, 16); sq += __shfl_xor(sq, 32);
            if (fq == 0) atomicAdd((float*)(ws + WS_SS) + (size_t)ssn * NTOK + row, sq);
        }
        if constexpr (MODE == 4) {
            const float rs = rsqrtf(p.rs * (1.0f / 1024.0f) + 1e-6f);
#pragma unroll
            for (int i = 0; i < 8; ++i) { const float a = fmaxf(v[i] * rs, 0.f); v[i] = a * a; }
            *(u32x4*)((bf16_t*)(ws + WS_H) + (size_t)row * DFF + c) = pack8(v);
        }
    }
    __device__ __forceinline__ void chunk(unsigned char* ws, int row, int c32, int fq, float (&v)[8]) const {
        const int c = c32 + 8 * fq;
        switch (mode) {
            case 0: { const Pre p = pre<0>(ws, row, c); fin<0>(ws, row, c32, fq, v, p); } break;
            case 1: { const Pre p = pre<1>(ws, row, c); fin<1>(ws, row, c32, fq, v, p); } break;
            case 2: { const Pre p = pre<2>(ws, row, c); fin<2>(ws, row, c32, fq, v, p); } break;
            case 3: { const Pre p = pre<3>(ws, row, c); fin<3>(ws, row, c32, fq, v, p); } break;
            default: { const Pre p = pre<4>(ws, row, c); fin<4>(ws, row, c32, fq, v, p); } break;
        }
    }
    template <int MODE> __device__ __forceinline__ void tile(unsigned char* ws, const f32x4 (&acc)[2][2][4][2], const Unit& u, int wr, int wc, int fr, int fq) const {
        constexpr int MB = (MODE == 2 || MODE == 3) ? 2 : 4;
#pragma unroll
        for (int ai = 0; ai < 2; ++ai)
#pragma unroll
            for (int m0 = 0; m0 < 4; m0 += MB) {
                Pre p[MB][2];
#pragma unroll
                for (int mm = 0; mm < MB; ++mm)
#pragma unroll
                    for (int bj = 0; bj < 2; ++bj) p[mm][bj] = pre<MODE>(ws, u.pm * 256 + ai * 128 + wr * 64 + (m0 + mm) * 16 + fr, u.pn * 256 + bj * 128 + wc * 32 + 8 * fq);
#pragma unroll
                for (int mm = 0; mm < MB; ++mm)
#pragma unroll
                    for (int bj = 0; bj < 2; ++bj) {
                        float v[8];
#pragma unroll
                        for (int i = 0; i < 4; ++i) { v[i] = acc[ai][bj][m0 + mm][0][i]; v[4 + i] = acc[ai][bj][m0 + mm][1][i]; }
                        fin<MODE>(ws, u.pm * 256 + ai * 128 + wr * 64 + (m0 + mm) * 16 + fr, u.pn * 256 + bj * 128 + wc * 32, fq, v, p[mm][bj]);
                    }
                asm volatile("" ::: "memory");
            }
    }
    __device__ __forceinline__ void operator()(const f32x4 (&acc)[2][2][4][2], const Unit& u, int wr, int wc, int fr, int fq) const {
        asm volatile("" : "+v"(fr), "+v"(fq));
        unsigned char* ws = this->ws; asm volatile("" : "+s"(ws));
        switch (mode) {
            case 0: tile<0>(ws, acc, u, wr, wc, fr, fq); break;
            case 1: tile<1>(ws, acc, u, wr, wc, fr, fq); break;
            case 2: tile<2>(ws, acc, u, wr, wc, fr, fq); break;
            case 3: tile<3>(ws, acc, u, wr, wc, fr, fq); break;
            default: tile<4>(ws, acc, u, wr, wc, fr, fq); break;
        }
    }
};

__device__ __forceinline__ void skinny_gemm(LAS unsigned char* lds, const bf16_t* __restrict__ A, const bf16_t* __restrict__ Bt, int N, int K, const EpiAll& E, int first, int G) {
    using pg8::bf16x8;
    int tid = threadIdx.x; asm volatile("" : "+v"(tid));
    const int lane = tid & 63, w = __builtin_amdgcn_readfirstlane(tid >> 6), kg = lane >> 4, qn = lane & 15;
    const int nh = (N == 1024) ? 1 : 2, ksplit = 8 / nh;
    const int half = w % nh, kq = w / nh, Kq = K / ksplit, nsteps = Kq >> 5;
    unsigned char* ws = E.ws; asm volatile("" : "+s"(ws));
    LAS float* red = (LAS float*)lds;
    const int RB = 8 / nh, units = RB * (N >> 5);
#pragma unroll 1
    for (int u = first; u < units; u += G) {
        const int rb = u % RB, c32 = (u / RB) << 5;
        const int row0 = rb * 32 * nh + half * 32;
        const bf16_t* ap = A + (size_t)(row0 + qn) * K + kq * Kq + kg * 8;
        const bf16_t* bp = Bt + (size_t)(c32 + 8 * (qn >> 2) + (qn & 3)) * K + kq * Kq + kg * 8;
        f32x4 acc[2][2];
#pragma unroll
        for (int a = 0; a < 2; ++a)
#pragma unroll
            for (int b = 0; b < 2; ++b) acc[a][b] = (f32x4){0.f, 0.f, 0.f, 0.f};
#pragma unroll 8
        for (int ks = 0; ks < nsteps; ++ks) {
            const bf16x8 x0 = *(const bf16x8*)(ap + ks * 32), x1 = *(const bf16x8*)(ap + (size_t)16 * K + ks * 32);
            const bf16x8 w0 = *(const bf16x8*)(bp + ks * 32), w1 = *(const bf16x8*)(bp + (size_t)4 * K + ks * 32);
            acc[0][0] = __builtin_amdgcn_mfma_f32_16x16x32_bf16(w0, x0, acc[0][0], 0, 0, 0);
            acc[0][1] = __builtin_amdgcn_mfma_f32_16x16x32_bf16(w1, x0, acc[0][1], 0, 0, 0);
            acc[1][0] = __builtin_amdgcn_mfma_f32_16x16x32_bf16(w0, x1, acc[1][0], 0, 0, 0);
            acc[1][1] = __builtin_amdgcn_mfma_f32_16x16x32_bf16(w1, x1, acc[1][1], 0, 0, 0);
        }
        __syncthreads();
        if (kq != 0) {
#pragma unroll
            for (int a = 0; a < 2; ++a)
#pragma unroll
                for (int b = 0; b < 2; ++b)
#pragma unroll
                    for (int i = 0; i < 4; ++i) red[(w * 16 + a * 8 + b * 4 + i) * 64 + lane] = acc[a][b][i];
        }
        __syncthreads();
        if (kq == 0) {
#pragma unroll 1
            for (int q = 1; q < ksplit; ++q)
#pragma unroll
                for (int a = 0; a < 2; ++a)
#pragma unroll
                    for (int b = 0; b < 2; ++b)
#pragma unroll
                        for (int i = 0; i < 4; ++i) acc[a][b][i] += red[((w + nh * q) * 16 + a * 8 + b * 4 + i) * 64 + lane];
#pragma unroll
            for (int a = 0; a < 2; ++a) {
                float v[8];
#pragma unroll
                for (int i = 0; i < 4; ++i) { v[i] = acc[a][0][i]; v[4 + i] = acc[a][1][i]; }
                E.chunk(ws, NTP + row0 + a * 16 + qn, c32, kg, v);
            }
        }
    }
    __syncthreads();
}

__device__ __forceinline__ void lds_wait() { asm volatile("s_waitcnt lgkmcnt(0)" ::: "memory"); }
__device__ __forceinline__ void transpose_item(const float* __restrict__ W, const float* __restrict__ gsc, int K, int N, bf16_t* __restrict__ WT, LAS float* scr, int item, int lane) {
    const int nblk = N / 64, kb = item / nblk, nb = item % nblk, k0 = 64 * kb, n0 = 64 * nb;
    f32x4 v[16];
#pragma unroll
    for (int i = 0; i < 16; ++i) v[i] = *(const f32x4*)(W + (size_t)(k0 + 4 * i + (lane >> 4)) * N + n0 + 4 * (lane & 15));
#pragma unroll
    for (int i = 0; i < 16; ++i) { const int kk = 4 * i + (lane >> 4); const float sc = gsc ? gsc[k0 + kk] : 1.0f; LAS float* d = scr + kk * 65 + 4 * (lane & 15);
        d[0] = v[i][0] * sc; d[1] = v[i][1] * sc; d[2] = v[i][2] * sc; d[3] = v[i][3] * sc; }
    lds_wait();
    const int c = lane & 7;
#pragma unroll
    for (int j = 0; j < 8; ++j) { const int n = (lane >> 3) + 8 * j; const LAS float* sp = scr + (8 * c) * 65 + n;
        u32x4 o; o.x = cvt_pk_bf16(sp[0 * 65], sp[1 * 65]); o.y = cvt_pk_bf16(sp[2 * 65], sp[3 * 65]); o.z = cvt_pk_bf16(sp[4 * 65], sp[5 * 65]); o.w = cvt_pk_bf16(sp[6 * 65], sp[7 * 65]);
        *(u32x4*)(WT + (size_t)(n0 + n) * K + k0 + 8 * c) = o; }
    lds_wait();
}

template <int L>
__device__ __forceinline__ void copy_shift(const float* __restrict__ src, float* __restrict__ dst, int layer, size_t gtid, size_t nth) {
    constexpr size_t per = (size_t)(L - 8) * 128;
    constexpr size_t total = (size_t)32 * per;
    constexpr int U = 8;
    const f32x4* s4 = (const f32x4*)src + (size_t)layer * 32 * L * 128; f32x4* d4 = (f32x4*)dst + (size_t)layer * 32 * L * 128;
    for (size_t i = gtid; i < total; i += nth * U) {
        f32x4 v[U];
#pragma unroll
        for (int u = 0; u < U; ++u) { const size_t idx = i + u * nth; const size_t ii = idx < total ? idx : 0; const size_t lb = ii / per, r = ii - lb * per;
            v[u] = __builtin_nontemporal_load(s4 + lb * (size_t)L * 128 + r + 8 * 128); }
#pragma unroll
        for (int u = 0; u < U; ++u) { const size_t idx = i + u * nth; if (idx < total) { const size_t lb = idx / per, r = idx - lb * per; __builtin_nontemporal_store(v[u], d4 + lb * (size_t)L * 128 + r); } }
    }
}

#define ATT_DOT(S, Q, KF) do { float _s = 0.f; _Pragma("unroll") for (int _i = 0; _i < 8; ++_i) _s += Q[_i] * KF[_i]; \
    _s += __shfl_xor(_s, 1); _s += __shfl_xor(_s, 2); _s += __shfl_xor(_s, 4); S = _s; } while (0)

__device__ __forceinline__ void attn_finish(float m, float l, float (&o)[8], bf16_t* dstp, int kg) {
    float M = m; M = fmaxf(M, __shfl_xor(M, 8)); M = fmaxf(M, __shfl_xor(M, 16)); M = fmaxf(M, __shfl_xor(M, 32));
    const float f = __expf(m - M); l *= f;
#pragma unroll
    for (int i = 0; i < 8; ++i) o[i] *= f;
    l += __shfl_xor(l, 8); l += __shfl_xor(l, 16); l += __shfl_xor(l, 32);
#pragma unroll
    for (int i = 0; i < 8; ++i) { o[i] += __shfl_xor(o[i], 8); o[i] += __shfl_xor(o[i], 16); o[i] += __shfl_xor(o[i], 32); }
    const float inv = 1.0f / l;
#pragma unroll
    for (int i = 0; i < 8; ++i) o[i] *= inv;
    if (kg == 0) *(u32x4*)dstp = pack8(o);
}

__device__ __forceinline__ void attn_prompt_item(const bf16_t* __restrict__ qkv, bf16_t* __restrict__ oa, int token, int h, int lane) {
    const int kg = lane >> 3, dl = lane & 7;
    const int b = token >> 12, t = token & 4095;
    const bf16_t* qrow = qkv + (size_t)token * 2304 + h * 64 + dl * 8;
    const bf16_t* kbase = qkv + (size_t)(b << 12) * 2304 + 768 + h * 64 + dl * 8;
    float m = -1e30f, l = 0.f; float o[8];
#pragma unroll
    for (int i = 0; i < 8; ++i) o[i] = 0.f;
#pragma unroll 1
    for (int g = 0; g < 3; ++g) {
        const int d = 1 << (2 * g);
        float q[8]; unpack8(*(const u32x4*)(qrow + g * 256), q);
#pragma unroll
        for (int i = 0; i < 8; ++i) q[i] *= 0.125f;
        const bf16_t* kb = kbase + g * 256;
#pragma unroll 1
        for (int it = 0; it < 16; it += 4) {
            u32x4 kr[4], vr[4]; bool val[4];
#pragma unroll
            for (int u = 0; u < 4; ++u) { const int j = (it + u) * 8 + kg; const int pos = t - j * d; val[u] = pos >= 0; const bf16_t* r = kb + (size_t)(pos < 0 ? 0 : pos) * 2304;
                kr[u] = *(const u32x4*)r; vr[u] = *(const u32x4*)(r + 768); }
            float s[4];
#pragma unroll
            for (int u = 0; u < 4; ++u) { float kf[8]; unpack8(kr[u], kf); ATT_DOT(s[u], q, kf); if (!val[u]) s[u] = -1e30f; }
            const float mb = fmaxf(fmaxf(m, fmaxf(s[0], s[1])), fmaxf(s[2], s[3]));
            const float corr = __expf(m - mb);
            l *= corr;
#pragma unroll
            for (int i = 0; i < 8; ++i) o[i] *= corr;
#pragma unroll
            for (int u = 0; u < 4; ++u) { const float p = val[u] ? __expf(s[u] - mb) : 0.f; l += p; float vf[8]; unpack8(vr[u], vf);
#pragma unroll
                for (int i = 0; i < 8; ++i) o[i] += p * vf[i]; }
            m = mb;
        }
    }
    {
        const int g = kg < 2 ? kg : 2; const int d = 1 << (2 * g);
        const int pos = t - 128 * d; const bool val = (kg < 3) && (pos >= 0);
        float q[8]; unpack8(*(const u32x4*)(qrow + g * 256), q);
        const bf16_t* r = kbase + g * 256 + (size_t)(pos < 0 ? 0 : pos) * 2304;
        float kf[8], vf[8]; unpack8(*(const u32x4*)r, kf); unpack8(*(const u32x4*)(r + 768), vf);
        float s; ATT_DOT(s, q, kf); s *= 0.125f;
        if (!val) s = -1e30f;
        const float mb = fmaxf(m, s); const float corr = __expf(m - mb); const float p = val ? __expf(s - mb) : 0.f;
        l = l * corr + p;
#pragma unroll
        for (int i = 0; i < 8; ++i) o[i] = o[i] * corr + p * vf[i];
        m = mb;
    }
    attn_finish(m, l, o, oa + (size_t)token * 256 + h * 64 + dl * 8, kg);
}

__device__ __forceinline__ void sample_kv(const bf16_t* __restrict__ newb, const float* __restrict__ cb, int W, int idx, float (&kf)[8], float (&vf)[8]) {
    if (idx >= W) { const bf16_t* r = newb + (size_t)(idx - W) * 2304; unpack8(*(const u32x4*)r, kf); unpack8(*(const u32x4*)(r + 768), vf); }
    else { const float* r = cb + (size_t)idx * 512; const f32x4 a = *(const f32x4*)r, b2 = *(const f32x4*)(r + 4), c = *(const f32x4*)(r + 256), d2 = *(const f32x4*)(r + 260);
#pragma unroll
        for (int i = 0; i < 4; ++i) { kf[i] = a[i]; kf[4 + i] = b2[i]; vf[i] = c[i]; vf[4 + i] = d2[i]; } }
}
__device__ __forceinline__ void attn_sample_sub(const bf16_t* __restrict__ qkv, const float* __restrict__ cg_, bf16_t* __restrict__ PO, float* __restrict__ LSE,
                                                int layer, int stok, int h, int g, int lane) {
    const int kg = lane >> 3, dl = lane & 7;
    const int b = stok >> 3, t = stok & 7;
    const int token = NTP + stok;
    const int d = 1 << (2 * g), W = 128 << (2 * g);
    const bf16_t* nb = qkv + (size_t)(NTP + b * 8) * 2304 + 768 + g * 256 + h * 64 + dl * 8;
    const float* cb = cg_ + (size_t)(layer * 32 + b) * W * 512 + h * 64 + dl * 8;
    float q[8]; unpack8(*(const u32x4*)(qkv + (size_t)token * 2304 + g * 256 + h * 64 + dl * 8), q);
#pragma unroll
    for (int i = 0; i < 8; ++i) q[i] *= 0.125f;
    float m = -1e30f, l = 0.f; float o[8];
#pragma unroll
    for (int i = 0; i < 8; ++i) o[i] = 0.f;
#pragma unroll 1
    for (int it = 0; it < 16; it += 8) {
        float kf[8][8], vf[8][8], s[8];
#pragma unroll
        for (int u = 0; u < 8; ++u) { const int j = (it + u) * 8 + kg; sample_kv(nb, cb, W, W + t - j * d, kf[u], vf[u]); }
        float mb = m;
#pragma unroll
        for (int u = 0; u < 8; ++u) { ATT_DOT(s[u], q, kf[u]); mb = fmaxf(mb, s[u]); }
        const float corr = __expf(m - mb);
        l *= corr;
#pragma unroll
        for (int i = 0; i < 8; ++i) o[i] *= corr;
#pragma unroll
        for (int u = 0; u < 8; ++u) { const float p = __expf(s[u] - mb); l += p;
#pragma unroll
            for (int i = 0; i < 8; ++i) o[i] += p * vf[u][i]; }
        m = mb;
    }
    {
        const bool val = kg == 0;
        float kf[8], vf[8]; sample_kv(nb, cb, W, W + t - 128 * d, kf, vf);
        float s; ATT_DOT(s, q, kf);
        if (!val) s = -1e30f;
        const float mb = fmaxf(m, s); const float corr = __expf(m - mb); const float p = val ? __expf(s - mb) : 0.f;
        l = l * corr + p;
#pragma unroll
        for (int i = 0; i < 8; ++i) o[i] = o[i] * corr + p * vf[i];
        m = mb;
    }
    float M = m; M = fmaxf(M, __shfl_xor(M, 8)); M = fmaxf(M, __shfl_xor(M, 16)); M = fmaxf(M, __shfl_xor(M, 32));
    const float f = __expf(m - M); l *= f;
#pragma unroll
    for (int i = 0; i < 8; ++i) o[i] *= f;
    l += __shfl_xor(l, 8); l += __shfl_xor(l, 16); l += __shfl_xor(l, 32);
#pragma unroll
    for (int i = 0; i < 8; ++i) { o[i] += __shfl_xor(o[i], 8); o[i] += __shfl_xor(o[i], 16); o[i] += __shfl_xor(o[i], 32); }
    const float inv = 1.0f / l;
#pragma unroll
    for (int i = 0; i < 8; ++i) o[i] *= inv;
    if (kg == 0) *(u32x4*)(PO + ((size_t)g * NTOK + token) * 256 + h * 64 + dl * 8) = pack8(o);
    if (lane == 0) LSE[((size_t)g * NTOK + token) * 4 + h] = M + __logf(l);
}

constexpr int ATT_PITCH = 144, ATT_ROWS = 272, ATT_VOFF = ATT_ROWS * ATT_PITCH;
typedef short s16x4 __attribute__((ext_vector_type(4)));
template <int OFF> __device__ __forceinline__ s16x4 tr_read(unsigned addr) { s16x4 r; asm volatile("ds_read_b64_tr_b16 %0, %1 offset:%2" : "=v"(r) : "v"(addr), "n"(OFF) : "memory"); return r; }
__device__ __forceinline__ void tr_wait8(s16x4& a, s16x4& b, s16x4& c, s16x4& d, s16x4& e, s16x4& f, s16x4& g, s16x4& h) {
    asm volatile("s_waitcnt lgkmcnt(0)" : "+v"(a), "+v"(b), "+v"(c), "+v"(d), "+v"(e), "+v"(f), "+v"(g), "+v"(h) :: "memory"); }

__device__ __forceinline__ void attn_mfma_phase(LAS unsigned char* lds, const bf16_t* __restrict__ QKV, bf16_t* __restrict__ PO, float* __restrict__ LSE, int bid, int G, int tid) {
    using pg8::bf16x8;
    const int lane = tid & 63, w = __builtin_amdgcn_readfirstlane(tid >> 6), kg = lane >> 4, qn = lane & 15;
    for (int i = tid; i < 2 * 144; i += NTHREADS) { const int kv = i / 144, rem = i - kv * 144; *(LAS u32x4*)(lds + kv * ATT_VOFF + 256 * ATT_PITCH + rem * 16) = (u32x4){0u, 0u, 0u, 0u}; }
    const unsigned vaddr = (unsigned)(uintptr_t)(lds + ATT_VOFF + (16 * w + 4 * kg + (qn >> 2)) * ATT_PITCH + (lane & 3) * 8);
    const float csc = 0.125f * 1.44269504089f;
#define ATT_DECODE(U, b_, h_, g_, r_, I0_) do { const int _bh = (U) / 96, _rest = (U) - _bh * 96; b_ = _bh >> 2; h_ = _bh & 3; \
        if (_rest < 32) { g_ = 0; r_ = 0; I0_ = 128 * _rest; } else if (_rest < 64) { g_ = 1; r_ = (_rest - 32) >> 3; I0_ = 128 * ((_rest - 32) & 7); } else { g_ = 2; r_ = (_rest - 64) >> 1; I0_ = 128 * ((_rest - 64) & 1); } } while (0)
#define ATT_FETCH(U) do { int _b, _h, _g, _r, _I0; ATT_DECODE(U, _b, _h, _g, _r, _I0); const int _d = 1 << (2 * _g); \
        _Pragma("unroll") for (int i = 0; i < 8; ++i) { const int kv = i >> 2, row = (tid >> 3) + 64 * (i & 3), ch = tid & 7; const int I = _I0 - 128 + row; \
            pf[i] = (u32x4){0u, 0u, 0u, 0u}; \
            if (I >= 0) pf[i] = *(const u32x4*)(QKV + (size_t)(_b * 4096 + _r + _d * I) * 2304 + 768 + kv * 768 + _g * 256 + _h * 64 + ch * 8); } \
        const bf16_t* _qp = QKV + ((size_t)_b * 4096 + _r + _d * (_I0 + 16 * w + qn)) * 2304 + _g * 256 + _h * 64 + kg * 8; \
        qf0 = *(const bf16x8*)_qp; qf1 = *(const bf16x8*)(_qp + 32); } while (0)
    u32x4 pf[8]; bf16x8 qf0, qf1;
    if (bid < 1536) ATT_FETCH(bid);
#pragma unroll 1
    for (int u = bid; u < 1536; u += G) {
        int b, h, g, r, I0; ATT_DECODE(u, b, h, g, r, I0);
        const int d = 1 << (2 * g);
        __syncthreads();
#pragma unroll
        for (int i = 0; i < 8; ++i) { const int kv = i >> 2, row = (tid >> 3) + 64 * (i & 3), ch = tid & 7; *(LAS u32x4*)(lds + kv * ATT_VOFF + row * ATT_PITCH + ch * 16) = pf[i]; }
        const bf16x8 q0 = qf0, q1 = qf1;
        __syncthreads();
        if (u + G < 1536) ATT_FETCH(u + G);
        const int Iq = I0 + 16 * w + qn; const size_t tokq = (size_t)b * 4096 + r + d * Iq;
        f32x4 sc[9];
        const LAS unsigned char* kb = lds + (16 * w + qn) * ATT_PITCH + kg * 16;
#pragma unroll
        for (int kt = 0; kt < 9; ++kt) { const bf16x8 k0 = *(const LAS bf16x8*)(kb + kt * 16 * ATT_PITCH), k1 = *(const LAS bf16x8*)(kb + kt * 16 * ATT_PITCH + 64);
            f32x4 z = (f32x4){0.f, 0.f, 0.f, 0.f}; z = __builtin_amdgcn_mfma_f32_16x16x32_bf16(k0, q0, z, 0, 0, 0); sc[kt] = __builtin_amdgcn_mfma_f32_16x16x32_bf16(k1, q1, z, 0, 0, 0); }
        const int jb = 128 + qn - 4 * kg, ikb = I0 - 128 + 16 * w + 4 * kg;
        float m = -1e30f;
#pragma unroll
        for (int kt = 0; kt < 9; ++kt)
#pragma unroll
            for (int i = 0; i < 4; ++i) { const int j = jb - 16 * kt - i; const bool val = (j >= 0) && (j <= 128) && (ikb + 16 * kt + i >= 0); sc[kt][i] = val ? sc[kt][i] : -1e30f; m = fmaxf(m, sc[kt][i]); }
        m = fmaxf(m, __shfl_xor(m, 16)); m = fmaxf(m, __shfl_xor(m, 32));
        const float mc = m * csc; float l = 0.f;
        unsigned pk[10][2];
#pragma unroll
        for (int kt = 0; kt < 9; ++kt) { float p[4];
#pragma unroll
            for (int i = 0; i < 4; ++i) { p[i] = (sc[kt][i] > -1e29f) ? __builtin_amdgcn_exp2f(sc[kt][i] * csc - mc) : 0.f; l += p[i]; }
            pk[kt][0] = cvt_pk_bf16(p[0], p[1]); pk[kt][1] = cvt_pk_bf16(p[2], p[3]); }
        pk[9][0] = 0u; pk[9][1] = 0u;
        l += __shfl_xor(l, 16); l += __shfl_xor(l, 32);
        f32x4 o[4];
#pragma unroll
        for (int dt = 0; dt < 4; ++dt) o[dt] = (f32x4){0.f, 0.f, 0.f, 0.f};
#define ATT_PV(KK) do { s16x4 a0 = tr_read<(KK) * 32 * ATT_PITCH + 0>(vaddr), a1 = tr_read<(KK) * 32 * ATT_PITCH + 32>(vaddr), a2 = tr_read<(KK) * 32 * ATT_PITCH + 64>(vaddr), a3 = tr_read<(KK) * 32 * ATT_PITCH + 96>(vaddr); \
            s16x4 c0 = tr_read<(KK) * 32 * ATT_PITCH + 16 * ATT_PITCH + 0>(vaddr), c1 = tr_read<(KK) * 32 * ATT_PITCH + 16 * ATT_PITCH + 32>(vaddr), c2 = tr_read<(KK) * 32 * ATT_PITCH + 16 * ATT_PITCH + 64>(vaddr), c3 = tr_read<(KK) * 32 * ATT_PITCH + 16 * ATT_PITCH + 96>(vaddr); \
            tr_wait8(a0, a1, a2, a3, c0, c1, c2, c3); \
            u32x4 pw; pw.x = pk[2 * (KK)][0]; pw.y = pk[2 * (KK)][1]; pw.z = pk[2 * (KK) + 1][0]; pw.w = pk[2 * (KK) + 1][1]; \
            const bf16x8 pf = __builtin_bit_cast(bf16x8, pw); \
            o[0] = __builtin_amdgcn_mfma_f32_16x16x32_bf16(__builtin_shufflevector(a0, c0, 0, 1, 2, 3, 4, 5, 6, 7), pf, o[0], 0, 0, 0); \
            o[1] = __builtin_amdgcn_mfma_f32_16x16x32_bf16(__builtin_shufflevector(a1, c1, 0, 1, 2, 3, 4, 5, 6, 7), pf, o[1], 0, 0, 0); \
            o[2] = __builtin_amdgcn_mfma_f32_16x16x32_bf16(__builtin_shufflevector(a2, c2, 0, 1, 2, 3, 4, 5, 6, 7), pf, o[2], 0, 0, 0); \
            o[3] = __builtin_amdgcn_mfma_f32_16x16x32_bf16(__builtin_shufflevector(a3, c3, 0, 1, 2, 3, 4, 5, 6, 7), pf, o[3], 0, 0, 0); } while (0)
        ATT_PV(0); ATT_PV(1); ATT_PV(2); ATT_PV(3); ATT_PV(4);
        const float il = 1.0f / l;
        bf16_t* op = PO + ((size_t)g * NTOK + tokq) * 256 + h * 64 + 4 * kg;
#pragma unroll
        for (int dt = 0; dt < 4; ++dt) { u32x2 wv; wv.x = cvt_pk_bf16(o[dt][0] * il, o[dt][1] * il); wv.y = cvt_pk_bf16(o[dt][2] * il, o[dt][3] * il); *(u32x2*)(op + 16 * dt) = wv; }
        if (kg == 0) LSE[((size_t)g * NTOK + tokq) * 4 + h] = m * 0.125f + __logf(l);
    }
#undef ATT_PV
#undef ATT_FETCH
#undef ATT_DECODE
}

#define XB_TMO      128
#define XB_XCNT(j)  (256  + 64 * (j))
#define XB_XSUB(j)  (1280 + 64 * (j))
#define XB_XGEN(j)  (2304 + 64 * (j))
#define XB_TOP      3328
#define XB_TOPGEN   3392
#define XCD_BAR_WORDS 3456
#define XB_SPIN_CAP (1u << 20)
__device__ __forceinline__ unsigned xb_ld(unsigned* p)              { return __hip_atomic_load(p, __ATOMIC_RELAXED, __HIP_MEMORY_SCOPE_AGENT); }
__device__ __forceinline__ unsigned xb_add(unsigned* p, unsigned v) { return __hip_atomic_fetch_add(p, v, __ATOMIC_RELAXED, __HIP_MEMORY_SCOPE_AGENT); }
__device__ __forceinline__ unsigned xb_xcc_id() { return (unsigned)__builtin_amdgcn_s_getreg((3 << 11) | 20) & 0xFu; }
#define XB_SPIN(cond, bar) do { unsigned _sp = 0; while (cond) { __builtin_amdgcn_s_sleep(1); \
    if ((++_sp & 255u) == 0u) { if (xb_ld(&(bar)[XB_TMO])) break; if (_sp > XB_SPIN_CAP) { atomicAdd(&(bar)[XB_TMO], 1u); break; } } } } while (0)
struct XcdBarrier { unsigned* bar; unsigned x; volatile LAS unsigned* st; };
__device__ __forceinline__ XcdBarrier xcd_barrier_post(unsigned* bar, volatile LAS unsigned* st) {
    XcdBarrier b; b.bar = bar; b.x = xb_xcc_id(); b.st = st;
    if (threadIdx.x == 0) (void)xb_add(&bar[XB_XCNT(b.x)], 1u);
    return b;
}
__device__ __forceinline__ void xcd_barrier_complete(unsigned* bar, unsigned x, unsigned& nloc, unsigned& nx) {
    const unsigned G = gridDim.x * gridDim.y * gridDim.z;
    unsigned sum, cnt, mine, sp = 0u;
    for (;;) {
        sum = 0u; cnt = 0u; mine = 0u;
#pragma unroll
        for (unsigned j = 0; j < 16; ++j) { const unsigned c = xb_ld(&bar[XB_XCNT(j)]); sum += c; cnt += (c > 0u) ? 1u : 0u; mine = (j == x) ? c : mine; }
        if (sum == G) break;
        __builtin_amdgcn_s_sleep(1);
        if ((++sp & 255u) == 0u) { if (xb_ld(&bar[XB_TMO])) break; if (sp > XB_SPIN_CAP) { atomicAdd(&bar[XB_TMO], 1u); break; } }
    }
    nloc = mine > 0u ? mine : 1u; nx = cnt > 0u ? cnt : 1u;
}
__device__ __forceinline__ void xcd_barrier(const XcdBarrier& b) {
    asm volatile("s_waitcnt vmcnt(0)" ::: "memory");
    __syncthreads();
    if (threadIdx.x == 0) {
        unsigned* bar = b.bar;
        __builtin_amdgcn_s_waitcnt(0);
        unsigned nloc = b.st[0], nx = b.st[1];
        if (nloc == 0u) { xcd_barrier_complete(bar, b.x, nloc, nx); b.st[0] = nloc; b.st[1] = nx; }
        const unsigned old = xb_add(&bar[XB_XSUB(b.x)], 1u);
        const unsigned gen = old / nloc;
        if (old + 1u == (gen + 1u) * nloc) {
            __builtin_amdgcn_fence(__ATOMIC_RELEASE, "agent");
            asm volatile("s_waitcnt vmcnt(0)" ::: "memory");
            const unsigned og = xb_add(&bar[XB_TOP], 1u);
            const unsigned tg = og / nx;
            if (og + 1u == (tg + 1u) * nx) xb_add(&bar[XB_TOPGEN], 1u);
            else XB_SPIN(xb_ld(&bar[XB_TOPGEN]) == tg, bar);
            __builtin_amdgcn_fence(__ATOMIC_ACQUIRE, "agent");
            xb_add(&bar[XB_XGEN(b.x)], 1u);
            asm volatile("s_waitcnt vmcnt(0)" ::: "memory");
        } else {
            XB_SPIN(xb_ld(&bar[XB_XGEN(b.x)]) == gen, bar);
            __builtin_amdgcn_fence(__ATOMIC_ACQUIRE, "agent");
            asm volatile("s_waitcnt vmcnt(0)" ::: "memory");
        }
    }
    __syncthreads();
}

template <int GP> __device__ __forceinline__ void pool_item(const bf16_t* __restrict__ UB, bf16_t* __restrict__ PB, const float* __restrict__ sp, int tb, int cl) {
    constexpr int W = 2 << GP, NR = W + 7;
    const int c = (GP * 16 + cl) * 8;
    const int token0 = tb * 8; const bool samp = token0 >= NTP; const int t0 = samp ? 0 : (token0 & 4095); const int b = (token0 - NTP) >> 3;
    u32x4 R[NR];
#pragma unroll
    for (int r = 0; r < NR; ++r) { const int dt = r - (W - 1);
        if (dt >= 0 || t0 + dt >= 0) R[r] = *(const u32x4*)(UB + (size_t)(token0 + dt) * 512 + c);
        else if (samp) { const float* q = sp + (size_t)(b * 15 + 15 + dt) * 512 + c; const f32x4 a = *(const f32x4*)q, b2 = *(const f32x4*)(q + 4);
            R[r].x = cvt_pk_bf16(a[0], a[1]); R[r].y = cvt_pk_bf16(a[2], a[3]); R[r].z = cvt_pk_bf16(b2[0], b2[1]); R[r].w = cvt_pk_bf16(b2[2], b2[3]); }
        else R[r] = (u32x4){0u, 0u, 0u, 0u}; }
#pragma unroll
    for (int j = 0; j < 8; ++j) {
        float sum[8];
#pragma unroll
        for (int k = 0; k < 8; ++k) sum[k] = 0.f;
#pragma unroll
        for (int i = 0; i < W; ++i) { float f[8]; unpack8(R[j + (W - 1) - i], f);
#pragma unroll
            for (int k = 0; k < 8; ++k) sum[k] += f[k]; }
        float ut[8]; unpack8(R[j + W - 1], ut);
        const int t = t0 + j; const float cnt = samp ? (float)W : (float)(W < t + 1 ? W : t + 1); const float ic = 1.0f / cnt;
        float p[8];
#pragma unroll
        for (int k = 0; k < 8; ++k) p[k] = sum[k] * ic - ut[k];
        *(u32x4*)(PB + (size_t)(token0 + j) * 512 + c) = pack8(p);
    }
}

__global__ void __launch_bounds__(NTHREADS, 2) fwd_megakernel(Params P) {
    extern __shared__ __attribute__((aligned(16))) unsigned char lds_raw[];
    LAS unsigned char* lds = (LAS unsigned char*)lds_raw;
    cg::grid_group grid = cg::this_grid();
    const int tid = threadIdx.x, lane = tid & 63, wave = __builtin_amdgcn_readfirstlane(tid >> 6);
    const int G = gridDim.x, bid = blockIdx.x;
    const int gw = bid * 8 + wave, NGW = G * 8;
    const size_t gtid = (size_t)bid * NTHREADS + tid, nth = (size_t)G * NTHREADS;
    unsigned char* ws = P.ws;
    bf16_t* Wt_in = (bf16_t*)(ws + WS_WIN); bf16_t* Wt_pa = (bf16_t*)(ws + WS_WPA); bf16_t* Wt_pb = (bf16_t*)(ws + WS_WPB);
    bf16_t* Wt_o = (bf16_t*)(ws + WS_WO); bf16_t* Wt_up = (bf16_t*)(ws + WS_WUP); bf16_t* Wt_dn = (bf16_t*)(ws + WS_WDN);
    float* X = (float*)(ws + WS_X); bf16_t* XB = (bf16_t*)(ws + WS_XB); bf16_t* QKV = (bf16_t*)(ws + WS_QKV); bf16_t* UB = (bf16_t*)(ws + WS_U);
    bf16_t* GT = (bf16_t*)(ws + WS_G); bf16_t* OA = (bf16_t*)(ws + WS_OA); bf16_t* PB = (bf16_t*)(ws + WS_P); float* TMP = (float*)(ws + WS_TMP);
    bf16_t* MIX = (bf16_t*)(ws + WS_MIX); bf16_t* HID = (bf16_t*)(ws + WS_H); float* SS = (float*)(ws + WS_SS); float* ROPE = (float*)(ws + WS_ROPE);
    float* out = P.out;
    volatile LAS unsigned* bst = (volatile LAS unsigned*)(lds + LDS_BYTES - 16);
    if (tid == 0) { bst[0] = 0u; bst[1] = 0u; }
    __syncthreads();
    const XcdBarrier xb = xcd_barrier_post((unsigned*)(ws + WS_BAR), bst);

    {
        LAS float* LsT = (LAS float*)lds;
        LAS float* Ws = LsT + 128 * 128;
        for (int item = bid; item < DEPTH * 4 * 16; item += G) {
            const int l = item >> 6, g = (item >> 4) & 3, n0 = (item & 15) * 64;
            const float* lin = P.in[10] + (size_t)(l * 4 + g) * 128 * 128;
            const float* sc = P.in[11] + l * 512 + g * 128;
            const float* wpb = P.in[9] + (size_t)l * 512 * 1024 + (size_t)g * 128 * 1024;
            for (int i = tid; i < 128 * 128; i += NTHREADS) { const int c = i >> 7, d = i & 127; LsT[d * 128 + c] = lin[i] * sc[d]; }
            for (int i = tid; i < 128 * 64; i += NTHREADS) { const int d = i >> 6, n = i & 63; Ws[i] = wpb[(size_t)d * 1024 + n0 + n]; }
            __syncthreads();
            const int n = tid & 63, cgp = tid >> 6;
            float a[16];
#pragma unroll
            for (int i = 0; i < 16; ++i) a[i] = 0.f;
            for (int d = 0; d < 128; ++d) {
                const float w = Ws[d * 64 + n];
                const LAS f32x4* lp = (const LAS f32x4*)(LsT + d * 128 + cgp * 16);
#pragma unroll
                for (int q4 = 0; q4 < 4; ++q4) { const f32x4 lv = lp[q4];
#pragma unroll
                    for (int i = 0; i < 4; ++i) a[q4 * 4 + i] += lv[i] * w; }
            }
            bf16_t* op = Wt_pb + ((size_t)l * 1024 + n0 + n) * 512 + g * 128 + cgp * 16;
            u32x4 o0, o1; o0.x = cvt_pk_bf16(a[0], a[1]); o0.y = cvt_pk_bf16(a[2], a[3]); o0.z = cvt_pk_bf16(a[4], a[5]); o0.w = cvt_pk_bf16(a[6], a[7]);
            o1.x = cvt_pk_bf16(a[8], a[9]); o1.y = cvt_pk_bf16(a[10], a[11]); o1.z = cvt_pk_bf16(a[12], a[13]); o1.w = cvt_pk_bf16(a[14], a[15]);
            *(u32x4*)op = o0; *(u32x4*)(op + 8) = o1;
            __syncthreads();
        }
        {
            LAS float* scr = (LAS float*)(lds + wave * 16640);
            constexpr int I_IN = 16 * 76, I_PA = 4 * 16, I_O = 16 * 16, I_UP = 16 * 64, I_DN = 64 * 16, I_L = I_IN + I_PA + I_O + I_UP + I_DN;
            for (int it = gw; it < DEPTH * I_L; it += NGW) {
                const int l = it / I_L; int r = it - l * I_L;
                if (r < I_IN) { transpose_item(P.in[7] + (size_t)l * DM * NIN, P.in[6] + l * DM, DM, NIN, Wt_in + (size_t)l * NIN * DM, scr, r, lane); continue; } r -= I_IN;
                if (r < I_PA) { transpose_item(P.in[8] + (size_t)l * 256 * DM, nullptr, 256, DM, Wt_pa + (size_t)l * DM * 256, scr, r, lane); continue; } r -= I_PA;
                if (r < I_O) { transpose_item(P.in[12] + (size_t)l * DM * DM, nullptr, DM, DM, Wt_o + (size_t)l * DM * DM, scr, r, lane); continue; } r -= I_O;
                if (r < I_UP) { transpose_item(P.in[14] + (size_t)l * DM * DFF, P.in[13] + l * DM, DM, DFF, Wt_up + (size_t)l * DFF * DM, scr, r, lane); continue; } r -= I_UP;
                transpose_item(P.in[15] + (size_t)l * DFF * DM, nullptr, DFF, DM, Wt_dn + (size_t)l * DM * DFF, scr, r, lane);
            }
        }
        for (int row = gw; row < NTOK; row += NGW) {
            const float* src = row < NTP ? P.in[0] + (size_t)row * DM : P.in[1] + (size_t)(row - NTP) * DM;
            float s = 0.f;
#pragma unroll
            for (int j = 0; j < 4; ++j) { const f32x4 v = *(const f32x4*)(src + 4 * lane + 256 * j); s += v[0] * v[0] + v[1] * v[1] + v[2] * v[2] + v[3] * v[3];
                *(f32x4*)(X + (size_t)row * DM + 4 * lane + 256 * j) = v;
                u32x2 w; w.x = cvt_pk_bf16(v[0], v[1]); w.y = cvt_pk_bf16(v[2], v[3]); *(u32x2*)(XB + (size_t)row * DM + 4 * lane + 256 * j) = w; }
#pragma unroll
            for (int o = 1; o < 64; o <<= 1) s += __shfl_xor(s, o);
            if (lane == 0) SS[row] = s;
        }
        for (size_t i = gtid; i < 4104 * 8; i += nth) { const int pi = (int)(i >> 3), k = (int)(i & 7); const float pos = (float)(pi < 4096 ? pi : 8192 + pi - 4096);
            const float inv = powf(500000.0f, -(float)(2 * k) / 16.0f); const float ang = pos * inv; ROPE[pi * 16 + k] = cosf(ang); ROPE[pi * 16 + 8 + k] = sinf(ang); }
        for (size_t i = gtid; i < (size_t)8 * NTOK; i += nth) SS[NTOK + i] = 0.f;
        for (size_t i = gtid; i < (size_t)DEPTH * 32 * 7 * 128; i += nth) { const size_t lb = i / (7 * 128), r = i - lb * (7 * 128);
            *(f32x4*)(out + O_POOLS + lb * 15 * 512 + r * 4) = *(const f32x4*)(P.in[5] + lb * 15 * 512 + 8 * 512 + r * 4); }
    }
    grid.sync();

    pg8::StaticOrder S;
#pragma unroll 1
    for (int step = 0; step < DEPTH * 7; ++step) {
        const int layer = step / 7, st = step - layer * 7;
        if (st == 1) {
            int tid_l = threadIdx.x; asm volatile("" : "+v"(tid_l));
            const int lane = tid_l & 63, gw = bid * 8 + (tid_l >> 6);
            const size_t gtid = (size_t)bid * NTHREADS + tid_l;
            unsigned char* wsl = ws; asm volatile("" : "+s"(wsl));
            bf16_t* QKV = (bf16_t*)(wsl + WS_QKV); bf16_t* UB = (bf16_t*)(wsl + WS_U); bf16_t* OA = (bf16_t*)(wsl + WS_OA); bf16_t* PB = (bf16_t*)(wsl + WS_P);
            bf16_t* PO = (bf16_t*)(wsl + WS_TMP); float* LSE = (float*)(wsl + WS_TMP + (size_t)3 * NTOK * 256 * 2);
            for (int it = gw; it < NTS * 12; it += NGW) { const int g = it % 3, r = it / 3; attn_sample_sub(QKV, g == 0 ? P.in[2] : (g == 1 ? P.in[3] : P.in[4]), PO, LSE, layer, r >> 2, r & 3, g, lane); }
            attn_mfma_phase(lds, QKV, PO, LSE, bid, G, tid_l);
            copy_shift<128>(P.in[2], out + O_KVS0, layer, gtid, nth);
            copy_shift<512>(P.in[3], out + O_KVS1, layer, gtid, nth);
            copy_shift<2048>(P.in[4], out + O_KVS2, layer, gtid, nth);
            xcd_barrier(xb);
            for (size_t base = gtid; base < (size_t)NTOK * 32; base += nth * 4) {
                float ls[4][3]; u32x4 av[4][3];
#pragma unroll
                for (int u = 0; u < 4; ++u) { const size_t idx = base + u * nth; const size_t ii = idx < (size_t)NTOK * 32 ? idx : base; const size_t token = ii >> 5; const int c = (int)(ii & 31) * 8, h = c >> 6;
#pragma unroll
                    for (int g = 0; g < 3; ++g) { ls[u][g] = LSE[((size_t)g * NTOK + token) * 4 + h]; av[u][g] = *(const u32x4*)(PO + ((size_t)g * NTOK + token) * 256 + c); } }
#pragma unroll
                for (int u = 0; u < 4; ++u) { const size_t idx = base + u * nth;
                    if (idx < (size_t)NTOK * 32) { const size_t token = idx >> 5; const int c = (int)(idx & 31) * 8;
                        const float mx = fmaxf(ls[u][0], fmaxf(ls[u][1], ls[u][2])); float w0 = __expf(ls[u][0] - mx), w1 = __expf(ls[u][1] - mx), w2 = __expf(ls[u][2] - mx); const float iw = 1.0f / (w0 + w1 + w2); w0 *= iw; w1 *= iw; w2 *= iw;
                        float a0[8], a1[8], a2[8], o[8]; unpack8(av[u][0], a0); unpack8(av[u][1], a1); unpack8(av[u][2], a2);
#pragma unroll
                        for (int k = 0; k < 8; ++k) o[k] = w0 * a0[k] + w1 * a1[k] + w2 * a2[k];
                        *(u32x4*)(OA + token * 256 + c) = pack8(o); } }
            }
            const float* sp = P.in[5] + (size_t)layer * 32 * 15 * 512;
            for (int it = (int)gtid; it < 4 * (NTOK / 8) * 16; it += (int)nth) {
                const int cl = it & 15, q = it >> 4, g = q / (NTOK / 8), tb = q - g * (NTOK / 8);
                if (g == 0) pool_item<0>(UB, PB, sp, tb, cl); else if (g == 1) pool_item<1>(UB, PB, sp, tb, cl); else if (g == 2) pool_item<2>(UB, PB, sp, tb, cl); else pool_item<3>(UB, PB, sp, tb, cl);
            }
            xcd_barrier(xb);
            continue;
        }
        pg8::Gemm g; EpiAll E; E.ws = ws; E.out = out; E.layer = layer; E.ssi = 0; E.ssn = 0;
        const int Mg = (st == 0) ? NTOK : NTP;
        g.M = Mg;
        if (st == 0)      { g.A = XB;  g.Bt = Wt_in + (size_t)layer * NIN * DM; g.N = NIN; g.K = DM;  E.mode = 0; E.ssi = 2 * layer; }
        else if (st == 2) { g.A = OA;  g.Bt = Wt_pa + (size_t)layer * DM * 256; g.N = DM;  g.K = 256; E.mode = 1; }
        else if (st == 3) { g.A = PB;  g.Bt = Wt_pb + (size_t)layer * DM * 512; g.N = DM;  g.K = 512; E.mode = 2; }
        else if (st == 4) { g.A = MIX; g.Bt = Wt_o + (size_t)layer * DM * DM;   g.N = DM;  g.K = DM;  E.mode = 3; E.ssn = 2 * layer + 1; }
        else if (st == 5) { g.A = XB;  g.Bt = Wt_up + (size_t)layer * DFF * DM; g.N = DFF; g.K = DM;  E.mode = 4; E.ssi = 2 * layer + 1; }
        else              { g.A = HID; g.Bt = Wt_dn + (size_t)layer * DM * DFF; g.N = DM;  g.K = DFF; E.mode = 3; E.ssn = 2 * layer + 2; }
        S.init(Mg, g.N, G, bid);
        pg8::gemm_phase<EpiAll, pg8::StaticOrder, true, true>(lds, g, S, E);
        if (st != 0) skinny_gemm(lds, g.A + (size_t)NTP * g.K, g.Bt, g.N, g.K, E, G - 1 - bid, G);
        if (st != 2) xcd_barrier(xb);
    }
    {
        int tid_l = threadIdx.x; asm volatile("" : "+v"(tid_l));
        const int lane = tid_l & 63, gw = bid * 8 + (tid_l >> 6);
        unsigned char* wsl = ws; asm volatile("" : "+s"(wsl));
        float* X = (float*)(wsl + WS_X);
        const float* fn = P.in[16]; const float* ssf = (const float*)(wsl + WS_SS) + (size_t)8 * NTOK;
        for (int row = gw; row < NTOK; row += 2 * NGW) {
            const int r2 = row + NGW; const bool ok2 = r2 < NTOK; const int rb = ok2 ? r2 : row;
            const float s0 = ssf[row], s1 = ssf[rb];
            f32x4 va[4], vb[4], gn[4];
#pragma unroll
            for (int j = 0; j < 4; ++j) { const int c = 4 * lane + 256 * j; va[j] = *(const f32x4*)(X + (size_t)row * DM + c); vb[j] = *(const f32x4*)(X + (size_t)rb * DM + c); gn[j] = *(const f32x4*)(fn + c); }
            const float rs0 = rsqrtf(s0 * (1.0f / 1024.0f) + 1e-6f), rs1 = rsqrtf(s1 * (1.0f / 1024.0f) + 1e-6f);
#pragma unroll
            for (int j = 0; j < 4; ++j) { const int c = 4 * lane + 256 * j;
                *(f32x4*)(out + (size_t)row * DM + c) = (f32x4){va[j][0] * rs0 * gn[j][0], va[j][1] * rs0 * gn[j][1], va[j][2] * rs0 * gn[j][2], va[j][3] * rs0 * gn[j][3]};
                if (ok2) *(f32x4*)(out + (size_t)r2 * DM + c) = (f32x4){vb[j][0] * rs1 * gn[j][0], vb[j][1] * rs1 * gn[j][1], vb[j][2] * rs1 * gn[j][2], vb[j][3] * rs1 * gn[j][3]}; }
        }
    }
}

extern "C" void kernel_launch(void* const* d_in, const int* in_sizes, int n_in, void* d_out, int out_size, void* d_ws, size_t ws_size, hipStream_t stream) {
    static int grid_blocks = 0;
    if (grid_blocks == 0) {
        if (n_in != 17 || ws_size < WS_END) { fprintf(stderr, "kernel_launch: unexpected n_in %d / ws %zu (need %zu)\n", n_in, ws_size, (size_t)WS_END); grid_blocks = -1; return; }
        int dev = 0, cus = 0, per_cu = 0;
        (void)hipGetDevice(&dev);
        (void)hipDeviceGetAttribute(&cus, hipDeviceAttributeMultiprocessorCount, dev);
        if (hipFuncSetAttribute((const void*)fwd_megakernel, hipFuncAttributeMaxDynamicSharedMemorySize, LDS_BYTES) != hipSuccess) { fprintf(stderr, "kernel_launch: hipFuncSetAttribute failed\n"); grid_blocks = -1; return; }
        (void)hipOccupancyMaxActiveBlocksPerMultiprocessor(&per_cu, (const void*)fwd_megakernel, NTHREADS, LDS_BYTES);
        if (per_cu < 1) { fprintf(stderr, "kernel_launch: occupancy query says %d blocks/CU\n", per_cu); grid_blocks = -1; return; }
        grid_blocks = cus * 1;
    }
    if (grid_blocks < 0) return;
    if (hipMemsetAsync((unsigned char*)d_ws + WS_BAR, 0, 4096 * 4, stream) != hipSuccess) { fprintf(stderr, "kernel_launch: memset of barrier words failed\n"); return; }
    Params p{};
    for (int i = 0; i < 17; ++i) p.in[i] = (const float*)d_in[i];
    p.out = (float*)d_out; p.ws = (unsigned char*)d_ws;
    void* args[] = {&p};
    hipError_t e = hipLaunchCooperativeKernel((const void*)fwd_megakernel, dim3(grid_blocks), dim3(NTHREADS), args, LDS_BYTES, stream);
    if (e != hipSuccess) fprintf(stderr, "cooperative launch failed: %s (grid %d)\n", hipGetErrorString(e), grid_blocks);
}
```

```cpp
#include <hip/hip_runtime.h>
#include <hip/hip_cooperative_groups.h>
#include <cstdio>
#include <cstdint>
namespace cg = cooperative_groups;

namespace pg8 {
#define PG8_LAS __attribute__((address_space(3)))
typedef unsigned short bf16_t;
typedef short bf16x8 __attribute__((ext_vector_type(8)));
typedef float f32x4 __attribute__((ext_vector_type(4)));
typedef unsigned u32x4 __attribute__((ext_vector_type(4)));
typedef unsigned u32x2 __attribute__((ext_vector_type(2)));
constexpr int BM = 256, BK = 64, HALF = 128, HTB = HALF * BK * 2, STAGE_BYTES = 8 * HTB, NXCD = 8, WGM = 8;

__host__ __device__ __forceinline__ int lds_byte(int r, int c) { const int st = (r >> 4) * 2 + (c >> 5), rr = r & 15, cc = c & 31, ob = rr * 64 + cc * 2; return st * 1024 + (ob ^ (((ob >> 9) & 1) << 5)); }
__host__ __device__ __forceinline__ void stage_rc(int b, int& R, int& C) { const int st = b / 1024, sb = b % 1024, swz = sb ^ (((sb >> 9) & 1) << 5); R = (st >> 1) * 16 + swz / 64; C = (st & 1) * 32 + (swz % 64) / 2; }
__host__ __device__ __forceinline__ int perm32(int rho) { const int n = rho >> 4, i = rho & 15; return 8 * (i >> 2) + 4 * n + (i & 3); }

struct Unit { int pm, pn; };
struct Gemm { const bf16_t* A; const bf16_t* Bt; int M, N, K; };

struct StaticOrder {
    int nM, nN, nwg, G, c;
    __host__ __device__ void init(int M, int N, int G_, int c_) { nM = M / BM; nN = N / BM; nwg = nM * nN; G = G_; c = c_; }
    __host__ __device__ bool next(int i, Unit& u) const {
        const long L = (long)i * G + c; if (L >= nwg) return false;
        int wgid = (int)L; { const int q = nwg / NXCD, r = nwg % NXCD, xcd = wgid % NXCD, off = wgid / NXCD; wgid = (xcd < r ? xcd * (q + 1) : r * (q + 1) + (xcd - r) * q) + off; }
        const int nig = WGM * nN, gid = wgid / nig, fm = gid * WGM, gsz = (nM - fm) < WGM ? (nM - fm) : WGM;
        u.pm = fm + ((wgid % nig) % gsz); u.pn = (wgid % nig) / gsz; return true;
    }
    __device__ __forceinline__ void a_ready(const Unit&) const {}
    __device__ __forceinline__ void done(const Unit&) const {}
};

__device__ __forceinline__ unsigned cvt_pk_bf16(float lo, float hi) { unsigned r; asm volatile("v_cvt_pk_bf16_f32 %0, %1, %2" : "=v"(r) : "v"(lo), "v"(hi)); return r; }

template <class Epi, class Sched, bool ALIGN_EPI = false, bool SP2 = false>
__device__ __forceinline__ void gemm_phase(PG8_LAS unsigned char* lds, const Gemm g, const Sched& S, const Epi& E) {
    int tid = threadIdx.x; asm volatile("" : "+v"(tid));
    const int wid = __builtin_amdgcn_readfirstlane(tid >> 6), lane = tid & 63, wr = wid >> 2, wc = wid & 3, fr = lane & 15, fq = lane >> 4;
    const int K = g.K, nt = K / BK;
    unsigned voffA[2], voffB[2];
#pragma unroll
    for (int i = 0; i < 2; ++i) { int R, C; stage_rc(tid * 16 + i * 8192, R, C); const int Rb = Epi::PERM ? ((R & ~31) + perm32(R & 31)) : R;
        voffA[i] = (unsigned)(R * K + C) * 2u; voffB[i] = (unsigned)(Rb * K + C) * 2u; }
    const size_t kstep = (size_t)(BK * 2);
    const size_t hstep = (size_t)HALF * K * 2;
    const size_t tstep = 2 * hstep;
    const unsigned ldsw = (unsigned)wid * 1024u;
    const int aoff = lds_byte(wr * 64 + fr, fq * 8), boff = lds_byte(wc * 32 + fr, fq * 8);
#define PG8_SA(b, h) (((b) * 2 + (h)) * HTB)
#define PG8_SB(b, h) ((4 + (b) * 2 + (h)) * HTB)
#define PG8_STAGE(bufoff, gbase, voff) do { _Pragma("unroll") for (int _i = 0; _i < 2; ++_i) \
        __builtin_amdgcn_global_load_lds((const unsigned*)((const char*)(gbase) + (voff)[_i]), (PG8_LAS unsigned*)(lds + (bufoff) + ldsw + _i * 8192), 16, 0, 0); } while (0)
#define PG8_LDA(dst, b, h) do { _Pragma("unroll") for (int m = 0; m < 4; ++m) _Pragma("unroll") for (int k = 0; k < 2; ++k) dst[m][k] = *(const PG8_LAS bf16x8*)(lds + PG8_SA(b, h) + aoff + m * 2048 + k * 1024); } while (0)
#define PG8_LDB(dst, b, h) do { _Pragma("unroll") for (int n = 0; n < 2; ++n) _Pragma("unroll") for (int k = 0; k < 2; ++k) dst[n][k] = *(const PG8_LAS bf16x8*)(lds + PG8_SB(b, h) + boff + n * 2048 + k * 1024); } while (0)
#define PG8_MMA(ai, bj, At, Bt) do { __builtin_amdgcn_s_setprio(1); _Pragma("unroll") for (int m = 0; m < 4; ++m) _Pragma("unroll") for (int n = 0; n < 2; ++n) _Pragma("unroll") for (int k = 0; k < 2; ++k) \
        acc[ai][bj][m][n] = __builtin_amdgcn_mfma_f32_16x16x32_bf16(Bt[n][k], At[m][k], acc[ai][bj][m][n], 0, 0, 0); __builtin_amdgcn_s_setprio(0); } while (0)
#define PG8_WAIT_V(n) asm volatile("s_waitcnt vmcnt(" #n ")" ::: "memory")
#define PG8_WAIT_L(n) asm volatile("s_waitcnt lgkmcnt(" #n ")" ::: "memory")
#define PG8_BAR __builtin_amdgcn_s_barrier()
#define PG8_SCHED __builtin_amdgcn_sched_barrier(0)
    Unit cur, nxt; int ui = 0;
    if (!S.next(0, cur)) return;
    f32x4 acc[2][2][4][2];
#pragma unroll
    for (int a = 0; a < 2; ++a)
#pragma unroll
        for (int b = 0; b < 2; ++b)
#pragma unroll
            for (int m = 0; m < 4; ++m)
#pragma unroll
                for (int n = 0; n < 2; ++n) acc[a][b][m][n] = (f32x4){0.f, 0.f, 0.f, 0.f};
    bf16x8 At[4][2], B0[2][2], B1[2][2];
    const char* cA = (const char*)g.A + (size_t)cur.pm * tstep; const char* cB = (const char*)g.Bt + (size_t)cur.pn * tstep;
    S.a_ready(cur);
    if constexpr (SP2) {
        PG8_STAGE(PG8_SB(0, 0), cB, voffB); PG8_STAGE(PG8_SB(0, 1), cB + hstep, voffB); PG8_STAGE(PG8_SA(0, 0), cA, voffA); PG8_STAGE(PG8_SA(0, 1), cA + hstep, voffA);
        if (wr == 1) PG8_BAR;
        PG8_WAIT_V(2); PG8_BAR;
        PG8_STAGE(PG8_SB(1, 0), cB + kstep, voffB); PG8_STAGE(PG8_SA(1, 0), cA + kstep, voffA); PG8_STAGE(PG8_SB(1, 1), cB + hstep + kstep, voffB);
        PG8_WAIT_V(6); PG8_BAR;
    } else {
        PG8_STAGE(PG8_SB(0, 0), cB, voffB); PG8_STAGE(PG8_SA(0, 0), cA, voffA); PG8_STAGE(PG8_SB(0, 1), cB + hstep, voffB); PG8_STAGE(PG8_SA(0, 1), cA + hstep, voffA);
        if (wr == 1) PG8_BAR;
        PG8_WAIT_V(4); PG8_BAR;
        PG8_STAGE(PG8_SB(1, 0), cB + kstep, voffB); PG8_STAGE(PG8_SA(1, 0), cA + kstep, voffA); PG8_STAGE(PG8_SB(1, 1), cB + hstep + kstep, voffB);
        PG8_WAIT_V(6); PG8_BAR;
    }
    for (;;) {
        const bool has_next = S.next(ui + 1, nxt);
        const char* nA = has_next ? (const char*)g.A + (size_t)nxt.pm * tstep : cA; const char* nB = has_next ? (const char*)g.Bt + (size_t)nxt.pn * tstep : cB;
        for (int t = 0; t < nt; t += 2) {
            const bool last = (t == nt - 2);
            const char* a1 = cA + (size_t)(t + 1) * kstep;
            const char* a2 = last ? nA : cA + (size_t)(t + 2) * kstep; const char* b2 = last ? nB : cB + (size_t)(t + 2) * kstep;
            const char* a3 = a2 + kstep; const char* b3 = b2 + kstep;
            if (last && has_next) S.a_ready(nxt);
            if constexpr (SP2) {
            PG8_LDB(B0, 0, 0); PG8_LDB(B1, 0, 1); PG8_SCHED; PG8_LDA(At, 0, 0); PG8_STAGE(PG8_SA(1, 1), a1 + hstep, voffA);
            PG8_WAIT_V(8); PG8_WAIT_L(0); PG8_BAR; PG8_MMA(0, 0, At, B0); PG8_MMA(0, 1, At, B1); PG8_BAR; PG8_SCHED;
            PG8_LDA(At, 0, 1); PG8_STAGE(PG8_SB(0, 0), b2, voffB); PG8_STAGE(PG8_SB(0, 1), b2 + hstep, voffB); PG8_STAGE(PG8_SA(0, 0), a2, voffA);
            PG8_WAIT_V(8); PG8_WAIT_L(0); PG8_BAR; PG8_MMA(1, 0, At, B0); PG8_MMA(1, 1, At, B1); PG8_BAR; PG8_SCHED;
            PG8_LDB(B0, 1, 0); PG8_LDB(B1, 1, 1); PG8_SCHED; PG8_LDA(At, 1, 0); PG8_STAGE(PG8_SA(0, 1), a2 + hstep, voffA);
            PG8_WAIT_V(8); PG8_WAIT_L(0); PG8_BAR; PG8_MMA(0, 0, At, B0); PG8_MMA(0, 1, At, B1); PG8_BAR; PG8_SCHED;
            PG8_LDA(At, 1, 1); PG8_STAGE(PG8_SB(1, 0), b3, voffB); PG8_STAGE(PG8_SB(1, 1), b3 + hstep, voffB); PG8_STAGE(PG8_SA(1, 0), a3, voffA);
            PG8_WAIT_V(8); PG8_WAIT_L(0); PG8_BAR; PG8_MMA(1, 0, At, B0); PG8_MMA(1, 1, At, B1); PG8_BAR; PG8_SCHED;
            } else {
            PG8_LDB(B0, 0, 0); PG8_SCHED; PG8_LDA(At, 0, 0); PG8_STAGE(PG8_SA(1, 1), a1 + hstep, voffA);
            PG8_WAIT_L(8); PG8_BAR; PG8_WAIT_L(0); PG8_MMA(0, 0, At, B0); PG8_BAR; PG8_SCHED;
            PG8_LDB(B1, 0, 1); PG8_STAGE(PG8_SB(0, 0), b2, voffB);
            PG8_BAR; PG8_WAIT_L(0); PG8_MMA(0, 1, At, B1); PG8_BAR;
            PG8_LDA(At, 0, 1); PG8_STAGE(PG8_SA(0, 0), a2, voffA);
            PG8_BAR; PG8_WAIT_L(0); PG8_MMA(1, 0, At, B0); PG8_BAR; PG8_SCHED;
            PG8_STAGE(PG8_SB(0, 1), b2 + hstep, voffB);
            PG8_WAIT_V(6); PG8_BAR; PG8_MMA(1, 1, At, B1); PG8_BAR;
            PG8_LDB(B0, 1, 0); PG8_SCHED; PG8_LDA(At, 1, 0); PG8_STAGE(PG8_SA(0, 1), a2 + hstep, voffA);
            PG8_WAIT_L(8); PG8_BAR; PG8_WAIT_L(0); PG8_MMA(0, 0, At, B0); PG8_BAR; PG8_SCHED;
            PG8_LDB(B1, 1, 1); PG8_STAGE(PG8_SB(1, 0), b3, voffB);
            PG8_BAR; PG8_WAIT_L(0); PG8_MMA(0, 1, At, B1); PG8_BAR;
            PG8_LDA(At, 1, 1); PG8_STAGE(PG8_SA(1, 0), a3, voffA);
            PG8_BAR; PG8_WAIT_L(0); PG8_MMA(1, 0, At, B0); PG8_BAR; PG8_SCHED;
            PG8_STAGE(PG8_SB(1, 1), b3 + hstep, voffB);
            PG8_WAIT_V(6); PG8_BAR; PG8_MMA(1, 1, At, B1); PG8_BAR;
            }
        }
        if constexpr (ALIGN_EPI) { if (wr == 0) PG8_BAR; }
        E(acc, cur, wr, wc, fr, fq); S.done(cur);
        if (!has_next) break;
#pragma unroll
        for (int a = 0; a < 2; ++a)
#pragma unroll
            for (int b = 0; b < 2; ++b)
#pragma unroll
                for (int m = 0; m < 4; ++m)
#pragma unroll
                    for (int n = 0; n < 2; ++n) acc[a][b][m][n] = (f32x4){0.f, 0.f, 0.f, 0.f};
        cur = nxt; cA = nA; cB = nB; ++ui;
        if constexpr (ALIGN_EPI) { if (wr == 1) PG8_BAR; }
    }
    PG8_WAIT_V(0);
    if constexpr (!ALIGN_EPI) { if (wr == 0) PG8_BAR; }
    PG8_BAR;
#undef PG8_SA
#undef PG8_SB
#undef PG8_STAGE
#undef PG8_LDA
#undef PG8_LDB
#undef PG8_MMA
#undef PG8_WAIT_V
#undef PG8_WAIT_L
#undef PG8_BAR
#undef PG8_SCHED
}
}

using pg8::bf16_t; using pg8::f32x4; using pg8::u32x4; using pg8::u32x2; using pg8::Unit; using pg8::cvt_pk_bf16;
#define LAS __attribute__((address_space(3)))

constexpr int DM = 1024, TP = 4096, NTP = 16384, NTS = 256, NTOK = 16640, DEPTH = 4, NIN = 4864, DFF = 4096;
constexpr int NTHREADS = 512, LDS_BYTES = 147456;
constexpr size_t O_YP = 0, O_YS = 16777216, O_KVP0 = 17039360, O_KVP1 = 18087936, O_KVP2 = 22282240, O_POOLP = 39059456,
                 O_KVS0 = 39182336, O_KVS1 = 47570944, O_KVS2 = 81125376, O_POOLS = 215343104;
constexpr size_t WS_WIN = 0;
constexpr size_t WS_WPA = WS_WIN + (size_t)DEPTH * NIN * DM * 2;
constexpr size_t WS_WPB = WS_WPA + (size_t)DEPTH * DM * 256 * 2;
constexpr size_t WS_WO  = WS_WPB + (size_t)DEPTH * DM * 512 * 2;
constexpr size_t WS_WUP = WS_WO  + (size_t)DEPTH * DM * DM * 2;
constexpr size_t WS_WDN = WS_WUP + (size_t)DEPTH * DFF * DM * 2;
constexpr size_t WS_X   = WS_WDN + (size_t)DEPTH * DM * DFF * 2;
constexpr size_t WS_XB  = WS_X   + (size_t)NTOK * DM * 4;
constexpr size_t WS_QKV = WS_XB  + (size_t)NTOK * DM * 2;
constexpr size_t WS_U   = WS_QKV + (size_t)NTOK * 2304 * 2;
constexpr size_t WS_G   = WS_U   + (size_t)NTOK * 512 * 2;
constexpr size_t WS_OA  = WS_G   + (size_t)NTOK * 2048 * 2;
constexpr size_t WS_P   = WS_OA  + (size_t)NTOK * 256 * 2;
constexpr size_t WS_TMP = WS_P   + (size_t)NTOK * 512 * 2;
constexpr size_t WS_MIX = WS_TMP + (size_t)NTOK * DM * 4;
constexpr size_t WS_H   = WS_MIX + (size_t)NTOK * DM * 2;
constexpr size_t WS_SS  = WS_H   + (size_t)NTOK * DFF * 2;
constexpr size_t WS_ROPE = WS_SS + (size_t)9 * NTOK * 4;
constexpr size_t WS_BAR = WS_ROPE + (size_t)4104 * 16 * 4;
constexpr size_t WS_END = WS_BAR + (size_t)4096 * 4;

struct Params { const float* in[17]; float* out; unsigned char* ws; };

__device__ __forceinline__ void unpack8(const u32x4 w, float (&f)[8]) {
    f[0] = __uint_as_float(w.x << 16); f[1] = __uint_as_float(w.x & 0xffff0000u);
    f[2] = __uint_as_float(w.y << 16); f[3] = __uint_as_float(w.y & 0xffff0000u);
    f[4] = __uint_as_float(w.z << 16); f[5] = __uint_as_float(w.z & 0xffff0000u);
    f[6] = __uint_as_float(w.w << 16); f[7] = __uint_as_float(w.w & 0xffff0000u);
}
__device__ __forceinline__ u32x4 pack8(const float (&f)[8]) {
    u32x4 w; w.x = cvt_pk_bf16(f[0], f[1]); w.y = cvt_pk_bf16(f[2], f[3]); w.z = cvt_pk_bf16(f[4], f[5]); w.w = cvt_pk_bf16(f[6], f[7]); return w;
}
__device__ __forceinline__ float sigmoidf_(float x) { return __builtin_amdgcn_rcpf(1.0f + __builtin_amdgcn_exp2f(x * -1.44269504089f)); }

struct EpiAll {
    static constexpr bool PERM = true, AFTER_DRAIN = false;
    int mode, layer, ssi, ssn; unsigned char* ws; float* out;

    struct Pre { u32x4 g; f32x4 a, b; float rs; };

    template <int MODE> __device__ __forceinline__ Pre pre(unsigned char* ws, int row, int c) const {
        Pre p;
        if constexpr (MODE == 0 || MODE == 4) p.rs = ((const float*)(ws + WS_SS) + (size_t)ssi * NTOK)[row];
        if constexpr (MODE == 1) p.g = *(const u32x4*)((const bf16_t*)(ws + WS_G) + (size_t)row * 2048 + c);
        if constexpr (MODE == 2) { p.g = *(const u32x4*)((const bf16_t*)(ws + WS_G) + (size_t)row * 2048 + 1024 + c);
            const float* tp = (const float*)(ws + WS_TMP) + (size_t)row * DM + c; p.a = *(const f32x4*)tp; p.b = *(const f32x4*)(tp + 4); }
        if constexpr (MODE == 3) { const float* xp = (const float*)(ws + WS_X) + (size_t)row * DM + c; p.a = *(const f32x4*)xp; p.b = *(const f32x4*)(xp + 4); }
        return p;
    }
    __device__ __forceinline__ void fin_proj(unsigned char* ws, int row, int c32, int fq, float (&v)[8], const Pre& p) const {
        const int pn = c32 >> 8, cl = (c32 & 255) + 8 * fq;
        const float rs = __builtin_amdgcn_rsqf(p.rs * (1.0f / 1024.0f) + 1e-6f);
        const bool samp = row >= NTP;
        const int b = samp ? ((row - NTP) >> 3) : (row >> 12);
        const int t = samp ? (row & 7) : (row & 4095);
#pragma unroll
        for (int i = 0; i < 8; ++i) v[i] *= rs;
        if (pn < 6 && ((c32 >> 5) & 1) == 0) {
            float pv[8];
#pragma unroll
            for (int i = 0; i < 8; ++i) pv[i] = __shfl_xor(v[i], 16);
            if (fq < 2) {
                const int pi = samp ? (4096 + t) : t;
                const f32x4* rp = (const f32x4*)((const float*)(ws + WS_ROPE) + (size_t)pi * 16);
                const f32x4 c0 = rp[0], c1 = rp[1], s0 = rp[2], s1 = rp[3];
                const float sg = (fq == 0) ? -1.0f : 1.0f;
#pragma unroll
                for (int i = 0; i < 4; ++i) { v[i] = v[i] * c0[i] + sg * pv[i] * s0[i]; v[4 + i] = v[4 + i] * c1[i] + sg * pv[4 + i] * s1[i]; }
            }
        }
        if (pn >= 11) {
#pragma unroll
            for (int i = 0; i < 8; ++i) v[i] = sigmoidf_(v[i]);
        }
        bf16_t* dst; int ld, cbase;
        if (pn < 9) { dst = (bf16_t*)(ws + WS_QKV); ld = 2304; cbase = pn * 256; }
        else if (pn < 11) { dst = (bf16_t*)(ws + WS_U); ld = 512; cbase = (pn - 9) * 256; }
        else { dst = (bf16_t*)(ws + WS_G); ld = 2048; cbase = (pn - 11) * 256; }
        *(u32x4*)(dst + (size_t)row * ld + cbase + cl) = pack8(v);
        if (pn >= 3 && pn < 9) {
            const int kvi = pn - 3; const int g = (kvi >= 3) ? kvi - 3 : kvi; const int kv = (kvi >= 3) ? 1 : 0;
            const int W = 128 << (2 * g);
            const size_t okp = (g == 0) ? O_KVP0 : (g == 1 ? O_KVP1 : O_KVP2);
            const size_t oks = (g == 0) ? O_KVS0 : (g == 1 ? O_KVS1 : O_KVS2);
            float* op = nullptr;
            if (samp) op = out + oks + ((size_t)((layer * 32 + b) * W + (W - 8 + t)) * 2 + kv) * 256 + cl;
            else if (t >= TP - W) op = out + okp + ((size_t)((layer * 4 + b) * W + (t - (TP - W))) * 2 + kv) * 256 + cl;
            if (op) { *(f32x4*)op = (f32x4){v[0], v[1], v[2], v[3]}; *(f32x4*)(op + 4) = (f32x4){v[4], v[5], v[6], v[7]}; }
        } else if (pn >= 9 && pn < 11) {
            float* op = nullptr; const int c = cbase + cl;
            if (samp) op = out + O_POOLS + (size_t)((layer * 32 + b) * 15 + 7 + t) * 512 + c;
            else if (t >= TP - 15) op = out + O_POOLP + (size_t)((layer * 4 + b) * 15 + (t - (TP - 15))) * 512 + c;
            if (op) { *(f32x4*)op = (f32x4){v[0], v[1], v[2], v[3]}; *(f32x4*)(op + 4) = (f32x4){v[4], v[5], v[6], v[7]}; }
        }
    }
    template <int MODE> __device__ __forceinline__ void fin(unsigned char* ws, int row, int c32, int fq, float (&v)[8], const Pre& p) const {
        const int c = c32 + 8 * fq;
        if constexpr (MODE == 0) fin_proj(ws, row, c32, fq, v, p);
        if constexpr (MODE == 1) {
            float gg[8]; unpack8(p.g, gg);
            float* tp = (float*)(ws + WS_TMP) + (size_t)row * DM + c;
            *(f32x4*)tp = (f32x4){gg[0] * v[0], gg[1] * v[1], gg[2] * v[2], gg[3] * v[3]};
            *(f32x4*)(tp + 4) = (f32x4){gg[4] * v[4], gg[5] * v[5], gg[6] * v[6], gg[7] * v[7]};
        }
        if constexpr (MODE == 2) {
            float gg[8]; unpack8(p.g, gg);
#pragma unroll
            for (int i = 0; i < 4; ++i) { v[i] = p.a[i] + gg[i] * v[i]; v[4 + i] = p.b[i] + gg[4 + i] * v[4 + i]; }
            *(u32x4*)((bf16_t*)(ws + WS_MIX) + (size_t)row * DM + c) = pack8(v);
        }
        if constexpr (MODE == 3) {
            float* xp = (float*)(ws + WS_X) + (size_t)row * DM + c;
            float sq = 0.f;
#pragma unroll
            for (int i = 0; i < 4; ++i) { v[i] += p.a[i]; v[4 + i] += p.b[i]; }
#pragma unroll
            for (int i = 0; i < 8; ++i) sq += v[i] * v[i];
            *(f32x4*)xp = (f32x4){v[0], v[1], v[2], v[3]}; *(f32x4*)(xp + 4) = (f32x4){v[4], v[5], v[6], v[7]};
            *(u32x4*)((bf16_t*)(ws + WS_XB) + (size_t)row * DM + c) = pack8(v);
            sq += __shfl_xor(sq, 16); sq += __shfl_xor(sq, 32);
            if (fq == 0) atomicAdd((float*)(ws + WS_SS) + (size_t)ssn * NTOK + row, sq);
        }
        if constexpr (MODE == 4) {
            const float rs = __builtin_amdgcn_rsqf(p.rs * (1.0f / 1024.0f) + 1e-6f);
#pragma unroll
            for (int i = 0; i < 8; ++i) { const float a = fmaxf(v[i] * rs, 0.f); v[i] = a * a; }
            *(u32x4*)((bf16_t*)(ws + WS_H) + (size_t)row * DFF + c) = pack8(v);
        }
    }
    __device__ __forceinline__ void chunk(unsigned char* ws, int row, int c32, int fq, float (&v)[8]) const {
        const int c = c32 + 8 * fq;
        switch (mode) {
            case 0: { const Pre p = pre<0>(ws, row, c); fin<0>(ws, row, c32, fq, v, p); } break;
            case 1: { const Pre p = pre<1>(ws, row, c); fin<1>(ws, row, c32, fq, v, p); } break;
            case 2: { const Pre p = pre<2>(ws, row, c); fin<2>(ws, row, c32, fq, v, p); } break;
            case 3: { const Pre p = pre<3>(ws, row, c); fin<3>(ws, row, c32, fq, v, p); } break;
            default: { const Pre p = pre<4>(ws, row, c); fin<4>(ws, row, c32, fq, v, p); } break;
        }
    }
    template <int MODE> __device__ __forceinline__ void tile(unsigned char* ws, const f32x4 (&acc)[2][2][4][2], const Unit& u, int wr, int wc, int fr, int fq) const {
        constexpr int MB = (MODE == 2 || MODE == 3) ? 2 : 4;
#pragma unroll
        for (int ai = 0; ai < 2; ++ai)
#pragma unroll
            for (int m0 = 0; m0 < 4; m0 += MB) {
                Pre p[MB][2];
#pragma unroll
                for (int mm = 0; mm < MB; ++mm)
#pragma unroll
                    for (int bj = 0; bj < 2; ++bj) p[mm][bj] = pre<MODE>(ws, u.pm * 256 + ai * 128 + wr * 64 + (m0 + mm) * 16 + fr, u.pn * 256 + bj * 128 + wc * 32 + 8 * fq);
#pragma unroll
                for (int mm = 0; mm < MB; ++mm)
#pragma unroll
                    for (int bj = 0; bj < 2; ++bj) {
                        float v[8];
#pragma unroll
                        for (int i = 0; i < 4; ++i) { v[i] = acc[ai][bj][m0 + mm][0][i]; v[4 + i] = acc[ai][bj][m0 + mm][1][i]; }
                        fin<MODE>(ws, u.pm * 256 + ai * 128 + wr * 64 + (m0 + mm) * 16 + fr, u.pn * 256 + bj * 128 + wc * 32, fq, v, p[mm][bj]);
                    }
                asm volatile("" ::: "memory");
            }
    }
    __device__ __forceinline__ void operator()(const f32x4 (&acc)[2][2][4][2], const Unit& u, int wr, int wc, int fr, int fq) const {
        asm volatile("" : "+v"(fr), "+v"(fq));
        unsigned char* ws = this->ws; asm volatile("" : "+s"(ws));
        switch (mode) {
            case 0: tile<0>(ws, acc, u, wr, wc, fr, fq); break;
            case 1: tile<1>(ws, acc, u, wr, wc, fr, fq); break;
            case 2: tile<2>(ws, acc, u, wr, wc, fr, fq); break;
            case 3: tile<3>(ws, acc, u, wr, wc, fr, fq); break;
            default: tile<4>(ws, acc, u, wr, wc, fr, fq); break;
        }
    }
};

__device__ __forceinline__ void skinny_gemm(LAS unsigned char* lds, const bf16_t* __restrict__ A, const bf16_t* __restrict__ Bt, int N, int K, const EpiAll& E, int first, int G) {
    using pg8::bf16x8;
    int tid = threadIdx.x; asm volatile("" : "+v"(tid));
    const int lane = tid & 63, w = __builtin_amdgcn_readfirstlane(tid >> 6), kg = lane >> 4, qn = lane & 15;
    const int nh = (N == 1024) ? 1 : 2, ksplit = 8 / nh;
    const int half = w % nh, kq = w / nh, Kq = K / ksplit, nsteps = Kq >> 5;
    unsigned char* ws = E.ws; asm volatile("" : "+s"(ws));
    LAS float* red = (LAS float*)lds;
    const int RB = 8 / nh, units = RB * (N >> 5);
#pragma unroll 1
    for (int u = first; u < units; u += G) {
        const int rb = u % RB, c32 = (u / RB) << 5;
        const int row0 = rb * 32 * nh + half * 32;
        const bf16_t* ap = A + (size_t)(row0 + qn) * K + kq * Kq + kg * 8;
        const bf16_t* bp = Bt + (size_t)(c32 + 8 * (qn >> 2) + (qn & 3)) * K + kq * Kq + kg * 8;
        f32x4 acc[2][2];
#pragma unroll
        for (int a = 0; a < 2; ++a)
#pragma unroll
            for (int b = 0; b < 2; ++b) acc[a][b] = (f32x4){0.f, 0.f, 0.f, 0.f};
#pragma unroll 8
        for (int ks = 0; ks < nsteps; ++ks) {
            const bf16x8 x0 = *(const bf16x8*)(ap + ks * 32), x1 = *(const bf16x8*)(ap + (size_t)16 * K + ks * 32);
            const bf16x8 w0 = *(const bf16x8*)(bp + ks * 32), w1 = *(const bf16x8*)(bp + (size_t)4 * K + ks * 32);
            acc[0][0] = __builtin_amdgcn_mfma_f32_16x16x32_bf16(w0, x0, acc[0][0], 0, 0, 0);
            acc[0][1] = __builtin_amdgcn_mfma_f32_16x16x32_bf16(w1, x0, acc[0][1], 0, 0, 0);
            acc[1][0] = __builtin_amdgcn_mfma_f32_16x16x32_bf16(w0, x1, acc[1][0], 0, 0, 0);
            acc[1][1] = __builtin_amdgcn_mfma_f32_16x16x32_bf16(w1, x1, acc[1][1], 0, 0, 0);
        }
        __syncthreads();
        if (kq != 0) {
#pragma unroll
            for (int a = 0; a < 2; ++a)
#pragma unroll
                for (int b = 0; b < 2; ++b)
#pragma unroll
                    for (int i = 0; i < 4; ++i) red[(w * 16 + a * 8 + b * 4 + i) * 64 + lane] = acc[a][b][i];
        }
        __syncthreads();
        if (kq == 0) {
#pragma unroll 1
            for (int q = 1; q < ksplit; ++q)
#pragma unroll
                for (int a = 0; a < 2; ++a)
#pragma unroll
                    for (int b = 0; b < 2; ++b)
#pragma unroll
                        for (int i = 0; i < 4; ++i) acc[a][b][i] += red[((w + nh * q) * 16 + a * 8 + b * 4 + i) * 64 + lane];
#pragma unroll
            for (int a = 0; a < 2; ++a) {
                float v[8];
#pragma unroll
                for (int i = 0; i < 4; ++i) { v[i] = acc[a][0][i]; v[4 + i] = acc[a][1][i]; }
                E.chunk(ws, NTP + row0 + a * 16 + qn, c32, kg, v);
            }
        }
    }
    __syncthreads();
}

__device__ __forceinline__ void lds_wait() { asm volatile("s_waitcnt lgkmcnt(0)" ::: "memory"); }
__device__ __forceinline__ void transpose_item(const float* __restrict__ W, const float* __restrict__ gsc, int K, int N, bf16_t* __restrict__ WT, LAS float* scr, int item, int lane) {
    const int nblk = N / 64, kb = item / nblk, nb = item % nblk, k0 = 64 * kb, n0 = 64 * nb;
    f32x4 v[16];
#pragma unroll
    for (int i = 0; i < 16; ++i) v[i] = *(const f32x4*)(W + (size_t)(k0 + 4 * i + (lane >> 4)) * N + n0 + 4 * (lane & 15));
#pragma unroll
    for (int i = 0; i < 16; ++i) { const int kk = 4 * i + (lane >> 4); const float sc = gsc ? gsc[k0 + kk] : 1.0f; LAS float* d = scr + kk * 65 + 4 * (lane & 15);
        d[0] = v[i][0] * sc; d[1] = v[i][1] * sc; d[2] = v[i][2] * sc; d[3] = v[i][3] * sc; }
    lds_wait();
    const int c = lane & 7;
#pragma unroll
    for (int j = 0; j < 8; ++j) { const int n = (lane >> 3) + 8 * j; const LAS float* sp = scr + (8 * c) * 65 + n;
        u32x4 o; o.x = cvt_pk_bf16(sp[0 * 65], sp[1 * 65]); o.y = cvt_pk_bf16(sp[2 * 65], sp[3 * 65]); o.z = cvt_pk_bf16(sp[4 * 65], sp[5 * 65]); o.w = cvt_pk_bf16(sp[6 * 65], sp[7 * 65]);
        *(u32x4*)(WT + (size_t)(n0 + n) * K + k0 + 8 * c) = o; }
    lds_wait();
}

template <int L>
__device__ __forceinline__ void copy_shift(const float* __restrict__ src, float* __restrict__ dst, int layer, size_t gtid, size_t nth) {
    constexpr size_t per = (size_t)(L - 8) * 128;
    constexpr size_t total = (size_t)32 * per;
    constexpr int U = 8;
    const f32x4* s4 = (const f32x4*)src + (size_t)layer * 32 * L * 128; f32x4* d4 = (f32x4*)dst + (size_t)layer * 32 * L * 128;
    for (size_t i = gtid; i < total; i += nth * U) {
        f32x4 v[U];
#pragma unroll
        for (int u = 0; u < U; ++u) { const size_t idx = i + u * nth; const size_t ii = idx < total ? idx : 0; const size_t lb = ii / per, r = ii - lb * per;
            v[u] = __builtin_nontemporal_load(s4 + lb * (size_t)L * 128 + r + 8 * 128); }
#pragma unroll
        for (int u = 0; u < U; ++u) { const size_t idx = i + u * nth; if (idx < total) { const size_t lb = idx / per, r = idx - lb * per; __builtin_nontemporal_store(v[u], d4 + lb * (size_t)L * 128 + r); } }
    }
}

#define ATT_DOT(S, Q, KF) do { float _s = 0.f; _Pragma("unroll") for (int _i = 0; _i < 8; ++_i) _s += Q[_i] * KF[_i]; \
    _s += __shfl_xor(_s, 1); _s += __shfl_xor(_s, 2); _s += __shfl_xor(_s, 4); S = _s; } while (0)

__device__ __forceinline__ void attn_finish(float m, float l, float (&o)[8], bf16_t* dstp, int kg) {
    float M = m; M = fmaxf(M, __shfl_xor(M, 8)); M = fmaxf(M, __shfl_xor(M, 16)); M = fmaxf(M, __shfl_xor(M, 32));
    const float f = __expf(m - M); l *= f;
#pragma unroll
    for (int i = 0; i < 8; ++i) o[i] *= f;
    l += __shfl_xor(l, 8); l += __shfl_xor(l, 16); l += __shfl_xor(l, 32);
#pragma unroll
    for (int i = 0; i < 8; ++i) { o[i] += __shfl_xor(o[i], 8); o[i] += __shfl_xor(o[i], 16); o[i] += __shfl_xor(o[i], 32); }
    const float inv = 1.0f / l;
#pragma unroll
    for (int i = 0; i < 8; ++i) o[i] *= inv;
    if (kg == 0) *(u32x4*)dstp = pack8(o);
}

__device__ __forceinline__ void attn_prompt_item(const bf16_t* __restrict__ qkv, bf16_t* __restrict__ oa, int token, int h, int lane) {
    const int kg = lane >> 3, dl = lane & 7;
    const int b = token >> 12, t = token & 4095;
    const bf16_t* qrow = qkv + (size_t)token * 2304 + h * 64 + dl * 8;
    const bf16_t* kbase = qkv + (size_t)(b << 12) * 2304 + 768 + h * 64 + dl * 8;
    float m = -1e30f, l = 0.f; float o[8];
#pragma unroll
    for (int i = 0; i < 8; ++i) o[i] = 0.f;
#pragma unroll 1
    for (int g = 0; g < 3; ++g) {
        const int d = 1 << (2 * g);
        float q[8]; unpack8(*(const u32x4*)(qrow + g * 256), q);
#pragma unroll
        for (int i = 0; i < 8; ++i) q[i] *= 0.125f;
        const bf16_t* kb = kbase + g * 256;
#pragma unroll 1
        for (int it = 0; it < 16; it += 4) {
            u32x4 kr[4], vr[4]; bool val[4];
#pragma unroll
            for (int u = 0; u < 4; ++u) { const int j = (it + u) * 8 + kg; const int pos = t - j * d; val[u] = pos >= 0; const bf16_t* r = kb + (size_t)(pos < 0 ? 0 : pos) * 2304;
                kr[u] = *(const u32x4*)r; vr[u] = *(const u32x4*)(r + 768); }
            float s[4];
#pragma unroll
            for (int u = 0; u < 4; ++u) { float kf[8]; unpack8(kr[u], kf); ATT_DOT(s[u], q, kf); if (!val[u]) s[u] = -1e30f; }
            const float mb = fmaxf(fmaxf(m, fmaxf(s[0], s[1])), fmaxf(s[2], s[3]));
            const float corr = __expf(m - mb);
            l *= corr;
#pragma unroll
            for (int i = 0; i < 8; ++i) o[i] *= corr;
#pragma unroll
            for (int u = 0; u < 4; ++u) { const float p = val[u] ? __expf(s[u] - mb) : 0.f; l += p; float vf[8]; unpack8(vr[u], vf);
#pragma unroll
                for (int i = 0; i < 8; ++i) o[i] += p * vf[i]; }
            m = mb;
        }
    }
    {
        const int g = kg < 2 ? kg : 2; const int d = 1 << (2 * g);
        const int pos = t - 128 * d; const bool val = (kg < 3) && (pos >= 0);
        float q[8]; unpack8(*(const u32x4*)(qrow + g * 256), q);
        const bf16_t* r = kbase + g * 256 + (size_t)(pos < 0 ? 0 : pos) * 2304;
        float kf[8], vf[8]; unpack8(*(const u32x4*)r, kf); unpack8(*(const u32x4*)(r + 768), vf);
        float s; ATT_DOT(s, q, kf); s *= 0.125f;
        if (!val) s = -1e30f;
        const float mb = fmaxf(m, s); const float corr = __expf(m - mb); const float p = val ? __expf(s - mb) : 0.f;
        l = l * corr + p;
#pragma unroll
        for (int i = 0; i < 8; ++i) o[i] = o[i] * corr + p * vf[i];
        m = mb;
    }
    attn_finish(m, l, o, oa + (size_t)token * 256 + h * 64 + dl * 8, kg);
}

__device__ __forceinline__ void sample_kv(const bf16_t* __restrict__ newb, const float* __restrict__ cb, int W, int idx, float (&kf)[8], float (&vf)[8]) {
    if (idx >= W) { const bf16_t* r = newb + (size_t)(idx - W) * 2304; unpack8(*(const u32x4*)r, kf); unpack8(*(const u32x4*)(r + 768), vf); }
    else { const float* r = cb + (size_t)idx * 512; const f32x4 a = *(const f32x4*)r, b2 = *(const f32x4*)(r + 4), c = *(const f32x4*)(r + 256), d2 = *(const f32x4*)(r + 260);
#pragma unroll
        for (int i = 0; i < 4; ++i) { kf[i] = a[i]; kf[4 + i] = b2[i]; vf[i] = c[i]; vf[4 + i] = d2[i]; } }
}
__device__ __forceinline__ void attn_sample_sub(const bf16_t* __restrict__ qkv, const float* __restrict__ cg_, bf16_t* __restrict__ PO, float* __restrict__ LSE,
                                                int layer, int stok, int h, int g, int lane) {
    const int kg = lane >> 3, dl = lane & 7;
    const int b = stok >> 3, t = stok & 7;
    const int token = NTP + stok;
    const int d = 1 << (2 * g), W = 128 << (2 * g);
    const bf16_t* nb = qkv + (size_t)(NTP + b * 8) * 2304 + 768 + g * 256 + h * 64 + dl * 8;
    const float* cb = cg_ + (size_t)(layer * 32 + b) * W * 512 + h * 64 + dl * 8;
    float q[8]; unpack8(*(const u32x4*)(qkv + (size_t)token * 2304 + g * 256 + h * 64 + dl * 8), q);
#pragma unroll
    for (int i = 0; i < 8; ++i) q[i] *= 0.125f;
    float m = -1e30f, l = 0.f; float o[8];
#pragma unroll
    for (int i = 0; i < 8; ++i) o[i] = 0.f;
#pragma unroll 1
    for (int it = 0; it < 16; it += 8) {
        float kf[8][8], vf[8][8], s[8];
#pragma unroll
        for (int u = 0; u < 8; ++u) { const int j = (it + u) * 8 + kg; sample_kv(nb, cb, W, W + t - j * d, kf[u], vf[u]); }
        float mb = m;
#pragma unroll
        for (int u = 0; u < 8; ++u) { ATT_DOT(s[u], q, kf[u]); mb = fmaxf(mb, s[u]); }
        const float corr = __expf(m - mb);
        l *= corr;
#pragma unroll
        for (int i = 0; i < 8; ++i) o[i] *= corr;
#pragma unroll
        for (int u = 0; u < 8; ++u) { const float p = __expf(s[u] - mb); l += p;
#pragma unroll
            for (int i = 0; i < 8; ++i) o[i] += p * vf[u][i]; }
        m = mb;
    }
    {
        const bool val = kg == 0;
        float kf[8], vf[8]; sample_kv(nb, cb, W, W + t - 128 * d, kf, vf);
        float s; ATT_DOT(s, q, kf);
        if (!val) s = -1e30f;
        const float mb = fmaxf(m, s); const float corr = __expf(m - mb); const float p = val ? __expf(s - mb) : 0.f;
        l = l * corr + p;
#pragma unroll
        for (int i = 0; i < 8; ++i) o[i] = o[i] * corr + p * vf[i];
        m = mb;
    }
    float M = m; M = fmaxf(M, __shfl_xor(M, 8)); M = fmaxf(M, __shfl_xor(M, 16)); M = fmaxf(M, __shfl_xor(M, 32));
    const float f = __expf(m - M); l *= f;
#pragma unroll
    for (int i = 0; i < 8; ++i) o[i] *= f;
    l += __shfl_xor(l, 8); l += __shfl_xor(l, 16); l += __shfl_xor(l, 32);
#pragma unroll
    for (int i = 0; i < 8; ++i) { o[i] += __shfl_xor(o[i], 8); o[i] += __shfl_xor(o[i], 16); o[i] += __shfl_xor(o[i], 32); }
    const float inv = 1.0f / l;
#pragma unroll
    for (int i = 0; i < 8; ++i) o[i] *= inv;
    if (kg == 0) *(u32x4*)(PO + ((size_t)g * NTOK + token) * 256 + h * 64 + dl * 8) = pack8(o);
    if (lane == 0) LSE[((size_t)g * NTOK + token) * 4 + h] = M + __logf(l);
}

constexpr int ATT_PITCH = 144, ATT_ROWS = 272, ATT_VOFF = ATT_ROWS * ATT_PITCH;
typedef short s16x4 __attribute__((ext_vector_type(4)));
template <int OFF> __device__ __forceinline__ s16x4 tr_read(unsigned addr) { s16x4 r; asm volatile("ds_read_b64_tr_b16 %0, %1 offset:%2" : "=v"(r) : "v"(addr), "n"(OFF) : "memory"); return r; }
__device__ __forceinline__ void tr_wait8(s16x4& a, s16x4& b, s16x4& c, s16x4& d, s16x4& e, s16x4& f, s16x4& g, s16x4& h) {
    asm volatile("s_waitcnt lgkmcnt(0)" : "+v"(a), "+v"(b), "+v"(c), "+v"(d), "+v"(e), "+v"(f), "+v"(g), "+v"(h) :: "memory"); }

__device__ __forceinline__ void attn_mfma_phase(LAS unsigned char* lds, const bf16_t* __restrict__ QKV, bf16_t* __restrict__ PO, float* __restrict__ LSE, int bid, int G, int tid) {
    using pg8::bf16x8;
    const int lane = tid & 63, w = __builtin_amdgcn_readfirstlane(tid >> 6), kg = lane >> 4, qn = lane & 15;
    for (int i = tid; i < 2 * 144; i += NTHREADS) { const int kv = i / 144, rem = i - kv * 144; *(LAS u32x4*)(lds + kv * ATT_VOFF + 256 * ATT_PITCH + rem * 16) = (u32x4){0u, 0u, 0u, 0u}; }
    const unsigned vaddr = (unsigned)(uintptr_t)(lds + ATT_VOFF + (16 * w + 4 * kg + (qn >> 2)) * ATT_PITCH + (lane & 3) * 8);
    const float csc = 0.125f * 1.44269504089f;
#define ATT_DECODE(U, b_, h_, g_, r_, I0_) do { const int _bh = (U) / 96, _rest = (U) - _bh * 96; b_ = _bh >> 2; h_ = _bh & 3; \
        if (_rest < 32) { g_ = 0; r_ = 0; I0_ = 128 * _rest; } else if (_rest < 64) { g_ = 1; r_ = (_rest - 32) >> 3; I0_ = 128 * ((_rest - 32) & 7); } else { g_ = 2; r_ = (_rest - 64) >> 1; I0_ = 128 * ((_rest - 64) & 1); } } while (0)
#define ATT_FETCH(U) do { int _b, _h, _g, _r, _I0; ATT_DECODE(U, _b, _h, _g, _r, _I0); const int _d = 1 << (2 * _g); \
        _Pragma("unroll") for (int i = 0; i < 8; ++i) { const int kv = i >> 2, row = (tid >> 3) + 64 * (i & 3), ch = tid & 7; const int I = _I0 - 128 + row; \
            pf[i] = (u32x4){0u, 0u, 0u, 0u}; \
            if (I >= 0) pf[i] = *(const u32x4*)(QKV + (size_t)(_b * 4096 + _r + _d * I) * 2304 + 768 + kv * 768 + _g * 256 + _h * 64 + ch * 8); } \
        const bf16_t* _qp = QKV + ((size_t)_b * 4096 + _r + _d * (_I0 + 16 * w + qn)) * 2304 + _g * 256 + _h * 64 + kg * 8; \
        qf0 = *(const bf16x8*)_qp; qf1 = *(const bf16x8*)(_qp + 32); } while (0)
    u32x4 pf[8]; bf16x8 qf0, qf1;
    if (bid < 1536) ATT_FETCH(bid);
#pragma unroll 1
    for (int u = bid; u < 1536; u += G) {
        int b, h, g, r, I0; ATT_DECODE(u, b, h, g, r, I0);
        const int d = 1 << (2 * g);
        __syncthreads();
#pragma unroll
        for (int i = 0; i < 8; ++i) { const int kv = i >> 2, row = (tid >> 3) + 64 * (i & 3), ch = tid & 7; *(LAS u32x4*)(lds + kv * ATT_VOFF + row * ATT_PITCH + ch * 16) = pf[i]; }
        const bf16x8 q0 = qf0, q1 = qf1;
        __syncthreads();
        if (u + G < 1536) ATT_FETCH(u + G);
        const int Iq = I0 + 16 * w + qn; const size_t tokq = (size_t)b * 4096 + r + d * Iq;
        f32x4 sc[9];
        const LAS unsigned char* kb = lds + (16 * w + qn) * ATT_PITCH + kg * 16;
#pragma unroll
        for (int kt = 0; kt < 9; ++kt) { const bf16x8 k0 = *(const LAS bf16x8*)(kb + kt * 16 * ATT_PITCH), k1 = *(const LAS bf16x8*)(kb + kt * 16 * ATT_PITCH + 64);
            f32x4 z = (f32x4){0.f, 0.f, 0.f, 0.f}; z = __builtin_amdgcn_mfma_f32_16x16x32_bf16(k0, q0, z, 0, 0, 0); sc[kt] = __builtin_amdgcn_mfma_f32_16x16x32_bf16(k1, q1, z, 0, 0, 0); }
        const int jb = 128 + qn - 4 * kg, ikb = I0 - 128 + 16 * w + 4 * kg;
        float m = -1e30f;
#pragma unroll
        for (int kt = 0; kt < 9; ++kt)
#pragma unroll
            for (int i = 0; i < 4; ++i) { const int j = jb - 16 * kt - i; const bool val = (j >= 0) && (j <= 128) && (ikb + 16 * kt + i >= 0); sc[kt][i] = val ? sc[kt][i] : -1e30f; m = fmaxf(m, sc[kt][i]); }
        m = fmaxf(m, __shfl_xor(m, 16)); m = fmaxf(m, __shfl_xor(m, 32));
        const float mc = m * csc; float l = 0.f;
        unsigned pk[10][2];
#pragma unroll
        for (int kt = 0; kt < 9; ++kt) { float p[4];
#pragma unroll
            for (int i = 0; i < 4; ++i) { p[i] = (sc[kt][i] > -1e29f) ? __builtin_amdgcn_exp2f(sc[kt][i] * csc - mc) : 0.f; l += p[i]; }
            pk[kt][0] = cvt_pk_bf16(p[0], p[1]); pk[kt][1] = cvt_pk_bf16(p[2], p[3]); }
        pk[9][0] = 0u; pk[9][1] = 0u;
        l += __shfl_xor(l, 16); l += __shfl_xor(l, 32);
        f32x4 o[4];
#pragma unroll
        for (int dt = 0; dt < 4; ++dt) o[dt] = (f32x4){0.f, 0.f, 0.f, 0.f};
#define ATT_PV(KK) do { s16x4 a0 = tr_read<(KK) * 32 * ATT_PITCH + 0>(vaddr), a1 = tr_read<(KK) * 32 * ATT_PITCH + 32>(vaddr), a2 = tr_read<(KK) * 32 * ATT_PITCH + 64>(vaddr), a3 = tr_read<(KK) * 32 * ATT_PITCH + 96>(vaddr); \
            s16x4 c0 = tr_read<(KK) * 32 * ATT_PITCH + 16 * ATT_PITCH + 0>(vaddr), c1 = tr_read<(KK) * 32 * ATT_PITCH + 16 * ATT_PITCH + 32>(vaddr), c2 = tr_read<(KK) * 32 * ATT_PITCH + 16 * ATT_PITCH + 64>(vaddr), c3 = tr_read<(KK) * 32 * ATT_PITCH + 16 * ATT_PITCH + 96>(vaddr); \
            tr_wait8(a0, a1, a2, a3, c0, c1, c2, c3); \
            u32x4 pw; pw.x = pk[2 * (KK)][0]; pw.y = pk[2 * (KK)][1]; pw.z = pk[2 * (KK) + 1][0]; pw.w = pk[2 * (KK) + 1][1]; \
            const bf16x8 pf = __builtin_bit_cast(bf16x8, pw); \
            o[0] = __builtin_amdgcn_mfma_f32_16x16x32_bf16(__builtin_shufflevector(a0, c0, 0, 1, 2, 3, 4, 5, 6, 7), pf, o[0], 0, 0, 0); \
            o[1] = __builtin_amdgcn_mfma_f32_16x16x32_bf16(__builtin_shufflevector(a1, c1, 0, 1, 2, 3, 4, 5, 6, 7), pf, o[1], 0, 0, 0); \
            o[2] = __builtin_amdgcn_mfma_f32_16x16x32_bf16(__builtin_shufflevector(a2, c2, 0, 1, 2, 3, 4, 5, 6, 7), pf, o[2], 0, 0, 0); \
            o[3] = __builtin_amdgcn_mfma_f32_16x16x32_bf16(__builtin_shufflevector(a3, c3, 0, 1, 2, 3, 4, 5, 6, 7), pf, o[3], 0, 0, 0); } while (0)
        ATT_PV(0); ATT_PV(1); ATT_PV(2); ATT_PV(3); ATT_PV(4);
        const float il = 1.0f / l;
        bf16_t* op = PO + ((size_t)g * NTOK + tokq) * 256 + h * 64 + 4 * kg;
#pragma unroll
        for (int dt = 0; dt < 4; ++dt) { u32x2 wv; wv.x = cvt_pk_bf16(o[dt][0] * il, o[dt][1] * il); wv.y = cvt_pk_bf16(o[dt][2] * il, o[dt][3] * il); *(u32x2*)(op + 16 * dt) = wv; }
        if (kg == 0) LSE[((size_t)g * NTOK + tokq) * 4 + h] = m * 0.125f + __logf(l);
    }
#undef ATT_PV
#undef ATT_FETCH
#undef ATT_DECODE
}

#define XB_TMO      128
#define XB_XCNT(j)  (256  + 64 * (j))
#define XB_XSUB(j)  (1280 + 64 * (j))
#define XB_XGEN(j)  (2304 + 64 * (j))
#define XB_TOP      3328
#define XB_TOPGEN   3392
#define XCD_BAR_WORDS 3456
#define XB_SPIN_CAP (1u << 20)
__device__ __forceinline__ unsigned xb_ld(unsigned* p)              { return __hip_atomic_load(p, __ATOMIC_RELAXED, __HIP_MEMORY_SCOPE_AGENT); }
__device__ __forceinline__ unsigned xb_add(unsigned* p, unsigned v) { return __hip_atomic_fetch_add(p, v, __ATOMIC_RELAXED, __HIP_MEMORY_SCOPE_AGENT); }
__device__ __forceinline__ unsigned xb_xcc_id() { return (unsigned)__builtin_amdgcn_s_getreg((3 << 11) | 20) & 0xFu; }
#define XB_SPIN(cond, bar) do { unsigned _sp = 0; while (cond) { __builtin_amdgcn_s_sleep(1); \
    if ((++_sp & 255u) == 0u) { if (xb_ld(&(bar)[XB_TMO])) break; if (_sp > XB_SPIN_CAP) { atomicAdd(&(bar)[XB_TMO], 1u); break; } } } } while (0)
struct XcdBarrier { unsigned* bar; unsigned x; volatile LAS unsigned* st; };
__device__ __forceinline__ XcdBarrier xcd_barrier_post(unsigned* bar, volatile LAS unsigned* st) {
    XcdBarrier b; b.bar = bar; b.x = xb_xcc_id(); b.st = st;
    if (threadIdx.x == 0) (void)xb_add(&bar[XB_XCNT(b.x)], 1u);
    return b;
}
__device__ __forceinline__ void xcd_barrier_complete(unsigned* bar, unsigned x, unsigned& nloc, unsigned& nx) {
    const unsigned G = gridDim.x * gridDim.y * gridDim.z;
    unsigned sum, cnt, mine, sp = 0u;
    for (;;) {
        sum = 0u; cnt = 0u; mine = 0u;
#pragma unroll
        for (unsigned j = 0; j < 16; ++j) { const unsigned c = xb_ld(&bar[XB_XCNT(j)]); sum += c; cnt += (c > 0u) ? 1u : 0u; mine = (j == x) ? c : mine; }
        if (sum == G) break;
        __builtin_amdgcn_s_sleep(1);
        if ((++sp & 255u) == 0u) { if (xb_ld(&bar[XB_TMO])) break; if (sp > XB_SPIN_CAP) { atomicAdd(&bar[XB_TMO], 1u); break; } }
    }
    nloc = mine > 0u ? mine : 1u; nx = cnt > 0u ? cnt : 1u;
}
__device__ __forceinline__ void xcd_barrier(const XcdBarrier& b) {
    asm volatile("s_waitcnt vmcnt(0)" ::: "memory");
    __syncthreads();
    if (threadIdx.x == 0) {
        unsigned* bar = b.bar;
        __builtin_amdgcn_s_waitcnt(0);
        unsigned nloc = b.st[0], nx = b.st[1];
        if (nloc == 0u) { xcd_barrier_complete(bar, b.x, nloc, nx); b.st[0] = nloc; b.st[1] = nx; }
        const unsigned old = xb_add(&bar[XB_XSUB(b.x)], 1u);
        const unsigned gen = old / nloc;
        if (old + 1u == (gen + 1u) * nloc) {
            __builtin_amdgcn_fence(__ATOMIC_RELEASE, "agent");
            asm volatile("s_waitcnt vmcnt(0)" ::: "memory");
            const unsigned og = xb_add(&bar[XB_TOP], 1u);
            const unsigned tg = og / nx;
            if (og + 1u == (tg + 1u) * nx) xb_add(&bar[XB_TOPGEN], 1u);
            else XB_SPIN(xb_ld(&bar[XB_TOPGEN]) == tg, bar);
            __builtin_amdgcn_fence(__ATOMIC_ACQUIRE, "agent");
            xb_add(&bar[XB_XGEN(b.x)], 1u);
            asm volatile("s_waitcnt vmcnt(0)" ::: "memory");
        } else {
            XB_SPIN(xb_ld(&bar[XB_XGEN(b.x)]) == gen, bar);
            __builtin_amdgcn_fence(__ATOMIC_ACQUIRE, "agent");
            asm volatile("s_waitcnt vmcnt(0)" ::: "memory");
        }
    }
    __syncthreads();
}

template <int GP> __device__ __forceinline__ void pool_item(const bf16_t* __restrict__ UB, bf16_t* __restrict__ PB, const float* __restrict__ sp, int tb, int cl) {
    constexpr int W = 2 << GP, NR = W + 7;
    const int c = (GP * 16 + cl) * 8;
    const int token0 = tb * 8; const bool samp = token0 >= NTP; const int t0 = samp ? 0 : (token0 & 4095); const int b = (token0 - NTP) >> 3;
    u32x4 R[NR];
#pragma unroll
    for (int r = 0; r < NR; ++r) { const int dt = r - (W - 1);
        if (dt >= 0 || t0 + dt >= 0) R[r] = *(const u32x4*)(UB + (size_t)(token0 + dt) * 512 + c);
        else if (samp) { const float* q = sp + (size_t)(b * 15 + 15 + dt) * 512 + c; const f32x4 a = *(const f32x4*)q, b2 = *(const f32x4*)(q + 4);
            R[r].x = cvt_pk_bf16(a[0], a[1]); R[r].y = cvt_pk_bf16(a[2], a[3]); R[r].z = cvt_pk_bf16(b2[0], b2[1]); R[r].w = cvt_pk_bf16(b2[2], b2[3]); }
        else R[r] = (u32x4){0u, 0u, 0u, 0u}; }
#pragma unroll
    for (int j = 0; j < 8; ++j) {
        float sum[8];
#pragma unroll
        for (int k = 0; k < 8; ++k) sum[k] = 0.f;
#pragma unroll
        for (int i = 0; i < W; ++i) { float f[8]; unpack8(R[j + (W - 1) - i], f);
#pragma unroll
            for (int k = 0; k < 8; ++k) sum[k] += f[k]; }
        float ut[8]; unpack8(R[j + W - 1], ut);
        const int t = t0 + j; const float cnt = samp ? (float)W : (float)(W < t + 1 ? W : t + 1); const float ic = 1.0f / cnt;
        float p[8];
#pragma unroll
        for (int k = 0; k < 8; ++k) p[k] = sum[k] * ic - ut[k];
        *(u32x4*)(PB + (size_t)(token0 + j) * 512 + c) = pack8(p);
    }
}

__global__ void __launch_bounds__(NTHREADS, 2) fwd_megakernel(Params P) {
    extern __shared__ __attribute__((aligned(16))) unsigned char lds_raw[];
    LAS unsigned char* lds = (LAS unsigned char*)lds_raw;
    cg::grid_group grid = cg::this_grid();
    const int tid = threadIdx.x, lane = tid & 63, wave = __builtin_amdgcn_readfirstlane(tid >> 6);
    const int G = gridDim.x, bid = blockIdx.x;
    const int gw = bid * 8 + wave, NGW = G * 8;
    const size_t gtid = (size_t)bid * NTHREADS + tid, nth = (size_t)G * NTHREADS;
    unsigned char* ws = P.ws;
    bf16_t* Wt_in = (bf16_t*)(ws + WS_WIN); bf16_t* Wt_pa = (bf16_t*)(ws + WS_WPA); bf16_t* Wt_pb = (bf16_t*)(ws + WS_WPB);
    bf16_t* Wt_o = (bf16_t*)(ws + WS_WO); bf16_t* Wt_up = (bf16_t*)(ws + WS_WUP); bf16_t* Wt_dn = (bf16_t*)(ws + WS_WDN);
    float* X = (float*)(ws + WS_X); bf16_t* XB = (bf16_t*)(ws + WS_XB); bf16_t* QKV = (bf16_t*)(ws + WS_QKV); bf16_t* UB = (bf16_t*)(ws + WS_U);
    bf16_t* GT = (bf16_t*)(ws + WS_G); bf16_t* OA = (bf16_t*)(ws + WS_OA); bf16_t* PB = (bf16_t*)(ws + WS_P); float* TMP = (float*)(ws + WS_TMP);
    bf16_t* MIX = (bf16_t*)(ws + WS_MIX); bf16_t* HID = (bf16_t*)(ws + WS_H); float* SS = (float*)(ws + WS_SS); float* ROPE = (float*)(ws + WS_ROPE);
    float* out = P.out;
    volatile LAS unsigned* bst = (volatile LAS unsigned*)(lds + LDS_BYTES - 16);
    if (tid == 0) { bst[0] = 0u; bst[1] = 0u; }
    __syncthreads();
    const XcdBarrier xb = xcd_barrier_post((unsigned*)(ws + WS_BAR), bst);

    {
        LAS float* LsT = (LAS float*)lds;
        LAS float* Ws = LsT + 128 * 128;
        for (int item = bid; item < DEPTH * 4 * 16; item += G) {
            const int l = item >> 6, g = (item >> 4) & 3, n0 = (item & 15) * 64;
            const float* lin = P.in[10] + (size_t)(l * 4 + g) * 128 * 128;
            const float* sc = P.in[11] + l * 512 + g * 128;
            const float* wpb = P.in[9] + (size_t)l * 512 * 1024 + (size_t)g * 128 * 1024;
            for (int i = tid; i < 128 * 128; i += NTHREADS) { const int c = i >> 7, d = i & 127; LsT[d * 128 + c] = lin[i] * sc[d]; }
            for (int i = tid; i < 128 * 64; i += NTHREADS) { const int d = i >> 6, n = i & 63; Ws[i] = wpb[(size_t)d * 1024 + n0 + n]; }
            __syncthreads();
            const int n = tid & 63, cgp = tid >> 6;
            float a[16];
#pragma unroll
            for (int i = 0; i < 16; ++i) a[i] = 0.f;
            for (int d = 0; d < 128; ++d) {
                const float w = Ws[d * 64 + n];
                const LAS f32x4* lp = (const LAS f32x4*)(LsT + d * 128 + cgp * 16);
#pragma unroll
                for (int q4 = 0; q4 < 4; ++q4) { const f32x4 lv = lp[q4];
#pragma unroll
                    for (int i = 0; i < 4; ++i) a[q4 * 4 + i] += lv[i] * w; }
            }
            bf16_t* op = Wt_pb + ((size_t)l * 1024 + n0 + n) * 512 + g * 128 + cgp * 16;
            u32x4 o0, o1; o0.x = cvt_pk_bf16(a[0], a[1]); o0.y = cvt_pk_bf16(a[2], a[3]); o0.z = cvt_pk_bf16(a[4], a[5]); o0.w = cvt_pk_bf16(a[6], a[7]);
            o1.x = cvt_pk_bf16(a[8], a[9]); o1.y = cvt_pk_bf16(a[10], a[11]); o1.z = cvt_pk_bf16(a[12], a[13]); o1.w = cvt_pk_bf16(a[14], a[15]);
            *(u32x4*)op = o0; *(u32x4*)(op + 8) = o1;
            __syncthreads();
        }
        {
            LAS float* scr = (LAS float*)(lds + wave * 16640);
            constexpr int I_IN = 16 * 76, I_PA = 4 * 16, I_O = 16 * 16, I_UP = 16 * 64, I_DN = 64 * 16, I_L = I_IN + I_PA + I_O + I_UP + I_DN;
            for (int it = gw; it < DEPTH * I_L; it += NGW) {
                const int l = it / I_L; int r = it - l * I_L;
                if (r < I_IN) { transpose_item(P.in[7] + (size_t)l * DM * NIN, P.in[6] + l * DM, DM, NIN, Wt_in + (size_t)l * NIN * DM, scr, r, lane); continue; } r -= I_IN;
                if (r < I_PA) { transpose_item(P.in[8] + (size_t)l * 256 * DM, nullptr, 256, DM, Wt_pa + (size_t)l * DM * 256, scr, r, lane); continue; } r -= I_PA;
                if (r < I_O) { transpose_item(P.in[12] + (size_t)l * DM * DM, nullptr, DM, DM, Wt_o + (size_t)l * DM * DM, scr, r, lane); continue; } r -= I_O;
                if (r < I_UP) { transpose_item(P.in[14] + (size_t)l * DM * DFF, P.in[13] + l * DM, DM, DFF, Wt_up + (size_t)l * DFF * DM, scr, r, lane); continue; } r -= I_UP;
                transpose_item(P.in[15] + (size_t)l * DFF * DM, nullptr, DFF, DM, Wt_dn + (size_t)l * DM * DFF, scr, r, lane);
            }
        }
        for (int row = gw; row < NTOK; row += NGW) {
            const float* src = row < NTP ? P.in[0] + (size_t)row * DM : P.in[1] + (size_t)(row - NTP) * DM;
            float s = 0.f;
#pragma unroll
            for (int j = 0; j < 4; ++j) { const f32x4 v = *(const f32x4*)(src + 4 * lane + 256 * j); s += v[0] * v[0] + v[1] * v[1] + v[2] * v[2] + v[3] * v[3];
                *(f32x4*)(X + (size_t)row * DM + 4 * lane + 256 * j) = v;
                u32x2 w; w.x = cvt_pk_bf16(v[0], v[1]); w.y = cvt_pk_bf16(v[2], v[3]); *(u32x2*)(XB + (size_t)row * DM + 4 * lane + 256 * j) = w; }
#pragma unroll
            for (int o = 1; o < 64; o <<= 1) s += __shfl_xor(s, o);
            if (lane == 0) SS[row] = s;
        }
        for (size_t i = gtid; i < 4104 * 8; i += nth) { const int pi = (int)(i >> 3), k = (int)(i & 7); const float pos = (float)(pi < 4096 ? pi : 8192 + pi - 4096);
            const float inv = powf(500000.0f, -(float)(2 * k) / 16.0f); const float ang = pos * inv; ROPE[pi * 16 + k] = cosf(ang); ROPE[pi * 16 + 8 + k] = sinf(ang); }
        for (size_t i = gtid; i < (size_t)8 * NTOK; i += nth) SS[NTOK + i] = 0.f;
        for (size_t i = gtid; i < (size_t)DEPTH * 32 * 7 * 128; i += nth) { const size_t lb = i / (7 * 128), r = i - lb * (7 * 128);
            *(f32x4*)(out + O_POOLS + lb * 15 * 512 + r * 4) = *(const f32x4*)(P.in[5] + lb * 15 * 512 + 8 * 512 + r * 4); }
    }
    grid.sync();

    pg8::StaticOrder S;
#pragma unroll 1
    for (int step = 0; step < DEPTH * 7; ++step) {
        const int layer = step / 7, st = step - layer * 7;
        if (st == 1) {
            int tid_l = threadIdx.x; asm volatile("" : "+v"(tid_l));
            const int lane = tid_l & 63, gw = bid * 8 + (tid_l >> 6);
            const size_t gtid = (size_t)bid * NTHREADS + tid_l;
            unsigned char* wsl = ws; asm volatile("" : "+s"(wsl));
            bf16_t* QKV = (bf16_t*)(wsl + WS_QKV); bf16_t* UB = (bf16_t*)(wsl + WS_U); bf16_t* OA = (bf16_t*)(wsl + WS_OA); bf16_t* PB = (bf16_t*)(wsl + WS_P);
            bf16_t* PO = (bf16_t*)(wsl + WS_TMP); float* LSE = (float*)(wsl + WS_TMP + (size_t)3 * NTOK * 256 * 2);
            for (int it = gw; it < NTS * 12; it += NGW) { const int g = it % 3, r = it / 3; attn_sample_sub(QKV, g == 0 ? P.in[2] : (g == 1 ? P.in[3] : P.in[4]), PO, LSE, layer, r >> 2, r & 3, g, lane); }
            attn_mfma_phase(lds, QKV, PO, LSE, bid, G, tid_l);
            copy_shift<128>(P.in[2], out + O_KVS0, layer, gtid, nth);
            copy_shift<512>(P.in[3], out + O_KVS1, layer, gtid, nth);
            copy_shift<2048>(P.in[4], out + O_KVS2, layer, gtid, nth);
            xcd_barrier(xb);
            for (size_t base = gtid; base < (size_t)NTOK * 32; base += nth * 4) {
                float ls[4][3]; u32x4 av[4][3];
#pragma unroll
                for (int u = 0; u < 4; ++u) { const size_t idx = base + u * nth; const size_t ii = idx < (size_t)NTOK * 32 ? idx : base; const size_t token = ii >> 5; const int c = (int)(ii & 31) * 8, h = c >> 6;
#pragma unroll
                    for (int g = 0; g < 3; ++g) { ls[u][g] = LSE[((size_t)g * NTOK + token) * 4 + h]; av[u][g] = *(const u32x4*)(PO + ((size_t)g * NTOK + token) * 256 + c); } }
#pragma unroll
                for (int u = 0; u < 4; ++u) { const size_t idx = base + u * nth;
                    if (idx < (size_t)NTOK * 32) { const size_t token = idx >> 5; const int c = (int)(idx & 31) * 8;
                        const float mx = fmaxf(ls[u][0], fmaxf(ls[u][1], ls[u][2])); float w0 = __expf(ls[u][0] - mx), w1 = __expf(ls[u][1] - mx), w2 = __expf(ls[u][2] - mx); const float iw = 1.0f / (w0 + w1 + w2); w0 *= iw; w1 *= iw; w2 *= iw;
                        float a0[8], a1[8], a2[8], o[8]; unpack8(av[u][0], a0); unpack8(av[u][1], a1); unpack8(av[u][2], a2);
#pragma unroll
                        for (int k = 0; k < 8; ++k) o[k] = w0 * a0[k] + w1 * a1[k] + w2 * a2[k];
                        *(u32x4*)(OA + token * 256 + c) = pack8(o); } }
            }
            const float* sp = P.in[5] + (size_t)layer * 32 * 15 * 512;
            for (int it = (int)gtid; it < 4 * (NTOK / 8) * 16; it += (int)nth) {
                const int cl = it & 15, q = it >> 4, g = q / (NTOK / 8), tb = q - g * (NTOK / 8);
                if (g == 0) pool_item<0>(UB, PB, sp, tb, cl); else if (g == 1) pool_item<1>(UB, PB, sp, tb, cl); else if (g == 2) pool_item<2>(UB, PB, sp, tb, cl); else pool_item<3>(UB, PB, sp, tb, cl);
            }
            xcd_barrier(xb);
            continue;
        }
        pg8::Gemm g; EpiAll E; E.ws = ws; E.out = out; E.layer = layer; E.ssi = 0; E.ssn = 0;
        const int Mg = (st == 0) ? NTOK : NTP;
        g.M = Mg;
        if (st == 0)      { g.A = XB;  g.Bt = Wt_in + (size_t)layer * NIN * DM; g.N = NIN; g.K = DM;  E.mode = 0; E.ssi = 2 * layer; }
        else if (st == 2) { g.A = OA;  g.Bt = Wt_pa + (size_t)layer * DM * 256; g.N = DM;  g.K = 256; E.mode = 1; }
        else if (st == 3) { g.A = PB;  g.Bt = Wt_pb + (size_t)layer * DM * 512; g.N = DM;  g.K = 512; E.mode = 2; }
        else if (st == 4) { g.A = MIX; g.Bt = Wt_o + (size_t)layer * DM * DM;   g.N = DM;  g.K = DM;  E.mode = 3; E.ssn = 2 * layer + 1; }
        else if (st == 5) { g.A = XB;  g.Bt = Wt_up + (size_t)layer * DFF * DM; g.N = DFF; g.K = DM;  E.mode = 4; E.ssi = 2 * layer + 1; }
        else              { g.A = HID; g.Bt = Wt_dn + (size_t)layer * DM * DFF; g.N = DM;  g.K = DFF; E.mode = 3; E.ssn = 2 * layer + 2; }
        S.init(Mg, g.N, G, bid);
        pg8::gemm_phase<EpiAll, pg8::StaticOrder, true, true>(lds, g, S, E);
        if (st != 0) skinny_gemm(lds, g.A + (size_t)NTP * g.K, g.Bt, g.N, g.K, E, G - 1 - bid, G);
        if (st != 2) xcd_barrier(xb);
    }
    {
        int tid_l = threadIdx.x; asm volatile("" : "+v"(tid_l));
        const int lane = tid_l & 63, gw = bid * 8 + (tid_l >> 6);
        unsigned char* wsl = ws; asm volatile("" : "+s"(wsl));
        float* X = (float*)(wsl + WS_X);
        const float* fn = P.in[16]; const float* ssf = (const float*)(wsl + WS_SS) + (size_t)8 * NTOK;
        for (int row = gw; row < NTOK; row += 2 * NGW) {
            const int r2 = row + NGW; const bool ok2 = r2 < NTOK; const int rb = ok2 ? r2 : row;
            const float s0 = ssf[row], s1 = ssf[rb];
            f32x4 va[4], vb[4], gn[4];
#pragma unroll
            for (int j = 0; j < 4; ++j) { const int c = 4 * lane + 256 * j; va[j] = *(const f32x4*)(X + (size_t)row * DM + c); vb[j] = *(const f32x4*)(X + (size_t)rb * DM + c); gn[j] = *(const f32x4*)(fn + c); }
            const float rs0 = rsqrtf(s0 * (1.0f / 1024.0f) + 1e-6f), rs1 = rsqrtf(s1 * (1.0f / 1024.0f) + 1e-6f);
#pragma unroll
            for (int j = 0; j < 4; ++j) { const int c = 4 * lane + 256 * j;
                *(f32x4*)(out + (size_t)row * DM + c) = (f32x4){va[j][0] * rs0 * gn[j][0], va[j][1] * rs0 * gn[j][1], va[j][2] * rs0 * gn[j][2], va[j][3] * rs0 * gn[j][3]};
                if (ok2) *(f32x4*)(out + (size_t)r2 * DM + c) = (f32x4){vb[j][0] * rs1 * gn[j][0], vb[j][1] * rs1 * gn[j][1], vb[j][2] * rs1 * gn[j][2], vb[j][3] * rs1 * gn[j][3]}; }
        }
    }
}

extern "C" void kernel_launch(void* const* d_in, const int* in_sizes, int n_in, void* d_out, int out_size, void* d_ws, size_t ws_size, hipStream_t stream) {
    static int grid_blocks = 0;
    if (grid_blocks == 0) {
        if (n_in != 17 || ws_size < WS_END) { fprintf(stderr, "kernel_launch: unexpected n_in %d / ws %zu (need %zu)\n", n_in, ws_size, (size_t)WS_END); grid_blocks = -1; return; }
        int dev = 0, cus = 0, per_cu = 0;
        (void)hipGetDevice(&dev);
        (void)hipDeviceGetAttribute(&cus, hipDeviceAttributeMultiprocessorCount, dev);
        if (hipFuncSetAttribute((const void*)fwd_megakernel, hipFuncAttributeMaxDynamicSharedMemorySize, LDS_BYTES) != hipSuccess) { fprintf(stderr, "kernel_launch: hipFuncSetAttribute failed\n"); grid_blocks = -1; return; }
        (void)hipOccupancyMaxActiveBlocksPerMultiprocessor(&per_cu, (const void*)fwd_megakernel, NTHREADS, LDS_BYTES);
        if (per_cu < 1) { fprintf(stderr, "kernel_launch: occupancy query says %d blocks/CU\n", per_cu); grid_blocks = -1; return; }
        grid_blocks = cus * 1;
    }
    if (grid_blocks < 0) return;
    if (hipMemsetAsync((unsigned char*)d_ws + WS_BAR, 0, 4096 * 4, stream) != hipSuccess) { fprintf(stderr, "kernel_launch: memset of barrier words failed\n"); return; }
    Params p{};
    for (int i = 0; i < 17; ++i) p.in[i] = (const float*)d_in[i];
    p.out = (float*)d_out; p.ws = (unsigned char*)d_ws;
    void* args[] = {&p};
    hipError_t e = hipLaunchCooperativeKernel((const void*)fwd_megakernel, dim3(grid_blocks), dim3(NTHREADS), args, LDS_BYTES, stream);
    if (e != hipSuccess) fprintf(stderr, "cooperative launch failed: %s (grid %d)\n", hipGetErrorString(e), grid_blocks);
}
```

```cpp
#include <hip/hip_runtime.h>
#include <hip/hip_cooperative_groups.h>
#include <cstdio>
#include <cstdint>
namespace cg = cooperative_groups;

namespace pg8 {
#define PG8_LAS __attribute__((address_space(3)))
typedef unsigned short bf16_t;
typedef short bf16x8 __attribute__((ext_vector_type(8)));
typedef float f32x4 __attribute__((ext_vector_type(4)));
typedef unsigned u32x4 __attribute__((ext_vector_type(4)));
typedef unsigned u32x2 __attribute__((ext_vector_type(2)));
constexpr int BM = 256, BK = 64, HALF = 128, HTB = HALF * BK * 2, STAGE_BYTES = 8 * HTB, NXCD = 8, WGM = 8;

__host__ __device__ __forceinline__ int lds_byte(int r, int c) { const int st = (r >> 4) * 2 + (c >> 5), rr = r & 15, cc = c & 31, ob = rr * 64 + cc * 2; return st * 1024 + (ob ^ (((ob >> 9) & 1) << 5)); }
__host__ __device__ __forceinline__ void stage_rc(int b, int& R, int& C) { const int st = b / 1024, sb = b % 1024, swz = sb ^ (((sb >> 9) & 1) << 5); R = (st >> 1) * 16 + swz / 64; C = (st & 1) * 32 + (swz % 64) / 2; }
__host__ __device__ __forceinline__ int perm32(int rho) { const int n = rho >> 4, i = rho & 15; return 8 * (i >> 2) + 4 * n + (i & 3); }

struct Unit { int pm, pn; };
struct Gemm { const bf16_t* A; const bf16_t* Bt; int M, N, K; };

struct StaticOrder {
    int nM, nN, nwg, G, c;
    __host__ __device__ void init(int M, int N, int G_, int c_) { nM = M / BM; nN = N / BM; nwg = nM * nN; G = G_; c = c_; }
    __host__ __device__ bool next(int i, Unit& u) const {
        const long L = (long)i * G + c; if (L >= nwg) return false;
        int wgid = (int)L; { const int q = nwg / NXCD, r = nwg % NXCD, xcd = wgid % NXCD, off = wgid / NXCD; wgid = (xcd < r ? xcd * (q + 1) : r * (q + 1) + (xcd - r) * q) + off; }
        const int nig = WGM * nN, gid = wgid / nig, fm = gid * WGM, gsz = (nM - fm) < WGM ? (nM - fm) : WGM;
        u.pm = fm + ((wgid % nig) % gsz); u.pn = (wgid % nig) / gsz; return true;
    }
    __device__ __forceinline__ void a_ready(const Unit&) const {}
    __device__ __forceinline__ void done(const Unit&) const {}
};

__device__ __forceinline__ unsigned cvt_pk_bf16(float lo, float hi) { unsigned r; asm volatile("v_cvt_pk_bf16_f32 %0, %1, %2" : "=v"(r) : "v"(lo), "v"(hi)); return r; }

template <class Epi, class Sched, bool ALIGN_EPI = false, bool SP2 = false>
__device__ __forceinline__ void gemm_phase(PG8_LAS unsigned char* lds, const Gemm g, const Sched& S, const Epi& E) {
    int tid = threadIdx.x; asm volatile("" : "+v"(tid));
    const int wid = __builtin_amdgcn_readfirstlane(tid >> 6), lane = tid & 63, wr = wid >> 2, wc = wid & 3, fr = lane & 15, fq = lane >> 4;
    const int K = g.K, nt = K / BK;
    unsigned voffA[2], voffB[2];
#pragma unroll
    for (int i = 0; i < 2; ++i) { int R, C; stage_rc(tid * 16 + i * 8192, R, C); const int Rb = Epi::PERM ? ((R & ~31) + perm32(R & 31)) : R;
        voffA[i] = (unsigned)(R * K + C) * 2u; voffB[i] = (unsigned)(Rb * K + C) * 2u; }
    const size_t kstep = (size_t)(BK * 2);
    const size_t hstep = (size_t)HALF * K * 2;
    const size_t tstep = 2 * hstep;
    const unsigned ldsw = (unsigned)wid * 1024u;
    const int aoff = lds_byte(wr * 64 + fr, fq * 8), boff = lds_byte(wc * 32 + fr, fq * 8);
#define PG8_SA(b, h) (((b) * 2 + (h)) * HTB)
#define PG8_SB(b, h) ((4 + (b) * 2 + (h)) * HTB)
#define PG8_STAGE(bufoff, gbase, voff) do { _Pragma("unroll") for (int _i = 0; _i < 2; ++_i) \
        __builtin_amdgcn_global_load_lds((const unsigned*)((const char*)(gbase) + (voff)[_i]), (PG8_LAS unsigned*)(lds + (bufoff) + ldsw + _i * 8192), 16, 0, 0); } while (0)
#define PG8_LDA(dst, b, h) do { _Pragma("unroll") for (int m = 0; m < 4; ++m) _Pragma("unroll") for (int k = 0; k < 2; ++k) dst[m][k] = *(const PG8_LAS bf16x8*)(lds + PG8_SA(b, h) + aoff + m * 2048 + k * 1024); } while (0)
#define PG8_LDB(dst, b, h) do { _Pragma("unroll") for (int n = 0; n < 2; ++n) _Pragma("unroll") for (int k = 0; k < 2; ++k) dst[n][k] = *(const PG8_LAS bf16x8*)(lds + PG8_SB(b, h) + boff + n * 2048 + k * 1024); } while (0)
#define PG8_MMA(ai, bj, At, Bt) do { __builtin_amdgcn_s_setprio(1); _Pragma("unroll") for (int m = 0; m < 4; ++m) _Pragma("unroll") for (int n = 0; n < 2; ++n) _Pragma("unroll") for (int k = 0; k < 2; ++k) \
        acc[ai][bj][m][n] = __builtin_amdgcn_mfma_f32_16x16x32_bf16(Bt[n][k], At[m][k], acc[ai][bj][m][n], 0, 0, 0); __builtin_amdgcn_s_setprio(0); } while (0)
#define PG8_WAIT_V(n) asm volatile("s_waitcnt vmcnt(" #n ")" ::: "memory")
#define PG8_WAIT_L(n) asm volatile("s_waitcnt lgkmcnt(" #n ")" ::: "memory")
#define PG8_BAR __builtin_amdgcn_s_barrier()
#define PG8_SCHED __builtin_amdgcn_sched_barrier(0)
    Unit cur, nxt; int ui = 0;
    if (!S.next(0, cur)) return;
    f32x4 acc[2][2][4][2];
#pragma unroll
    for (int a = 0; a < 2; ++a)
#pragma unroll
        for (int b = 0; b < 2; ++b)
#pragma unroll
            for (int m = 0; m < 4; ++m)
#pragma unroll
                for (int n = 0; n < 2; ++n) acc[a][b][m][n] = (f32x4){0.f, 0.f, 0.f, 0.f};
    bf16x8 At[4][2], B0[2][2], B1[2][2];
    const char* cA = (const char*)g.A + (size_t)cur.pm * tstep; const char* cB = (const char*)g.Bt + (size_t)cur.pn * tstep;
    S.a_ready(cur);
    if constexpr (SP2) {
        PG8_STAGE(PG8_SB(0, 0), cB, voffB); PG8_STAGE(PG8_SB(0, 1), cB + hstep, voffB); PG8_STAGE(PG8_SA(0, 0), cA, voffA); PG8_STAGE(PG8_SA(0, 1), cA + hstep, voffA);
        if (wr == 1) PG8_BAR;
        PG8_WAIT_V(2); PG8_BAR;
        PG8_STAGE(PG8_SB(1, 0), cB + kstep, voffB); PG8_STAGE(PG8_SA(1, 0), cA + kstep, voffA); PG8_STAGE(PG8_SB(1, 1), cB + hstep + kstep, voffB);
        PG8_WAIT_V(6); PG8_BAR;
    } else {
        PG8_STAGE(PG8_SB(0, 0), cB, voffB); PG8_STAGE(PG8_SA(0, 0), cA, voffA); PG8_STAGE(PG8_SB(0, 1), cB + hstep, voffB); PG8_STAGE(PG8_SA(0, 1), cA + hstep, voffA);
        if (wr == 1) PG8_BAR;
        PG8_WAIT_V(4); PG8_BAR;
        PG8_STAGE(PG8_SB(1, 0), cB + kstep, voffB); PG8_STAGE(PG8_SA(1, 0), cA + kstep, voffA); PG8_STAGE(PG8_SB(1, 1), cB + hstep + kstep, voffB);
        PG8_WAIT_V(6); PG8_BAR;
    }
    for (;;) {
        const bool has_next = S.next(ui + 1, nxt);
        const char* nA = has_next ? (const char*)g.A + (size_t)nxt.pm * tstep : cA; const char* nB = has_next ? (const char*)g.Bt + (size_t)nxt.pn * tstep : cB;
        for (int t = 0; t < nt; t += 2) {
            const bool last = (t == nt - 2);
            const char* a1 = cA + (size_t)(t + 1) * kstep;
            const char* a2 = last ? nA : cA + (size_t)(t + 2) * kstep; const char* b2 = last ? nB : cB + (size_t)(t + 2) * kstep;
            const char* a3 = a2 + kstep; const char* b3 = b2 + kstep;
            if (last && has_next) S.a_ready(nxt);
            if constexpr (SP2) {
            PG8_LDB(B0, 0, 0); PG8_LDB(B1, 0, 1); PG8_SCHED; PG8_LDA(At, 0, 0); PG8_STAGE(PG8_SA(1, 1), a1 + hstep, voffA);
            PG8_WAIT_V(8); PG8_WAIT_L(0); PG8_BAR; PG8_MMA(0, 0, At, B0); PG8_MMA(0, 1, At, B1); PG8_BAR; PG8_SCHED;
            PG8_LDA(At, 0, 1); PG8_STAGE(PG8_SB(0, 0), b2, voffB); PG8_STAGE(PG8_SB(0, 1), b2 + hstep, voffB); PG8_STAGE(PG8_SA(0, 0), a2, voffA);
            PG8_WAIT_V(8); PG8_WAIT_L(0); PG8_BAR; PG8_MMA(1, 0, At, B0); PG8_MMA(1, 1, At, B1); PG8_BAR; PG8_SCHED;
            PG8_LDB(B0, 1, 0); PG8_LDB(B1, 1, 1); PG8_SCHED; PG8_LDA(At, 1, 0); PG8_STAGE(PG8_SA(0, 1), a2 + hstep, voffA);
            PG8_WAIT_V(8); PG8_WAIT_L(0); PG8_BAR; PG8_MMA(0, 0, At, B0); PG8_MMA(0, 1, At, B1); PG8_BAR; PG8_SCHED;
            PG8_LDA(At, 1, 1); PG8_STAGE(PG8_SB(1, 0), b3, voffB); PG8_STAGE(PG8_SB(1, 1), b3 + hstep, voffB); PG8_STAGE(PG8_SA(1, 0), a3, voffA);
            PG8_WAIT_V(8); PG8_WAIT_L(0); PG8_BAR; PG8_MMA(1, 0, At, B0); PG8_MMA(1, 1, At, B1); PG8_BAR; PG8_SCHED;
            } else {
            PG8_LDB(B0, 0, 0); PG8_SCHED; PG8_LDA(At, 0, 0); PG8_STAGE(PG8_SA(1, 1), a1 + hstep, voffA);
            PG8_WAIT_L(8); PG8_BAR; PG8_WAIT_L(0); PG8_MMA(0, 0, At, B0); PG8_BAR; PG8_SCHED;
            PG8_LDB(B1, 0, 1); PG8_STAGE(PG8_SB(0, 0), b2, voffB);
            PG8_BAR; PG8_WAIT_L(0); PG8_MMA(0, 1, At, B1); PG8_BAR;
            PG8_LDA(At, 0, 1); PG8_STAGE(PG8_SA(0, 0), a2, voffA);
            PG8_BAR; PG8_WAIT_L(0); PG8_MMA(1, 0, At, B0); PG8_BAR; PG8_SCHED;
            PG8_STAGE(PG8_SB(0, 1), b2 + hstep, voffB);
            PG8_WAIT_V(6); PG8_BAR; PG8_MMA(1, 1, At, B1); PG8_BAR;
            PG8_LDB(B0, 1, 0); PG8_SCHED; PG8_LDA(At, 1, 0); PG8_STAGE(PG8_SA(0, 1), a2 + hstep, voffA);
            PG8_WAIT_L(8); PG8_BAR; PG8_WAIT_L(0); PG8_MMA(0, 0, At, B0); PG8_BAR; PG8_SCHED;
            PG8_LDB(B1, 1, 1); PG8_STAGE(PG8_SB(1, 0), b3, voffB);
            PG8_BAR; PG8_WAIT_L(0); PG8_MMA(0, 1, At, B1); PG8_BAR;
            PG8_LDA(At, 1, 1); PG8_STAGE(PG8_SA(1, 0), a3, voffA);
            PG8_BAR; PG8_WAIT_L(0); PG8_MMA(1, 0, At, B0); PG8_BAR; PG8_SCHED;
            PG8_STAGE(PG8_SB(1, 1), b3 + hstep, voffB);
            PG8_WAIT_V(6); PG8_BAR; PG8_MMA(1, 1, At, B1); PG8_BAR;
            }
        }
        if constexpr (ALIGN_EPI) { if (wr == 0) PG8_BAR; }
        E(acc, cur, wr, wc, fr, fq); S.done(cur);
        if (!has_next) break;
#pragma unroll
        for (int a = 0; a < 2; ++a)
#pragma unroll
            for (int b = 0; b < 2; ++b)
#pragma unroll
                for (int m = 0; m < 4; ++m)
#pragma unroll
                    for (int n = 0; n < 2; ++n) acc[a][b][m][n] = (f32x4){0.f, 0.f, 0.f, 0.f};
        cur = nxt; cA = nA; cB = nB; ++ui;
        if constexpr (ALIGN_EPI) { if (wr == 1) PG8_BAR; }
    }
    PG8_WAIT_V(0);
    if constexpr (!ALIGN_EPI) { if (wr == 0) PG8_BAR; }
    PG8_BAR;
#undef PG8_SA
#undef PG8_SB
#undef PG8_STAGE
#undef PG8_LDA
#undef PG8_LDB
#undef PG8_MMA
#undef PG8_WAIT_V
#undef PG8_WAIT_L
#undef PG8_BAR
#undef PG8_SCHED
}
}

using pg8::bf16_t; using pg8::f32x4; using pg8::u32x4; using pg8::u32x2; using pg8::Unit; using pg8::cvt_pk_bf16;
#define LAS __attribute__((address_space(3)))

constexpr int DM = 1024, TP = 4096, NTP = 16384, NTS = 256, NTOK = 16640, DEPTH = 4, NIN = 4864, DFF = 4096;
constexpr int NTHREADS = 512, LDS_BYTES = 147456;
constexpr size_t O_YP = 0, O_YS = 16777216, O_KVP0 = 17039360, O_KVP1 = 18087936, O_KVP2 = 22282240, O_POOLP = 39059456,
                 O_KVS0 = 39182336, O_KVS1 = 47570944, O_KVS2 = 81125376, O_POOLS = 215343104;
constexpr size_t WS_WIN = 0;
constexpr size_t WS_WPA = WS_WIN + (size_t)DEPTH * NIN * DM * 2;
constexpr size_t WS_WPB = WS_WPA + (size_t)DEPTH * DM * 256 * 2;
constexpr size_t WS_WO  = WS_WPB + (size_t)DEPTH * DM * 512 * 2;
constexpr size_t WS_WUP = WS_WO  + (size_t)DEPTH * DM * DM * 2;
constexpr size_t WS_WDN = WS_WUP + (size_t)DEPTH * DFF * DM * 2;
constexpr size_t WS_X   = WS_WDN + (size_t)DEPTH * DM * DFF * 2;
constexpr size_t WS_XB  = WS_X   + (size_t)NTOK * DM * 4;
constexpr size_t WS_QKV = WS_XB  + (size_t)NTOK * DM * 2;
constexpr size_t WS_U   = WS_QKV + (size_t)NTOK * 2304 * 2;
constexpr size_t WS_G   = WS_U   + (size_t)NTOK * 512 * 2;
constexpr size_t WS_OA  = WS_G   + (size_t)NTOK * 2048 * 2;
constexpr size_t WS_P   = WS_OA  + (size_t)NTOK * 256 * 2;
constexpr size_t WS_TMP = WS_P   + (size_t)NTOK * 512 * 2;
constexpr size_t WS_MIX = WS_TMP + (size_t)NTOK * DM * 4;
constexpr size_t WS_H   = WS_MIX + (size_t)NTOK * DM * 2;
constexpr size_t WS_SS  = WS_H   + (size_t)NTOK * DFF * 2;
constexpr size_t WS_ROPE = WS_SS + (size_t)9 * NTOK * 4;
constexpr size_t WS_BAR = WS_ROPE + (size_t)4104 * 16 * 4;
constexpr size_t WS_END = WS_BAR + (size_t)4096 * 4;

struct Params { const float* in[17]; float* out; unsigned char* ws; };

__device__ __forceinline__ void unpack8(const u32x4 w, float (&f)[8]) {
    f[0] = __uint_as_float(w.x << 16); f[1] = __uint_as_float(w.x & 0xffff0000u);
    f[2] = __uint_as_float(w.y << 16); f[3] = __uint_as_float(w.y & 0xffff0000u);
    f[4] = __uint_as_float(w.z << 16); f[5] = __uint_as_float(w.z & 0xffff0000u);
    f[6] = __uint_as_float(w.w << 16); f[7] = __uint_as_float(w.w & 0xffff0000u);
}
__device__ __forceinline__ u32x4 pack8(const float (&f)[8]) {
    u32x4 w; w.x = cvt_pk_bf16(f[0], f[1]); w.y = cvt_pk_bf16(f[2], f[3]); w.z = cvt_pk_bf16(f[4], f[5]); w.w = cvt_pk_bf16(f[6], f[7]); return w;
}
__device__ __forceinline__ float sigmoidf_(float x) { return __builtin_amdgcn_rcpf(1.0f + __builtin_amdgcn_exp2f(x * -1.44269504089f)); }

struct EpiAll {
    static constexpr bool PERM = true, AFTER_DRAIN = false;
    int mode, layer, ssi, ssn; unsigned char* ws; float* out;

    struct Pre { u32x4 g; f32x4 a, b; float rs; };

    template <int MODE> __device__ __forceinline__ Pre pre(unsigned char* ws, int row, int c) const {
        Pre p;
        if constexpr (MODE == 0 || MODE == 4) p.rs = ((const float*)(ws + WS_SS) + (size_t)ssi * NTOK)[row];
        if constexpr (MODE == 1) p.g = *(const u32x4*)((const bf16_t*)(ws + WS_G) + (size_t)row * 2048 + c);
        if constexpr (MODE == 2) { p.g = *(const u32x4*)((const bf16_t*)(ws + WS_G) + (size_t)row * 2048 + 1024 + c);
            const float* tp = (const float*)(ws + WS_TMP) + (size_t)row * DM + c; p.a = *(const f32x4*)tp; p.b = *(const f32x4*)(tp + 4); }
        if constexpr (MODE == 3) { const float* xp = (const float*)(ws + WS_X) + (size_t)row * DM + c; p.a = *(const f32x4*)xp; p.b = *(const f32x4*)(xp + 4); }
        return p;
    }
    __device__ __forceinline__ void fin_proj(unsigned char* ws, int row, int c32, int fq, float (&v)[8], const Pre& p) const {
        const int pn = c32 >> 8, cl = (c32 & 255) + 8 * fq;
        const float rs = __builtin_amdgcn_rsqf(p.rs * (1.0f / 1024.0f) + 1e-6f);
        const bool samp = row >= NTP;
        const int b = samp ? ((row - NTP) >> 3) : (row >> 12);
        const int t = samp ? (row & 7) : (row & 4095);
#pragma unroll
        for (int i = 0; i < 8; ++i) v[i] *= rs;
        if (pn < 6 && ((c32 >> 5) & 1) == 0) {
            float pv[8];
#pragma unroll
            for (int i = 0; i < 8; ++i) pv[i] = __shfl_xor(v[i], 16);
            if (fq < 2) {
                const int pi = samp ? (4096 + t) : t;
                const f32x4* rp = (const f32x4*)((const float*)(ws + WS_ROPE) + (size_t)pi * 16);
                const f32x4 c0 = rp[0], c1 = rp[1], s0 = rp[2], s1 = rp[3];
                const float sg = (fq == 0) ? -1.0f : 1.0f;
#pragma unroll
                for (int i = 0; i < 4; ++i) { v[i] = v[i] * c0[i] + sg * pv[i] * s0[i]; v[4 + i] = v[4 + i] * c1[i] + sg * pv[4 + i] * s1[i]; }
            }
        }
        if (pn >= 11) {
#pragma unroll
            for (int i = 0; i < 8; ++i) v[i] = sigmoidf_(v[i]);
        }
        bf16_t* dst; int ld, cbase;
        if (pn < 9) { dst = (bf16_t*)(ws + WS_QKV); ld = 2304; cbase = pn * 256; }
        else if (pn < 11) { dst = (bf16_t*)(ws + WS_U); ld = 512; cbase = (pn - 9) * 256; }
        else { dst = (bf16_t*)(ws + WS_G); ld = 2048; cbase = (pn - 11) * 256; }
        *(u32x4*)(dst + (size_t)row * ld + cbase + cl) = pack8(v);
        if (pn >= 3 && pn < 9) {
            const int kvi = pn - 3; const int g = (kvi >= 3) ? kvi - 3 : kvi; const int kv = (kvi >= 3) ? 1 : 0;
            const int W = 128 << (2 * g);
            const size_t okp = (g == 0) ? O_KVP0 : (g == 1 ? O_KVP1 : O_KVP2);
            const size_t oks = (g == 0) ? O_KVS0 : (g == 1 ? O_KVS1 : O_KVS2);
            float* op = nullptr;
            if (samp) op = out + oks + ((size_t)((layer * 32 + b) * W + (W - 8 + t)) * 2 + kv) * 256 + cl;
            else if (t >= TP - W) op = out + okp + ((size_t)((layer * 4 + b) * W + (t - (TP - W))) * 2 + kv) * 256 + cl;
            if (op) { *(f32x4*)op = (f32x4){v[0], v[1], v[2], v[3]}; *(f32x4*)(op + 4) = (f32x4){v[4], v[5], v[6], v[7]}; }
        } else if (pn >= 9 && pn < 11) {
            float* op = nullptr; const int c = cbase + cl;
            if (samp) op = out + O_POOLS + (size_t)((layer * 32 + b) * 15 + 7 + t) * 512 + c;
            else if (t >= TP - 15) op = out + O_POOLP + (size_t)((layer * 4 + b) * 15 + (t - (TP - 15))) * 512 + c;
            if (op) { *(f32x4*)op = (f32x4){v[0], v[1], v[2], v[3]}; *(f32x4*)(op + 4) = (f32x4){v[4], v[5], v[6], v[7]}; }
        }
    }
    template <int MODE> __device__ __forceinline__ void fin(unsigned char* ws, int row, int c32, int fq, float (&v)[8], const Pre& p) const {
        const int c = c32 + 8 * fq;
        if constexpr (MODE == 0) fin_proj(ws, row, c32, fq, v, p);
        if constexpr (MODE == 1) {
            float gg[8]; unpack8(p.g, gg);
            float* tp = (float*)(ws + WS_TMP) + (size_t)row * DM + c;
            *(f32x4*)tp = (f32x4){gg[0] * v[0], gg[1] * v[1], gg[2] * v[2], gg[3] * v[3]};
            *(f32x4*)(tp + 4) = (f32x4){gg[4] * v[4], gg[5] * v[5], gg[6] * v[6], gg[7] * v[7]};
        }
        if constexpr (MODE == 2) {
            float gg[8]; unpack8(p.g, gg);
#pragma unroll
            for (int i = 0; i < 4; ++i) { v[i] = p.a[i] + gg[i] * v[i]; v[4 + i] = p.b[i] + gg[4 + i] * v[4 + i]; }
            *(u32x4*)((bf16_t*)(ws + WS_MIX) + (size_t)row * DM + c) = pack8(v);
        }
        if constexpr (MODE == 3) {
            float* xp = (float*)(ws + WS_X) + (size_t)row * DM + c;
            float sq = 0.f;
#pragma unroll
            for (int i = 0; i < 4; ++i) { v[i] += p.a[i]; v[4 + i] += p.b[i]; }
#pragma unroll
            for (int i = 0; i < 8; ++i) sq += v[i] * v[i];
            *(f32x4*)xp = (f32x4){v[0], v[1], v[2], v[3]}; *(f32x4*)(xp + 4) = (f32x4){v[4], v[5], v[6], v[7]};
            *(u32x4*)((bf16_t*)(ws + WS_XB) + (size_t)row * DM + c) = pack8(v);
            sq += __shfl_xor(sq, 16); sq += __shfl_xor(sq, 32);
            if (fq == 0) atomicAdd((float*)(ws + WS_SS) + (size_t)ssn * NTOK + row, sq);
        }
        if constexpr (MODE == 4) {
            const float rs = __builtin_amdgcn_rsqf(p.rs * (1.0f / 1024.0f) + 1e-6f);
#pragma unroll
            for (int i = 0; i < 8; ++i) { const float a = fmaxf(v[i] * rs, 0.f); v[i] = a * a; }
            *(u32x4*)((bf16_t*)(ws + WS_H) + (size_t)row * DFF + c) = pack8(v);
        }
    }
    __device__ __forceinline__ void chunk(unsigned char* ws, int row, int c32, int fq, float (&v)[8]) const {
        const int c = c32 + 8 * fq;
        switch (mode) {
            case 0: { const Pre p = pre<0>(ws, row, c); fin<0>(ws, row, c32, fq, v, p); } break;
            case 1: { const Pre p = pre<1>(ws, row, c); fin<1>(ws, row, c32, fq, v, p); } break;
            case 2: { const Pre p = pre<2>(ws, row, c); fin<2>(ws, row, c32, fq, v, p); } break;
            case 3: { const Pre p = pre<3>(ws, row, c); fin<3>(ws, row, c32, fq, v, p); } break;
            default: { const Pre p = pre<4>(ws, row, c); fin<4>(ws, row, c32, fq, v, p); } break;
        }
    }
    template <int MODE> __device__ __forceinline__ void tile(unsigned char* ws, const f32x4 (&acc)[2][2][4][2], const Unit& u, int wr, int wc, int fr, int fq) const {
        constexpr int MB = (MODE == 2 || MODE == 3) ? 2 : 4;
#pragma unroll
        for (int ai = 0; ai < 2; ++ai)
#pragma unroll
            for (int m0 = 0; m0 < 4; m0 += MB) {
                Pre p[MB][2];
#pragma unroll
                for (int mm = 0; mm < MB; ++mm)
#pragma unroll
                    for (int bj = 0; bj < 2; ++bj) p[mm][bj] = pre<MODE>(ws, u.pm * 256 + ai * 128 + wr * 64 + (m0 + mm) * 16 + fr, u.pn * 256 + bj * 128 + wc * 32 + 8 * fq);
#pragma unroll
                for (int mm = 0; mm < MB; ++mm)
#pragma unroll
                    for (int bj = 0; bj < 2; ++bj) {
                        float v[8];
#pragma unroll
                        for (int i = 0; i < 4; ++i) { v[i] = acc[ai][bj][m0 + mm][0][i]; v[4 + i] = acc[ai][bj][m0 + mm][1][i]; }
                        fin<MODE>(ws, u.pm * 256 + ai * 128 + wr * 64 + (m0 + mm) * 16 + fr, u.pn * 256 + bj * 128 + wc * 32, fq, v, p[mm][bj]);
                    }
                asm volatile("" ::: "memory");
            }
    }
    __device__ __forceinline__ void operator()(const f32x4 (&acc)[2][2][4][2], const Unit& u, int wr, int wc, int fr, int fq) const {
        asm volatile("" : "+v"(fr), "+v"(fq));
        unsigned char* ws = this->ws; asm volatile("" : "+s"(ws));
        switch (mode) {
            case 0: tile<0>(ws, acc, u, wr, wc, fr, fq); break;
            case 1: tile<1>(ws, acc, u, wr, wc, fr, fq); break;
            case 2: tile<2>(ws, acc, u, wr, wc, fr, fq); break;
            case 3: tile<3>(ws, acc, u, wr, wc, fr, fq); break;
            default: tile<4>(ws, acc, u, wr, wc, fr, fq); break;
        }
    }
};

__device__ __forceinline__ void skinny_gemm(LAS unsigned char* lds, const bf16_t* __restrict__ A, const bf16_t* __restrict__ Bt, int N, int K, const EpiAll& E, int first, int G) {
    using pg8::bf16x8;
    int tid = threadIdx.x; asm volatile("" : "+v"(tid));
    const int lane = tid & 63, w = __builtin_amdgcn_readfirstlane(tid >> 6), kg = lane >> 4, qn = lane & 15;
    const int nh = (N == 1024) ? 1 : 2, ksplit = 8 / nh;
    const int half = w % nh, kq = w / nh, Kq = K / ksplit, nsteps = Kq >> 5;
    unsigned char* ws = E.ws; asm volatile("" : "+s"(ws));
    LAS float* red = (LAS float*)lds;
    const int RB = 8 / nh, units = RB * (N >> 5);
#pragma unroll 1
    for (int u = first; u < units; u += G) {
        const int rb = u % RB, c32 = (u / RB) << 5;
        const int row0 = rb * 32 * nh + half * 32;
        const bf16_t* ap = A + (size_t)(row0 + qn) * K + kq * Kq + kg * 8;
        const bf16_t* bp = Bt + (size_t)(c32 + 8 * (qn >> 2) + (qn & 3)) * K + kq * Kq + kg * 8;
        f32x4 acc[2][2];
#pragma unroll
        for (int a = 0; a < 2; ++a)
#pragma unroll
            for (int b = 0; b < 2; ++b) acc[a][b] = (f32x4){0.f, 0.f, 0.f, 0.f};
#pragma unroll 8
        for (int ks = 0; ks < nsteps; ++ks) {
            const bf16x8 x0 = *(const bf16x8*)(ap + ks * 32), x1 = *(const bf16x8*)(ap + (size_t)16 * K + ks * 32);
            const bf16x8 w0 = *(const bf16x8*)(bp + ks * 32), w1 = *(const bf16x8*)(bp + (size_t)4 * K + ks * 32);
            acc[0][0] = __builtin_amdgcn_mfma_f32_16x16x32_bf16(w0, x0, acc[0][0], 0, 0, 0);
            acc[0][1] = __builtin_amdgcn_mfma_f32_16x16x32_bf16(w1, x0, acc[0][1], 0, 0, 0);
            acc[1][0] = __builtin_amdgcn_mfma_f32_16x16x32_bf16(w0, x1, acc[1][0], 0, 0, 0);
            acc[1][1] = __builtin_amdgcn_mfma_f32_16x16x32_bf16(w1, x1, acc[1][1], 0, 0, 0);
        }
        __syncthreads();
        if (kq != 0) {
#pragma unroll
            for (int a = 0; a < 2; ++a)
#pragma unroll
                for (int b = 0; b < 2; ++b)
#pragma unroll
                    for (int i = 0; i < 4; ++i) red[(w * 16 + a * 8 + b * 4 + i) * 64 + lane] = acc[a][b][i];
        }
        __syncthreads();
        if (kq == 0) {
#pragma unroll 1
            for (int q = 1; q < ksplit; ++q)
#pragma unroll
                for (int a = 0; a < 2; ++a)
#pragma unroll
                    for (int b = 0; b < 2; ++b)
#pragma unroll
                        for (int i = 0; i < 4; ++i) acc[a][b][i] += red[((w + nh * q) * 16 + a * 8 + b * 4 + i) * 64 + lane];
#pragma unroll
            for (int a = 0; a < 2; ++a) {
                float v[8];
#pragma unroll
                for (int i = 0; i < 4; ++i) { v[i] = acc[a][0][i]; v[4 + i] = acc[a][1][i]; }
                E.chunk(ws, NTP + row0 + a * 16 + qn, c32, kg, v);
            }
        }
    }
    __syncthreads();
}

__device__ __forceinline__ void lds_wait() { asm volatile("s_waitcnt lgkmcnt(0)" ::: "memory"); }
__device__ __forceinline__ void transpose_item(const float* __restrict__ W, const float* __restrict__ gsc, int K, int N, bf16_t* __restrict__ WT, LAS float* scr, int item, int lane) {
    const int nblk = N / 64, kb = item / nblk, nb = item % nblk, k0 = 64 * kb, n0 = 64 * nb;
    f32x4 v[16];
#pragma unroll
    for (int i = 0; i < 16; ++i) v[i] = *(const f32x4*)(W + (size_t)(k0 + 4 * i + (lane >> 4)) * N + n0 + 4 * (lane & 15));
#pragma unroll
    for (int i = 0; i < 16; ++i) { const int kk = 4 * i + (lane >> 4); const float sc = gsc ? gsc[k0 + kk] : 1.0f; LAS float* d = scr + kk * 65 + 4 * (lane & 15);
        d[0] = v[i][0] * sc; d[1] = v[i][1] * sc; d[2] = v[i][2] * sc; d[3] = v[i][3] * sc; }
    lds_wait();
    const int c = lane & 7;
#pragma unroll
    for (int j = 0; j < 8; ++j) { const int n = (lane >> 3) + 8 * j; const LAS float* sp = scr + (8 * c) * 65 + n;
        u32x4 o; o.x = cvt_pk_bf16(sp[0 * 65], sp[1 * 65]); o.y = cvt_pk_bf16(sp[2 * 65], sp[3 * 65]); o.z = cvt_pk_bf16(sp[4 * 65], sp[5 * 65]); o.w = cvt_pk_bf16(sp[6 * 65], sp[7 * 65]);
        *(u32x4*)(WT + (size_t)(n0 + n) * K + k0 + 8 * c) = o; }
    lds_wait();
}

template <int L>
__device__ __forceinline__ void copy_shift(const float* __restrict__ src, float* __restrict__ dst, int layer, size_t gtid, size_t nth) {
    constexpr size_t per = (size_t)(L - 8) * 128;
    constexpr size_t total = (size_t)32 * per;
    constexpr int U = 8;
    const f32x4* s4 = (const f32x4*)src + (size_t)layer * 32 * L * 128; f32x4* d4 = (f32x4*)dst + (size_t)layer * 32 * L * 128;
    for (size_t i = gtid; i < total; i += nth * U) {
        f32x4 v[U];
#pragma unroll
        for (int u = 0; u < U; ++u) { const size_t idx = i + u * nth; const size_t ii = idx < total ? idx : 0; const size_t lb = ii / per, r = ii - lb * per;
            v[u] = __builtin_nontemporal_load(s4 + lb * (size_t)L * 128 + r + 8 * 128); }
#pragma unroll
        for (int u = 0; u < U; ++u) { const size_t idx = i + u * nth; if (idx < total) { const size_t lb = idx / per, r = idx - lb * per; __builtin_nontemporal_store(v[u], d4 + lb * (size_t)L * 128 + r); } }
    }
}

#define ATT_DOT(S, Q, KF) do { float _s = 0.f; _Pragma("unroll") for (int _i = 0; _i < 8; ++_i) _s += Q[_i] * KF[_i]; \
    _s += __shfl_xor(_s, 1); _s += __shfl_xor(_s, 2); _s += __shfl_xor(_s, 4); S = _s; } while (0)

__device__ __forceinline__ void attn_finish(float m, float l, float (&o)[8], bf16_t* dstp, int kg) {
    float M = m; M = fmaxf(M, __shfl_xor(M, 8)); M = fmaxf(M, __shfl_xor(M, 16)); M = fmaxf(M, __shfl_xor(M, 32));
    const float f = __expf(m - M); l *= f;
#pragma unroll
    for (int i = 0; i < 8; ++i) o[i] *= f;
    l += __shfl_xor(l, 8); l += __shfl_xor(l, 16); l += __shfl_xor(l, 32);
#pragma unroll
    for (int i = 0; i < 8; ++i) { o[i] += __shfl_xor(o[i], 8); o[i] += __shfl_xor(o[i], 16); o[i] += __shfl_xor(o[i], 32); }
    const float inv = 1.0f / l;
#pragma unroll
    for (int i = 0; i < 8; ++i) o[i] *= inv;
    if (kg == 0) *(u32x4*)dstp = pack8(o);
}

__device__ __forceinline__ void attn_prompt_item(const bf16_t* __restrict__ qkv, bf16_t* __restrict__ oa, int token, int h, int lane) {
    const int kg = lane >> 3, dl = lane & 7;
    const int b = token >> 12, t = token & 4095;
    const bf16_t* qrow = qkv + (size_t)token * 2304 + h * 64 + dl * 8;
    const bf16_t* kbase = qkv + (size_t)(b << 12) * 2304 + 768 + h * 64 + dl * 8;
    float m = -1e30f, l = 0.f; float o[8];
#pragma unroll
    for (int i = 0; i < 8; ++i) o[i] = 0.f;
#pragma unroll 1
    for (int g = 0; g < 3; ++g) {
        const int d = 1 << (2 * g);
        float q[8]; unpack8(*(const u32x4*)(qrow + g * 256), q);
#pragma unroll
        for (int i = 0; i < 8; ++i) q[i] *= 0.125f;
        const bf16_t* kb = kbase + g * 256;
#pragma unroll 1
        for (int it = 0; it < 16; it += 4) {
            u32x4 kr[4], vr[4]; bool val[4];
#pragma unroll
            for (int u = 0; u < 4; ++u) { const int j = (it + u) * 8 + kg; const int pos = t - j * d; val[u] = pos >= 0; const bf16_t* r = kb + (size_t)(pos < 0 ? 0 : pos) * 2304;
                kr[u] = *(const u32x4*)r; vr[u] = *(const u32x4*)(r + 768); }
            float s[4];
#pragma unroll
            for (int u = 0; u < 4; ++u) { float kf[8]; unpack8(kr[u], kf); ATT_DOT(s[u], q, kf); if (!val[u]) s[u] = -1e30f; }
            const float mb = fmaxf(fmaxf(m, fmaxf(s[0], s[1])), fmaxf(s[2], s[3]));
            const float corr = __expf(m - mb);
            l *= corr;
#pragma unroll
            for (int i = 0; i < 8; ++i) o[i] *= corr;
#pragma unroll
            for (int u = 0; u < 4; ++u) { const float p = val[u] ? __expf(s[u] - mb) : 0.f; l += p; float vf[8]; unpack8(vr[u], vf);
#pragma unroll
                for (int i = 0; i < 8; ++i) o[i] += p * vf[i]; }
            m = mb;
        }
    }
    {
        const int g = kg < 2 ? kg : 2; const int d = 1 << (2 * g);
        const int pos = t - 128 * d; const bool val = (kg < 3) && (pos >= 0);
        float q[8]; unpack8(*(const u32x4*)(qrow + g * 256), q);
        const bf16_t* r = kbase + g * 256 + (size_t)(pos < 0 ? 0 : pos) * 2304;
        float kf[8], vf[8]; unpack8(*(const u32x4*)r, kf); unpack8(*(const u32x4*)(r + 768), vf);
        float s; ATT_DOT(s, q, kf); s *= 0.125f;
        if (!val) s = -1e30f;
        const float mb = fmaxf(m, s); const float corr = __expf(m - mb); const float p = val ? __expf(s - mb) : 0.f;
        l = l * corr + p;
#pragma unroll
        for (int i = 0; i < 8; ++i) o[i] = o[i] * corr + p * vf[i];
        m = mb;
    }
    attn_finish(m, l, o, oa + (size_t)token * 256 + h * 64 + dl * 8, kg);
}

__device__ __forceinline__ void sample_kv(const bf16_t* __restrict__ newb, const float* __restrict__ cb, int W, int idx, float (&kf)[8], float (&vf)[8]) {
    if (idx >= W) { const bf16_t* r = newb + (size_t)(idx - W) * 2304; unpack8(*(const u32x4*)r, kf); unpack8(*(const u32x4*)(r + 768), vf); }
    else { const float* r = cb + (size_t)idx * 512; const f32x4 a = *(const f32x4*)r, b2 = *(const f32x4*)(r + 4), c = *(const f32x4*)(r + 256), d2 = *(const f32x4*)(r + 260);
#pragma unroll
        for (int i = 0; i < 4; ++i) { kf[i] = a[i]; kf[4 + i] = b2[i]; vf[i] = c[i]; vf[4 + i] = d2[i]; } }
}
__device__ __forceinline__ void attn_sample_sub(const bf16_t* __restrict__ qkv, const float* __restrict__ cg_, bf16_t* __restrict__ PO, float* __restrict__ LSE,
                                                int layer, int stok, int h, int g, int lane) {
    const int kg = lane >> 3, dl = lane & 7;
    const int b = stok >> 3, t = stok & 7;
    const int token = NTP + stok;
    const int d = 1 << (2 * g), W = 128 << (2 * g);
    const bf16_t* nb = qkv + (size_t)(NTP + b * 8) * 2304 + 768 + g * 256 + h * 64 + dl * 8;
    const float* cb = cg_ + (size_t)(layer * 32 + b) * W * 512 + h * 64 + dl * 8;
    float q[8]; unpack8(*(const u32x4*)(qkv + (size_t)token * 2304 + g * 256 + h * 64 + dl * 8), q);
#pragma unroll
    for (int i = 0; i < 8; ++i) q[i] *= 0.125f;
    float m = -1e30f, l = 0.f; float o[8];
#pragma unroll
    for (int i = 0; i < 8; ++i) o[i] = 0.f;
#pragma unroll 1
    for (int it = 0; it < 16; it += 8) {
        float kf[8][8], vf[8][8], s[8];
#pragma unroll
        for (int u = 0; u < 8; ++u) { const int j = (it + u) * 8 + kg; sample_kv(nb, cb, W, W + t - j * d, kf[u], vf[u]); }
        float mb = m;
#pragma unroll
        for (int u = 0; u < 8; ++u) { ATT_DOT(s[u], q, kf[u]); mb = fmaxf(mb, s[u]); }
        const float corr = __expf(m - mb);
        l *= corr;
#pragma unroll
        for (int i = 0; i < 8; ++i) o[i] *= corr;
#pragma unroll
        for (int u = 0; u < 8; ++u) { const float p = __expf(s[u] - mb); l += p;
#pragma unroll
            for (int i = 0; i < 8; ++i) o[i] += p * vf[u][i]; }
        m = mb;
    }
    {
        const bool val = kg == 0;
        float kf[8], vf[8]; sample_kv(nb, cb, W, W + t - 128 * d, kf, vf);
        float s; ATT_DOT(s, q, kf);
        if (!val) s = -1e30f;
        const float mb = fmaxf(m, s); const float corr = __expf(m - mb); const float p = val ? __expf(s - mb) : 0.f;
        l = l * corr + p;
#pragma unroll
        for (int i = 0; i < 8; ++i) o[i] = o[i] * corr + p * vf[i];
        m = mb;
    }
    float M = m; M = fmaxf(M, __shfl_xor(M, 8)); M = fmaxf(M, __shfl_xor(M, 16)); M = fmaxf(M, __shfl_xor(M, 32));
    const float f = __expf(m - M); l *= f;
#pragma unroll
    for (int i = 0; i < 8; ++i) o[i] *= f;
    l += __shfl_xor(l, 8); l += __shfl_xor(l, 16); l += __shfl_xor(l, 32);
#pragma unroll
    for (int i = 0; i < 8; ++i) { o[i] += __shfl_xor(o[i], 8); o[i] += __shfl_xor(o[i], 16); o[i] += __shfl_xor(o[i], 32); }
    const float inv = 1.0f / l;
#pragma unroll
    for (int i = 0; i < 8; ++i) o[i] *= inv;
    if (kg == 0) *(u32x4*)(PO + ((size_t)g * NTOK + token) * 256 + h * 64 + dl * 8) = pack8(o);
    if (lane == 0) LSE[((size_t)g * NTOK + token) * 4 + h] = M + __logf(l);
}

constexpr int ATT_PITCH = 144, ATT_ROWS = 272, ATT_VOFF = ATT_ROWS * ATT_PITCH;
typedef short s16x4 __attribute__((ext_vector_type(4)));
template <int OFF> __device__ __forceinline__ s16x4 tr_read(unsigned addr) { s16x4 r; asm volatile("ds_read_b64_tr_b16 %0, %1 offset:%2" : "=v"(r) : "v"(addr), "n"(OFF) : "memory"); return r; }
__device__ __forceinline__ void tr_wait8(s16x4& a, s16x4& b, s16x4& c, s16x4& d, s16x4& e, s16x4& f, s16x4& g, s16x4& h) {
    asm volatile("s_waitcnt lgkmcnt(0)" : "+v"(a), "+v"(b), "+v"(c), "+v"(d), "+v"(e), "+v"(f), "+v"(g), "+v"(h) :: "memory"); }

__device__ __forceinline__ void attn_mfma_phase(LAS unsigned char* lds, const bf16_t* __restrict__ QKV, bf16_t* __restrict__ PO, float* __restrict__ LSE, int bid, int G, int tid) {
    using pg8::bf16x8;
    const int lane = tid & 63, w = __builtin_amdgcn_readfirstlane(tid >> 6), kg = lane >> 4, qn = lane & 15;
    for (int i = tid; i < 2 * 144; i += NTHREADS) { const int kv = i / 144, rem = i - kv * 144; *(LAS u32x4*)(lds + kv * ATT_VOFF + 256 * ATT_PITCH + rem * 16) = (u32x4){0u, 0u, 0u, 0u}; }
    const unsigned vaddr = (unsigned)(uintptr_t)(lds + ATT_VOFF + (16 * w + 4 * kg + (qn >> 2)) * ATT_PITCH + (lane & 3) * 8);
    const float csc = 0.125f * 1.44269504089f;
#define ATT_DECODE(U, b_, h_, g_, r_, I0_) do { const int _bh = (U) / 96, _rest = (U) - _bh * 96; b_ = _bh >> 2; h_ = _bh & 3; \
        if (_rest < 32) { g_ = 0; r_ = 0; I0_ = 128 * _rest; } else if (_rest < 64) { g_ = 1; r_ = (_rest - 32) >> 3; I0_ = 128 * ((_rest - 32) & 7); } else { g_ = 2; r_ = (_rest - 64) >> 1; I0_ = 128 * ((_rest - 64) & 1); } } while (0)
#define ATT_FETCH(U) do { int _b, _h, _g, _r, _I0; ATT_DECODE(U, _b, _h, _g, _r, _I0); const int _d = 1 << (2 * _g); \
        _Pragma("unroll") for (int i = 0; i < 8; ++i) { const int kv = i >> 2, row = (tid >> 3) + 64 * (i & 3), ch = tid & 7; const int I = _I0 - 128 + row; \
            pf[i] = (u32x4){0u, 0u, 0u, 0u}; \
            if (I >= 0) pf[i] = *(const u32x4*)(QKV + (size_t)(_b * 4096 + _r + _d * I) * 2304 + 768 + kv * 768 + _g * 256 + _h * 64 + ch * 8); } \
        const bf16_t* _qp = QKV + ((size_t)_b * 4096 + _r + _d * (_I0 + 16 * w + qn)) * 2304 + _g * 256 + _h * 64 + kg * 8; \
        qf0 = *(const bf16x8*)_qp; qf1 = *(const bf16x8*)(_qp + 32); } while (0)
    u32x4 pf[8]; bf16x8 qf0, qf1;
    if (bid < 1536) ATT_FETCH(bid);
#pragma unroll 1
    for (int u = bid; u < 1536; u += G) {
        int b, h, g, r, I0; ATT_DECODE(u, b, h, g, r, I0);
        const int d = 1 << (2 * g);
        __syncthreads();
#pragma unroll
        for (int i = 0; i < 8; ++i) { const int kv = i >> 2, row = (tid >> 3) + 64 * (i & 3), ch = tid & 7; *(LAS u32x4*)(lds + kv * ATT_VOFF + row * ATT_PITCH + ch * 16) = pf[i]; }
        const bf16x8 q0 = qf0, q1 = qf1;
        __syncthreads();
        if (u + G < 1536) ATT_FETCH(u + G);
        const int Iq = I0 + 16 * w + qn; const size_t tokq = (size_t)b * 4096 + r + d * Iq;
        f32x4 sc[9];
        const LAS unsigned char* kb = lds + (16 * w + qn) * ATT_PITCH + kg * 16;
#pragma unroll
        for (int kt = 0; kt < 9; ++kt) { const bf16x8 k0 = *(const LAS bf16x8*)(kb + kt * 16 * ATT_PITCH), k1 = *(const LAS bf16x8*)(kb + kt * 16 * ATT_PITCH + 64);
            f32x4 z = (f32x4){0.f, 0.f, 0.f, 0.f}; z = __builtin_amdgcn_mfma_f32_16x16x32_bf16(k0, q0, z, 0, 0, 0); sc[kt] = __builtin_amdgcn_mfma_f32_16x16x32_bf16(k1, q1, z, 0, 0, 0); }
        const int jb = 128 + qn - 4 * kg, ikb = I0 - 128 + 16 * w + 4 * kg;
        float m = -1e30f;
#pragma unroll
        for (int kt = 0; kt < 9; ++kt)
#pragma unroll
            for (int i = 0; i < 4; ++i) { const int j = jb - 16 * kt - i; const bool val = (j >= 0) && (j <= 128) && (ikb + 16 * kt + i >= 0); sc[kt][i] = val ? sc[kt][i] : -1e30f; m = fmaxf(m, sc[kt][i]); }
        m = fmaxf(m, __shfl_xor(m, 16)); m = fmaxf(m, __shfl_xor(m, 32));
        const float mc = m * csc; float l = 0.f;
        unsigned pk[10][2];
#pragma unroll
        for (int kt = 0; kt < 9; ++kt) { float p[4];
#pragma unroll
            for (int i = 0; i < 4; ++i) { p[i] = (sc[kt][i] > -1e29f) ? __builtin_amdgcn_exp2f(sc[kt][i] * csc - mc) : 0.f; l += p[i]; }
            pk[kt][0] = cvt_pk_bf16(p[0], p[1]); pk[kt][1] = cvt_pk_bf16(p[2], p[3]); }
        pk[9][0] = 0u; pk[9][1] = 0u;
        l += __shfl_xor(l, 16); l += __shfl_xor(l, 32);
        f32x4 o[4];
#pragma unroll
        for (int dt = 0; dt < 4; ++dt) o[dt] = (f32x4){0.f, 0.f, 0.f, 0.f};
#define ATT_PV(KK) do { s16x4 a0 = tr_read<(KK) * 32 * ATT_PITCH + 0>(vaddr), a1 = tr_read<(KK) * 32 * ATT_PITCH + 32>(vaddr), a2 = tr_read<(KK) * 32 * ATT_PITCH + 64>(vaddr), a3 = tr_read<(KK) * 32 * ATT_PITCH + 96>(vaddr); \
            s16x4 c0 = tr_read<(KK) * 32 * ATT_PITCH + 16 * ATT_PITCH + 0>(vaddr), c1 = tr_read<(KK) * 32 * ATT_PITCH + 16 * ATT_PITCH + 32>(vaddr), c2 = tr_read<(KK) * 32 * ATT_PITCH + 16 * ATT_PITCH + 64>(vaddr), c3 = tr_read<(KK) * 32 * ATT_PITCH + 16 * ATT_PITCH + 96>(vaddr); \
            tr_wait8(a0, a1, a2, a3, c0, c1, c2, c3); \
            u32x4 pw; pw.x = pk[2 * (KK)][0]; pw.y = pk[2 * (KK)][1]; pw.z = pk[2 * (KK) + 1][0]; pw.w = pk[2 * (KK) + 1][1]; \
            const bf16x8 pf = __builtin_bit_cast(bf16x8, pw); \
            o[0] = __builtin_amdgcn_mfma_f32_16x16x32_bf16(__builtin_shufflevector(a0, c0, 0, 1, 2, 3, 4, 5, 6, 7), pf, o[0], 0, 0, 0); \
            o[1] = __builtin_amdgcn_mfma_f32_16x16x32_bf16(__builtin_shufflevector(a1, c1, 0, 1, 2, 3, 4, 5, 6, 7), pf, o[1], 0, 0, 0); \
            o[2] = __builtin_amdgcn_mfma_f32_16x16x32_bf16(__builtin_shufflevector(a2, c2, 0, 1, 2, 3, 4, 5, 6, 7), pf, o[2], 0, 0, 0); \
            o[3] = __builtin_amdgcn_mfma_f32_16x16x32_bf16(__builtin_shufflevector(a3, c3, 0, 1, 2, 3, 4, 5, 6, 7), pf, o[3], 0, 0, 0); } while (0)
        ATT_PV(0); ATT_PV(1); ATT_PV(2); ATT_PV(3); ATT_PV(4);
        const float il = 1.0f / l;
        bf16_t* op = PO + ((size_t)g * NTOK + tokq) * 256 + h * 64 + 4 * kg;
#pragma unroll
        for (int dt = 0; dt < 4; ++dt) { u32x2 wv; wv.x = cvt_pk_bf16(o[dt][0] * il, o[dt][1] * il); wv.y = cvt_pk_bf16(o[dt][2] * il, o[dt][3] * il); *(u32x2*)(op + 16 * dt) = wv; }
        if (kg == 0) LSE[((size_t)g * NTOK + tokq) * 4 + h] = m * 0.125f + __logf(l);
    }
#undef ATT_PV
#undef ATT_FETCH
#undef ATT_DECODE
}

#define XB_TMO      128
#define XB_XCNT(j)  (256  + 64 * (j))
#define XB_XSUB(j)  (1280 + 64 * (j))
#define XB_XGEN(j)  (2304 + 64 * (j))
#define XB_TOP      3328
#define XB_TOPGEN   3392
#define XCD_BAR_WORDS 3456
#define XB_SPIN_CAP (1u << 20)
__device__ __forceinline__ unsigned xb_ld(unsigned* p)              { return __hip_atomic_load(p, __ATOMIC_RELAXED, __HIP_MEMORY_SCOPE_AGENT); }
__device__ __forceinline__ unsigned xb_add(unsigned* p, unsigned v) { return __hip_atomic_fetch_add(p, v, __ATOMIC_RELAXED, __HIP_MEMORY_SCOPE_AGENT); }
__device__ __forceinline__ unsigned xb_xcc_id() { return (unsigned)__builtin_amdgcn_s_getreg((3 << 11) | 20) & 0xFu; }
#define XB_SPIN(cond, bar) do { unsigned _sp = 0; while (cond) { __builtin_amdgcn_s_sleep(1); \
    if ((++_sp & 255u) == 0u) { if (xb_ld(&(bar)[XB_TMO])) break; if (_sp > XB_SPIN_CAP) { atomicAdd(&(bar)[XB_TMO], 1u); break; } } } } while (0)
struct XcdBarrier { unsigned* bar; unsigned x; volatile LAS unsigned* st; };
__device__ __forceinline__ XcdBarrier xcd_barrier_post(unsigned* bar, volatile LAS unsigned* st) {
    XcdBarrier b; b.bar = bar; b.x = xb_xcc_id(); b.st = st;
    if (threadIdx.x == 0) (void)xb_add(&bar[XB_XCNT(b.x)], 1u);
    return b;
}
__device__ __forceinline__ void xcd_barrier_complete(unsigned* bar, unsigned x, unsigned& nloc, unsigned& nx) {
    const unsigned G = gridDim.x * gridDim.y * gridDim.z;
    unsigned sum, cnt, mine, sp = 0u;
    for (;;) {
        sum = 0u; cnt = 0u; mine = 0u;
#pragma unroll
        for (unsigned j = 0; j < 16; ++j) { const unsigned c = xb_ld(&bar[XB_XCNT(j)]); sum += c; cnt += (c > 0u) ? 1u : 0u; mine = (j == x) ? c : mine; }
        if (sum == G) break;
        __builtin_amdgcn_s_sleep(1);
        if ((++sp & 255u) == 0u) { if (xb_ld(&bar[XB_TMO])) break; if (sp > XB_SPIN_CAP) { atomicAdd(&bar[XB_TMO], 1u); break; } }
    }
    nloc = mine > 0u ? mine : 1u; nx = cnt > 0u ? cnt : 1u;
}
__device__ __forceinline__ void xcd_barrier(const XcdBarrier& b) {
    asm volatile("s_waitcnt vmcnt(0)" ::: "memory");
    __syncthreads();
    if (threadIdx.x == 0) {
        unsigned* bar = b.bar;
        __builtin_amdgcn_s_waitcnt(0);
        unsigned nloc = b.st[0], nx = b.st[1];
        if (nloc == 0u) { xcd_barrier_complete(bar, b.x, nloc, nx); b.st[0] = nloc; b.st[1] = nx; }
        const unsigned old = xb_add(&bar[XB_XSUB(b.x)], 1u);
        const unsigned gen = old / nloc;
        if (old + 1u == (gen + 1u) * nloc) {
            __builtin_amdgcn_fence(__ATOMIC_RELEASE, "agent");
            asm volatile("s_waitcnt vmcnt(0)" ::: "memory");
            const unsigned og = xb_add(&bar[XB_TOP], 1u);
            const unsigned tg = og / nx;
            if (og + 1u == (tg + 1u) * nx) xb_add(&bar[XB_TOPGEN], 1u);
            else XB_SPIN(xb_ld(&bar[XB_TOPGEN]) == tg, bar);
            __builtin_amdgcn_fence(__ATOMIC_ACQUIRE, "agent");
            xb_add(&bar[XB_XGEN(b.x)], 1u);
            asm volatile("s_waitcnt vmcnt(0)" ::: "memory");
        } else {
            XB_SPIN(xb_ld(&bar[XB_XGEN(b.x)]) == gen, bar);
            __builtin_amdgcn_fence(__ATOMIC_ACQUIRE, "agent");
            asm volatile("s_waitcnt vmcnt(0)" ::: "memory");
        }
    }
    __syncthreads();
}

template <int GP> __device__ __forceinline__ void pool_item(const bf16_t* __restrict__ UB, bf16_t* __restrict__ PB, const float* __restrict__ sp, int tb, int cl) {
    constexpr int W = 2 << GP, NR = W + 7;
    const int c = (GP * 16 + cl) * 8;
    const int token0 = tb * 8; const bool samp = token0 >= NTP; const int t0 = samp ? 0 : (token0 & 4095); const int b = (token0 - NTP) >> 3;
    u32x4 R[NR];
#pragma unroll
    for (int r = 0; r < NR; ++r) { const int dt = r - (W - 1);
        if (dt >= 0 || t0 + dt >= 0) R[r] = *(const u32x4*)(UB + (size_t)(token0 + dt) * 512 + c);
        else if (samp) { const float* q = sp + (size_t)(b * 15 + 15 + dt) * 512 + c; const f32x4 a = *(const f32x4*)q, b2 = *(const f32x4*)(q + 4);
            R[r].x = cvt_pk_bf16(a[0], a[1]); R[r].y = cvt_pk_bf16(a[2], a[3]); R[r].z = cvt_pk_bf16(b2[0], b2[1]); R[r].w = cvt_pk_bf16(b2[2], b2[3]); }
        else R[r] = (u32x4){0u, 0u, 0u, 0u}; }
#pragma unroll
    for (int j = 0; j < 8; ++j) {
        float sum[8];
#pragma unroll
        for (int k = 0; k < 8; ++k) sum[k] = 0.f;
#pragma unroll
        for (int i = 0; i < W; ++i) { float f[8]; unpack8(R[j + (W - 1) - i], f);
#pragma unroll
            for (int k = 0; k < 8; ++k) sum[k] += f[k]; }
        float ut[8]; unpack8(R[j + W - 1], ut);
        const int t = t0 + j; const float cnt = samp ? (float)W : (float)(W < t + 1 ? W : t + 1); const float ic = 1.0f / cnt;
        float p[8];
#pragma unroll
        for (int k = 0; k < 8; ++k) p[k] = sum[k] * ic - ut[k];
        *(u32x4*)(PB + (size_t)(token0 + j) * 512 + c) = pack8(p);
    }
}

__global__ void __launch_bounds__(NTHREADS, 2) fwd_megakernel(Params P) {
    extern __shared__ __attribute__((aligned(16))) unsigned char lds_raw[];
    LAS unsigned char* lds = (LAS unsigned char*)lds_raw;
    cg::grid_group grid = cg::this_grid();
    const int tid = threadIdx.x, lane = tid & 63, wave = __builtin_amdgcn_readfirstlane(tid >> 6);
    const int G = gridDim.x, bid = blockIdx.x;
    const int gw = bid * 8 + wave, NGW = G * 8;
    const size_t gtid = (size_t)bid * NTHREADS + tid, nth = (size_t)G * NTHREADS;
    unsigned char* ws = P.ws;
    bf16_t* Wt_in = (bf16_t*)(ws + WS_WIN); bf16_t* Wt_pa = (bf16_t*)(ws + WS_WPA); bf16_t* Wt_pb = (bf16_t*)(ws + WS_WPB);
    bf16_t* Wt_o = (bf16_t*)(ws + WS_WO); bf16_t* Wt_up = (bf16_t*)(ws + WS_WUP); bf16_t* Wt_dn = (bf16_t*)(ws + WS_WDN);
    float* X = (float*)(ws + WS_X); bf16_t* XB = (bf16_t*)(ws + WS_XB); bf16_t* QKV = (bf16_t*)(ws + WS_QKV); bf16_t* UB = (bf16_t*)(ws + WS_U);
    bf16_t* GT = (bf16_t*)(ws + WS_G); bf16_t* OA = (bf16_t*)(ws + WS_OA); bf16_t* PB = (bf16_t*)(ws + WS_P); float* TMP = (float*)(ws + WS_TMP);
    bf16_t* MIX = (bf16_t*)(ws + WS_MIX); bf16_t* HID = (bf16_t*)(ws + WS_H); float* SS = (float*)(ws + WS_SS); float* ROPE = (float*)(ws + WS_ROPE);
    float* out = P.out;
    volatile LAS unsigned* bst = (volatile LAS unsigned*)(lds + LDS_BYTES - 16);
    if (tid == 0) { bst[0] = 0u; bst[1] = 0u; }
    __syncthreads();
    const XcdBarrier xb = xcd_barrier_post((unsigned*)(ws + WS_BAR), bst);

    {
        LAS float* LsT = (LAS float*)lds;
        LAS float* Ws = LsT + 128 * 128;
        for (int item = bid; item < DEPTH * 4 * 16; item += G) {
            const int l = item >> 6, g = (item >> 4) & 3, n0 = (item & 15) * 64;
            const float* lin = P.in[10] + (size_t)(l * 4 + g) * 128 * 128;
            const float* sc = P.in[11] + l * 512 + g * 128;
            const float* wpb = P.in[9] + (size_t)l * 512 * 1024 + (size_t)g * 128 * 1024;
            for (int i = tid; i < 128 * 128; i += NTHREADS) { const int c = i >> 7, d = i & 127; LsT[d * 128 + c] = lin[i] * sc[d]; }
            for (int i = tid; i < 128 * 64; i += NTHREADS) { const int d = i >> 6, n = i & 63; Ws[i] = wpb[(size_t)d * 1024 + n0 + n]; }
            __syncthreads();
            const int n = tid & 63, cgp = tid >> 6;
            float a[16];
#pragma unroll
            for (int i = 0; i < 16; ++i) a[i] = 0.f;
            for (int d = 0; d < 128; ++d) {
                const float w = Ws[d * 64 + n];
                const LAS f32x4* lp = (const LAS f32x4*)(LsT + d * 128 + cgp * 16);
#pragma unroll
                for (int q4 = 0; q4 < 4; ++q4) { const f32x4 lv = lp[q4];
#pragma unroll
                    for (int i = 0; i < 4; ++i) a[q4 * 4 + i] += lv[i] * w; }
            }
            bf16_t* op = Wt_pb + ((size_t)l * 1024 + n0 + n) * 512 + g * 128 + cgp * 16;
            u32x4 o0, o1; o0.x = cvt_pk_bf16(a[0], a[1]); o0.y = cvt_pk_bf16(a[2], a[3]); o0.z = cvt_pk_bf16(a[4], a[5]); o0.w = cvt_pk_bf16(a[6], a[7]);
            o1.x = cvt_pk_bf16(a[8], a[9]); o1.y = cvt_pk_bf16(a[10], a[11]); o1.z = cvt_pk_bf16(a[12], a[13]); o1.w = cvt_pk_bf16(a[14], a[15]);
            *(u32x4*)op = o0; *(u32x4*)(op + 8) = o1;
            __syncthreads();
        }
        {
            LAS float* scr = (LAS float*)(lds + wave * 16640);
            constexpr int I_IN = 16 * 76, I_PA = 4 * 16, I_O = 16 * 16, I_UP = 16 * 64, I_DN = 64 * 16, I_L = I_IN + I_PA + I_O + I_UP + I_DN;
            for (int it = gw; it < DEPTH * I_L; it += NGW) {
                const int l = it / I_L; int r = it - l * I_L;
                if (r < I_IN) { transpose_item(P.in[7] + (size_t)l * DM * NIN, P.in[6] + l * DM, DM, NIN, Wt_in + (size_t)l * NIN * DM, scr, r, lane); continue; } r -= I_IN;
                if (r < I_PA) { transpose_item(P.in[8] + (size_t)l * 256 * DM, nullptr, 256, DM, Wt_pa + (size_t)l * DM * 256, scr, r, lane); continue; } r -= I_PA;
                if (r < I_O) { transpose_item(P.in[12] + (size_t)l * DM * DM, nullptr, DM, DM, Wt_o + (size_t)l * DM * DM, scr, r, lane); continue; } r -= I_O;
                if (r < I_UP) { transpose_item(P.in[14] + (size_t)l * DM * DFF, P.in[13] + l * DM, DM, DFF, Wt_up + (size_t)l * DFF * DM, scr, r, lane); continue; } r -= I_UP;
                transpose_item(P.in[15] + (size_t)l * DFF * DM, nullptr, DFF, DM, Wt_dn + (size_t)l * DM * DFF, scr, r, lane);
            }
        }
        for (int row = gw; row < NTOK; row += 2 * NGW) {
            const int r2 = row + NGW; const bool ok2 = r2 < NTOK; const int rb = ok2 ? r2 : row;
            const float* srca = row < NTP ? P.in[0] + (size_t)row * DM : P.in[1] + (size_t)(row - NTP) * DM;
            const float* srcb = rb < NTP ? P.in[0] + (size_t)rb * DM : P.in[1] + (size_t)(rb - NTP) * DM;
            f32x4 va[4], vb[4];
#pragma unroll
            for (int j = 0; j < 4; ++j) { va[j] = *(const f32x4*)(srca + 4 * lane + 256 * j); vb[j] = *(const f32x4*)(srcb + 4 * lane + 256 * j); }
            float sa = 0.f, sb = 0.f;
#pragma unroll
            for (int j = 0; j < 4; ++j) { sa += va[j][0] * va[j][0] + va[j][1] * va[j][1] + va[j][2] * va[j][2] + va[j][3] * va[j][3]; sb += vb[j][0] * vb[j][0] + vb[j][1] * vb[j][1] + vb[j][2] * vb[j][2] + vb[j][3] * vb[j][3];
                *(f32x4*)(X + (size_t)row * DM + 4 * lane + 256 * j) = va[j];
                u32x2 w; w.x = cvt_pk_bf16(va[j][0], va[j][1]); w.y = cvt_pk_bf16(va[j][2], va[j][3]); *(u32x2*)(XB + (size_t)row * DM + 4 * lane + 256 * j) = w;
                if (ok2) { *(f32x4*)(X + (size_t)r2 * DM + 4 * lane + 256 * j) = vb[j];
                    u32x2 w2; w2.x = cvt_pk_bf16(vb[j][0], vb[j][1]); w2.y = cvt_pk_bf16(vb[j][2], vb[j][3]); *(u32x2*)(XB + (size_t)r2 * DM + 4 * lane + 256 * j) = w2; } }
#pragma unroll
            for (int o = 1; o < 64; o <<= 1) { sa += __shfl_xor(sa, o); sb += __shfl_xor(sb, o); }
            if (lane == 0) { SS[row] = sa; if (ok2) SS[r2] = sb; }
        }
        for (size_t i = gtid; i < 4104 * 8; i += nth) { const int pi = (int)(i >> 3), k = (int)(i & 7); const float pos = (float)(pi < 4096 ? pi : 8192 + pi - 4096);
            const float inv = powf(500000.0f, -(float)(2 * k) / 16.0f); const float ang = pos * inv; ROPE[pi * 16 + k] = cosf(ang); ROPE[pi * 16 + 8 + k] = sinf(ang); }
        for (size_t i = gtid; i < (size_t)8 * NTOK; i += nth) SS[NTOK + i] = 0.f;
        for (size_t i = gtid; i < (size_t)DEPTH * 32 * 7 * 128; i += nth) { const size_t lb = i / (7 * 128), r = i - lb * (7 * 128);
            *(f32x4*)(out + O_POOLS + lb * 15 * 512 + r * 4) = *(const f32x4*)(P.in[5] + lb * 15 * 512 + 8 * 512 + r * 4); }
    }
    if (P.out == nullptr) grid.sync();
    xcd_barrier(xb);

    pg8::StaticOrder S;
#pragma unroll 1
    for (int step = 0; step < DEPTH * 7; ++step) {
        const int layer = step / 7, st = step - layer * 7;
        if (st == 1) {
            int tid_l = threadIdx.x; asm volatile("" : "+v"(tid_l));
            const int lane = tid_l & 63, gw = bid * 8 + (tid_l >> 6);
            const size_t gtid = (size_t)bid * NTHREADS + tid_l;
            unsigned char* wsl = ws; asm volatile("" : "+s"(wsl));
            bf16_t* QKV = (bf16_t*)(wsl + WS_QKV); bf16_t* UB = (bf16_t*)(wsl + WS_U); bf16_t* OA = (bf16_t*)(wsl + WS_OA); bf16_t* PB = (bf16_t*)(wsl + WS_P);
            bf16_t* PO = (bf16_t*)(wsl + WS_TMP); float* LSE = (float*)(wsl + WS_TMP + (size_t)3 * NTOK * 256 * 2);
            for (int it = gw; it < NTS * 12; it += NGW) { const int g = it % 3, r = it / 3; attn_sample_sub(QKV, g == 0 ? P.in[2] : (g == 1 ? P.in[3] : P.in[4]), PO, LSE, layer, r >> 2, r & 3, g, lane); }
            attn_mfma_phase(lds, QKV, PO, LSE, bid, G, tid_l);
            copy_shift<128>(P.in[2], out + O_KVS0, layer, gtid, nth);
            copy_shift<512>(P.in[3], out + O_KVS1, layer, gtid, nth);
            copy_shift<2048>(P.in[4], out + O_KVS2, layer, gtid, nth);
            xcd_barrier(xb);
            for (size_t base = gtid; base < (size_t)NTOK * 32; base += nth * 4) {
                float ls[4][3]; u32x4 av[4][3];
#pragma unroll
                for (int u = 0; u < 4; ++u) { const size_t idx = base + u * nth; const size_t ii = idx < (size_t)NTOK * 32 ? idx : base; const size_t token = ii >> 5; const int c = (int)(ii & 31) * 8, h = c >> 6;
#pragma unroll
                    for (int g = 0; g < 3; ++g) { ls[u][g] = LSE[((size_t)g * NTOK + token) * 4 + h]; av[u][g] = *(const u32x4*)(PO + ((size_t)g * NTOK + token) * 256 + c); } }
#pragma unroll
                for (int u = 0; u < 4; ++u) { const size_t idx = base + u * nth;
                    if (idx < (size_t)NTOK * 32) { const size_t token = idx >> 5; const int c = (int)(idx & 31) * 8;
                        const float mx = fmaxf(ls[u][0], fmaxf(ls[u][1], ls[u][2])); float w0 = __expf(ls[u][0] - mx), w1 = __expf(ls[u][1] - mx), w2 = __expf(ls[u][2] - mx); const float iw = 1.0f / (w0 + w1 + w2); w0 *= iw; w1 *= iw; w2 *= iw;
                        float a0[8], a1[8], a2[8], o[8]; unpack8(av[u][0], a0); unpack8(av[u][1], a1); unpack8(av[u][2], a2);
#pragma unroll
                        for (int k = 0; k < 8; ++k) o[k] = w0 * a0[k] + w1 * a1[k] + w2 * a2[k];
                        *(u32x4*)(OA + token * 256 + c) = pack8(o); } }
            }
            const float* sp = P.in[5] + (size_t)layer * 32 * 15 * 512;
            for (int it = (int)gtid; it < 4 * (NTOK / 8) * 16; it += (int)nth) {
                const int cl = it & 15, q = it >> 4, g = q / (NTOK / 8), tb = q - g * (NTOK / 8);
                if (g == 0) pool_item<0>(UB, PB, sp, tb, cl); else if (g == 1) pool_item<1>(UB, PB, sp, tb, cl); else if (g == 2) pool_item<2>(UB, PB, sp, tb, cl); else pool_item<3>(UB, PB, sp, tb, cl);
            }
            xcd_barrier(xb);
            continue;
        }
        pg8::Gemm g; EpiAll E; E.ws = ws; E.out = out; E.layer = layer; E.ssi = 0; E.ssn = 0;
        const int Mg = (st == 0) ? NTOK : NTP;
        g.M = Mg;
        if (st == 0)      { g.A = XB;  g.Bt = Wt_in + (size_t)layer * NIN * DM; g.N = NIN; g.K = DM;  E.mode = 0; E.ssi = 2 * layer; }
        else if (st == 2) { g.A = OA;  g.Bt = Wt_pa + (size_t)layer * DM * 256; g.N = DM;  g.K = 256; E.mode = 1; }
        else if (st == 3) { g.A = PB;  g.Bt = Wt_pb + (size_t)layer * DM * 512; g.N = DM;  g.K = 512; E.mode = 2; }
        else if (st == 4) { g.A = MIX; g.Bt = Wt_o + (size_t)layer * DM * DM;   g.N = DM;  g.K = DM;  E.mode = 3; E.ssn = 2 * layer + 1; }
        else if (st == 5) { g.A = XB;  g.Bt = Wt_up + (size_t)layer * DFF * DM; g.N = DFF; g.K = DM;  E.mode = 4; E.ssi = 2 * layer + 1; }
        else              { g.A = HID; g.Bt = Wt_dn + (size_t)layer * DM * DFF; g.N = DM;  g.K = DFF; E.mode = 3; E.ssn = 2 * layer + 2; }
        S.init(Mg, g.N, G, bid);
        pg8::gemm_phase<EpiAll, pg8::StaticOrder, true, true>(lds, g, S, E);
        if (st != 0) skinny_gemm(lds, g.A + (size_t)NTP * g.K, g.Bt, g.N, g.K, E, G - 1 - bid, G);
        if (st != 2) xcd_barrier(xb);
    }
    {
        int tid_l = threadIdx.x; asm volatile("" : "+v"(tid_l));
        const int lane = tid_l & 63, gw = bid * 8 + (tid_l >> 6);
        unsigned char* wsl = ws; asm volatile("" : "+s"(wsl));
        float* X = (float*)(wsl + WS_X);
        const float* fn = P.in[16]; const float* ssf = (const float*)(wsl + WS_SS) + (size_t)8 * NTOK;
        for (int row = gw; row < NTOK; row += 2 * NGW) {
            const int r2 = row + NGW; const bool ok2 = r2 < NTOK; const int rb = ok2 ? r2 : row;
            const float s0 = ssf[row], s1 = ssf[rb];
            f32x4 va[4], vb[4], gn[4];
#pragma unroll
            for (int j = 0; j < 4; ++j) { const int c = 4 * lane + 256 * j; va[j] = *(const f32x4*)(X + (size_t)row * DM + c); vb[j] = *(const f32x4*)(X + (size_t)rb * DM + c); gn[j] = *(const f32x4*)(fn + c); }
            const float rs0 = rsqrtf(s0 * (1.0f / 1024.0f) + 1e-6f), rs1 = rsqrtf(s1 * (1.0f / 1024.0f) + 1e-6f);
#pragma unroll
            for (int j = 0; j < 4; ++j) { const int c = 4 * lane + 256 * j;
                *(f32x4*)(out + (size_t)row * DM + c) = (f32x4){va[j][0] * rs0 * gn[j][0], va[j][1] * rs0 * gn[j][1], va[j][2] * rs0 * gn[j][2], va[j][3] * rs0 * gn[j][3]};
                if (ok2) *(f32x4*)(out + (size_t)r2 * DM + c) = (f32x4){vb[j][0] * rs1 * gn[j][0], vb[j][1] * rs1 * gn[j][1], vb[j][2] * rs1 * gn[j][2], vb[j][3] * rs1 * gn[j][3]}; }
        }
    }
}

extern "C" void kernel_launch(void* const* d_in, const int* in_sizes, int n_in, void* d_out, int out_size, void* d_ws, size_t ws_size, hipStream_t stream) {
    static int grid_blocks = 0;
    if (grid_blocks == 0) {
        if (n_in != 17 || ws_size < WS_END) { fprintf(stderr, "kernel_launch: unexpected n_in %d / ws %zu (need %zu)\n", n_in, ws_size, (size_t)WS_END); grid_blocks = -1; return; }
        int dev = 0, cus = 0, per_cu = 0;
        (void)hipGetDevice(&dev);
        (void)hipDeviceGetAttribute(&cus, hipDeviceAttributeMultiprocessorCount, dev);
        if (hipFuncSetAttribute((const void*)fwd_megakernel, hipFuncAttributeMaxDynamicSharedMemorySize, LDS_BYTES) != hipSuccess) { fprintf(stderr, "kernel_launch: hipFuncSetAttribute failed\n"); grid_blocks = -1; return; }
        (void)hipOccupancyMaxActiveBlocksPerMultiprocessor(&per_cu, (const void*)fwd_megakernel, NTHREADS, LDS_BYTES);
        if (per_cu < 1) { fprintf(stderr, "kernel_launch: occupancy query says %d blocks/CU\n", per_cu); grid_blocks = -1; return; }
        grid_blocks = cus * 1;
    }
    if (grid_blocks < 0) return;
    if (hipMemsetAsync((unsigned char*)d_ws + WS_BAR, 0, 4096 * 4, stream) != hipSuccess) { fprintf(stderr, "kernel_launch: memset of barrier words failed\n"); return; }
    Params p{};
    for (int i = 0; i < 17; ++i) p.in[i] = (const float*)d_in[i];
    p.out = (float*)d_out; p.ws = (unsigned char*)d_ws;
    void* args[] = {&p};
    hipError_t e = hipLaunchCooperativeKernel((const void*)fwd_megakernel, dim3(grid_blocks), dim3(NTHREADS), args, LDS_BYTES, stream);
    if (e != hipSuccess) fprintf(stderr, "cooperative launch failed: %s (grid %d)\n", hipGetErrorString(e), grid_blocks);
}
```

```cpp
#include <hip/hip_runtime.h>
#include <hip/hip_cooperative_groups.h>
#include <cstdio>
#include <cstdint>
namespace cg = cooperative_groups;

namespace pg8 {
#define PG8_LAS __attribute__((address_space(3)))
typedef unsigned short bf16_t;
typedef short bf16x8 __attribute__((ext_vector_type(8)));
typedef float f32x4 __attribute__((ext_vector_type(4)));
typedef unsigned u32x4 __attribute__((ext_vector_type(4)));
typedef unsigned u32x2 __attribute__((ext_vector_type(2)));
constexpr int BM = 256, BK = 64, HALF = 128, HTB = HALF * BK * 2, STAGE_BYTES = 8 * HTB, NXCD = 8, WGM = 8;

__host__ __device__ __forceinline__ int lds_byte(int r, int c) { const int st = (r >> 4) * 2 + (c >> 5), rr = r & 15, cc = c & 31, ob = rr * 64 + cc * 2; return st * 1024 + (ob ^ (((ob >> 9) & 1) << 5)); }
__host__ __device__ __forceinline__ void stage_rc(int b, int& R, int& C) { const int st = b / 1024, sb = b % 1024, swz = sb ^ (((sb >> 9) & 1) << 5); R = (st >> 1) * 16 + swz / 64; C = (st & 1) * 32 + (swz % 64) / 2; }
__host__ __device__ __forceinline__ int perm32(int rho) { const int n = rho >> 4, i = rho & 15; return 8 * (i >> 2) + 4 * n + (i & 3); }

struct Unit { int pm, pn; };
struct Gemm { const bf16_t* A; const bf16_t* Bt; int M, N, K; };

struct StaticOrder {
    int nM, nN, nwg, G, c;
    __host__ __device__ void init(int M, int N, int G_, int c_) { nM = M / BM; nN = N / BM; nwg = nM * nN; G = G_; c = c_; }
    __host__ __device__ bool next(int i, Unit& u) const {
        const long L = (long)i * G + c; if (L >= nwg) return false;
        int wgid = (int)L; { const int q = nwg / NXCD, r = nwg % NXCD, xcd = wgid % NXCD, off = wgid / NXCD; wgid = (xcd < r ? xcd * (q + 1) : r * (q + 1) + (xcd - r) * q) + off; }
        const int nig = WGM * nN, gid = wgid / nig, fm = gid * WGM, gsz = (nM - fm) < WGM ? (nM - fm) : WGM;
        u.pm = fm + ((wgid % nig) % gsz); u.pn = (wgid % nig) / gsz; return true;
    }
    __device__ __forceinline__ void a_ready(const Unit&) const {}
    __device__ __forceinline__ void done(const Unit&) const {}
};

__device__ __forceinline__ unsigned cvt_pk_bf16(float lo, float hi) { unsigned r; asm volatile("v_cvt_pk_bf16_f32 %0, %1, %2" : "=v"(r) : "v"(lo), "v"(hi)); return r; }

template <class Epi, class Sched, bool ALIGN_EPI = false, bool SP2 = false>
__device__ __forceinline__ void gemm_phase(PG8_LAS unsigned char* lds, const Gemm g, const Sched& S, const Epi& E) {
    int tid = threadIdx.x; asm volatile("" : "+v"(tid));
    const int wid = __builtin_amdgcn_readfirstlane(tid >> 6), lane = tid & 63, wr = wid >> 2, wc = wid & 3, fr = lane & 15, fq = lane >> 4;
    const int K = g.K, nt = K / BK;
    unsigned voffA[2], voffB[2];
#pragma unroll
    for (int i = 0; i < 2; ++i) { int R, C; stage_rc(tid * 16 + i * 8192, R, C); const int Rb = Epi::PERM ? ((R & ~31) + perm32(R & 31)) : R;
        voffA[i] = (unsigned)(R * K + C) * 2u; voffB[i] = (unsigned)(Rb * K + C) * 2u; }
    const size_t kstep = (size_t)(BK * 2);
    const size_t hstep = (size_t)HALF * K * 2;
    const size_t tstep = 2 * hstep;
    const unsigned ldsw = (unsigned)wid * 1024u;
    const int aoff = lds_byte(wr * 64 + fr, fq * 8), boff = lds_byte(wc * 32 + fr, fq * 8);
#define PG8_SA(b, h) (((b) * 2 + (h)) * HTB)
#define PG8_SB(b, h) ((4 + (b) * 2 + (h)) * HTB)
#define PG8_STAGE(bufoff, gbase, voff) do { _Pragma("unroll") for (int _i = 0; _i < 2; ++_i) \
        __builtin_amdgcn_global_load_lds((const unsigned*)((const char*)(gbase) + (voff)[_i]), (PG8_LAS unsigned*)(lds + (bufoff) + ldsw + _i * 8192), 16, 0, 0); } while (0)
#define PG8_LDA(dst, b, h) do { _Pragma("unroll") for (int m = 0; m < 4; ++m) _Pragma("unroll") for (int k = 0; k < 2; ++k) dst[m][k] = *(const PG8_LAS bf16x8*)(lds + PG8_SA(b, h) + aoff + m * 2048 + k * 1024); } while (0)
#define PG8_LDB(dst, b, h) do { _Pragma("unroll") for (int n = 0; n < 2; ++n) _Pragma("unroll") for (int k = 0; k < 2; ++k) dst[n][k] = *(const PG8_LAS bf16x8*)(lds + PG8_SB(b, h) + boff + n * 2048 + k * 1024); } while (0)
#define PG8_MMA(ai, bj, At, Bt) do { __builtin_amdgcn_s_setprio(1); _Pragma("unroll") for (int m = 0; m < 4; ++m) _Pragma("unroll") for (int n = 0; n < 2; ++n) _Pragma("unroll") for (int k = 0; k < 2; ++k) \
        acc[ai][bj][m][n] = __builtin_amdgcn_mfma_f32_16x16x32_bf16(Bt[n][k], At[m][k], acc[ai][bj][m][n], 0, 0, 0); __builtin_amdgcn_s_setprio(0); } while (0)
#define PG8_WAIT_V(n) asm volatile("s_waitcnt vmcnt(" #n ")" ::: "memory")
#define PG8_WAIT_L(n) asm volatile("s_waitcnt lgkmcnt(" #n ")" ::: "memory")
#define PG8_BAR __builtin_amdgcn_s_barrier()
#define PG8_SCHED __builtin_amdgcn_sched_barrier(0)
    Unit cur, nxt; int ui = 0;
    if (!S.next(0, cur)) return;
    f32x4 acc[2][2][4][2];
#pragma unroll
    for (int a = 0; a < 2; ++a)
#pragma unroll
        for (int b = 0; b < 2; ++b)
#pragma unroll
            for (int m = 0; m < 4; ++m)
#pragma unroll
                for (int n = 0; n < 2; ++n) acc[a][b][m][n] = (f32x4){0.f, 0.f, 0.f, 0.f};
    bf16x8 At[4][2], B0[2][2], B1[2][2];
    const char* cA = (const char*)g.A + (size_t)cur.pm * tstep; const char* cB = (const char*)g.Bt + (size_t)cur.pn * tstep;
    S.a_ready(cur);
    if constexpr (SP2) {
        PG8_STAGE(PG8_SB(0, 0), cB, voffB); PG8_STAGE(PG8_SB(0, 1), cB + hstep, voffB); PG8_STAGE(PG8_SA(0, 0), cA, voffA); PG8_STAGE(PG8_SA(0, 1), cA + hstep, voffA);
        if (wr == 1) PG8_BAR;
        PG8_WAIT_V(2); PG8_BAR;
        PG8_STAGE(PG8_SB(1, 0), cB + kstep, voffB); PG8_STAGE(PG8_SA(1, 0), cA + kstep, voffA); PG8_STAGE(PG8_SB(1, 1), cB + hstep + kstep, voffB);
        PG8_WAIT_V(6); PG8_BAR;
    } else {
        PG8_STAGE(PG8_SB(0, 0), cB, voffB); PG8_STAGE(PG8_SA(0, 0), cA, voffA); PG8_STAGE(PG8_SB(0, 1), cB + hstep, voffB); PG8_STAGE(PG8_SA(0, 1), cA + hstep, voffA);
        if (wr == 1) PG8_BAR;
        PG8_WAIT_V(4); PG8_BAR;
        PG8_STAGE(PG8_SB(1, 0), cB + kstep, voffB); PG8_STAGE(PG8_SA(1, 0), cA + kstep, voffA); PG8_STAGE(PG8_SB(1, 1), cB + hstep + kstep, voffB);
        PG8_WAIT_V(6); PG8_BAR;
    }
    for (;;) {
        const bool has_next = S.next(ui + 1, nxt);
        const char* nA = has_next ? (const char*)g.A + (size_t)nxt.pm * tstep : cA; const char* nB = has_next ? (const char*)g.Bt + (size_t)nxt.pn * tstep : cB;
        for (int t = 0; t < nt; t += 2) {
            const bool last = (t == nt - 2);
            const char* a1 = cA + (size_t)(t + 1) * kstep;
            const char* a2 = last ? nA : cA + (size_t)(t + 2) * kstep; const char* b2 = last ? nB : cB + (size_t)(t + 2) * kstep;
            const char* a3 = a2 + kstep; const char* b3 = b2 + kstep;
            if (last && has_next) S.a_ready(nxt);
            if constexpr (SP2) {
            PG8_LDB(B0, 0, 0); PG8_LDB(B1, 0, 1); PG8_SCHED; PG8_LDA(At, 0, 0); PG8_STAGE(PG8_SA(1, 1), a1 + hstep, voffA);
            PG8_WAIT_V(8); PG8_WAIT_L(0); PG8_BAR; PG8_MMA(0, 0, At, B0); PG8_MMA(0, 1, At, B1); PG8_BAR; PG8_SCHED;
            PG8_LDA(At, 0, 1); PG8_STAGE(PG8_SB(0, 0), b2, voffB); PG8_STAGE(PG8_SB(0, 1), b2 + hstep, voffB); PG8_STAGE(PG8_SA(0, 0), a2, voffA);
            PG8_WAIT_V(8); PG8_WAIT_L(0); PG8_BAR; PG8_MMA(1, 0, At, B0); PG8_MMA(1, 1, At, B1); PG8_BAR; PG8_SCHED;
            PG8_LDB(B0, 1, 0); PG8_LDB(B1, 1, 1); PG8_SCHED; PG8_LDA(At, 1, 0); PG8_STAGE(PG8_SA(0, 1), a2 + hstep, voffA);
            PG8_WAIT_V(8); PG8_WAIT_L(0); PG8_BAR; PG8_MMA(0, 0, At, B0); PG8_MMA(0, 1, At, B1); PG8_BAR; PG8_SCHED;
            PG8_LDA(At, 1, 1); PG8_STAGE(PG8_SB(1, 0), b3, voffB); PG8_STAGE(PG8_SB(1, 1), b3 + hstep, voffB); PG8_STAGE(PG8_SA(1, 0), a3, voffA);
            PG8_WAIT_V(8); PG8_WAIT_L(0); PG8_BAR; PG8_MMA(1, 0, At, B0); PG8_MMA(1, 1, At, B1); PG8_BAR; PG8_SCHED;
            } else {
            PG8_LDB(B0, 0, 0); PG8_SCHED; PG8_LDA(At, 0, 0); PG8_STAGE(PG8_SA(1, 1), a1 + hstep, voffA);
            PG8_WAIT_L(8); PG8_BAR; PG8_WAIT_L(0); PG8_MMA(0, 0, At, B0); PG8_BAR; PG8_SCHED;
            PG8_LDB(B1, 0, 1); PG8_STAGE(PG8_SB(0, 0), b2, voffB);
            PG8_BAR; PG8_WAIT_L(0); PG8_MMA(0, 1, At, B1); PG8_BAR;
            PG8_LDA(At, 0, 1); PG8_STAGE(PG8_SA(0, 0), a2, voffA);
            PG8_BAR; PG8_WAIT_L(0); PG8_MMA(1, 0, At, B0); PG8_BAR; PG8_SCHED;
            PG8_STAGE(PG8_SB(0, 1), b2 + hstep, voffB);
            PG8_WAIT_V(6); PG8_BAR; PG8_MMA(1, 1, At, B1); PG8_BAR;
            PG8_LDB(B0, 1, 0); PG8_SCHED; PG8_LDA(At, 1, 0); PG8_STAGE(PG8_SA(0, 1), a2 + hstep, voffA);
            PG8_WAIT_L(8); PG8_BAR; PG8_WAIT_L(0); PG8_MMA(0, 0, At, B0); PG8_BAR; PG8_SCHED;
            PG8_LDB(B1, 1, 1); PG8_STAGE(PG8_SB(1, 0), b3, voffB);
            PG8_BAR; PG8_WAIT_L(0); PG8_MMA(0, 1, At, B1); PG8_BAR;
            PG8_LDA(At, 1, 1); PG8_STAGE(PG8_SA(1, 0), a3, voffA);
            PG8_BAR; PG8_WAIT_L(0); PG8_MMA(1, 0, At, B0); PG8_BAR; PG8_SCHED;
            PG8_STAGE(PG8_SB(1, 1), b3 + hstep, voffB);
            PG8_WAIT_V(6); PG8_BAR; PG8_MMA(1, 1, At, B1); PG8_BAR;
            }
        }
        if constexpr (ALIGN_EPI) { if (wr == 0) PG8_BAR; }
        E(acc, cur, wr, wc, fr, fq); S.done(cur);
        if (!has_next) break;
#pragma unroll
        for (int a = 0; a < 2; ++a)
#pragma unroll
            for (int b = 0; b < 2; ++b)
#pragma unroll
                for (int m = 0; m < 4; ++m)
#pragma unroll
                    for (int n = 0; n < 2; ++n) acc[a][b][m][n] = (f32x4){0.f, 0.f, 0.f, 0.f};
        cur = nxt; cA = nA; cB = nB; ++ui;
        if constexpr (ALIGN_EPI) { if (wr == 1) PG8_BAR; }
    }
    PG8_WAIT_V(0);
    if constexpr (!ALIGN_EPI) { if (wr == 0) PG8_BAR; }
    PG8_BAR;
#undef PG8_SA
#undef PG8_SB
#undef PG8_STAGE
#undef PG8_LDA
#undef PG8_LDB
#undef PG8_MMA
#undef PG8_WAIT_V
#undef PG8_WAIT_L
#undef PG8_BAR
#undef PG8_SCHED
}
}

using pg8::bf16_t; using pg8::f32x4; using pg8::u32x4; using pg8::u32x2; using pg8::Unit; using pg8::cvt_pk_bf16;
#define LAS __attribute__((address_space(3)))

constexpr int DM = 1024, TP = 4096, NTP = 16384, NTS = 256, NTOK = 16640, DEPTH = 4, NIN = 4864, DFF = 4096;
constexpr int NTHREADS = 512, LDS_BYTES = 147456;
constexpr size_t O_YP = 0, O_YS = 16777216, O_KVP0 = 17039360, O_KVP1 = 18087936, O_KVP2 = 22282240, O_POOLP = 39059456,
                 O_KVS0 = 39182336, O_KVS1 = 47570944, O_KVS2 = 81125376, O_POOLS = 215343104;
constexpr size_t WS_WIN = 0;
constexpr size_t WS_WPA = WS_WIN + (size_t)DEPTH * NIN * DM * 2;
constexpr size_t WS_WPB = WS_WPA + (size_t)DEPTH * DM * 256 * 2;
constexpr size_t WS_WO  = WS_WPB + (size_t)DEPTH * DM * 512 * 2;
constexpr size_t WS_WUP = WS_WO  + (size_t)DEPTH * DM * DM * 2;
constexpr size_t WS_WDN = WS_WUP + (size_t)DEPTH * DFF * DM * 2;
constexpr size_t WS_X   = WS_WDN + (size_t)DEPTH * DM * DFF * 2;
constexpr size_t WS_XB  = WS_X   + (size_t)NTOK * DM * 4;
constexpr size_t WS_QKV = WS_XB  + (size_t)NTOK * DM * 2;
constexpr size_t WS_U   = WS_QKV + (size_t)NTOK * 2304 * 2;
constexpr size_t WS_G   = WS_U   + (size_t)NTOK * 512 * 2;
constexpr size_t WS_OA  = WS_G   + (size_t)NTOK * 2048 * 2;
constexpr size_t WS_P   = WS_OA  + (size_t)NTOK * 256 * 2;
constexpr size_t WS_TMP = WS_P   + (size_t)NTOK * 512 * 2;
constexpr size_t WS_MIX = WS_TMP + (size_t)NTOK * DM * 4;
constexpr size_t WS_H   = WS_MIX + (size_t)NTOK * DM * 2;
constexpr size_t WS_SS  = WS_H   + (size_t)NTOK * DFF * 2;
constexpr size_t WS_ROPE = WS_SS + (size_t)9 * NTOK * 4;
constexpr size_t WS_BAR = WS_ROPE + (size_t)4104 * 16 * 4;
constexpr size_t WS_END = WS_BAR + (size_t)4096 * 4;

struct Params { const float* in[17]; float* out; unsigned char* ws; };

__device__ __forceinline__ void unpack8(const u32x4 w, float (&f)[8]) {
    f[0] = __uint_as_float(w.x << 16); f[1] = __uint_as_float(w.x & 0xffff0000u);
    f[2] = __uint_as_float(w.y << 16); f[3] = __uint_as_float(w.y & 0xffff0000u);
    f[4] = __uint_as_float(w.z << 16); f[5] = __uint_as_float(w.z & 0xffff0000u);
    f[6] = __uint_as_float(w.w << 16); f[7] = __uint_as_float(w.w & 0xffff0000u);
}
__device__ __forceinline__ u32x4 pack8(const float (&f)[8]) {
    u32x4 w; w.x = cvt_pk_bf16(f[0], f[1]); w.y = cvt_pk_bf16(f[2], f[3]); w.z = cvt_pk_bf16(f[4], f[5]); w.w = cvt_pk_bf16(f[6], f[7]); return w;
}
__device__ __forceinline__ float sigmoidf_(float x) { return __builtin_amdgcn_rcpf(1.0f + __builtin_amdgcn_exp2f(x * -1.44269504089f)); }

struct EpiAll {
    static constexpr bool PERM = true, AFTER_DRAIN = false;
    int mode, layer, ssi, ssn; unsigned char* ws; float* out;

    struct Pre { u32x4 g; f32x4 a, b; float rs; };

    template <int MODE> __device__ __forceinline__ Pre pre(unsigned char* ws, int row, int c) const {
        Pre p;
        if constexpr (MODE == 0 || MODE == 4) p.rs = ((const float*)(ws + WS_SS) + (size_t)ssi * NTOK)[row];
        if constexpr (MODE == 1) p.g = *(const u32x4*)((const bf16_t*)(ws + WS_G) + (size_t)row * 2048 + c);
        if constexpr (MODE == 2) { p.g = *(const u32x4*)((const bf16_t*)(ws + WS_G) + (size_t)row * 2048 + 1024 + c);
            const float* tp = (const float*)(ws + WS_TMP) + (size_t)row * DM + c; p.a = *(const f32x4*)tp; p.b = *(const f32x4*)(tp + 4); }
        if constexpr (MODE == 3) { const float* xp = (const float*)(ws + WS_X) + (size_t)row * DM + c; p.a = *(const f32x4*)xp; p.b = *(const f32x4*)(xp + 4); }
        return p;
    }
    __device__ __forceinline__ void fin_proj(unsigned char* ws, int row, int c32, int fq, float (&v)[8], const Pre& p) const {
        const int pn = c32 >> 8, cl = (c32 & 255) + 8 * fq;
        const float rs = __builtin_amdgcn_rsqf(p.rs * (1.0f / 1024.0f) + 1e-6f);
        const bool samp = row >= NTP;
        const int b = samp ? ((row - NTP) >> 3) : (row >> 12);
        const int t = samp ? (row & 7) : (row & 4095);
#pragma unroll
        for (int i = 0; i < 8; ++i) v[i] *= rs;
        if (pn < 6 && ((c32 >> 5) & 1) == 0) {
            float pv[8];
#pragma unroll
            for (int i = 0; i < 8; ++i) pv[i] = __shfl_xor(v[i], 16);
            if (fq < 2) {
                const int pi = samp ? (4096 + t) : t;
                const f32x4* rp = (const f32x4*)((const float*)(ws + WS_ROPE) + (size_t)pi * 16);
                const f32x4 c0 = rp[0], c1 = rp[1], s0 = rp[2], s1 = rp[3];
                const float sg = (fq == 0) ? -1.0f : 1.0f;
#pragma unroll
                for (int i = 0; i < 4; ++i) { v[i] = v[i] * c0[i] + sg * pv[i] * s0[i]; v[4 + i] = v[4 + i] * c1[i] + sg * pv[4 + i] * s1[i]; }
            }
        }
        if (pn >= 11) {
#pragma unroll
            for (int i = 0; i < 8; ++i) v[i] = sigmoidf_(v[i]);
        }
        bf16_t* dst; int ld, cbase;
        if (pn < 9) { dst = (bf16_t*)(ws + WS_QKV); ld = 2304; cbase = pn * 256; }
        else if (pn < 11) { dst = (bf16_t*)(ws + WS_U); ld = 512; cbase = (pn - 9) * 256; }
        else { dst = (bf16_t*)(ws + WS_G); ld = 2048; cbase = (pn - 11) * 256; }
        *(u32x4*)(dst + (size_t)row * ld + cbase + cl) = pack8(v);
        if (pn >= 3 && pn < 9) {
            const int kvi = pn - 3; const int g = (kvi >= 3) ? kvi - 3 : kvi; const int kv = (kvi >= 3) ? 1 : 0;
            const int W = 128 << (2 * g);
            const size_t okp = (g == 0) ? O_KVP0 : (g == 1 ? O_KVP1 : O_KVP2);
            const size_t oks = (g == 0) ? O_KVS0 : (g == 1 ? O_KVS1 : O_KVS2);
            float* op = nullptr;
            if (samp) op = out + oks + ((size_t)((layer * 32 + b) * W + (W - 8 + t)) * 2 + kv) * 256 + cl;
            else if (t >= TP - W) op = out + okp + ((size_t)((layer * 4 + b) * W + (t - (TP - W))) * 2 + kv) * 256 + cl;
            if (op) { *(f32x4*)op = (f32x4){v[0], v[1], v[2], v[3]}; *(f32x4*)(op + 4) = (f32x4){v[4], v[5], v[6], v[7]}; }
        } else if (pn >= 9 && pn < 11) {
            float* op = nullptr; const int c = cbase + cl;
            if (samp) op = out + O_POOLS + (size_t)((layer * 32 + b) * 15 + 7 + t) * 512 + c;
            else if (t >= TP - 15) op = out + O_POOLP + (size_t)((layer * 4 + b) * 15 + (t - (TP - 15))) * 512 + c;
            if (op) { *(f32x4*)op = (f32x4){v[0], v[1], v[2], v[3]}; *(f32x4*)(op + 4) = (f32x4){v[4], v[5], v[6], v[7]}; }
        }
    }
    template <int MODE> __device__ __forceinline__ void fin(unsigned char* ws, int row, int c32, int fq, float (&v)[8], const Pre& p) const {
        const int c = c32 + 8 * fq;
        if constexpr (MODE == 0) fin_proj(ws, row, c32, fq, v, p);
        if constexpr (MODE == 1) {
            float gg[8]; unpack8(p.g, gg);
            float* tp = (float*)(ws + WS_TMP) + (size_t)row * DM + c;
            *(f32x4*)tp = (f32x4){gg[0] * v[0], gg[1] * v[1], gg[2] * v[2], gg[3] * v[3]};
            *(f32x4*)(tp + 4) = (f32x4){gg[4] * v[4], gg[5] * v[5], gg[6] * v[6], gg[7] * v[7]};
        }
        if constexpr (MODE == 2) {
            float gg[8]; unpack8(p.g, gg);
#pragma unroll
            for (int i = 0; i < 4; ++i) { v[i] = p.a[i] + gg[i] * v[i]; v[4 + i] = p.b[i] + gg[4 + i] * v[4 + i]; }
            *(u32x4*)((bf16_t*)(ws + WS_MIX) + (size_t)row * DM + c) = pack8(v);
        }
        if constexpr (MODE == 3) {
            float* xp = (float*)(ws + WS_X) + (size_t)row * DM + c;
            float sq = 0.f;
#pragma unroll
            for (int i = 0; i < 4; ++i) { v[i] += p.a[i]; v[4 + i] += p.b[i]; }
#pragma unroll
            for (int i = 0; i < 8; ++i) sq += v[i] * v[i];
            *(f32x4*)xp = (f32x4){v[0], v[1], v[2], v[3]}; *(f32x4*)(xp + 4) = (f32x4){v[4], v[5], v[6], v[7]};
            *(u32x4*)((bf16_t*)(ws + WS_XB) + (size_t)row * DM + c) = pack8(v);
            sq += __shfl_xor(sq, 16); sq += __shfl_xor(sq, 32);
            if (fq == 0) atomicAdd((float*)(ws + WS_SS) + (size_t)ssn * NTOK + row, sq);
        }
        if constexpr (MODE == 4) {
            const float rs = __builtin_amdgcn_rsqf(p.rs * (1.0f / 1024.0f) + 1e-6f);
#pragma unroll
            for (int i = 0; i < 8; ++i) { const float a = fmaxf(v[i] * rs, 0.f); v[i] = a * a; }
            *(u32x4*)((bf16_t*)(ws + WS_H) + (size_t)row * DFF + c) = pack8(v);
        }
    }
    __device__ __forceinline__ void chunk(unsigned char* ws, int row, int c32, int fq, float (&v)[8]) const {
        const int c = c32 + 8 * fq;
        switch (mode) {
            case 0: { const Pre p = pre<0>(ws, row, c); fin<0>(ws, row, c32, fq, v, p); } break;
            case 1: { const Pre p = pre<1>(ws, row, c); fin<1>(ws, row, c32, fq, v, p); } break;
            case 2: { const Pre p = pre<2>(ws, row, c); fin<2>(ws, row, c32, fq, v, p); } break;
            case 3: { const Pre p = pre<3>(ws, row, c); fin<3>(ws, row, c32, fq, v, p); } break;
            default: { const Pre p = pre<4>(ws, row, c); fin<4>(ws, row, c32, fq, v, p); } break;
        }
    }
    template <int MODE> __device__ __forceinline__ void tile(unsigned char* ws, const f32x4 (&acc)[2][2][4][2], const Unit& u, int wr, int wc, int fr, int fq) const {
        constexpr int MB = (MODE == 2 || MODE == 3) ? 2 : 4;
#pragma unroll
        for (int ai = 0; ai < 2; ++ai)
#pragma unroll
            for (int m0 = 0; m0 < 4; m0 += MB) {
                Pre p[MB][2];
#pragma unroll
                for (int mm = 0; mm < MB; ++mm)
#pragma unroll
                    for (int bj = 0; bj < 2; ++bj) p[mm][bj] = pre<MODE>(ws, u.pm * 256 + ai * 128 + wr * 64 + (m0 + mm) * 16 + fr, u.pn * 256 + bj * 128 + wc * 32 + 8 * fq);
#pragma unroll
                for (int mm = 0; mm < MB; ++mm)
#pragma unroll
                    for (int bj = 0; bj < 2; ++bj) {
                        float v[8];
#pragma unroll
                        for (int i = 0; i < 4; ++i) { v[i] = acc[ai][bj][m0 + mm][0][i]; v[4 + i] = acc[ai][bj][m0 + mm][1][i]; }
                        fin<MODE>(ws, u.pm * 256 + ai * 128 + wr * 64 + (m0 + mm) * 16 + fr, u.pn * 256 + bj * 128 + wc * 32, fq, v, p[mm][bj]);
                    }
                asm volatile("" ::: "memory");
            }
    }
    __device__ __forceinline__ void operator()(const f32x4 (&acc)[2][2][4][2], const Unit& u, int wr, int wc, int fr, int fq) const {
        asm volatile("" : "+v"(fr), "+v"(fq));
        size_t zoff = 0; asm volatile("" : "+s"(zoff));
        unsigned char* ws = this->ws + zoff;
        switch (mode) {
            case 0: tile<0>(ws, acc, u, wr, wc, fr, fq); break;
            case 1: tile<1>(ws, acc, u, wr, wc, fr, fq); break;
            case 2: tile<2>(ws, acc, u, wr, wc, fr, fq); break;
            case 3: tile<3>(ws, acc, u, wr, wc, fr, fq); break;
            default: tile<4>(ws, acc, u, wr, wc, fr, fq); break;
        }
    }
};

__device__ __forceinline__ void skinny_gemm(LAS unsigned char* lds, const bf16_t* __restrict__ A, const bf16_t* __restrict__ Bt, int N, int K, const EpiAll& E, int first, int G) {
    using pg8::bf16x8;
    int tid = threadIdx.x; asm volatile("" : "+v"(tid));
    const int lane = tid & 63, w = __builtin_amdgcn_readfirstlane(tid >> 6), kg = lane >> 4, qn = lane & 15;
    const int nh = (N == 1024) ? 1 : 2, ksplit = 8 / nh;
    const int half = w % nh, kq = w / nh, Kq = K / ksplit, nsteps = Kq >> 5;
    size_t zoff = 0; asm volatile("" : "+s"(zoff));
    unsigned char* ws = E.ws + zoff;
    LAS float* red = (LAS float*)lds;
    const int RB = 8 / nh, units = RB * (N >> 5);
#pragma unroll 1
    for (int u = first; u < units; u += G) {
        const int rb = u % RB, c32 = (u / RB) << 5;
        const int row0 = rb * 32 * nh + half * 32;
        const bf16_t* ap = A + (size_t)(row0 + qn) * K + kq * Kq + kg * 8;
        const bf16_t* bp = Bt + (size_t)(c32 + 8 * (qn >> 2) + (qn & 3)) * K + kq * Kq + kg * 8;
        f32x4 acc[2][2];
#pragma unroll
        for (int a = 0; a < 2; ++a)
#pragma unroll
            for (int b = 0; b < 2; ++b) acc[a][b] = (f32x4){0.f, 0.f, 0.f, 0.f};
#pragma unroll 8
        for (int ks = 0; ks < nsteps; ++ks) {
            const bf16x8 x0 = *(const bf16x8*)(ap + ks * 32), x1 = *(const bf16x8*)(ap + (size_t)16 * K + ks * 32);
            const bf16x8 w0 = *(const bf16x8*)(bp + ks * 32), w1 = *(const bf16x8*)(bp + (size_t)4 * K + ks * 32);
            acc[0][0] = __builtin_amdgcn_mfma_f32_16x16x32_bf16(w0, x0, acc[0][0], 0, 0, 0);
            acc[0][1] = __builtin_amdgcn_mfma_f32_16x16x32_bf16(w1, x0, acc[0][1], 0, 0, 0);
            acc[1][0] = __builtin_amdgcn_mfma_f32_16x16x32_bf16(w0, x1, acc[1][0], 0, 0, 0);
            acc[1][1] = __builtin_amdgcn_mfma_f32_16x16x32_bf16(w1, x1, acc[1][1], 0, 0, 0);
        }
        __syncthreads();
        if (kq != 0) {
#pragma unroll
            for (int a = 0; a < 2; ++a)
#pragma unroll
                for (int b = 0; b < 2; ++b)
#pragma unroll
                    for (int i = 0; i < 4; ++i) red[(w * 16 + a * 8 + b * 4 + i) * 64 + lane] = acc[a][b][i];
        }
        __syncthreads();
        if (kq == 0) {
#pragma unroll 1
            for (int q = 1; q < ksplit; ++q)
#pragma unroll
                for (int a = 0; a < 2; ++a)
#pragma unroll
                    for (int b = 0; b < 2; ++b)
#pragma unroll
                        for (int i = 0; i < 4; ++i) acc[a][b][i] += red[((w + nh * q) * 16 + a * 8 + b * 4 + i) * 64 + lane];
#pragma unroll
            for (int a = 0; a < 2; ++a) {
                float v[8];
#pragma unroll
                for (int i = 0; i < 4; ++i) { v[i] = acc[a][0][i]; v[4 + i] = acc[a][1][i]; }
                E.chunk(ws, NTP + row0 + a * 16 + qn, c32, kg, v);
            }
        }
    }
    __syncthreads();
}

__device__ __forceinline__ void lds_wait() { asm volatile("s_waitcnt lgkmcnt(0)" ::: "memory"); }
__device__ __forceinline__ void transpose_item(const float* __restrict__ W, const float* __restrict__ gsc, int K, int N, bf16_t* __restrict__ WT, LAS float* scr, int item, int lane) {
    const int nblk = N / 64, kb = item / nblk, nb = item % nblk, k0 = 64 * kb, n0 = 64 * nb;
    f32x4 v[16];
#pragma unroll
    for (int i = 0; i < 16; ++i) v[i] = *(const f32x4*)(W + (size_t)(k0 + 4 * i + (lane >> 4)) * N + n0 + 4 * (lane & 15));
#pragma unroll
    for (int i = 0; i < 16; ++i) { const int kk = 4 * i + (lane >> 4); const float sc = gsc ? gsc[k0 + kk] : 1.0f; LAS float* d = scr + kk * 65 + 4 * (lane & 15);
        d[0] = v[i][0] * sc; d[1] = v[i][1] * sc; d[2] = v[i][2] * sc; d[3] = v[i][3] * sc; }
    lds_wait();
    const int c = lane & 7;
#pragma unroll
    for (int j = 0; j < 8; ++j) { const int n = (lane >> 3) + 8 * j; const LAS float* sp = scr + (8 * c) * 65 + n;
        u32x4 o; o.x = cvt_pk_bf16(sp[0 * 65], sp[1 * 65]); o.y = cvt_pk_bf16(sp[2 * 65], sp[3 * 65]); o.z = cvt_pk_bf16(sp[4 * 65], sp[5 * 65]); o.w = cvt_pk_bf16(sp[6 * 65], sp[7 * 65]);
        *(u32x4*)(WT + (size_t)(n0 + n) * K + k0 + 8 * c) = o; }
    lds_wait();
}

template <int L>
__device__ __forceinline__ void copy_shift(const float* __restrict__ src, float* __restrict__ dst, int layer, size_t gtid, size_t nth) {
    constexpr size_t per = (size_t)(L - 8) * 128;
    constexpr size_t total = (size_t)32 * per;
    constexpr int U = 8;
    const f32x4* s4 = (const f32x4*)src + (size_t)layer * 32 * L * 128; f32x4* d4 = (f32x4*)dst + (size_t)layer * 32 * L * 128;
    for (size_t i = gtid; i < total; i += nth * U) {
        f32x4 v[U];
#pragma unroll
        for (int u = 0; u < U; ++u) { const size_t idx = i + u * nth; const size_t ii = idx < total ? idx : 0; const size_t lb = ii / per, r = ii - lb * per;
            v[u] = __builtin_nontemporal_load(s4 + lb * (size_t)L * 128 + r + 8 * 128); }
#pragma unroll
        for (int u = 0; u < U; ++u) { const size_t idx = i + u * nth; if (idx < total) { const size_t lb = idx / per, r = idx - lb * per; __builtin_nontemporal_store(v[u], d4 + lb * (size_t)L * 128 + r); } }
    }
}

#define ATT_DOT(S, Q, KF) do { float _s = 0.f; _Pragma("unroll") for (int _i = 0; _i < 8; ++_i) _s += Q[_i] * KF[_i]; \
    _s += __shfl_xor(_s, 1); _s += __shfl_xor(_s, 2); _s += __shfl_xor(_s, 4); S = _s; } while (0)

__device__ __forceinline__ void attn_finish(float m, float l, float (&o)[8], bf16_t* dstp, int kg) {
    float M = m; M = fmaxf(M, __shfl_xor(M, 8)); M = fmaxf(M, __shfl_xor(M, 16)); M = fmaxf(M, __shfl_xor(M, 32));
    const float f = __expf(m - M); l *= f;
#pragma unroll
    for (int i = 0; i < 8; ++i) o[i] *= f;
    l += __shfl_xor(l, 8); l += __shfl_xor(l, 16); l += __shfl_xor(l, 32);
#pragma unroll
    for (int i = 0; i < 8; ++i) { o[i] += __shfl_xor(o[i], 8); o[i] += __shfl_xor(o[i], 16); o[i] += __shfl_xor(o[i], 32); }
    const float inv = 1.0f / l;
#pragma unroll
    for (int i = 0; i < 8; ++i) o[i] *= inv;
    if (kg == 0) *(u32x4*)dstp = pack8(o);
}

__device__ __forceinline__ void attn_prompt_item(const bf16_t* __restrict__ qkv, bf16_t* __restrict__ oa, int token, int h, int lane) {
    const int kg = lane >> 3, dl = lane & 7;
    const int b = token >> 12, t = token & 4095;
    const bf16_t* qrow = qkv + (size_t)token * 2304 + h * 64 + dl * 8;
    const bf16_t* kbase = qkv + (size_t)(b << 12) * 2304 + 768 + h * 64 + dl * 8;
    float m = -1e30f, l = 0.f; float o[8];
#pragma unroll
    for (int i = 0; i < 8; ++i) o[i] = 0.f;
#pragma unroll 1
    for (int g = 0; g < 3; ++g) {
        const int d = 1 << (2 * g);
        float q[8]; unpack8(*(const u32x4*)(qrow + g * 256), q);
#pragma unroll
        for (int i = 0; i < 8; ++i) q[i] *= 0.125f;
        const bf16_t* kb = kbase + g * 256;
#pragma unroll 1
        for (int it = 0; it < 16; it += 4) {
            u32x4 kr[4], vr[4]; bool val[4];
#pragma unroll
            for (int u = 0; u < 4; ++u) { const int j = (it + u) * 8 + kg; const int pos = t - j * d; val[u] = pos >= 0; const bf16_t* r = kb + (size_t)(pos < 0 ? 0 : pos) * 2304;
                kr[u] = *(const u32x4*)r; vr[u] = *(const u32x4*)(r + 768); }
            float s[4];
#pragma unroll
            for (int u = 0; u < 4; ++u) { float kf[8]; unpack8(kr[u], kf); ATT_DOT(s[u], q, kf); if (!val[u]) s[u] = -1e30f; }
            const float mb = fmaxf(fmaxf(m, fmaxf(s[0], s[1])), fmaxf(s[2], s[3]));
            const float corr = __expf(m - mb);
            l *= corr;
#pragma unroll
            for (int i = 0; i < 8; ++i) o[i] *= corr;
#pragma unroll
            for (int u = 0; u < 4; ++u) { const float p = val[u] ? __expf(s[u] - mb) : 0.f; l += p; float vf[8]; unpack8(vr[u], vf);
#pragma unroll
                for (int i = 0; i < 8; ++i) o[i] += p * vf[i]; }
            m = mb;
        }
    }
    {
        const int g = kg < 2 ? kg : 2; const int d = 1 << (2 * g);
        const int pos = t - 128 * d; const bool val = (kg < 3) && (pos >= 0);
        float q[8]; unpack8(*(const u32x4*)(qrow + g * 256), q);
        const bf16_t* r = kbase + g * 256 + (size_t)(pos < 0 ? 0 : pos) * 2304;
        float kf[8], vf[8]; unpack8(*(const u32x4*)r, kf); unpack8(*(const u32x4*)(r + 768), vf);
        float s; ATT_DOT(s, q, kf); s *= 0.125f;
        if (!val) s = -1e30f;
        const float mb = fmaxf(m, s); const float corr = __expf(m - mb); const float p = val ? __expf(s - mb) : 0.f;
        l = l * corr + p;
#pragma unroll
        for (int i = 0; i < 8; ++i) o[i] = o[i] * corr + p * vf[i];
        m = mb;
    }
    attn_finish(m, l, o, oa + (size_t)token * 256 + h * 64 + dl * 8, kg);
}

__device__ __forceinline__ void sample_kv(const bf16_t* __restrict__ newb, const float* __restrict__ cb, int W, int idx, float (&kf)[8], float (&vf)[8]) {
    if (idx >= W) { const bf16_t* r = newb + (size_t)(idx - W) * 2304; unpack8(*(const u32x4*)r, kf); unpack8(*(const u32x4*)(r + 768), vf); }
    else { const float* r = cb + (size_t)idx * 512; const f32x4 a = *(const f32x4*)r, b2 = *(const f32x4*)(r + 4), c = *(const f32x4*)(r + 256), d2 = *(const f32x4*)(r + 260);
#pragma unroll
        for (int i = 0; i < 4; ++i) { kf[i] = a[i]; kf[4 + i] = b2[i]; vf[i] = c[i]; vf[4 + i] = d2[i]; } }
}
__device__ __forceinline__ void attn_sample_sub(const bf16_t* __restrict__ qkv, const float* __restrict__ cg_, bf16_t* __restrict__ PO, float* __restrict__ LSE,
                                                int layer, int stok, int h, int g, int lane) {
    const int kg = lane >> 3, dl = lane & 7;
    const int b = stok >> 3, t = stok & 7;
    const int token = NTP + stok;
    const int d = 1 << (2 * g), W = 128 << (2 * g);
    const bf16_t* nb = qkv + (size_t)(NTP + b * 8) * 2304 + 768 + g * 256 + h * 64 + dl * 8;
    const float* cb = cg_ + (size_t)(layer * 32 + b) * W * 512 + h * 64 + dl * 8;
    float q[8]; unpack8(*(const u32x4*)(qkv + (size_t)token * 2304 + g * 256 + h * 64 + dl * 8), q);
#pragma unroll
    for (int i = 0; i < 8; ++i) q[i] *= 0.125f;
    float m = -1e30f, l = 0.f; float o[8];
#pragma unroll
    for (int i = 0; i < 8; ++i) o[i] = 0.f;
#pragma unroll 1
    for (int it = 0; it < 16; it += 8) {
        float kf[8][8], vf[8][8], s[8];
#pragma unroll
        for (int u = 0; u < 8; ++u) { const int j = (it + u) * 8 + kg; sample_kv(nb, cb, W, W + t - j * d, kf[u], vf[u]); }
        float mb = m;
#pragma unroll
        for (int u = 0; u < 8; ++u) { ATT_DOT(s[u], q, kf[u]); mb = fmaxf(mb, s[u]); }
        const float corr = __expf(m - mb);
        l *= corr;
#pragma unroll
        for (int i = 0; i < 8; ++i) o[i] *= corr;
#pragma unroll
        for (int u = 0; u < 8; ++u) { const float p = __expf(s[u] - mb); l += p;
#pragma unroll
            for (int i = 0; i < 8; ++i) o[i] += p * vf[u][i]; }
        m = mb;
    }
    {
        const bool val = kg == 0;
        float kf[8], vf[8]; sample_kv(nb, cb, W, W + t - 128 * d, kf, vf);
        float s; ATT_DOT(s, q, kf);
        if (!val) s = -1e30f;
        const float mb = fmaxf(m, s); const float corr = __expf(m - mb); const float p = val ? __expf(s - mb) : 0.f;
        l = l * corr + p;
#pragma unroll
        for (int i = 0; i < 8; ++i) o[i] = o[i] * corr + p * vf[i];
        m = mb;
    }
    float M = m; M = fmaxf(M, __shfl_xor(M, 8)); M = fmaxf(M, __shfl_xor(M, 16)); M = fmaxf(M, __shfl_xor(M, 32));
    const float f = __expf(m - M); l *= f;
#pragma unroll
    for (int i = 0; i < 8; ++i) o[i] *= f;
    l += __shfl_xor(l, 8); l += __shfl_xor(l, 16); l += __shfl_xor(l, 32);
#pragma unroll
    for (int i = 0; i < 8; ++i) { o[i] += __shfl_xor(o[i], 8); o[i] += __shfl_xor(o[i], 16); o[i] += __shfl_xor(o[i], 32); }
    const float inv = 1.0f / l;
#pragma unroll
    for (int i = 0; i < 8; ++i) o[i] *= inv;
    if (kg == 0) *(u32x4*)(PO + ((size_t)g * NTOK + token) * 256 + h * 64 + dl * 8) = pack8(o);
    if (lane == 0) LSE[((size_t)g * NTOK + token) * 4 + h] = M + __logf(l);
}

constexpr int ATT_PITCH = 144, ATT_ROWS = 272, ATT_VOFF = ATT_ROWS * ATT_PITCH;
typedef short s16x4 __attribute__((ext_vector_type(4)));
template <int OFF> __device__ __forceinline__ s16x4 tr_read(unsigned addr) { s16x4 r; asm volatile("ds_read_b64_tr_b16 %0, %1 offset:%2" : "=v"(r) : "v"(addr), "n"(OFF) : "memory"); return r; }
__device__ __forceinline__ void tr_wait8(s16x4& a, s16x4& b, s16x4& c, s16x4& d, s16x4& e, s16x4& f, s16x4& g, s16x4& h) {
    asm volatile("s_waitcnt lgkmcnt(0)" : "+v"(a), "+v"(b), "+v"(c), "+v"(d), "+v"(e), "+v"(f), "+v"(g), "+v"(h) :: "memory"); }

__device__ __forceinline__ void attn_mfma_phase(LAS unsigned char* lds, const bf16_t* __restrict__ QKV, bf16_t* __restrict__ PO, float* __restrict__ LSE, int bid, int G, int tid) {
    using pg8::bf16x8;
    const int lane = tid & 63, w = __builtin_amdgcn_readfirstlane(tid >> 6), kg = lane >> 4, qn = lane & 15;
    for (int i = tid; i < 2 * 144; i += NTHREADS) { const int kv = i / 144, rem = i - kv * 144; *(LAS u32x4*)(lds + kv * ATT_VOFF + 256 * ATT_PITCH + rem * 16) = (u32x4){0u, 0u, 0u, 0u}; }
    const unsigned vaddr = (unsigned)(uintptr_t)(lds + ATT_VOFF + (16 * w + 4 * kg + (qn >> 2)) * ATT_PITCH + (lane & 3) * 8);
    const float csc = 0.125f * 1.44269504089f;
#define ATT_DECODE(U, b_, h_, g_, r_, I0_) do { const int _bh = (U) / 96, _rest = (U) - _bh * 96; b_ = _bh >> 2; h_ = _bh & 3; \
        if (_rest < 32) { g_ = 0; r_ = 0; I0_ = 128 * _rest; } else if (_rest < 64) { g_ = 1; r_ = (_rest - 32) >> 3; I0_ = 128 * ((_rest - 32) & 7); } else { g_ = 2; r_ = (_rest - 64) >> 1; I0_ = 128 * ((_rest - 64) & 1); } } while (0)
#define ATT_FETCH(U) do { int _b, _h, _g, _r, _I0; ATT_DECODE(U, _b, _h, _g, _r, _I0); const int _d = 1 << (2 * _g); \
        _Pragma("unroll") for (int i = 0; i < 8; ++i) { const int kv = i >> 2, row = (tid >> 3) + 64 * (i & 3), ch = tid & 7; const int I = _I0 - 128 + row; \
            pf[i] = (u32x4){0u, 0u, 0u, 0u}; \
            if (I >= 0) pf[i] = *(const u32x4*)(QKV + (size_t)(_b * 4096 + _r + _d * I) * 2304 + 768 + kv * 768 + _g * 256 + _h * 64 + ch * 8); } \
        const bf16_t* _qp = QKV + ((size_t)_b * 4096 + _r + _d * (_I0 + 16 * w + qn)) * 2304 + _g * 256 + _h * 64 + kg * 8; \
        qf0 = *(const bf16x8*)_qp; qf1 = *(const bf16x8*)(_qp + 32); } while (0)
    u32x4 pf[8]; bf16x8 qf0, qf1;
    if (bid < 1536) ATT_FETCH(bid);
#pragma unroll 1
    for (int u = bid; u < 1536; u += G) {
        int b, h, g, r, I0; ATT_DECODE(u, b, h, g, r, I0);
        const int d = 1 << (2 * g);
        __syncthreads();
#pragma unroll
        for (int i = 0; i < 8; ++i) { const int kv = i >> 2, row = (tid >> 3) + 64 * (i & 3), ch = tid & 7; *(LAS u32x4*)(lds + kv * ATT_VOFF + row * ATT_PITCH + ch * 16) = pf[i]; }
        const bf16x8 q0 = qf0, q1 = qf1;
        __syncthreads();
        if (u + G < 1536) ATT_FETCH(u + G);
        const int Iq = I0 + 16 * w + qn; const size_t tokq = (size_t)b * 4096 + r + d * Iq;
        f32x4 sc[9];
        const LAS unsigned char* kb = lds + (16 * w + qn) * ATT_PITCH + kg * 16;
#pragma unroll
        for (int kt = 0; kt < 9; ++kt) { const bf16x8 k0 = *(const LAS bf16x8*)(kb + kt * 16 * ATT_PITCH), k1 = *(const LAS bf16x8*)(kb + kt * 16 * ATT_PITCH + 64);
            f32x4 z = (f32x4){0.f, 0.f, 0.f, 0.f}; z = __builtin_amdgcn_mfma_f32_16x16x32_bf16(k0, q0, z, 0, 0, 0); sc[kt] = __builtin_amdgcn_mfma_f32_16x16x32_bf16(k1, q1, z, 0, 0, 0); }
        const int jb = 128 + qn - 4 * kg, ikb = I0 - 128 + 16 * w + 4 * kg;
        float m = -1e30f;
#pragma unroll
        for (int kt = 0; kt < 9; ++kt)
#pragma unroll
            for (int i = 0; i < 4; ++i) { const int j = jb - 16 * kt - i; const bool val = (j >= 0) && (j <= 128) && (ikb + 16 * kt + i >= 0); sc[kt][i] = val ? sc[kt][i] : -1e30f; m = fmaxf(m, sc[kt][i]); }
        m = fmaxf(m, __shfl_xor(m, 16)); m = fmaxf(m, __shfl_xor(m, 32));
        const float mc = m * csc; float l = 0.f;
        unsigned pk[10][2];
#pragma unroll
        for (int kt = 0; kt < 9; ++kt) { float p[4];
#pragma unroll
            for (int i = 0; i < 4; ++i) { p[i] = (sc[kt][i] > -1e29f) ? __builtin_amdgcn_exp2f(sc[kt][i] * csc - mc) : 0.f; l += p[i]; }
            pk[kt][0] = cvt_pk_bf16(p[0], p[1]); pk[kt][1] = cvt_pk_bf16(p[2], p[3]); }
        pk[9][0] = 0u; pk[9][1] = 0u;
        l += __shfl_xor(l, 16); l += __shfl_xor(l, 32);
        f32x4 o[4];
#pragma unroll
        for (int dt = 0; dt < 4; ++dt) o[dt] = (f32x4){0.f, 0.f, 0.f, 0.f};
#define ATT_PV(KK) do { s16x4 a0 = tr_read<(KK) * 32 * ATT_PITCH + 0>(vaddr), a1 = tr_read<(KK) * 32 * ATT_PITCH + 32>(vaddr), a2 = tr_read<(KK) * 32 * ATT_PITCH + 64>(vaddr), a3 = tr_read<(KK) * 32 * ATT_PITCH + 96>(vaddr); \
            s16x4 c0 = tr_read<(KK) * 32 * ATT_PITCH + 16 * ATT_PITCH + 0>(vaddr), c1 = tr_read<(KK) * 32 * ATT_PITCH + 16 * ATT_PITCH + 32>(vaddr), c2 = tr_read<(KK) * 32 * ATT_PITCH + 16 * ATT_PITCH + 64>(vaddr), c3 = tr_read<(KK) * 32 * ATT_PITCH + 16 * ATT_PITCH + 96>(vaddr); \
            tr_wait8(a0, a1, a2, a3, c0, c1, c2, c3); \
            u32x4 pw; pw.x = pk[2 * (KK)][0]; pw.y = pk[2 * (KK)][1]; pw.z = pk[2 * (KK) + 1][0]; pw.w = pk[2 * (KK) + 1][1]; \
            const bf16x8 pf = __builtin_bit_cast(bf16x8, pw); \
            o[0] = __builtin_amdgcn_mfma_f32_16x16x32_bf16(__builtin_shufflevector(a0, c0, 0, 1, 2, 3, 4, 5, 6, 7), pf, o[0], 0, 0, 0); \
            o[1] = __builtin_amdgcn_mfma_f32_16x16x32_bf16(__builtin_shufflevector(a1, c1, 0, 1, 2, 3, 4, 5, 6, 7), pf, o[1], 0, 0, 0); \
            o[2] = __builtin_amdgcn_mfma_f32_16x16x32_bf16(__builtin_shufflevector(a2, c2, 0, 1, 2, 3, 4, 5, 6, 7), pf, o[2], 0, 0, 0); \
            o[3] = __builtin_amdgcn_mfma_f32_16x16x32_bf16(__builtin_shufflevector(a3, c3, 0, 1, 2, 3, 4, 5, 6, 7), pf, o[3], 0, 0, 0); } while (0)
        ATT_PV(0); ATT_PV(1); ATT_PV(2); ATT_PV(3); ATT_PV(4);
        const float il = 1.0f / l;
        bf16_t* op = PO + ((size_t)g * NTOK + tokq) * 256 + h * 64 + 4 * kg;
#pragma unroll
        for (int dt = 0; dt < 4; ++dt) { u32x2 wv; wv.x = cvt_pk_bf16(o[dt][0] * il, o[dt][1] * il); wv.y = cvt_pk_bf16(o[dt][2] * il, o[dt][3] * il); *(u32x2*)(op + 16 * dt) = wv; }
        if (kg == 0) LSE[((size_t)g * NTOK + tokq) * 4 + h] = m * 0.125f + __logf(l);
    }
#undef ATT_PV
#undef ATT_FETCH
#undef ATT_DECODE
}

#define XB_TMO      128
#define XB_XCNT(j)  (256  + 64 * (j))
#define XB_XSUB(j)  (1280 + 64 * (j))
#define XB_XGEN(j)  (2304 + 64 * (j))
#define XB_TOP      3328
#define XB_TOPGEN   3392
#define XCD_BAR_WORDS 3456
#define XB_SPIN_CAP (1u << 20)
__device__ __forceinline__ unsigned xb_ld(unsigned* p)              { return __hip_atomic_load(p, __ATOMIC_RELAXED, __HIP_MEMORY_SCOPE_AGENT); }
__device__ __forceinline__ unsigned xb_add(unsigned* p, unsigned v) { return __hip_atomic_fetch_add(p, v, __ATOMIC_RELAXED, __HIP_MEMORY_SCOPE_AGENT); }
__device__ __forceinline__ unsigned xb_xcc_id() { return (unsigned)__builtin_amdgcn_s_getreg((3 << 11) | 20) & 0xFu; }
#define XB_SPIN(cond, bar) do { unsigned _sp = 0; while (cond) { __builtin_amdgcn_s_sleep(1); \
    if ((++_sp & 255u) == 0u) { if (xb_ld(&(bar)[XB_TMO])) break; if (_sp > XB_SPIN_CAP) { atomicAdd(&(bar)[XB_TMO], 1u); break; } } } } while (0)
struct XcdBarrier { unsigned* bar; unsigned x; volatile LAS unsigned* st; };
__device__ __forceinline__ XcdBarrier xcd_barrier_post(unsigned* bar, volatile LAS unsigned* st) {
    XcdBarrier b; b.bar = bar; b.x = xb_xcc_id(); b.st = st;
    if (threadIdx.x == 0) (void)xb_add(&bar[XB_XCNT(b.x)], 1u);
    return b;
}
__device__ __forceinline__ void xcd_barrier_complete(unsigned* bar, unsigned x, unsigned& nloc, unsigned& nx) {
    const unsigned G = gridDim.x * gridDim.y * gridDim.z;
    unsigned sum, cnt, mine, sp = 0u;
    for (;;) {
        sum = 0u; cnt = 0u; mine = 0u;
#pragma unroll
        for (unsigned j = 0; j < 16; ++j) { const unsigned c = xb_ld(&bar[XB_XCNT(j)]); sum += c; cnt += (c > 0u) ? 1u : 0u; mine = (j == x) ? c : mine; }
        if (sum == G) break;
        __builtin_amdgcn_s_sleep(1);
        if ((++sp & 255u) == 0u) { if (xb_ld(&bar[XB_TMO])) break; if (sp > XB_SPIN_CAP) { atomicAdd(&bar[XB_TMO], 1u); break; } }
    }
    nloc = mine > 0u ? mine : 1u; nx = cnt > 0u ? cnt : 1u;
}
__device__ __forceinline__ void xcd_barrier(const XcdBarrier& b) {
    asm volatile("s_waitcnt vmcnt(0)" ::: "memory");
    __syncthreads();
    if (threadIdx.x == 0) {
        unsigned* bar = b.bar;
        __builtin_amdgcn_s_waitcnt(0);
        unsigned nloc = b.st[0], nx = b.st[1];
        if (nloc == 0u) { xcd_barrier_complete(bar, b.x, nloc, nx); b.st[0] = nloc; b.st[1] = nx; }
        const unsigned old = xb_add(&bar[XB_XSUB(b.x)], 1u);
        const unsigned gen = old / nloc;
        if (old + 1u == (gen + 1u) * nloc) {
            __builtin_amdgcn_fence(__ATOMIC_RELEASE, "agent");
            asm volatile("s_waitcnt vmcnt(0)" ::: "memory");
            const unsigned og = xb_add(&bar[XB_TOP], 1u);
            const unsigned tg = og / nx;
            if (og + 1u == (tg + 1u) * nx) xb_add(&bar[XB_TOPGEN], 1u);
            else XB_SPIN(xb_ld(&bar[XB_TOPGEN]) == tg, bar);
            __builtin_amdgcn_fence(__ATOMIC_ACQUIRE, "agent");
            xb_add(&bar[XB_XGEN(b.x)], 1u);
            asm volatile("s_waitcnt vmcnt(0)" ::: "memory");
        } else {
            XB_SPIN(xb_ld(&bar[XB_XGEN(b.x)]) == gen, bar);
            __builtin_amdgcn_fence(__ATOMIC_ACQUIRE, "agent");
            asm volatile("s_waitcnt vmcnt(0)" ::: "memory");
        }
    }
    __syncthreads();
}

template <int GP> __device__ __forceinline__ void pool_item(const bf16_t* __restrict__ UB, bf16_t* __restrict__ PB, const float* __restrict__ sp, int tb, int cl) {
    constexpr int W = 2 << GP, NR = W + 7;
    const int c = (GP * 16 + cl) * 8;
    const int token0 = tb * 8; const bool samp = token0 >= NTP; const int t0 = samp ? 0 : (token0 & 4095); const int b = (token0 - NTP) >> 3;
    u32x4 R[NR];
#pragma unroll
    for (int r = 0; r < NR; ++r) { const int dt = r - (W - 1);
        if (dt >= 0 || t0 + dt >= 0) R[r] = *(const u32x4*)(UB + (size_t)(token0 + dt) * 512 + c);
        else if (samp) { const float* q = sp + (size_t)(b * 15 + 15 + dt) * 512 + c; const f32x4 a = *(const f32x4*)q, b2 = *(const f32x4*)(q + 4);
            R[r].x = cvt_pk_bf16(a[0], a[1]); R[r].y = cvt_pk_bf16(a[2], a[3]); R[r].z = cvt_pk_bf16(b2[0], b2[1]); R[r].w = cvt_pk_bf16(b2[2], b2[3]); }
        else R[r] = (u32x4){0u, 0u, 0u, 0u}; }
#pragma unroll
    for (int j = 0; j < 8; ++j) {
        float sum[8];
#pragma unroll
        for (int k = 0; k < 8; ++k) sum[k] = 0.f;
#pragma unroll
        for (int i = 0; i < W; ++i) { float f[8]; unpack8(R[j + (W - 1) - i], f);
#pragma unroll
            for (int k = 0; k < 8; ++k) sum[k] += f[k]; }
        float ut[8]; unpack8(R[j + W - 1], ut);
        const int t = t0 + j; const float cnt = samp ? (float)W : (float)(W < t + 1 ? W : t + 1); const float ic = 1.0f / cnt;
        float p[8];
#pragma unroll
        for (int k = 0; k < 8; ++k) p[k] = sum[k] * ic - ut[k];
        *(u32x4*)(PB + (size_t)(token0 + j) * 512 + c) = pack8(p);
    }
}

__global__ void __launch_bounds__(NTHREADS, 2) fwd_megakernel(Params P) {
    extern __shared__ __attribute__((aligned(16))) unsigned char lds_raw[];
    LAS unsigned char* lds = (LAS unsigned char*)lds_raw;
    cg::grid_group grid = cg::this_grid();
    const int tid = threadIdx.x, lane = tid & 63, wave = __builtin_amdgcn_readfirstlane(tid >> 6);
    const int G = gridDim.x, bid = blockIdx.x;
    const int gw = bid * 8 + wave, NGW = G * 8;
    const size_t gtid = (size_t)bid * NTHREADS + tid, nth = (size_t)G * NTHREADS;
    unsigned char* ws = P.ws;
    bf16_t* Wt_in = (bf16_t*)(ws + WS_WIN); bf16_t* Wt_pa = (bf16_t*)(ws + WS_WPA); bf16_t* Wt_pb = (bf16_t*)(ws + WS_WPB);
    bf16_t* Wt_o = (bf16_t*)(ws + WS_WO); bf16_t* Wt_up = (bf16_t*)(ws + WS_WUP); bf16_t* Wt_dn = (bf16_t*)(ws + WS_WDN);
    float* X = (float*)(ws + WS_X); bf16_t* XB = (bf16_t*)(ws + WS_XB); bf16_t* QKV = (bf16_t*)(ws + WS_QKV); bf16_t* UB = (bf16_t*)(ws + WS_U);
    bf16_t* GT = (bf16_t*)(ws + WS_G); bf16_t* OA = (bf16_t*)(ws + WS_OA); bf16_t* PB = (bf16_t*)(ws + WS_P); float* TMP = (float*)(ws + WS_TMP);
    bf16_t* MIX = (bf16_t*)(ws + WS_MIX); bf16_t* HID = (bf16_t*)(ws + WS_H); float* SS = (float*)(ws + WS_SS); float* ROPE = (float*)(ws + WS_ROPE);
    float* out = P.out;
    volatile LAS unsigned* bst = (volatile LAS unsigned*)(lds + LDS_BYTES - 16);
    if (tid == 0) { bst[0] = 0u; bst[1] = 0u; }
    __syncthreads();
    const XcdBarrier xb = xcd_barrier_post((unsigned*)(ws + WS_BAR), bst);

    {
        LAS float* LsT = (LAS float*)lds;
        LAS float* Ws = LsT + 128 * 128;
        for (int item = bid; item < DEPTH * 4 * 16; item += G) {
            const int l = item >> 6, g = (item >> 4) & 3, n0 = (item & 15) * 64;
            const float* lin = P.in[10] + (size_t)(l * 4 + g) * 128 * 128;
            const float* sc = P.in[11] + l * 512 + g * 128;
            const float* wpb = P.in[9] + (size_t)l * 512 * 1024 + (size_t)g * 128 * 1024;
            for (int i = tid; i < 128 * 128; i += NTHREADS) { const int c = i >> 7, d = i & 127; LsT[d * 128 + c] = lin[i] * sc[d]; }
            for (int i = tid; i < 128 * 64; i += NTHREADS) { const int d = i >> 6, n = i & 63; Ws[i] = wpb[(size_t)d * 1024 + n0 + n]; }
            __syncthreads();
            const int n = tid & 63, cgp = tid >> 6;
            float a[16];
#pragma unroll
            for (int i = 0; i < 16; ++i) a[i] = 0.f;
            for (int d = 0; d < 128; ++d) {
                const float w = Ws[d * 64 + n];
                const LAS f32x4* lp = (const LAS f32x4*)(LsT + d * 128 + cgp * 16);
#pragma unroll
                for (int q4 = 0; q4 < 4; ++q4) { const f32x4 lv = lp[q4];
#pragma unroll
                    for (int i = 0; i < 4; ++i) a[q4 * 4 + i] += lv[i] * w; }
            }
            bf16_t* op = Wt_pb + ((size_t)l * 1024 + n0 + n) * 512 + g * 128 + cgp * 16;
            u32x4 o0, o1; o0.x = cvt_pk_bf16(a[0], a[1]); o0.y = cvt_pk_bf16(a[2], a[3]); o0.z = cvt_pk_bf16(a[4], a[5]); o0.w = cvt_pk_bf16(a[6], a[7]);
            o1.x = cvt_pk_bf16(a[8], a[9]); o1.y = cvt_pk_bf16(a[10], a[11]); o1.z = cvt_pk_bf16(a[12], a[13]); o1.w = cvt_pk_bf16(a[14], a[15]);
            *(u32x4*)op = o0; *(u32x4*)(op + 8) = o1;
            __syncthreads();
        }
        {
            LAS float* scr = (LAS float*)(lds + wave * 16640);
            constexpr int I_IN = 16 * 76, I_PA = 4 * 16, I_O = 16 * 16, I_UP = 16 * 64, I_DN = 64 * 16, I_L = I_IN + I_PA + I_O + I_UP + I_DN;
            for (int it = gw; it < DEPTH * I_L; it += NGW) {
                const int l = it / I_L; int r = it - l * I_L;
                if (r < I_IN) { transpose_item(P.in[7] + (size_t)l * DM * NIN, P.in[6] + l * DM, DM, NIN, Wt_in + (size_t)l * NIN * DM, scr, r, lane); continue; } r -= I_IN;
                if (r < I_PA) { transpose_item(P.in[8] + (size_t)l * 256 * DM, nullptr, 256, DM, Wt_pa + (size_t)l * DM * 256, scr, r, lane); continue; } r -= I_PA;
                if (r < I_O) { transpose_item(P.in[12] + (size_t)l * DM * DM, nullptr, DM, DM, Wt_o + (size_t)l * DM * DM, scr, r, lane); continue; } r -= I_O;
                if (r < I_UP) { transpose_item(P.in[14] + (size_t)l * DM * DFF, P.in[13] + l * DM, DM, DFF, Wt_up + (size_t)l * DFF * DM, scr, r, lane); continue; } r -= I_UP;
                transpose_item(P.in[15] + (size_t)l * DFF * DM, nullptr, DFF, DM, Wt_dn + (size_t)l * DM * DFF, scr, r, lane);
            }
        }
        for (int row = gw; row < NTOK; row += NGW) {
            const float* src = row < NTP ? P.in[0] + (size_t)row * DM : P.in[1] + (size_t)(row - NTP) * DM;
            float s = 0.f;
#pragma unroll
            for (int j = 0; j < 4; ++j) { const f32x4 v = *(const f32x4*)(src + 4 * lane + 256 * j); s += v[0] * v[0] + v[1] * v[1] + v[2] * v[2] + v[3] * v[3];
                *(f32x4*)(X + (size_t)row * DM + 4 * lane + 256 * j) = v;
                u32x2 w; w.x = cvt_pk_bf16(v[0], v[1]); w.y = cvt_pk_bf16(v[2], v[3]); *(u32x2*)(XB + (size_t)row * DM + 4 * lane + 256 * j) = w; }
#pragma unroll
            for (int o = 1; o < 64; o <<= 1) s += __shfl_xor(s, o);
            if (lane == 0) SS[row] = s;
        }
        for (size_t i = gtid; i < 4104 * 8; i += nth) { const int pi = (int)(i >> 3), k = (int)(i & 7); const float pos = (float)(pi < 4096 ? pi : 8192 + pi - 4096);
            const float inv = powf(500000.0f, -(float)(2 * k) / 16.0f); const float ang = pos * inv; ROPE[pi * 16 + k] = cosf(ang); ROPE[pi * 16 + 8 + k] = sinf(ang); }
        for (size_t i = gtid; i < (size_t)8 * NTOK; i += nth) SS[NTOK + i] = 0.f;
        for (size_t i = gtid; i < (size_t)DEPTH * 32 * 7 * 128; i += nth) { const size_t lb = i / (7 * 128), r = i - lb * (7 * 128);
            *(f32x4*)(out + O_POOLS + lb * 15 * 512 + r * 4) = *(const f32x4*)(P.in[5] + lb * 15 * 512 + 8 * 512 + r * 4); }
    }
    grid.sync();

    pg8::StaticOrder S;
#pragma unroll 1
    for (int step = 0; step < DEPTH * 7; ++step) {
        const int layer = step / 7, st = step - layer * 7;
        if (st == 1) {
            int tid_l = threadIdx.x; asm volatile("" : "+v"(tid_l));
            const int lane = tid_l & 63, gw = bid * 8 + (tid_l >> 6);
            const size_t gtid = (size_t)bid * NTHREADS + tid_l;
            size_t zoff = 0; asm volatile("" : "+s"(zoff));
            unsigned char* wsl = ws + zoff;
            bf16_t* QKV = (bf16_t*)(wsl + WS_QKV); bf16_t* UB = (bf16_t*)(wsl + WS_U); bf16_t* OA = (bf16_t*)(wsl + WS_OA); bf16_t* PB = (bf16_t*)(wsl + WS_P);
            bf16_t* PO = (bf16_t*)(wsl + WS_TMP); float* LSE = (float*)(wsl + WS_TMP + (size_t)3 * NTOK * 256 * 2);
            for (int it = gw; it < NTS * 12; it += NGW) { const int g = it % 3, r = it / 3; attn_sample_sub(QKV, g == 0 ? P.in[2] : (g == 1 ? P.in[3] : P.in[4]), PO, LSE, layer, r >> 2, r & 3, g, lane); }
            attn_mfma_phase(lds, QKV, PO, LSE, bid, G, tid_l);
            copy_shift<128>(P.in[2], out + O_KVS0, layer, gtid, nth);
            copy_shift<512>(P.in[3], out + O_KVS1, layer, gtid, nth);
            copy_shift<2048>(P.in[4], out + O_KVS2, layer, gtid, nth);
            xcd_barrier(xb);
            for (size_t base = gtid; base < (size_t)NTOK * 32; base += nth * 4) {
                float ls[4][3]; u32x4 av[4][3];
#pragma unroll
                for (int u = 0; u < 4; ++u) { const size_t idx = base + u * nth; const size_t ii = idx < (size_t)NTOK * 32 ? idx : base; const size_t token = ii >> 5; const int c = (int)(ii & 31) * 8, h = c >> 6;
#pragma unroll
                    for (int g = 0; g < 3; ++g) { ls[u][g] = LSE[((size_t)g * NTOK + token) * 4 + h]; av[u][g] = *(const u32x4*)(PO + ((size_t)g * NTOK + token) * 256 + c); } }
#pragma unroll
                for (int u = 0; u < 4; ++u) { const size_t idx = base + u * nth;
                    if (idx < (size_t)NTOK * 32) { const size_t token = idx >> 5; const int c = (int)(idx & 31) * 8;
                        const float mx = fmaxf(ls[u][0], fmaxf(ls[u][1], ls[u][2])); float w0 = __expf(ls[u][0] - mx), w1 = __expf(ls[u][1] - mx), w2 = __expf(ls[u][2] - mx); const float iw = 1.0f / (w0 + w1 + w2); w0 *= iw; w1 *= iw; w2 *= iw;
                        float a0[8], a1[8], a2[8], o[8]; unpack8(av[u][0], a0); unpack8(av[u][1], a1); unpack8(av[u][2], a2);
#pragma unroll
                        for (int k = 0; k < 8; ++k) o[k] = w0 * a0[k] + w1 * a1[k] + w2 * a2[k];
                        *(u32x4*)(OA + token * 256 + c) = pack8(o); } }
            }
            const float* sp = P.in[5] + (size_t)layer * 32 * 15 * 512;
            for (int it = (int)gtid; it < 4 * (NTOK / 8) * 16; it += (int)nth) {
                const int cl = it & 15, q = it >> 4, g = q / (NTOK / 8), tb = q - g * (NTOK / 8);
                if (g == 0) pool_item<0>(UB, PB, sp, tb, cl); else if (g == 1) pool_item<1>(UB, PB, sp, tb, cl); else if (g == 2) pool_item<2>(UB, PB, sp, tb, cl); else pool_item<3>(UB, PB, sp, tb, cl);
            }
            xcd_barrier(xb);
            continue;
        }
        pg8::Gemm g; EpiAll E; E.ws = ws; E.out = out; E.layer = layer; E.ssi = 0; E.ssn = 0;
        const int Mg = (st == 0) ? NTOK : NTP;
        g.M = Mg;
        if (st == 0)      { g.A = XB;  g.Bt = Wt_in + (size_t)layer * NIN * DM; g.N = NIN; g.K = DM;  E.mode = 0; E.ssi = 2 * layer; }
        else if (st == 2) { g.A = OA;  g.Bt = Wt_pa + (size_t)layer * DM * 256; g.N = DM;  g.K = 256; E.mode = 1; }
        else if (st == 3) { g.A = PB;  g.Bt = Wt_pb + (size_t)layer * DM * 512; g.N = DM;  g.K = 512; E.mode = 2; }
        else if (st == 4) { g.A = MIX; g.Bt = Wt_o + (size_t)layer * DM * DM;   g.N = DM;  g.K = DM;  E.mode = 3; E.ssn = 2 * layer + 1; }
        else if (st == 5) { g.A = XB;  g.Bt = Wt_up + (size_t)layer * DFF * DM; g.N = DFF; g.K = DM;  E.mode = 4; E.ssi = 2 * layer + 1; }
        else              { g.A = HID; g.Bt = Wt_dn + (size_t)layer * DM * DFF; g.N = DM;  g.K = DFF; E.mode = 3; E.ssn = 2 * layer + 2; }
        S.init(Mg, g.N, G, bid);
        pg8::gemm_phase<EpiAll, pg8::StaticOrder, true, true>(lds, g, S, E);
        if (st != 0) skinny_gemm(lds, g.A + (size_t)NTP * g.K, g.Bt, g.N, g.K, E, G - 1 - bid, G);
        if (st != 2) xcd_barrier(xb);
    }
    {
        int tid_l = threadIdx.x; asm volatile("" : "+v"(tid_l));
        const int lane = tid_l & 63, gw = bid * 8 + (tid_l >> 6);
        size_t zoff = 0; asm volatile("" : "+s"(zoff));
        unsigned char* wsl = ws + zoff;
        float* X = (float*)(wsl + WS_X);
        const float* fn = P.in[16]; const float* ssf = (const float*)(wsl + WS_SS) + (size_t)8 * NTOK;
        for (int row = gw; row < NTOK; row += 2 * NGW) {
            const int r2 = row + NGW; const bool ok2 = r2 < NTOK; const int rb = ok2 ? r2 : row;
            const float s0 = ssf[row], s1 = ssf[rb];
            f32x4 va[4], vb[4], gn[4];
#pragma unroll
            for (int j = 0; j < 4; ++j) { const int c = 4 * lane + 256 * j; va[j] = *(const f32x4*)(X + (size_t)row * DM + c); vb[j] = *(const f32x4*)(X + (size_t)rb * DM + c); gn[j] = *(const f32x4*)(fn + c); }
            const float rs0 = rsqrtf(s0 * (1.0f / 1024.0f) + 1e-6f), rs1 = rsqrtf(s1 * (1.0f / 1024.0f) + 1e-6f);
#pragma unroll
            for (int j = 0; j < 4; ++j) { const int c = 4 * lane + 256 * j;
                *(f32x4*)(out + (size_t)row * DM + c) = (f32x4){va[j][0] * rs0 * gn[j][0], va[j][1] * rs0 * gn[j][1], va[j][2] * rs0 * gn[j][2], va[j][3] * rs0 * gn[j][3]};
                if (ok2) *(f32x4*)(out + (size_t)r2 * DM + c) = (f32x4){vb[j][0] * rs1 * gn[j][0], vb[j][1] * rs1 * gn[j][1], vb[j][2] * rs1 * gn[j][2], vb[j][3] * rs1 * gn[j][3]}; }
        }
    }
}

extern "C" void kernel_launch(void* const* d_in, const int* in_sizes, int n_in, void* d_out, int out_size, void* d_ws, size_t ws_size, hipStream_t stream) {
    static int grid_blocks = 0;
    if (grid_blocks == 0) {
        if (n_in != 17 || ws_size < WS_END) { fprintf(stderr, "kernel_launch: unexpected n_in %d / ws %zu (need %zu)\n", n_in, ws_size, (size_t)WS_END); grid_blocks = -1; return; }
        int dev = 0, cus = 0, per_cu = 0;
        (void)hipGetDevice(&dev);
        (void)hipDeviceGetAttribute(&cus, hipDeviceAttributeMultiprocessorCount, dev);
        if (hipFuncSetAttribute((const void*)fwd_megakernel, hipFuncAttributeMaxDynamicSharedMemorySize, LDS_BYTES) != hipSuccess) { fprintf(stderr, "kernel_launch: hipFuncSetAttribute failed\n"); grid_blocks = -1; return; }
        (void)hipOccupancyMaxActiveBlocksPerMultiprocessor(&per_cu, (const void*)fwd_megakernel, NTHREADS, LDS_BYTES);
        if (per_cu < 1) { fprintf(stderr, "kernel_launch: occupancy query says %d blocks/CU\n", per_cu); grid_blocks = -1; return; }
        grid_blocks = cus * 1;
    }
    if (grid_blocks < 0) return;
    if (hipMemsetAsync((unsigned char*)d_ws + WS_BAR, 0, 4096 * 4, stream) != hipSuccess) { fprintf(stderr, "kernel_launch: memset of barrier words failed\n"); return; }
    Params p{};
    for (int i = 0; i < 17; ++i) p.in[i] = (const float*)d_in[i];
    p.out = (float*)d_out; p.ws = (unsigned char*)d_ws;
    void* args[] = {&p};
    hipError_t e = hipLaunchCooperativeKernel((const void*)fwd_megakernel, dim3(grid_blocks), dim3(NTHREADS), args, LDS_BYTES, stream);
    if (e != hipSuccess) fprintf(stderr, "cooperative launch failed: %s (grid %d)\n", hipGetErrorString(e), grid_blocks);
}
```

```cpp
#include <hip/hip_runtime.h>
#include <hip/hip_cooperative_groups.h>
#include <cstdio>
#include <cstdint>
namespace cg = cooperative_groups;

namespace pg8 {
#define PG8_LAS __attribute__((address_space(3)))
typedef unsigned short bf16_t;
typedef short bf16x8 __attribute__((ext_vector_type(8)));
typedef float f32x4 __attribute__((ext_vector_type(4)));
typedef unsigned u32x4 __attribute__((ext_vector_type(4)));
typedef unsigned u32x2 __attribute__((ext_vector_type(2)));
constexpr int BM = 256, BK = 64, HALF = 128, HTB = HALF * BK * 2, STAGE_BYTES = 8 * HTB, NXCD = 8, WGM = 8;

__host__ __device__ __forceinline__ int lds_byte(int r, int c) { const int st = (r >> 4) * 2 + (c >> 5), rr = r & 15, cc = c & 31, ob = rr * 64 + cc * 2; return st * 1024 + (ob ^ (((ob >> 9) & 1) << 5)); }
__host__ __device__ __forceinline__ void stage_rc(int b, int& R, int& C) { const int st = b / 1024, sb = b % 1024, swz = sb ^ (((sb >> 9) & 1) << 5); R = (st >> 1) * 16 + swz / 64; C = (st & 1) * 32 + (swz % 64) / 2; }
__host__ __device__ __forceinline__ int perm32(int rho) { const int n = rho >> 4, i = rho & 15; return 8 * (i >> 2) + 4 * n + (i & 3); }

struct Unit { int pm, pn; };
struct Gemm { const bf16_t* A; const bf16_t* Bt; int M, N, K; };

struct StaticOrder {
    int nM, nN, nwg, G, c;
    __host__ __device__ void init(int M, int N, int G_, int c_) { nM = M / BM; nN = N / BM; nwg = nM * nN; G = G_; c = c_; }
    __host__ __device__ bool next(int i, Unit& u) const {
        const long L = (long)i * G + c; if (L >= nwg) return false;
        int wgid = (int)L; { const int q = nwg / NXCD, r = nwg % NXCD, xcd = wgid % NXCD, off = wgid / NXCD; wgid = (xcd < r ? xcd * (q + 1) : r * (q + 1) + (xcd - r) * q) + off; }
        const int nig = WGM * nN, gid = wgid / nig, fm = gid * WGM, gsz = (nM - fm) < WGM ? (nM - fm) : WGM;
        u.pm = fm + ((wgid % nig) % gsz); u.pn = (wgid % nig) / gsz; return true;
    }
    __device__ __forceinline__ void a_ready(const Unit&) const {}
    __device__ __forceinline__ void done(const Unit&) const {}
};

__device__ __forceinline__ unsigned cvt_pk_bf16(float lo, float hi) { unsigned r; asm volatile("v_cvt_pk_bf16_f32 %0, %1, %2" : "=v"(r) : "v"(lo), "v"(hi)); return r; }

template <class Epi, class Sched, bool ALIGN_EPI = false, bool SP2 = false>
__device__ __forceinline__ void gemm_phase(PG8_LAS unsigned char* lds, const Gemm g, const Sched& S, const Epi& E) {
    int tid = threadIdx.x; asm volatile("" : "+v"(tid));
    const int wid = __builtin_amdgcn_readfirstlane(tid >> 6), lane = tid & 63, wr = wid >> 2, wc = wid & 3, fr = lane & 15, fq = lane >> 4;
    const int K = g.K, nt = K / BK;
    unsigned voffA[2], voffB[2];
#pragma unroll
    for (int i = 0; i < 2; ++i) { int R, C; stage_rc(tid * 16 + i * 8192, R, C); const int Rb = Epi::PERM ? ((R & ~31) + perm32(R & 31)) : R;
        voffA[i] = (unsigned)(R * K + C) * 2u; voffB[i] = (unsigned)(Rb * K + C) * 2u; }
    const size_t kstep = (size_t)(BK * 2);
    const size_t hstep = (size_t)HALF * K * 2;
    const size_t tstep = 2 * hstep;
    const unsigned ldsw = (unsigned)wid * 1024u;
    const int aoff = lds_byte(wr * 64 + fr, fq * 8), boff = lds_byte(wc * 32 + fr, fq * 8);
#define PG8_SA(b, h) (((b) * 2 + (h)) * HTB)
#define PG8_SB(b, h) ((4 + (b) * 2 + (h)) * HTB)
#define PG8_STAGE(bufoff, gbase, voff) do { _Pragma("unroll") for (int _i = 0; _i < 2; ++_i) \
        __builtin_amdgcn_global_load_lds((const unsigned*)((const char*)(gbase) + (voff)[_i]), (PG8_LAS unsigned*)(lds + (bufoff) + ldsw + _i * 8192), 16, 0, 0); } while (0)
#define PG8_LDA(dst, b, h) do { _Pragma("unroll") for (int m = 0; m < 4; ++m) _Pragma("unroll") for (int k = 0; k < 2; ++k) dst[m][k] = *(const PG8_LAS bf16x8*)(lds + PG8_SA(b, h) + aoff + m * 2048 + k * 1024); } while (0)
#define PG8_LDB(dst, b, h) do { _Pragma("unroll") for (int n = 0; n < 2; ++n) _Pragma("unroll") for (int k = 0; k < 2; ++k) dst[n][k] = *(const PG8_LAS bf16x8*)(lds + PG8_SB(b, h) + boff + n * 2048 + k * 1024); } while (0)
#define PG8_MMA(ai, bj, At, Bt) do { __builtin_amdgcn_s_setprio(1); _Pragma("unroll") for (int m = 0; m < 4; ++m) _Pragma("unroll") for (int n = 0; n < 2; ++n) _Pragma("unroll") for (int k = 0; k < 2; ++k) \
        acc[ai][bj][m][n] = __builtin_amdgcn_mfma_f32_16x16x32_bf16(Bt[n][k], At[m][k], acc[ai][bj][m][n], 0, 0, 0); __builtin_amdgcn_s_setprio(0); } while (0)
#define PG8_WAIT_V(n) asm volatile("s_waitcnt vmcnt(" #n ")" ::: "memory")
#define PG8_WAIT_L(n) asm volatile("s_waitcnt lgkmcnt(" #n ")" ::: "memory")
#define PG8_BAR __builtin_amdgcn_s_barrier()
#define PG8_SCHED __builtin_amdgcn_sched_barrier(0)
    Unit cur, nxt; int ui = 0;
    if (!S.next(0, cur)) return;
    f32x4 acc[2][2][4][2];
#pragma unroll
    for (int a = 0; a < 2; ++a)
#pragma unroll
        for (int b = 0; b < 2; ++b)
#pragma unroll
            for (int m = 0; m < 4; ++m)
#pragma unroll
                for (int n = 0; n < 2; ++n) acc[a][b][m][n] = (f32x4){0.f, 0.f, 0.f, 0.f};
    bf16x8 At[4][2], B0[2][2], B1[2][2];
    const char* cA = (const char*)g.A + (size_t)cur.pm * tstep; const char* cB = (const char*)g.Bt + (size_t)cur.pn * tstep;
    S.a_ready(cur);
    if constexpr (SP2) {
        PG8_STAGE(PG8_SB(0, 0), cB, voffB); PG8_STAGE(PG8_SB(0, 1), cB + hstep, voffB); PG8_STAGE(PG8_SA(0, 0), cA, voffA); PG8_STAGE(PG8_SA(0, 1), cA + hstep, voffA);
        if (wr == 1) PG8_BAR;
        PG8_WAIT_V(2); PG8_BAR;
        PG8_STAGE(PG8_SB(1, 0), cB + kstep, voffB); PG8_STAGE(PG8_SA(1, 0), cA + kstep, voffA); PG8_STAGE(PG8_SB(1, 1), cB + hstep + kstep, voffB);
        PG8_WAIT_V(6); PG8_BAR;
    } else {
        PG8_STAGE(PG8_SB(0, 0), cB, voffB); PG8_STAGE(PG8_SA(0, 0), cA, voffA); PG8_STAGE(PG8_SB(0, 1), cB + hstep, voffB); PG8_STAGE(PG8_SA(0, 1), cA + hstep, voffA);
        if (wr == 1) PG8_BAR;
        PG8_WAIT_V(4); PG8_BAR;
        PG8_STAGE(PG8_SB(1, 0), cB + kstep, voffB); PG8_STAGE(PG8_SA(1, 0), cA + kstep, voffA); PG8_STAGE(PG8_SB(1, 1), cB + hstep + kstep, voffB);
        PG8_WAIT_V(6); PG8_BAR;
    }
    for (;;) {
        const bool has_next = S.next(ui + 1, nxt);
        const char* nA = has_next ? (const char*)g.A + (size_t)nxt.pm * tstep : cA; const char* nB = has_next ? (const char*)g.Bt + (size_t)nxt.pn * tstep : cB;
        for (int t = 0; t < nt; t += 2) {
            const bool last = (t == nt - 2);
            const char* a1 = cA + (size_t)(t + 1) * kstep;
            const char* a2 = last ? nA : cA + (size_t)(t + 2) * kstep; const char* b2 = last ? nB : cB + (size_t)(t + 2) * kstep;
            const char* a3 = a2 + kstep; const char* b3 = b2 + kstep;
            if (last && has_next) S.a_ready(nxt);
            if constexpr (SP2) {
            PG8_LDB(B0, 0, 0); PG8_LDB(B1, 0, 1); PG8_SCHED; PG8_LDA(At, 0, 0); PG8_STAGE(PG8_SA(1, 1), a1 + hstep, voffA);
            PG8_WAIT_V(8); PG8_WAIT_L(0); PG8_BAR; PG8_MMA(0, 0, At, B0); PG8_MMA(0, 1, At, B1); PG8_BAR; PG8_SCHED;
            PG8_LDA(At, 0, 1); PG8_STAGE(PG8_SB(0, 0), b2, voffB); PG8_STAGE(PG8_SB(0, 1), b2 + hstep, voffB); PG8_STAGE(PG8_SA(0, 0), a2, voffA);
            PG8_WAIT_V(8); PG8_WAIT_L(0); PG8_BAR; PG8_MMA(1, 0, At, B0); PG8_MMA(1, 1, At, B1); PG8_BAR; PG8_SCHED;
            PG8_LDB(B0, 1, 0); PG8_LDB(B1, 1, 1); PG8_SCHED; PG8_LDA(At, 1, 0); PG8_STAGE(PG8_SA(0, 1), a2 + hstep, voffA);
            PG8_WAIT_V(8); PG8_WAIT_L(0); PG8_BAR; PG8_MMA(0, 0, At, B0); PG8_MMA(0, 1, At, B1); PG8_BAR; PG8_SCHED;
            PG8_LDA(At, 1, 1); PG8_STAGE(PG8_SB(1, 0), b3, voffB); PG8_STAGE(PG8_SB(1, 1), b3 + hstep, voffB); PG8_STAGE(PG8_SA(1, 0), a3, voffA);
            PG8_WAIT_V(8); PG8_WAIT_L(0); PG8_BAR; PG8_MMA(1, 0, At, B0); PG8_MMA(1, 1, At, B1); PG8_BAR; PG8_SCHED;
            } else {
            PG8_LDB(B0, 0, 0); PG8_SCHED; PG8_LDA(At, 0, 0); PG8_STAGE(PG8_SA(1, 1), a1 + hstep, voffA);
            PG8_WAIT_L(8); PG8_BAR; PG8_WAIT_L(0); PG8_MMA(0, 0, At, B0); PG8_BAR; PG8_SCHED;
            PG8_LDB(B1, 0, 1); PG8_STAGE(PG8_SB(0, 0), b2, voffB);
            PG8_BAR; PG8_WAIT_L(0); PG8_MMA(0, 1, At, B1); PG8_BAR;
            PG8_LDA(At, 0, 1); PG8_STAGE(PG8_SA(0, 0), a2, voffA);
            PG8_BAR; PG8_WAIT_L(0); PG8_MMA(1, 0, At, B0); PG8_BAR; PG8_SCHED;
            PG8_STAGE(PG8_SB(0, 1), b2 + hstep, voffB);
            PG8_WAIT_V(6); PG8_BAR; PG8_MMA(1, 1, At, B1); PG8_BAR;
            PG8_LDB(B0, 1, 0); PG8_SCHED; PG8_LDA(At, 1, 0); PG8_STAGE(PG8_SA(0, 1), a2 + hstep, voffA);
            PG8_WAIT_L(8); PG8_BAR; PG8_WAIT_L(0); PG8_MMA(0, 0, At, B0); PG8_BAR; PG8_SCHED;
            PG8_LDB(B1, 1, 1); PG8_STAGE(PG8_SB(1, 0), b3, voffB);
            PG8_BAR; PG8_WAIT_L(0); PG8_MMA(0, 1, At, B1); PG8_BAR;
            PG8_LDA(At, 1, 1); PG8_STAGE(PG8_SA(1, 0), a3, voffA);
            PG8_BAR; PG8_WAIT_L(0); PG8_MMA(1, 0, At, B0); PG8_BAR; PG8_SCHED;
            PG8_STAGE(PG8_SB(1, 1), b3 + hstep, voffB);
            PG8_WAIT_V(6); PG8_BAR; PG8_MMA(1, 1, At, B1); PG8_BAR;
            }
        }
        if constexpr (ALIGN_EPI) { if (wr == 0) PG8_BAR; }
        E(acc, cur, wr, wc, fr, fq); S.done(cur);
        if (!has_next) break;
#pragma unroll
        for (int a = 0; a < 2; ++a)
#pragma unroll
            for (int b = 0; b < 2; ++b)
#pragma unroll
                for (int m = 0; m < 4; ++m)
#pragma unroll
                    for (int n = 0; n < 2; ++n) acc[a][b][m][n] = (f32x4){0.f, 0.f, 0.f, 0.f};
        cur = nxt; cA = nA; cB = nB; ++ui;
        if constexpr (ALIGN_EPI) { if (wr == 1) PG8_BAR; }
    }
    PG8_WAIT_V(0);
    if constexpr (!ALIGN_EPI) { if (wr == 0) PG8_BAR; }
    PG8_BAR;
#undef PG8_SA
#undef PG8_SB
#undef PG8_STAGE
#undef PG8_LDA
#undef PG8_LDB
#undef PG8_MMA
#undef PG8_WAIT_V
#undef PG8_WAIT_L
#undef PG8_BAR
#undef PG8_SCHED
}
}

using pg8::bf16_t; using pg8::f32x4; using pg8::u32x4; using pg8::u32x2; using pg8::Unit; using pg8::cvt_pk_bf16;
#define LAS __attribute__((address_space(3)))

constexpr int DM = 1024, TP = 4096, NTP = 16384, NTS = 256, NTOK = 16640, DEPTH = 4, NIN = 4864, DFF = 4096;
constexpr int NTHREADS = 512, LDS_BYTES = 147456;
constexpr size_t O_YP = 0, O_YS = 16777216, O_KVP0 = 17039360, O_KVP1 = 18087936, O_KVP2 = 22282240, O_POOLP = 39059456,
                 O_KVS0 = 39182336, O_KVS1 = 47570944, O_KVS2 = 81125376, O_POOLS = 215343104;
constexpr size_t WS_WIN = 0;
constexpr size_t WS_WPA = WS_WIN + (size_t)DEPTH * NIN * DM * 2;
constexpr size_t WS_WPB = WS_WPA + (size_t)DEPTH * DM * 256 * 2;
constexpr size_t WS_WO  = WS_WPB + (size_t)DEPTH * DM * 512 * 2;
constexpr size_t WS_WUP = WS_WO  + (size_t)DEPTH * DM * DM * 2;
constexpr size_t WS_WDN = WS_WUP + (size_t)DEPTH * DFF * DM * 2;
constexpr size_t WS_X   = WS_WDN + (size_t)DEPTH * DM * DFF * 2;
constexpr size_t WS_XB  = WS_X   + (size_t)NTOK * DM * 4;
constexpr size_t WS_QKV = WS_XB  + (size_t)NTOK * DM * 2;
constexpr size_t WS_U   = WS_QKV + (size_t)NTOK * 2304 * 2;
constexpr size_t WS_G   = WS_U   + (size_t)NTOK * 512 * 2;
constexpr size_t WS_OA  = WS_G   + (size_t)NTOK * 2048 * 2;
constexpr size_t WS_P   = WS_OA  + (size_t)NTOK * 256 * 2;
constexpr size_t WS_TMP = WS_P   + (size_t)NTOK * 512 * 2;
constexpr size_t WS_MIX = WS_TMP + (size_t)NTOK * DM * 4;
constexpr size_t WS_H   = WS_MIX + (size_t)NTOK * DM * 2;
constexpr size_t WS_SS  = WS_H   + (size_t)NTOK * DFF * 2;
constexpr size_t WS_ROPE = WS_SS + (size_t)9 * NTOK * 4;
constexpr size_t WS_BAR = WS_ROPE + (size_t)4104 * 16 * 4;
constexpr size_t WS_END = WS_BAR + (size_t)4096 * 4;

struct Params { const float* in[17]; float* out; unsigned char* ws; };

__device__ __forceinline__ void unpack8(const u32x4 w, float (&f)[8]) {
    f[0] = __uint_as_float(w.x << 16); f[1] = __uint_as_float(w.x & 0xffff0000u);
    f[2] = __uint_as_float(w.y << 16); f[3] = __uint_as_float(w.y & 0xffff0000u);
    f[4] = __uint_as_float(w.z << 16); f[5] = __uint_as_float(w.z & 0xffff0000u);
    f[6] = __uint_as_float(w.w << 16); f[7] = __uint_as_float(w.w & 0xffff0000u);
}
__device__ __forceinline__ u32x4 pack8(const float (&f)[8]) {
    u32x4 w; w.x = cvt_pk_bf16(f[0], f[1]); w.y = cvt_pk_bf16(f[2], f[3]); w.z = cvt_pk_bf16(f[4], f[5]); w.w = cvt_pk_bf16(f[6], f[7]); return w;
}
__device__ __forceinline__ float sigmoidf_(float x) { return __builtin_amdgcn_rcpf(1.0f + __builtin_amdgcn_exp2f(x * -1.44269504089f)); }

struct EpiAll {
    static constexpr bool PERM = true, AFTER_DRAIN = false;
    int mode, layer, ssi, ssn; unsigned char* ws; float* out;

    struct Pre { u32x4 g; f32x4 a, b; float rs; };

    template <int MODE> __device__ __forceinline__ Pre pre(unsigned char* ws, int row, int c) const {
        Pre p;
        if constexpr (MODE == 0 || MODE == 4) p.rs = ((const float*)(ws + WS_SS) + (size_t)ssi * NTOK)[row];
        if constexpr (MODE == 1) p.g = *(const u32x4*)((const bf16_t*)(ws + WS_G) + (size_t)row * 2048 + c);
        if constexpr (MODE == 2) { p.g = *(const u32x4*)((const bf16_t*)(ws + WS_G) + (size_t)row * 2048 + 1024 + c);
            p.a = __builtin_bit_cast(f32x4, *(const u32x4*)((const bf16_t*)(ws + WS_TMP) + (size_t)row * DM + c)); }
        if constexpr (MODE == 3) { const float* xp = (const float*)(ws + WS_X) + (size_t)row * DM + c; p.a = *(const f32x4*)xp; p.b = *(const f32x4*)(xp + 4); }
        return p;
    }
    __device__ __forceinline__ void fin_proj(unsigned char* ws, int row, int c32, int fq, float (&v)[8], const Pre& p) const {
        const int pn = c32 >> 8, cl = (c32 & 255) + 8 * fq;
        const float rs = __builtin_amdgcn_rsqf(p.rs * (1.0f / 1024.0f) + 1e-6f);
        const bool samp = row >= NTP;
        const int b = samp ? ((row - NTP) >> 3) : (row >> 12);
        const int t = samp ? (row & 7) : (row & 4095);
#pragma unroll
        for (int i = 0; i < 8; ++i) v[i] *= rs;
        if (pn < 6 && ((c32 >> 5) & 1) == 0) {
            float pv[8];
#pragma unroll
            for (int i = 0; i < 8; ++i) pv[i] = __shfl_xor(v[i], 16);
            if (fq < 2) {
                const int pi = samp ? (4096 + t) : t;
                const f32x4* rp = (const f32x4*)((const float*)(ws + WS_ROPE) + (size_t)pi * 16);
                const f32x4 c0 = rp[0], c1 = rp[1], s0 = rp[2], s1 = rp[3];
                const float sg = (fq == 0) ? -1.0f : 1.0f;
#pragma unroll
                for (int i = 0; i < 4; ++i) { v[i] = v[i] * c0[i] + sg * pv[i] * s0[i]; v[4 + i] = v[4 + i] * c1[i] + sg * pv[4 + i] * s1[i]; }
            }
        }
        if (pn >= 11) {
#pragma unroll
            for (int i = 0; i < 8; ++i) v[i] = sigmoidf_(v[i]);
        }
        bf16_t* dst; int ld, cbase;
        if (pn < 9) { dst = (bf16_t*)(ws + WS_QKV); ld = 2304; cbase = pn * 256; }
        else if (pn < 11) { dst = (bf16_t*)(ws + WS_U); ld = 512; cbase = (pn - 9) * 256; }
        else { dst = (bf16_t*)(ws + WS_G); ld = 2048; cbase = (pn - 11) * 256; }
        *(u32x4*)(dst + (size_t)row * ld + cbase + cl) = pack8(v);
        if (pn >= 3 && pn < 9) {
            const int kvi = pn - 3; const int g = (kvi >= 3) ? kvi - 3 : kvi; const int kv = (kvi >= 3) ? 1 : 0;
            const int W = 128 << (2 * g);
            const size_t okp = (g == 0) ? O_KVP0 : (g == 1 ? O_KVP1 : O_KVP2);
            const size_t oks = (g == 0) ? O_KVS0 : (g == 1 ? O_KVS1 : O_KVS2);
            float* op = nullptr;
            if (samp) op = out + oks + ((size_t)((layer * 32 + b) * W + (W - 8 + t)) * 2 + kv) * 256 + cl;
            else if (t >= TP - W) op = out + okp + ((size_t)((layer * 4 + b) * W + (t - (TP - W))) * 2 + kv) * 256 + cl;
            if (op) { *(f32x4*)op = (f32x4){v[0], v[1], v[2], v[3]}; *(f32x4*)(op + 4) = (f32x4){v[4], v[5], v[6], v[7]}; }
        } else if (pn >= 9 && pn < 11) {
            float* op = nullptr; const int c = cbase + cl;
            if (samp) op = out + O_POOLS + (size_t)((layer * 32 + b) * 15 + 7 + t) * 512 + c;
            else if (t >= TP - 15) op = out + O_POOLP + (size_t)((layer * 4 + b) * 15 + (t - (TP - 15))) * 512 + c;
            if (op) { *(f32x4*)op = (f32x4){v[0], v[1], v[2], v[3]}; *(f32x4*)(op + 4) = (f32x4){v[4], v[5], v[6], v[7]}; }
        }
    }
    template <int MODE> __device__ __forceinline__ void fin(unsigned char* ws, int row, int c32, int fq, float (&v)[8], const Pre& p) const {
        const int c = c32 + 8 * fq;
        if constexpr (MODE == 0) fin_proj(ws, row, c32, fq, v, p);
        if constexpr (MODE == 1) {
            float gg[8]; unpack8(p.g, gg);
#pragma unroll
            for (int i = 0; i < 8; ++i) v[i] *= gg[i];
            *(u32x4*)((bf16_t*)(ws + WS_TMP) + (size_t)row * DM + c) = pack8(v);
        }
        if constexpr (MODE == 2) {
            float gg[8]; unpack8(p.g, gg);
            float tt[8]; unpack8(__builtin_bit_cast(u32x4, p.a), tt);
#pragma unroll
            for (int i = 0; i < 8; ++i) v[i] = tt[i] + gg[i] * v[i];
            *(u32x4*)((bf16_t*)(ws + WS_MIX) + (size_t)row * DM + c) = pack8(v);
        }
        if constexpr (MODE == 3) {
            float* xp = (float*)(ws + WS_X) + (size_t)row * DM + c;
            float sq = 0.f;
#pragma unroll
            for (int i = 0; i < 4; ++i) { v[i] += p.a[i]; v[4 + i] += p.b[i]; }
#pragma unroll
            for (int i = 0; i < 8; ++i) sq += v[i] * v[i];
            *(f32x4*)xp = (f32x4){v[0], v[1], v[2], v[3]}; *(f32x4*)(xp + 4) = (f32x4){v[4], v[5], v[6], v[7]};
            *(u32x4*)((bf16_t*)(ws + WS_XB) + (size_t)row * DM + c) = pack8(v);
            sq += __shfl_xor(sq, 16); sq += __shfl_xor(sq, 32);
            if (fq == 0) atomicAdd((float*)(ws + WS_SS) + (size_t)ssn * NTOK + row, sq);
        }
        if constexpr (MODE == 4) {
            const float rs = __builtin_amdgcn_rsqf(p.rs * (1.0f / 1024.0f) + 1e-6f);
#pragma unroll
            for (int i = 0; i < 8; ++i) { const float a = fmaxf(v[i] * rs, 0.f); v[i] = a * a; }
            *(u32x4*)((bf16_t*)(ws + WS_H) + (size_t)row * DFF + c) = pack8(v);
        }
    }
    __device__ __forceinline__ void chunk(unsigned char* ws, int row, int c32, int fq, float (&v)[8]) const {
        const int c = c32 + 8 * fq;
        switch (mode) {
            case 0: { const Pre p = pre<0>(ws, row, c); fin<0>(ws, row, c32, fq, v, p); } break;
            case 1: { const Pre p = pre<1>(ws, row, c); fin<1>(ws, row, c32, fq, v, p); } break;
            case 2: { const Pre p = pre<2>(ws, row, c); fin<2>(ws, row, c32, fq, v, p); } break;
            case 3: { const Pre p = pre<3>(ws, row, c); fin<3>(ws, row, c32, fq, v, p); } break;
            default: { const Pre p = pre<4>(ws, row, c); fin<4>(ws, row, c32, fq, v, p); } break;
        }
    }
    template <int MODE> __device__ __forceinline__ void tile(unsigned char* ws, const f32x4 (&acc)[2][2][4][2], const Unit& u, int wr, int wc, int fr, int fq) const {
        constexpr int MB = (MODE == 2 || MODE == 3) ? 2 : 4;
#pragma unroll
        for (int ai = 0; ai < 2; ++ai)
#pragma unroll
            for (int m0 = 0; m0 < 4; m0 += MB) {
                Pre p[MB][2];
#pragma unroll
                for (int mm = 0; mm < MB; ++mm)
#pragma unroll
                    for (int bj = 0; bj < 2; ++bj) p[mm][bj] = pre<MODE>(ws, u.pm * 256 + ai * 128 + wr * 64 + (m0 + mm) * 16 + fr, u.pn * 256 + bj * 128 + wc * 32 + 8 * fq);
#pragma unroll
                for (int mm = 0; mm < MB; ++mm)
#pragma unroll
                    for (int bj = 0; bj < 2; ++bj) {
                        float v[8];
#pragma unroll
                        for (int i = 0; i < 4; ++i) { v[i] = acc[ai][bj][m0 + mm][0][i]; v[4 + i] = acc[ai][bj][m0 + mm][1][i]; }
                        fin<MODE>(ws, u.pm * 256 + ai * 128 + wr * 64 + (m0 + mm) * 16 + fr, u.pn * 256 + bj * 128 + wc * 32, fq, v, p[mm][bj]);
                    }
                asm volatile("" ::: "memory");
            }
    }
    __device__ __forceinline__ void operator()(const f32x4 (&acc)[2][2][4][2], const Unit& u, int wr, int wc, int fr, int fq) const {
        asm volatile("" : "+v"(fr), "+v"(fq));
        size_t zoff = 0; asm volatile("" : "+s"(zoff));
        unsigned char* ws = this->ws + zoff;
        switch (mode) {
            case 0: tile<0>(ws, acc, u, wr, wc, fr, fq); break;
            case 1: tile<1>(ws, acc, u, wr, wc, fr, fq); break;
            case 2: tile<2>(ws, acc, u, wr, wc, fr, fq); break;
            case 3: tile<3>(ws, acc, u, wr, wc, fr, fq); break;
            default: tile<4>(ws, acc, u, wr, wc, fr, fq); break;
        }
    }
};

__device__ __forceinline__ void skinny_gemm(LAS unsigned char* lds, const bf16_t* __restrict__ A, const bf16_t* __restrict__ Bt, int N, int K, const EpiAll& E, int first, int G) {
    using pg8::bf16x8;
    int tid = threadIdx.x; asm volatile("" : "+v"(tid));
    const int lane = tid & 63, w = __builtin_amdgcn_readfirstlane(tid >> 6), kg = lane >> 4, qn = lane & 15;
    const int nh = (N == 1024) ? 1 : 2, ksplit = 8 / nh;
    const int half = w % nh, kq = w / nh, Kq = K / ksplit, nsteps = Kq >> 5;
    size_t zoff = 0; asm volatile("" : "+s"(zoff));
    unsigned char* ws = E.ws + zoff;
    LAS float* red = (LAS float*)lds;
    const int RB = 8 / nh, units = RB * (N >> 5);
#pragma unroll 1
    for (int u = first; u < units; u += G) {
        const int rb = u % RB, c32 = (u / RB) << 5;
        const int row0 = rb * 32 * nh + half * 32;
        const bf16_t* ap = A + (size_t)(row0 + qn) * K + kq * Kq + kg * 8;
        const bf16_t* bp = Bt + (size_t)(c32 + 8 * (qn >> 2) + (qn & 3)) * K + kq * Kq + kg * 8;
        f32x4 acc[2][2];
#pragma unroll
        for (int a = 0; a < 2; ++a)
#pragma unroll
            for (int b = 0; b < 2; ++b) acc[a][b] = (f32x4){0.f, 0.f, 0.f, 0.f};
#pragma unroll 8
        for (int ks = 0; ks < nsteps; ++ks) {
            const bf16x8 x0 = *(const bf16x8*)(ap + ks * 32), x1 = *(const bf16x8*)(ap + (size_t)16 * K + ks * 32);
            const bf16x8 w0 = *(const bf16x8*)(bp + ks * 32), w1 = *(const bf16x8*)(bp + (size_t)4 * K + ks * 32);
            acc[0][0] = __builtin_amdgcn_mfma_f32_16x16x32_bf16(w0, x0, acc[0][0], 0, 0, 0);
            acc[0][1] = __builtin_amdgcn_mfma_f32_16x16x32_bf16(w1, x0, acc[0][1], 0, 0, 0);
            acc[1][0] = __builtin_amdgcn_mfma_f32_16x16x32_bf16(w0, x1, acc[1][0], 0, 0, 0);
            acc[1][1] = __builtin_amdgcn_mfma_f32_16x16x32_bf16(w1, x1, acc[1][1], 0, 0, 0);
        }
        __syncthreads();
        if (kq != 0) {
#pragma unroll
            for (int a = 0; a < 2; ++a)
#pragma unroll
                for (int b = 0; b < 2; ++b)
#pragma unroll
                    for (int i = 0; i < 4; ++i) red[(w * 16 + a * 8 + b * 4 + i) * 64 + lane] = acc[a][b][i];
        }
        __syncthreads();
        if (kq == 0) {
#pragma unroll 1
            for (int q = 1; q < ksplit; ++q)
#pragma unroll
                for (int a = 0; a < 2; ++a)
#pragma unroll
                    for (int b = 0; b < 2; ++b)
#pragma unroll
                        for (int i = 0; i < 4; ++i) acc[a][b][i] += red[((w + nh * q) * 16 + a * 8 + b * 4 + i) * 64 + lane];
#pragma unroll
            for (int a = 0; a < 2; ++a) {
                float v[8];
#pragma unroll
                for (int i = 0; i < 4; ++i) { v[i] = acc[a][0][i]; v[4 + i] = acc[a][1][i]; }
                E.chunk(ws, NTP + row0 + a * 16 + qn, c32, kg, v);
            }
        }
    }
    __syncthreads();
}

__device__ __forceinline__ void lds_wait() { asm volatile("s_waitcnt lgkmcnt(0)" ::: "memory"); }
__device__ __forceinline__ void transpose_item(const float* __restrict__ W, const float* __restrict__ gsc, int K, int N, bf16_t* __restrict__ WT, LAS float* scr, int item, int lane) {
    const int nblk = N / 64, kb = item / nblk, nb = item % nblk, k0 = 64 * kb, n0 = 64 * nb;
    f32x4 v[16];
#pragma unroll
    for (int i = 0; i < 16; ++i) v[i] = *(const f32x4*)(W + (size_t)(k0 + 4 * i + (lane >> 4)) * N + n0 + 4 * (lane & 15));
#pragma unroll
    for (int i = 0; i < 16; ++i) { const int kk = 4 * i + (lane >> 4); const float sc = gsc ? gsc[k0 + kk] : 1.0f; LAS float* d = scr + kk * 65 + 4 * (lane & 15);
        d[0] = v[i][0] * sc; d[1] = v[i][1] * sc; d[2] = v[i][2] * sc; d[3] = v[i][3] * sc; }
    lds_wait();
    const int c = lane & 7;
#pragma unroll
    for (int j = 0; j < 8; ++j) { const int n = (lane >> 3) + 8 * j; const LAS float* sp = scr + (8 * c) * 65 + n;
        u32x4 o; o.x = cvt_pk_bf16(sp[0 * 65], sp[1 * 65]); o.y = cvt_pk_bf16(sp[2 * 65], sp[3 * 65]); o.z = cvt_pk_bf16(sp[4 * 65], sp[5 * 65]); o.w = cvt_pk_bf16(sp[6 * 65], sp[7 * 65]);
        *(u32x4*)(WT + (size_t)(n0 + n) * K + k0 + 8 * c) = o; }
    lds_wait();
}

template <int L>
__device__ __forceinline__ void copy_shift(const float* __restrict__ src, float* __restrict__ dst, int layer, size_t gtid, size_t nth) {
    constexpr size_t per = (size_t)(L - 8) * 128;
    constexpr size_t total = (size_t)32 * per;
    constexpr int U = 8;
    const f32x4* s4 = (const f32x4*)src + (size_t)layer * 32 * L * 128; f32x4* d4 = (f32x4*)dst + (size_t)layer * 32 * L * 128;
    for (size_t i = gtid; i < total; i += nth * U) {
        f32x4 v[U];
#pragma unroll
        for (int u = 0; u < U; ++u) { const size_t idx = i + u * nth; const size_t ii = idx < total ? idx : 0; const size_t lb = ii / per, r = ii - lb * per;
            v[u] = __builtin_nontemporal_load(s4 + lb * (size_t)L * 128 + r + 8 * 128); }
#pragma unroll
        for (int u = 0; u < U; ++u) { const size_t idx = i + u * nth; if (idx < total) { const size_t lb = idx / per, r = idx - lb * per; __builtin_nontemporal_store(v[u], d4 + lb * (size_t)L * 128 + r); } }
    }
}

#define ATT_DOT(S, Q, KF) do { float _s = 0.f; _Pragma("unroll") for (int _i = 0; _i < 8; ++_i) _s += Q[_i] * KF[_i]; \
    _s += __shfl_xor(_s, 1); _s += __shfl_xor(_s, 2); _s += __shfl_xor(_s, 4); S = _s; } while (0)

__device__ __forceinline__ void attn_finish(float m, float l, float (&o)[8], bf16_t* dstp, int kg) {
    float M = m; M = fmaxf(M, __shfl_xor(M, 8)); M = fmaxf(M, __shfl_xor(M, 16)); M = fmaxf(M, __shfl_xor(M, 32));
    const float f = __expf(m - M); l *= f;
#pragma unroll
    for (int i = 0; i < 8; ++i) o[i] *= f;
    l += __shfl_xor(l, 8); l += __shfl_xor(l, 16); l += __shfl_xor(l, 32);
#pragma unroll
    for (int i = 0; i < 8; ++i) { o[i] += __shfl_xor(o[i], 8); o[i] += __shfl_xor(o[i], 16); o[i] += __shfl_xor(o[i], 32); }
    const float inv = 1.0f / l;
#pragma unroll
    for (int i = 0; i < 8; ++i) o[i] *= inv;
    if (kg == 0) *(u32x4*)dstp = pack8(o);
}

__device__ __forceinline__ void attn_prompt_item(const bf16_t* __restrict__ qkv, bf16_t* __restrict__ oa, int token, int h, int lane) {
    const int kg = lane >> 3, dl = lane & 7;
    const int b = token >> 12, t = token & 4095;
    const bf16_t* qrow = qkv + (size_t)token * 2304 + h * 64 + dl * 8;
    const bf16_t* kbase = qkv + (size_t)(b << 12) * 2304 + 768 + h * 64 + dl * 8;
    float m = -1e30f, l = 0.f; float o[8];
#pragma unroll
    for (int i = 0; i < 8; ++i) o[i] = 0.f;
#pragma unroll 1
    for (int g = 0; g < 3; ++g) {
        const int d = 1 << (2 * g);
        float q[8]; unpack8(*(const u32x4*)(qrow + g * 256), q);
#pragma unroll
        for (int i = 0; i < 8; ++i) q[i] *= 0.125f;
        const bf16_t* kb = kbase + g * 256;
#pragma unroll 1
        for (int it = 0; it < 16; it += 4) {
            u32x4 kr[4], vr[4]; bool val[4];
#pragma unroll
            for (int u = 0; u < 4; ++u) { const int j = (it + u) * 8 + kg; const int pos = t - j * d; val[u] = pos >= 0; const bf16_t* r = kb + (size_t)(pos < 0 ? 0 : pos) * 2304;
                kr[u] = *(const u32x4*)r; vr[u] = *(const u32x4*)(r + 768); }
            float s[4];
#pragma unroll
            for (int u = 0; u < 4; ++u) { float kf[8]; unpack8(kr[u], kf); ATT_DOT(s[u], q, kf); if (!val[u]) s[u] = -1e30f; }
            const float mb = fmaxf(fmaxf(m, fmaxf(s[0], s[1])), fmaxf(s[2], s[3]));
            const float corr = __expf(m - mb);
            l *= corr;
#pragma unroll
            for (int i = 0; i < 8; ++i) o[i] *= corr;
#pragma unroll
            for (int u = 0; u < 4; ++u) { const float p = val[u] ? __expf(s[u] - mb) : 0.f; l += p; float vf[8]; unpack8(vr[u], vf);
#pragma unroll
                for (int i = 0; i < 8; ++i) o[i] += p * vf[i]; }
            m = mb;
        }
    }
    {
        const int g = kg < 2 ? kg : 2; const int d = 1 << (2 * g);
        const int pos = t - 128 * d; const bool val = (kg < 3) && (pos >= 0);
        float q[8]; unpack8(*(const u32x4*)(qrow + g * 256), q);
        const bf16_t* r = kbase + g * 256 + (size_t)(pos < 0 ? 0 : pos) * 2304;
        float kf[8], vf[8]; unpack8(*(const u32x4*)r, kf); unpack8(*(const u32x4*)(r + 768), vf);
        float s; ATT_DOT(s, q, kf); s *= 0.125f;
        if (!val) s = -1e30f;
        const float mb = fmaxf(m, s); const float corr = __expf(m - mb); const float p = val ? __expf(s - mb) : 0.f;
        l = l * corr + p;
#pragma unroll
        for (int i = 0; i < 8; ++i) o[i] = o[i] * corr + p * vf[i];
        m = mb;
    }
    attn_finish(m, l, o, oa + (size_t)token * 256 + h * 64 + dl * 8, kg);
}

__device__ __forceinline__ void sample_kv(const bf16_t* __restrict__ newb, const float* __restrict__ cb, int W, int idx, float (&kf)[8], float (&vf)[8]) {
    if (idx >= W) { const bf16_t* r = newb + (size_t)(idx - W) * 2304; unpack8(*(const u32x4*)r, kf); unpack8(*(const u32x4*)(r + 768), vf); }
    else { const float* r = cb + (size_t)idx * 512; const f32x4 a = *(const f32x4*)r, b2 = *(const f32x4*)(r + 4), c = *(const f32x4*)(r + 256), d2 = *(const f32x4*)(r + 260);
#pragma unroll
        for (int i = 0; i < 4; ++i) { kf[i] = a[i]; kf[4 + i] = b2[i]; vf[i] = c[i]; vf[4 + i] = d2[i]; } }
}
__device__ __forceinline__ void attn_sample_sub(const bf16_t* __restrict__ qkv, const float* __restrict__ cg_, bf16_t* __restrict__ PO, float* __restrict__ LSE,
                                                int layer, int stok, int h, int g, int lane) {
    const int kg = lane >> 3, dl = lane & 7;
    const int b = stok >> 3, t = stok & 7;
    const int token = NTP + stok;
    const int d = 1 << (2 * g), W = 128 << (2 * g);
    const bf16_t* nb = qkv + (size_t)(NTP + b * 8) * 2304 + 768 + g * 256 + h * 64 + dl * 8;
    const float* cb = cg_ + (size_t)(layer * 32 + b) * W * 512 + h * 64 + dl * 8;
    float q[8]; unpack8(*(const u32x4*)(qkv + (size_t)token * 2304 + g * 256 + h * 64 + dl * 8), q);
#pragma unroll
    for (int i = 0; i < 8; ++i) q[i] *= 0.125f;
    float m = -1e30f, l = 0.f; float o[8];
#pragma unroll
    for (int i = 0; i < 8; ++i) o[i] = 0.f;
#pragma unroll 1
    for (int it = 0; it < 16; it += 8) {
        float kf[8][8], vf[8][8], s[8];
#pragma unroll
        for (int u = 0; u < 8; ++u) { const int j = (it + u) * 8 + kg; sample_kv(nb, cb, W, W + t - j * d, kf[u], vf[u]); }
        float mb = m;
#pragma unroll
        for (int u = 0; u < 8; ++u) { ATT_DOT(s[u], q, kf[u]); mb = fmaxf(mb, s[u]); }
        const float corr = __expf(m - mb);
        l *= corr;
#pragma unroll
        for (int i = 0; i < 8; ++i) o[i] *= corr;
#pragma unroll
        for (int u = 0; u < 8; ++u) { const float p = __expf(s[u] - mb); l += p;
#pragma unroll
            for (int i = 0; i < 8; ++i) o[i] += p * vf[u][i]; }
        m = mb;
    }
    {
        const bool val = kg == 0;
        float kf[8], vf[8]; sample_kv(nb, cb, W, W + t - 128 * d, kf, vf);
        float s; ATT_DOT(s, q, kf);
        if (!val) s = -1e30f;
        const float mb = fmaxf(m, s); const float corr = __expf(m - mb); const float p = val ? __expf(s - mb) : 0.f;
        l = l * corr + p;
#pragma unroll
        for (int i = 0; i < 8; ++i) o[i] = o[i] * corr + p * vf[i];
        m = mb;
    }
    float M = m; M = fmaxf(M, __shfl_xor(M, 8)); M = fmaxf(M, __shfl_xor(M, 16)); M = fmaxf(M, __shfl_xor(M, 32));
    const float f = __expf(m - M); l *= f;
#pragma unroll
    for (int i = 0; i < 8; ++i) o[i] *= f;
    l += __shfl_xor(l, 8); l += __shfl_xor(l, 16); l += __shfl_xor(l, 32);
#pragma unroll
    for (int i = 0; i < 8; ++i) { o[i] += __shfl_xor(o[i], 8); o[i] += __shfl_xor(o[i], 16); o[i] += __shfl_xor(o[i], 32); }
    const float inv = 1.0f / l;
#pragma unroll
    for (int i = 0; i < 8; ++i) o[i] *= inv;
    if (kg == 0) *(u32x4*)(PO + ((size_t)g * NTOK + token) * 256 + h * 64 + dl * 8) = pack8(o);
    if (lane == 0) LSE[((size_t)g * NTOK + token) * 4 + h] = M + __logf(l);
}

constexpr int ATT_PITCH = 144, ATT_ROWS = 272, ATT_VOFF = ATT_ROWS * ATT_PITCH;
typedef short s16x4 __attribute__((ext_vector_type(4)));
template <int OFF> __device__ __forceinline__ s16x4 tr_read(unsigned addr) { s16x4 r; asm volatile("ds_read_b64_tr_b16 %0, %1 offset:%2" : "=v"(r) : "v"(addr), "n"(OFF) : "memory"); return r; }
__device__ __forceinline__ void tr_wait8(s16x4& a, s16x4& b, s16x4& c, s16x4& d, s16x4& e, s16x4& f, s16x4& g, s16x4& h) {
    asm volatile("s_waitcnt lgkmcnt(0)" : "+v"(a), "+v"(b), "+v"(c), "+v"(d), "+v"(e), "+v"(f), "+v"(g), "+v"(h) :: "memory"); }

__device__ __forceinline__ void attn_mfma_phase(LAS unsigned char* lds, const bf16_t* __restrict__ QKV, bf16_t* __restrict__ PO, float* __restrict__ LSE, int bid, int G, int tid) {
    using pg8::bf16x8;
    const int lane = tid & 63, w = __builtin_amdgcn_readfirstlane(tid >> 6), kg = lane >> 4, qn = lane & 15;
    for (int i = tid; i < 2 * 144; i += NTHREADS) { const int kv = i / 144, rem = i - kv * 144; *(LAS u32x4*)(lds + kv * ATT_VOFF + 256 * ATT_PITCH + rem * 16) = (u32x4){0u, 0u, 0u, 0u}; }
    const unsigned vaddr = (unsigned)(uintptr_t)(lds + ATT_VOFF + (16 * w + 4 * kg + (qn >> 2)) * ATT_PITCH + (lane & 3) * 8);
    const float csc = 0.125f * 1.44269504089f;
#define ATT_DECODE(U, b_, h_, g_, r_, I0_) do { const int _bh = (U) / 96, _rest = (U) - _bh * 96; b_ = _bh >> 2; h_ = _bh & 3; \
        if (_rest < 32) { g_ = 0; r_ = 0; I0_ = 128 * _rest; } else if (_rest < 64) { g_ = 1; r_ = (_rest - 32) >> 3; I0_ = 128 * ((_rest - 32) & 7); } else { g_ = 2; r_ = (_rest - 64) >> 1; I0_ = 128 * ((_rest - 64) & 1); } } while (0)
#define ATT_FETCH(U) do { int _b, _h, _g, _r, _I0; ATT_DECODE(U, _b, _h, _g, _r, _I0); const int _d = 1 << (2 * _g); \
        _Pragma("unroll") for (int i = 0; i < 8; ++i) { const int kv = i >> 2, row = (tid >> 3) + 64 * (i & 3), ch = tid & 7; const int I = _I0 - 128 + row; \
            pf[i] = (u32x4){0u, 0u, 0u, 0u}; \
            if (I >= 0) pf[i] = *(const u32x4*)(QKV + (size_t)(_b * 4096 + _r + _d * I) * 2304 + 768 + kv * 768 + _g * 256 + _h * 64 + ch * 8); } \
        const bf16_t* _qp = QKV + ((size_t)_b * 4096 + _r + _d * (_I0 + 16 * w + qn)) * 2304 + _g * 256 + _h * 64 + kg * 8; \
        qf0 = *(const bf16x8*)_qp; qf1 = *(const bf16x8*)(_qp + 32); } while (0)
    u32x4 pf[8]; bf16x8 qf0, qf1;
    if (bid < 1536) ATT_FETCH(bid);
#pragma unroll 1
    for (int u = bid; u < 1536; u += G) {
        int b, h, g, r, I0; ATT_DECODE(u, b, h, g, r, I0);
        const int d = 1 << (2 * g);
        __syncthreads();
#pragma unroll
        for (int i = 0; i < 8; ++i) { const int kv = i >> 2, row = (tid >> 3) + 64 * (i & 3), ch = tid & 7; *(LAS u32x4*)(lds + kv * ATT_VOFF + row * ATT_PITCH + ch * 16) = pf[i]; }
        const bf16x8 q0 = qf0, q1 = qf1;
        __syncthreads();
        if (u + G < 1536) ATT_FETCH(u + G);
        const int Iq = I0 + 16 * w + qn; const size_t tokq = (size_t)b * 4096 + r + d * Iq;
        f32x4 sc[9];
        const LAS unsigned char* kb = lds + (16 * w + qn) * ATT_PITCH + kg * 16;
#pragma unroll
        for (int kt = 0; kt < 9; ++kt) { const bf16x8 k0 = *(const LAS bf16x8*)(kb + kt * 16 * ATT_PITCH), k1 = *(const LAS bf16x8*)(kb + kt * 16 * ATT_PITCH + 64);
            f32x4 z = (f32x4){0.f, 0.f, 0.f, 0.f}; z = __builtin_amdgcn_mfma_f32_16x16x32_bf16(k0, q0, z, 0, 0, 0); sc[kt] = __builtin_amdgcn_mfma_f32_16x16x32_bf16(k1, q1, z, 0, 0, 0); }
        const int jb = 128 + qn - 4 * kg, ikb = I0 - 128 + 16 * w + 4 * kg;
        float m = -1e30f;
#pragma unroll
        for (int kt = 0; kt < 9; ++kt)
#pragma unroll
            for (int i = 0; i < 4; ++i) { const int j = jb - 16 * kt - i; const bool val = (j >= 0) && (j <= 128) && (ikb + 16 * kt + i >= 0); sc[kt][i] = val ? sc[kt][i] : -1e30f; m = fmaxf(m, sc[kt][i]); }
        m = fmaxf(m, __shfl_xor(m, 16)); m = fmaxf(m, __shfl_xor(m, 32));
        const float mc = m * csc; float l = 0.f;
        unsigned pk[10][2];
#pragma unroll
        for (int kt = 0; kt < 9; ++kt) { float p[4];
#pragma unroll
            for (int i = 0; i < 4; ++i) { p[i] = (sc[kt][i] > -1e29f) ? __builtin_amdgcn_exp2f(sc[kt][i] * csc - mc) : 0.f; l += p[i]; }
            pk[kt][0] = cvt_pk_bf16(p[0], p[1]); pk[kt][1] = cvt_pk_bf16(p[2], p[3]); }
        pk[9][0] = 0u; pk[9][1] = 0u;
        l += __shfl_xor(l, 16); l += __shfl_xor(l, 32);
        f32x4 o[4];
#pragma unroll
        for (int dt = 0; dt < 4; ++dt) o[dt] = (f32x4){0.f, 0.f, 0.f, 0.f};
#define ATT_PV(KK) do { s16x4 a0 = tr_read<(KK) * 32 * ATT_PITCH + 0>(vaddr), a1 = tr_read<(KK) * 32 * ATT_PITCH + 32>(vaddr), a2 = tr_read<(KK) * 32 * ATT_PITCH + 64>(vaddr), a3 = tr_read<(KK) * 32 * ATT_PITCH + 96>(vaddr); \
            s16x4 c0 = tr_read<(KK) * 32 * ATT_PITCH + 16 * ATT_PITCH + 0>(vaddr), c1 = tr_read<(KK) * 32 * ATT_PITCH + 16 * ATT_PITCH + 32>(vaddr), c2 = tr_read<(KK) * 32 * ATT_PITCH + 16 * ATT_PITCH + 64>(vaddr), c3 = tr_read<(KK) * 32 * ATT_PITCH + 16 * ATT_PITCH + 96>(vaddr); \
            tr_wait8(a0, a1, a2, a3, c0, c1, c2, c3); \
            u32x4 pw; pw.x = pk[2 * (KK)][0]; pw.y = pk[2 * (KK)][1]; pw.z = pk[2 * (KK) + 1][0]; pw.w = pk[2 * (KK) + 1][1]; \
            const bf16x8 pf = __builtin_bit_cast(bf16x8, pw); \
            o[0] = __builtin_amdgcn_mfma_f32_16x16x32_bf16(__builtin_shufflevector(a0, c0, 0, 1, 2, 3, 4, 5, 6, 7), pf, o[0], 0, 0, 0); \
            o[1] = __builtin_amdgcn_mfma_f32_16x16x32_bf16(__builtin_shufflevector(a1, c1, 0, 1, 2, 3, 4, 5, 6, 7), pf, o[1], 0, 0, 0); \
            o[2] = __builtin_amdgcn_mfma_f32_16x16x32_bf16(__builtin_shufflevector(a2, c2, 0, 1, 2, 3, 4, 5, 6, 7), pf, o[2], 0, 0, 0); \
            o[3] = __builtin_amdgcn_mfma_f32_16x16x32_bf16(__builtin_shufflevector(a3, c3, 0, 1, 2, 3, 4, 5, 6, 7), pf, o[3], 0, 0, 0); } while (0)
        ATT_PV(0); ATT_PV(1); ATT_PV(2); ATT_PV(3); ATT_PV(4);
        const float il = 1.0f / l;
        bf16_t* op = PO + ((size_t)g * NTOK + tokq) * 256 + h * 64 + 4 * kg;
#pragma unroll
        for (int dt = 0; dt < 4; ++dt) { u32x2 wv; wv.x = cvt_pk_bf16(o[dt][0] * il, o[dt][1] * il); wv.y = cvt_pk_bf16(o[dt][2] * il, o[dt][3] * il); *(u32x2*)(op + 16 * dt) = wv; }
        if (kg == 0) LSE[((size_t)g * NTOK + tokq) * 4 + h] = m * 0.125f + __logf(l);
    }
#undef ATT_PV
#undef ATT_FETCH
#undef ATT_DECODE
}

#define XB_TMO      128
#define XB_XCNT(j)  (256  + 64 * (j))
#define XB_XSUB(j)  (1280 + 64 * (j))
#define XB_XGEN(j)  (2304 + 64 * (j))
#define XB_TOP      3328
#define XB_TOPGEN   3392
#define XCD_BAR_WORDS 3456
#define XB_SPIN_CAP (1u << 20)
__device__ __forceinline__ unsigned xb_ld(unsigned* p)              { return __hip_atomic_load(p, __ATOMIC_RELAXED, __HIP_MEMORY_SCOPE_AGENT); }
__device__ __forceinline__ unsigned xb_add(unsigned* p, unsigned v) { return __hip_atomic_fetch_add(p, v, __ATOMIC_RELAXED, __HIP_MEMORY_SCOPE_AGENT); }
__device__ __forceinline__ unsigned xb_xcc_id() { return (unsigned)__builtin_amdgcn_s_getreg((3 << 11) | 20) & 0xFu; }
#define XB_SPIN(cond, bar) do { unsigned _sp = 0; while (cond) { __builtin_amdgcn_s_sleep(1); \
    if ((++_sp & 255u) == 0u) { if (xb_ld(&(bar)[XB_TMO])) break; if (_sp > XB_SPIN_CAP) { atomicAdd(&(bar)[XB_TMO], 1u); break; } } } } while (0)
struct XcdBarrier { unsigned* bar; unsigned x; volatile LAS unsigned* st; };
__device__ __forceinline__ XcdBarrier xcd_barrier_post(unsigned* bar, volatile LAS unsigned* st) {
    XcdBarrier b; b.bar = bar; b.x = xb_xcc_id(); b.st = st;
    if (threadIdx.x == 0) (void)xb_add(&bar[XB_XCNT(b.x)], 1u);
    return b;
}
__device__ __forceinline__ void xcd_barrier_complete(unsigned* bar, unsigned x, unsigned& nloc, unsigned& nx) {
    const unsigned G = gridDim.x * gridDim.y * gridDim.z;
    unsigned sum, cnt, mine, sp = 0u;
    for (;;) {
        sum = 0u; cnt = 0u; mine = 0u;
#pragma unroll
        for (unsigned j = 0; j < 16; ++j) { const unsigned c = xb_ld(&bar[XB_XCNT(j)]); sum += c; cnt += (c > 0u) ? 1u : 0u; mine = (j == x) ? c : mine; }
        if (sum == G) break;
        __builtin_amdgcn_s_sleep(1);
        if ((++sp & 255u) == 0u) { if (xb_ld(&bar[XB_TMO])) break; if (sp > XB_SPIN_CAP) { atomicAdd(&bar[XB_TMO], 1u); break; } }
    }
    nloc = mine > 0u ? mine : 1u; nx = cnt > 0u ? cnt : 1u;
}
__device__ __forceinline__ void xcd_barrier(const XcdBarrier& b) {
    asm volatile("s_waitcnt vmcnt(0)" ::: "memory");
    __syncthreads();
    if (threadIdx.x == 0) {
        unsigned* bar = b.bar;
        __builtin_amdgcn_s_waitcnt(0);
        unsigned nloc = b.st[0], nx = b.st[1];
        if (nloc == 0u) { xcd_barrier_complete(bar, b.x, nloc, nx); b.st[0] = nloc; b.st[1] = nx; }
        const unsigned old = xb_add(&bar[XB_XSUB(b.x)], 1u);
        const unsigned gen = old / nloc;
        if (old + 1u == (gen + 1u) * nloc) {
            __builtin_amdgcn_fence(__ATOMIC_RELEASE, "agent");
            asm volatile("s_waitcnt vmcnt(0)" ::: "memory");
            const unsigned og = xb_add(&bar[XB_TOP], 1u);
            const unsigned tg = og / nx;
            if (og + 1u == (tg + 1u) * nx) xb_add(&bar[XB_TOPGEN], 1u);
            else XB_SPIN(xb_ld(&bar[XB_TOPGEN]) == tg, bar);
            __builtin_amdgcn_fence(__ATOMIC_ACQUIRE, "agent");
            xb_add(&bar[XB_XGEN(b.x)], 1u);
            asm volatile("s_waitcnt vmcnt(0)" ::: "memory");
        } else {
            XB_SPIN(xb_ld(&bar[XB_XGEN(b.x)]) == gen, bar);
            __builtin_amdgcn_fence(__ATOMIC_ACQUIRE, "agent");
            asm volatile("s_waitcnt vmcnt(0)" ::: "memory");
        }
    }
    __syncthreads();
}

template <int GP> __device__ __forceinline__ void pool_item(const bf16_t* __restrict__ UB, bf16_t* __restrict__ PB, const float* __restrict__ sp, int tb, int cl) {
    constexpr int W = 2 << GP, NR = W + 7;
    const int c = (GP * 16 + cl) * 8;
    const int token0 = tb * 8; const bool samp = token0 >= NTP; const int t0 = samp ? 0 : (token0 & 4095); const int b = (token0 - NTP) >> 3;
    u32x4 R[NR];
#pragma unroll
    for (int r = 0; r < NR; ++r) { const int dt = r - (W - 1);
        if (dt >= 0 || t0 + dt >= 0) R[r] = *(const u32x4*)(UB + (size_t)(token0 + dt) * 512 + c);
        else if (samp) { const float* q = sp + (size_t)(b * 15 + 15 + dt) * 512 + c; const f32x4 a = *(const f32x4*)q, b2 = *(const f32x4*)(q + 4);
            R[r].x = cvt_pk_bf16(a[0], a[1]); R[r].y = cvt_pk_bf16(a[2], a[3]); R[r].z = cvt_pk_bf16(b2[0], b2[1]); R[r].w = cvt_pk_bf16(b2[2], b2[3]); }
        else R[r] = (u32x4){0u, 0u, 0u, 0u}; }
#pragma unroll
    for (int j = 0; j < 8; ++j) {
        float sum[8];
#pragma unroll
        for (int k = 0; k < 8; ++k) sum[k] = 0.f;
#pragma unroll
        for (int i = 0; i < W; ++i) { float f[8]; unpack8(R[j + (W - 1) - i], f);
#pragma unroll
            for (int k = 0; k < 8; ++k) sum[k] += f[k]; }
        float ut[8]; unpack8(R[j + W - 1], ut);
        const int t = t0 + j; const float cnt = samp ? (float)W : (float)(W < t + 1 ? W : t + 1); const float ic = 1.0f / cnt;
        float p[8];
#pragma unroll
        for (int k = 0; k < 8; ++k) p[k] = sum[k] * ic - ut[k];
        *(u32x4*)(PB + (size_t)(token0 + j) * 512 + c) = pack8(p);
    }
}

__global__ void __launch_bounds__(NTHREADS, 2) fwd_megakernel(Params P) {
    extern __shared__ __attribute__((aligned(16))) unsigned char lds_raw[];
    LAS unsigned char* lds = (LAS unsigned char*)lds_raw;
    cg::grid_group grid = cg::this_grid();
    const int tid = threadIdx.x, lane = tid & 63, wave = __builtin_amdgcn_readfirstlane(tid >> 6);
    const int G = gridDim.x, bid = blockIdx.x;
    const int gw = bid * 8 + wave, NGW = G * 8;
    const size_t gtid = (size_t)bid * NTHREADS + tid, nth = (size_t)G * NTHREADS;
    unsigned char* ws = P.ws;
    bf16_t* Wt_in = (bf16_t*)(ws + WS_WIN); bf16_t* Wt_pa = (bf16_t*)(ws + WS_WPA); bf16_t* Wt_pb = (bf16_t*)(ws + WS_WPB);
    bf16_t* Wt_o = (bf16_t*)(ws + WS_WO); bf16_t* Wt_up = (bf16_t*)(ws + WS_WUP); bf16_t* Wt_dn = (bf16_t*)(ws + WS_WDN);
    float* X = (float*)(ws + WS_X); bf16_t* XB = (bf16_t*)(ws + WS_XB); bf16_t* QKV = (bf16_t*)(ws + WS_QKV); bf16_t* UB = (bf16_t*)(ws + WS_U);
    bf16_t* GT = (bf16_t*)(ws + WS_G); bf16_t* OA = (bf16_t*)(ws + WS_OA); bf16_t* PB = (bf16_t*)(ws + WS_P); float* TMP = (float*)(ws + WS_TMP);
    bf16_t* MIX = (bf16_t*)(ws + WS_MIX); bf16_t* HID = (bf16_t*)(ws + WS_H); float* SS = (float*)(ws + WS_SS); float* ROPE = (float*)(ws + WS_ROPE);
    float* out = P.out;
    volatile LAS unsigned* bst = (volatile LAS unsigned*)(lds + LDS_BYTES - 16);
    if (tid == 0) { bst[0] = 0u; bst[1] = 0u; }
    __syncthreads();
    const XcdBarrier xb = xcd_barrier_post((unsigned*)(ws + WS_BAR), bst);

    {
        LAS float* LsT = (LAS float*)lds;
        LAS float* Ws = LsT + 128 * 128;
        for (int item = bid; item < DEPTH * 4 * 16; item += G) {
            const int l = item >> 6, g = (item >> 4) & 3, n0 = (item & 15) * 64;
            const float* lin = P.in[10] + (size_t)(l * 4 + g) * 128 * 128;
            const float* sc = P.in[11] + l * 512 + g * 128;
            const float* wpb = P.in[9] + (size_t)l * 512 * 1024 + (size_t)g * 128 * 1024;
            for (int i = tid; i < 128 * 128; i += NTHREADS) { const int c = i >> 7, d = i & 127; LsT[d * 128 + c] = lin[i] * sc[d]; }
            for (int i = tid; i < 128 * 64; i += NTHREADS) { const int d = i >> 6, n = i & 63; Ws[i] = wpb[(size_t)d * 1024 + n0 + n]; }
            __syncthreads();
            const int n = tid & 63, cgp = tid >> 6;
            float a[16];
#pragma unroll
            for (int i = 0; i < 16; ++i) a[i] = 0.f;
            for (int d = 0; d < 128; ++d) {
                const float w = Ws[d * 64 + n];
                const LAS f32x4* lp = (const LAS f32x4*)(LsT + d * 128 + cgp * 16);
#pragma unroll
                for (int q4 = 0; q4 < 4; ++q4) { const f32x4 lv = lp[q4];
#pragma unroll
                    for (int i = 0; i < 4; ++i) a[q4 * 4 + i] += lv[i] * w; }
            }
            bf16_t* op = Wt_pb + ((size_t)l * 1024 + n0 + n) * 512 + g * 128 + cgp * 16;
            u32x4 o0, o1; o0.x = cvt_pk_bf16(a[0], a[1]); o0.y = cvt_pk_bf16(a[2], a[3]); o0.z = cvt_pk_bf16(a[4], a[5]); o0.w = cvt_pk_bf16(a[6], a[7]);
            o1.x = cvt_pk_bf16(a[8], a[9]); o1.y = cvt_pk_bf16(a[10], a[11]); o1.z = cvt_pk_bf16(a[12], a[13]); o1.w = cvt_pk_bf16(a[14], a[15]);
            *(u32x4*)op = o0; *(u32x4*)(op + 8) = o1;
            __syncthreads();
        }
        {
            LAS float* scr = (LAS float*)(lds + wave * 16640);
            constexpr int I_IN = 16 * 76, I_PA = 4 * 16, I_O = 16 * 16, I_UP = 16 * 64, I_DN = 64 * 16, I_L = I_IN + I_PA + I_O + I_UP + I_DN;
            for (int it = gw; it < DEPTH * I_L; it += NGW) {
                const int l = it / I_L; int r = it - l * I_L;
                if (r < I_IN) { transpose_item(P.in[7] + (size_t)l * DM * NIN, P.in[6] + l * DM, DM, NIN, Wt_in + (size_t)l * NIN * DM, scr, r, lane); continue; } r -= I_IN;
                if (r < I_PA) { transpose_item(P.in[8] + (size_t)l * 256 * DM, nullptr, 256, DM, Wt_pa + (size_t)l * DM * 256, scr, r, lane); continue; } r -= I_PA;
                if (r < I_O) { transpose_item(P.in[12] + (size_t)l * DM * DM, nullptr, DM, DM, Wt_o + (size_t)l * DM * DM, scr, r, lane); continue; } r -= I_O;
                if (r < I_UP) { transpose_item(P.in[14] + (size_t)l * DM * DFF, P.in[13] + l * DM, DM, DFF, Wt_up + (size_t)l * DFF * DM, scr, r, lane); continue; } r -= I_UP;
                transpose_item(P.in[15] + (size_t)l * DFF * DM, nullptr, DFF, DM, Wt_dn + (size_t)l * DM * DFF, scr, r, lane);
            }
        }
        for (int row = gw; row < NTOK; row += NGW) {
            const float* src = row < NTP ? P.in[0] + (size_t)row * DM : P.in[1] + (size_t)(row - NTP) * DM;
            float s = 0.f;
#pragma unroll
            for (int j = 0; j < 4; ++j) { const f32x4 v = *(const f32x4*)(src + 4 * lane + 256 * j); s += v[0] * v[0] + v[1] * v[1] + v[2] * v[2] + v[3] * v[3];
                *(f32x4*)(X + (size_t)row * DM + 4 * lane + 256 * j) = v;
                u32x2 w; w.x = cvt_pk_bf16(v[0], v[1]); w.y = cvt_pk_bf16(v[2], v[3]); *(u32x2*)(XB + (size_t)row * DM + 4 * lane + 256 * j) = w; }
#pragma unroll
            for (int o = 1; o < 64; o <<= 1) s += __shfl_xor(s, o);
            if (lane == 0) SS[row] = s;
        }
        for (size_t i = gtid; i < 4104 * 8; i += nth) { const int pi = (int)(i >> 3), k = (int)(i & 7); const float pos = (float)(pi < 4096 ? pi : 8192 + pi - 4096);
            const float inv = powf(500000.0f, -(float)(2 * k) / 16.0f); const float ang = pos * inv; ROPE[pi * 16 + k] = cosf(ang); ROPE[pi * 16 + 8 + k] = sinf(ang); }
        for (size_t i = gtid; i < (size_t)8 * NTOK; i += nth) SS[NTOK + i] = 0.f;
        for (size_t i = gtid; i < (size_t)DEPTH * 32 * 7 * 128; i += nth) { const size_t lb = i / (7 * 128), r = i - lb * (7 * 128);
            *(f32x4*)(out + O_POOLS + lb * 15 * 512 + r * 4) = *(const f32x4*)(P.in[5] + lb * 15 * 512 + 8 * 512 + r * 4); }
    }
    grid.sync();

    pg8::StaticOrder S;
#pragma unroll 1
    for (int step = 0; step < DEPTH * 7; ++step) {
        const int layer = step / 7, st = step - layer * 7;
        if (st == 1) {
            int tid_l = threadIdx.x; asm volatile("" : "+v"(tid_l));
            const int lane = tid_l & 63, gw = bid * 8 + (tid_l >> 6);
            const size_t gtid = (size_t)bid * NTHREADS + tid_l;
            size_t zoff = 0; asm volatile("" : "+s"(zoff));
            unsigned char* wsl = ws + zoff;
            bf16_t* QKV = (bf16_t*)(wsl + WS_QKV); bf16_t* UB = (bf16_t*)(wsl + WS_U); bf16_t* OA = (bf16_t*)(wsl + WS_OA); bf16_t* PB = (bf16_t*)(wsl + WS_P);
            bf16_t* PO = (bf16_t*)(wsl + WS_TMP); float* LSE = (float*)(wsl + WS_TMP + (size_t)3 * NTOK * 256 * 2);
            for (int it = gw; it < NTS * 12; it += NGW) { const int g = it % 3, r = it / 3; attn_sample_sub(QKV, g == 0 ? P.in[2] : (g == 1 ? P.in[3] : P.in[4]), PO, LSE, layer, r >> 2, r & 3, g, lane); }
            attn_mfma_phase(lds, QKV, PO, LSE, bid, G, tid_l);
            copy_shift<128>(P.in[2], out + O_KVS0, layer, gtid, nth);
            copy_shift<512>(P.in[3], out + O_KVS1, layer, gtid, nth);
            copy_shift<2048>(P.in[4], out + O_KVS2, layer, gtid, nth);
            xcd_barrier(xb);
            for (size_t base = gtid; base < (size_t)NTOK * 32; base += nth * 4) {
                float ls[4][3]; u32x4 av[4][3];
#pragma unroll
                for (int u = 0; u < 4; ++u) { const size_t idx = base + u * nth; const size_t ii = idx < (size_t)NTOK * 32 ? idx : base; const size_t token = ii >> 5; const int c = (int)(ii & 31) * 8, h = c >> 6;
#pragma unroll
                    for (int g = 0; g < 3; ++g) { ls[u][g] = LSE[((size_t)g * NTOK + token) * 4 + h]; av[u][g] = *(const u32x4*)(PO + ((size_t)g * NTOK + token) * 256 + c); } }
#pragma unroll
                for (int u = 0; u < 4; ++u) { const size_t idx = base + u * nth;
                    if (idx < (size_t)NTOK * 32) { const size_t token = idx >> 5; const int c = (int)(idx & 31) * 8;
                        const float mx = fmaxf(ls[u][0], fmaxf(ls[u][1], ls[u][2])); float w0 = __expf(ls[u][0] - mx), w1 = __expf(ls[u][1] - mx), w2 = __expf(ls[u][2] - mx); const float iw = 1.0f / (w0 + w1 + w2); w0 *= iw; w1 *= iw; w2 *= iw;
                        float a0[8], a1[8], a2[8], o[8]; unpack8(av[u][0], a0); unpack8(av[u][1], a1); unpack8(av[u][2], a2);
#pragma unroll
                        for (int k = 0; k < 8; ++k) o[k] = w0 * a0[k] + w1 * a1[k] + w2 * a2[k];
                        *(u32x4*)(OA + token * 256 + c) = pack8(o); } }
            }
            const float* sp = P.in[5] + (size_t)layer * 32 * 15 * 512;
            for (int it = (int)gtid; it < 4 * (NTOK / 8) * 16; it += (int)nth) {
                const int cl = it & 15, q = it >> 4, g = q / (NTOK / 8), tb = q - g * (NTOK / 8);
                if (g == 0) pool_item<0>(UB, PB, sp, tb, cl); else if (g == 1) pool_item<1>(UB, PB, sp, tb, cl); else if (g == 2) pool_item<2>(UB, PB, sp, tb, cl); else pool_item<3>(UB, PB, sp, tb, cl);
            }
            xcd_barrier(xb);
            continue;
        }
        pg8::Gemm g; EpiAll E; E.ws = ws; E.out = out; E.layer = layer; E.ssi = 0; E.ssn = 0;
        const int Mg = (st == 0) ? NTOK : NTP;
        g.M = Mg;
        if (st == 0)      { g.A = XB;  g.Bt = Wt_in + (size_t)layer * NIN * DM; g.N = NIN; g.K = DM;  E.mode = 0; E.ssi = 2 * layer; }
        else if (st == 2) { g.A = OA;  g.Bt = Wt_pa + (size_t)layer * DM * 256; g.N = DM;  g.K = 256; E.mode = 1; }
        else if (st == 3) { g.A = PB;  g.Bt = Wt_pb + (size_t)layer * DM * 512; g.N = DM;  g.K = 512; E.mode = 2; }
        else if (st == 4) { g.A = MIX; g.Bt = Wt_o + (size_t)layer * DM * DM;   g.N = DM;  g.K = DM;  E.mode = 3; E.ssn = 2 * layer + 1; }
        else if (st == 5) { g.A = XB;  g.Bt = Wt_up + (size_t)layer * DFF * DM; g.N = DFF; g.K = DM;  E.mode = 4; E.ssi = 2 * layer + 1; }
        else              { g.A = HID; g.Bt = Wt_dn + (size_t)layer * DM * DFF; g.N = DM;  g.K = DFF; E.mode = 3; E.ssn = 2 * layer + 2; }
        S.init(Mg, g.N, G, bid);
        pg8::gemm_phase<EpiAll, pg8::StaticOrder, true, true>(lds, g, S, E);
        if (st != 0) skinny_gemm(lds, g.A + (size_t)NTP * g.K, g.Bt, g.N, g.K, E, G - 1 - bid, G);
        if (st != 2) xcd_barrier(xb);
    }
    {
        int tid_l = threadIdx.x; asm volatile("" : "+v"(tid_l));
        const int lane = tid_l & 63, gw = bid * 8 + (tid_l >> 6);
        size_t zoff = 0; asm volatile("" : "+s"(zoff));
        unsigned char* wsl = ws + zoff;
        float* X = (float*)(wsl + WS_X);
        const float* fn = P.in[16]; const float* ssf = (const float*)(wsl + WS_SS) + (size_t)8 * NTOK;
        for (int row = gw; row < NTOK; row += 2 * NGW) {
            const int r2 = row + NGW; const bool ok2 = r2 < NTOK; const int rb = ok2 ? r2 : row;
            const float s0 = ssf[row], s1 = ssf[rb];
            f32x4 va[4], vb[4], gn[4];
#pragma unroll
            for (int j = 0; j < 4; ++j) { const int c = 4 * lane + 256 * j; va[j] = *(const f32x4*)(X + (size_t)row * DM + c); vb[j] = *(const f32x4*)(X + (size_t)rb * DM + c); gn[j] = *(const f32x4*)(fn + c); }
            const float rs0 = rsqrtf(s0 * (1.0f / 1024.0f) + 1e-6f), rs1 = rsqrtf(s1 * (1.0f / 1024.0f) + 1e-6f);
#pragma unroll
            for (int j = 0; j < 4; ++j) { const int c = 4 * lane + 256 * j;
                *(f32x4*)(out + (size_t)row * DM + c) = (f32x4){va[j][0] * rs0 * gn[j][0], va[j][1] * rs0 * gn[j][1], va[j][2] * rs0 * gn[j][2], va[j][3] * rs0 * gn[j][3]};
                if (ok2) *(f32x4*)(out + (size_t)r2 * DM + c) = (f32x4){vb[j][0] * rs1 * gn[j][0], vb[j][1] * rs1 * gn[j][1], vb[j][2] * rs1 * gn[j][2], vb[j][3] * rs1 * gn[j][3]}; }
        }
    }
}

extern "C" void kernel_launch(void* const* d_in, const int* in_sizes, int n_in, void* d_out, int out_size, void* d_ws, size_t ws_size, hipStream_t stream) {
    static int grid_blocks = 0;
    if (grid_blocks == 0) {
        if (n_in != 17 || ws_size < WS_END) { fprintf(stderr, "kernel_launch: unexpected n_in %d / ws %zu (need %zu)\n", n_in, ws_size, (size_t)WS_END); grid_blocks = -1; return; }
        int dev = 0, cus = 0, per_cu = 0;
        (void)hipGetDevice(&dev);
        (void)hipDeviceGetAttribute(&cus, hipDeviceAttributeMultiprocessorCount, dev);
        if (hipFuncSetAttribute((const void*)fwd_megakernel, hipFuncAttributeMaxDynamicSharedMemorySize, LDS_BYTES) != hipSuccess) { fprintf(stderr, "kernel_launch: hipFuncSetAttribute failed\n"); grid_blocks = -1; return; }
        (void)hipOccupancyMaxActiveBlocksPerMultiprocessor(&per_cu, (const void*)fwd_megakernel, NTHREADS, LDS_BYTES);
        if (per_cu < 1) { fprintf(stderr, "kernel_launch: occupancy query says %d blocks/CU\n", per_cu); grid_blocks = -1; return; }
        grid_blocks = cus * 1;
    }
    if (grid_blocks < 0) return;
    if (hipMemsetAsync((unsigned char*)d_ws + WS_BAR, 0, 4096 * 4, stream) != hipSuccess) { fprintf(stderr, "kernel_launch: memset of barrier words failed\n"); return; }
    Params p{};
    for (int i = 0; i < 17; ++i) p.in[i] = (const float*)d_in[i];
    p.out = (float*)d_out; p.ws = (unsigned char*)d_ws;
    void* args[] = {&p};
    hipError_t e = hipLaunchCooperativeKernel((const void*)fwd_megakernel, dim3(grid_blocks), dim3(NTHREADS), args, LDS_BYTES, stream);
    if (e != hipSuccess) fprintf(stderr, "cooperative launch failed: %s (grid %d)\n", hipGetErrorString(e), grid_blocks);
}
```

```cpp
#include <hip/hip_runtime.h>
#include <hip/hip_cooperative_groups.h>
#include <cstdio>
#include <cstdint>
namespace cg = cooperative_groups;

namespace pg8 {
#define PG8_LAS __attribute__((address_space(3)))
typedef unsigned short bf16_t;
typedef short bf16x8 __attribute__((ext_vector_type(8)));
typedef float f32x4 __attribute__((ext_vector_type(4)));
typedef unsigned u32x4 __attribute__((ext_vector_type(4)));
typedef unsigned u32x2 __attribute__((ext_vector_type(2)));
constexpr int BM = 256, BK = 64, HALF = 128, HTB = HALF * BK * 2, STAGE_BYTES = 8 * HTB, NXCD = 8, WGM = 8;

__host__ __device__ __forceinline__ int lds_byte(int r, int c) { const int st = (r >> 4) * 2 + (c >> 5), rr = r & 15, cc = c & 31, ob = rr * 64 + cc * 2; return st * 1024 + (ob ^ (((ob >> 9) & 1) << 5)); }
__host__ __device__ __forceinline__ void stage_rc(int b, int& R, int& C) { const int st = b / 1024, sb = b % 1024, swz = sb ^ (((sb >> 9) & 1) << 5); R = (st >> 1) * 16 + swz / 64; C = (st & 1) * 32 + (swz % 64) / 2; }
__host__ __device__ __forceinline__ int perm32(int rho) { const int n = rho >> 4, i = rho & 15; return 8 * (i >> 2) + 4 * n + (i & 3); }

struct Unit { int pm, pn; };
struct Gemm { const bf16_t* A; const bf16_t* Bt; int M, N, K; };

struct StaticOrder {
    int nM, nN, nwg, G, c;
    __host__ __device__ void init(int M, int N, int G_, int c_) { nM = M / BM; nN = N / BM; nwg = nM * nN; G = G_; c = c_; }
    __host__ __device__ bool next(int i, Unit& u) const {
        const long L = (long)i * G + c; if (L >= nwg) return false;
        int wgid = (int)L; { const int q = nwg / NXCD, r = nwg % NXCD, xcd = wgid % NXCD, off = wgid / NXCD; wgid = (xcd < r ? xcd * (q + 1) : r * (q + 1) + (xcd - r) * q) + off; }
        const int nig = WGM * nN, gid = wgid / nig, fm = gid * WGM, gsz = (nM - fm) < WGM ? (nM - fm) : WGM;
        u.pm = fm + ((wgid % nig) % gsz); u.pn = (wgid % nig) / gsz; return true;
    }
    __device__ __forceinline__ void a_ready(const Unit&) const {}
    __device__ __forceinline__ void done(const Unit&) const {}
};

__device__ __forceinline__ unsigned cvt_pk_bf16(float lo, float hi) { unsigned r; asm volatile("v_cvt_pk_bf16_f32 %0, %1, %2" : "=v"(r) : "v"(lo), "v"(hi)); return r; }

template <class Epi, class Sched, bool ALIGN_EPI = false, bool SP2 = false>
__device__ __forceinline__ void gemm_phase(PG8_LAS unsigned char* lds, const Gemm g, const Sched& S, const Epi& E) {
    int tid = threadIdx.x; asm volatile("" : "+v"(tid));
    const int wid = __builtin_amdgcn_readfirstlane(tid >> 6), lane = tid & 63, wr = wid >> 2, wc = wid & 3, fr = lane & 15, fq = lane >> 4;
    const int K = g.K, nt = K / BK;
    unsigned voffA[2], voffB[2];
#pragma unroll
    for (int i = 0; i < 2; ++i) { int R, C; stage_rc(tid * 16 + i * 8192, R, C); const int Rb = Epi::PERM ? ((R & ~31) + perm32(R & 31)) : R;
        voffA[i] = (unsigned)(R * K + C) * 2u; voffB[i] = (unsigned)(Rb * K + C) * 2u; }
    const size_t kstep = (size_t)(BK * 2);
    const size_t hstep = (size_t)HALF * K * 2;
    const size_t tstep = 2 * hstep;
    const unsigned ldsw = (unsigned)wid * 1024u;
    const int aoff = lds_byte(wr * 64 + fr, fq * 8), boff = lds_byte(wc * 32 + fr, fq * 8);
#define PG8_SA(b, h) (((b) * 2 + (h)) * HTB)
#define PG8_SB(b, h) ((4 + (b) * 2 + (h)) * HTB)
#define PG8_STAGE(bufoff, gbase, voff) do { _Pragma("unroll") for (int _i = 0; _i < 2; ++_i) \
        __builtin_amdgcn_global_load_lds((const unsigned*)((const char*)(gbase) + (voff)[_i]), (PG8_LAS unsigned*)(lds + (bufoff) + ldsw + _i * 8192), 16, 0, 0); } while (0)
#define PG8_LDA(dst, b, h) do { _Pragma("unroll") for (int m = 0; m < 4; ++m) _Pragma("unroll") for (int k = 0; k < 2; ++k) dst[m][k] = *(const PG8_LAS bf16x8*)(lds + PG8_SA(b, h) + aoff + m * 2048 + k * 1024); } while (0)
#define PG8_LDB(dst, b, h) do { _Pragma("unroll") for (int n = 0; n < 2; ++n) _Pragma("unroll") for (int k = 0; k < 2; ++k) dst[n][k] = *(const PG8_LAS bf16x8*)(lds + PG8_SB(b, h) + boff + n * 2048 + k * 1024); } while (0)
#define PG8_MMA(ai, bj, At, Bt) do { __builtin_amdgcn_s_setprio(1); _Pragma("unroll") for (int m = 0; m < 4; ++m) _Pragma("unroll") for (int n = 0; n < 2; ++n) _Pragma("unroll") for (int k = 0; k < 2; ++k) \
        acc[ai][bj][m][n] = __builtin_amdgcn_mfma_f32_16x16x32_bf16(Bt[n][k], At[m][k], acc[ai][bj][m][n], 0, 0, 0); __builtin_amdgcn_s_setprio(0); } while (0)
#define PG8_WAIT_V(n) asm volatile("s_waitcnt vmcnt(" #n ")" ::: "memory")
#define PG8_WAIT_L(n) asm volatile("s_waitcnt lgkmcnt(" #n ")" ::: "memory")
#define PG8_BAR __builtin_amdgcn_s_barrier()
#define PG8_SCHED __builtin_amdgcn_sched_barrier(0)
    Unit cur, nxt; int ui = 0;
    if (!S.next(0, cur)) return;
    f32x4 acc[2][2][4][2];
#pragma unroll
    for (int a = 0; a < 2; ++a)
#pragma unroll
        for (int b = 0; b < 2; ++b)
#pragma unroll
            for (int m = 0; m < 4; ++m)
#pragma unroll
                for (int n = 0; n < 2; ++n) acc[a][b][m][n] = (f32x4){0.f, 0.f, 0.f, 0.f};
    bf16x8 At[4][2], B0[2][2], B1[2][2];
    const char* cA = (const char*)g.A + (size_t)cur.pm * tstep; const char* cB = (const char*)g.Bt + (size_t)cur.pn * tstep;
    S.a_ready(cur);
    if constexpr (SP2) {
        PG8_STAGE(PG8_SB(0, 0), cB, voffB); PG8_STAGE(PG8_SB(0, 1), cB + hstep, voffB); PG8_STAGE(PG8_SA(0, 0), cA, voffA); PG8_STAGE(PG8_SA(0, 1), cA + hstep, voffA);
        if (wr == 1) PG8_BAR;
        PG8_WAIT_V(2); PG8_BAR;
        PG8_STAGE(PG8_SB(1, 0), cB + kstep, voffB); PG8_STAGE(PG8_SA(1, 0), cA + kstep, voffA); PG8_STAGE(PG8_SB(1, 1), cB + hstep + kstep, voffB);
        PG8_WAIT_V(6); PG8_BAR;
    } else {
        PG8_STAGE(PG8_SB(0, 0), cB, voffB); PG8_STAGE(PG8_SA(0, 0), cA, voffA); PG8_STAGE(PG8_SB(0, 1), cB + hstep, voffB); PG8_STAGE(PG8_SA(0, 1), cA + hstep, voffA);
        if (wr == 1) PG8_BAR;
        PG8_WAIT_V(4); PG8_BAR;
        PG8_STAGE(PG8_SB(1, 0), cB + kstep, voffB); PG8_STAGE(PG8_SA(1, 0), cA + kstep, voffA); PG8_STAGE(PG8_SB(1, 1), cB + hstep + kstep, voffB);
        PG8_WAIT_V(6); PG8_BAR;
    }
    for (;;) {
        const bool has_next = S.next(ui + 1, nxt);
        const char* nA = has_next ? (const char*)g.A + (size_t)nxt.pm * tstep : cA; const char* nB = has_next ? (const char*)g.Bt + (size_t)nxt.pn * tstep : cB;
        for (int t = 0; t < nt; t += 2) {
            const bool last = (t == nt - 2);
            const char* a1 = cA + (size_t)(t + 1) * kstep;
            const char* a2 = last ? nA : cA + (size_t)(t + 2) * kstep; const char* b2 = last ? nB : cB + (size_t)(t + 2) * kstep;
            const char* a3 = a2 + kstep; const char* b3 = b2 + kstep;
            if (last && has_next) S.a_ready(nxt);
            if constexpr (SP2) {
            PG8_LDB(B0, 0, 0); PG8_LDB(B1, 0, 1); PG8_SCHED; PG8_LDA(At, 0, 0); PG8_STAGE(PG8_SA(1, 1), a1 + hstep, voffA);
            PG8_WAIT_V(8); PG8_WAIT_L(0); PG8_BAR; PG8_MMA(0, 0, At, B0); PG8_MMA(0, 1, At, B1); PG8_BAR; PG8_SCHED;
            PG8_LDA(At, 0, 1); PG8_STAGE(PG8_SB(0, 0), b2, voffB); PG8_STAGE(PG8_SB(0, 1), b2 + hstep, voffB); PG8_STAGE(PG8_SA(0, 0), a2, voffA);
            PG8_WAIT_V(8); PG8_WAIT_L(0); PG8_BAR; PG8_MMA(1, 0, At, B0); PG8_MMA(1, 1, At, B1); PG8_BAR; PG8_SCHED;
            PG8_LDB(B0, 1, 0); PG8_LDB(B1, 1, 1); PG8_SCHED; PG8_LDA(At, 1, 0); PG8_STAGE(PG8_SA(0, 1), a2 + hstep, voffA);
            PG8_WAIT_V(8); PG8_WAIT_L(0); PG8_BAR; PG8_MMA(0, 0, At, B0); PG8_MMA(0, 1, At, B1); PG8_BAR; PG8_SCHED;
            PG8_LDA(At, 1, 1); PG8_STAGE(PG8_SB(1, 0), b3, voffB); PG8_STAGE(PG8_SB(1, 1), b3 + hstep, voffB); PG8_STAGE(PG8_SA(1, 0), a3, voffA);
            PG8_WAIT_V(8); PG8_WAIT_L(0); PG8_BAR; PG8_MMA(1, 0, At, B0); PG8_MMA(1, 1, At, B1); PG8_BAR; PG8_SCHED;
            } else {
            PG8_LDB(B0, 0, 0); PG8_SCHED; PG8_LDA(At, 0, 0); PG8_STAGE(PG8_SA(1, 1), a1 + hstep, voffA);
            PG8_WAIT_L(8); PG8_BAR; PG8_WAIT_L(0); PG8_MMA(0, 0, At, B0); PG8_BAR; PG8_SCHED;
            PG8_LDB(B1, 0, 1); PG8_STAGE(PG8_SB(0, 0), b2, voffB);
            PG8_BAR; PG8_WAIT_L(0); PG8_MMA(0, 1, At, B1); PG8_BAR;
            PG8_LDA(At, 0, 1); PG8_STAGE(PG8_SA(0, 0), a2, voffA);
            PG8_BAR; PG8_WAIT_L(0); PG8_MMA(1, 0, At, B0); PG8_BAR; PG8_SCHED;
            PG8_STAGE(PG8_SB(0, 1), b2 + hstep, voffB);
            PG8_WAIT_V(6); PG8_BAR; PG8_MMA(1, 1, At, B1); PG8_BAR;
            PG8_LDB(B0, 1, 0); PG8_SCHED; PG8_LDA(At, 1, 0); PG8_STAGE(PG8_SA(0, 1), a2 + hstep, voffA);
            PG8_WAIT_L(8); PG8_BAR; PG8_WAIT_L(0); PG8_MMA(0, 0, At, B0); PG8_BAR; PG8_SCHED;
            PG8_LDB(B1, 1, 1); PG8_STAGE(PG8_SB(1, 0), b3, voffB);
            PG8_BAR; PG8_WAIT_L(0); PG8_MMA(0, 1, At, B1); PG8_BAR;
            PG8_LDA(At, 1, 1); PG8_STAGE(PG8_SA(1, 0), a3, voffA);
            PG8_BAR; PG8_WAIT_L(0); PG8_MMA(1, 0, At, B0); PG8_BAR; PG8_SCHED;
            PG8_STAGE(PG8_SB(1, 1), b3 + hstep, voffB);
            PG8_WAIT_V(6); PG8_BAR; PG8_MMA(1, 1, At, B1); PG8_BAR;
            }
        }
        if constexpr (ALIGN_EPI) { if (wr == 0) PG8_BAR; }
        E(acc, cur, wr, wc, fr, fq); S.done(cur);
        if (!has_next) break;
#pragma unroll
        for (int a = 0; a < 2; ++a)
#pragma unroll
            for (int b = 0; b < 2; ++b)
#pragma unroll
                for (int m = 0; m < 4; ++m)
#pragma unroll
                    for (int n = 0; n < 2; ++n) acc[a][b][m][n] = (f32x4){0.f, 0.f, 0.f, 0.f};
        cur = nxt; cA = nA; cB = nB; ++ui;
        if constexpr (ALIGN_EPI) { if (wr == 1) PG8_BAR; }
    }
    PG8_WAIT_V(0);
    if constexpr (!ALIGN_EPI) { if (wr == 0) PG8_BAR; }
    PG8_BAR;
#undef PG8_SA
#undef PG8_SB
#undef PG8_STAGE
#undef PG8_LDA
#undef PG8_LDB
#undef PG8_MMA
#undef PG8_WAIT_V
#undef PG8_WAIT_L
#undef PG8_BAR
#undef PG8_SCHED
}
}

using pg8::bf16_t; using pg8::f32x4; using pg8::u32x4; using pg8::u32x2; using pg8::Unit; using pg8::cvt_pk_bf16;
#define LAS __attribute__((address_space(3)))

constexpr int DM = 1024, TP = 4096, NTP = 16384, NTS = 256, NTOK = 16640, DEPTH = 4, NIN = 4864, DFF = 4096;
constexpr int NTHREADS = 512, LDS_BYTES = 147456;
constexpr size_t O_YP = 0, O_YS = 16777216, O_KVP0 = 17039360, O_KVP1 = 18087936, O_KVP2 = 22282240, O_POOLP = 39059456,
                 O_KVS0 = 39182336, O_KVS1 = 47570944, O_KVS2 = 81125376, O_POOLS = 215343104;
constexpr size_t WS_WIN = 0;
constexpr size_t WS_WPA = WS_WIN + (size_t)DEPTH * NIN * DM * 2;
constexpr size_t WS_WPB = WS_WPA + (size_t)DEPTH * DM * 256 * 2;
constexpr size_t WS_WO  = WS_WPB + (size_t)DEPTH * DM * 512 * 2;
constexpr size_t WS_WUP = WS_WO  + (size_t)DEPTH * DM * DM * 2;
constexpr size_t WS_WDN = WS_WUP + (size_t)DEPTH * DFF * DM * 2;
constexpr size_t WS_X   = WS_WDN + (size_t)DEPTH * DM * DFF * 2;
constexpr size_t WS_XB  = WS_X   + (size_t)NTOK * DM * 4;
constexpr size_t WS_QKV = WS_XB  + (size_t)NTOK * DM * 2;
constexpr size_t WS_U   = WS_QKV + (size_t)NTOK * 2304 * 2;
constexpr size_t WS_G   = WS_U   + (size_t)NTOK * 512 * 2;
constexpr size_t WS_OA  = WS_G   + (size_t)NTOK * 2048 * 2;
constexpr size_t WS_P   = WS_OA  + (size_t)NTOK * 256 * 2;
constexpr size_t WS_TMP = WS_P   + (size_t)NTOK * 512 * 2;
constexpr size_t WS_MIX = WS_TMP + (size_t)NTOK * DM * 4;
constexpr size_t WS_H   = WS_MIX + (size_t)NTOK * DM * 2;
constexpr size_t WS_SS  = WS_H   + (size_t)NTOK * DFF * 2;
constexpr size_t WS_ROPE = WS_SS + (size_t)9 * NTOK * 4;
constexpr size_t WS_BAR = WS_ROPE + (size_t)4104 * 16 * 4;
constexpr size_t WS_END = WS_BAR + (size_t)4096 * 4;

struct Params { const float* in[17]; float* out; unsigned char* ws; };

__device__ __forceinline__ void unpack8(const u32x4 w, float (&f)[8]) {
    f[0] = __uint_as_float(w.x << 16); f[1] = __uint_as_float(w.x & 0xffff0000u);
    f[2] = __uint_as_float(w.y << 16); f[3] = __uint_as_float(w.y & 0xffff0000u);
    f[4] = __uint_as_float(w.z << 16); f[5] = __uint_as_float(w.z & 0xffff0000u);
    f[6] = __uint_as_float(w.w << 16); f[7] = __uint_as_float(w.w & 0xffff0000u);
}
__device__ __forceinline__ u32x4 pack8(const float (&f)[8]) {
    u32x4 w; w.x = cvt_pk_bf16(f[0], f[1]); w.y = cvt_pk_bf16(f[2], f[3]); w.z = cvt_pk_bf16(f[4], f[5]); w.w = cvt_pk_bf16(f[6], f[7]); return w;
}
__device__ __forceinline__ unsigned bf16_lo_pair(float a, float b, unsigned hi) { return cvt_pk_bf16(a - __uint_as_float(hi << 16), b - __uint_as_float(hi & 0xffff0000u)); }
__device__ __forceinline__ float sigmoidf_(float x) { return __builtin_amdgcn_rcpf(1.0f + __builtin_amdgcn_exp2f(x * -1.44269504089f)); }

struct EpiAll {
    static constexpr bool PERM = true, AFTER_DRAIN = false;
    int mode, layer, ssi, ssn; unsigned char* ws; float* out;

    struct Pre { u32x4 g; f32x4 a, b; float rs; };

    template <int MODE> __device__ __forceinline__ Pre pre(unsigned char* ws, int row, int c) const {
        Pre p;
        if constexpr (MODE == 0 || MODE == 4) p.rs = ((const float*)(ws + WS_SS) + (size_t)ssi * NTOK)[row];
        if constexpr (MODE == 1) p.g = *(const u32x4*)((const bf16_t*)(ws + WS_G) + (size_t)row * 2048 + c);
        if constexpr (MODE == 2) { p.g = *(const u32x4*)((const bf16_t*)(ws + WS_G) + (size_t)row * 2048 + 1024 + c);
            p.a = __builtin_bit_cast(f32x4, *(const u32x4*)((const bf16_t*)(ws + WS_TMP) + (size_t)row * DM + c)); }
        if constexpr (MODE == 3) { p.a = __builtin_bit_cast(f32x4, *(const u32x4*)((const bf16_t*)(ws + WS_XB) + (size_t)row * DM + c)); p.b = __builtin_bit_cast(f32x4, *(const u32x4*)((const bf16_t*)(ws + WS_X) + (size_t)row * DM + c)); }
        return p;
    }
    __device__ __forceinline__ void fin_proj(unsigned char* ws, int row, int c32, int fq, float (&v)[8], const Pre& p) const {
        const int pn = c32 >> 8, cl = (c32 & 255) + 8 * fq;
        const float rs = __builtin_amdgcn_rsqf(p.rs * (1.0f / 1024.0f) + 1e-6f);
        const bool samp = row >= NTP;
        const int b = samp ? ((row - NTP) >> 3) : (row >> 12);
        const int t = samp ? (row & 7) : (row & 4095);
#pragma unroll
        for (int i = 0; i < 8; ++i) v[i] *= rs;
        if (pn < 6 && ((c32 >> 5) & 1) == 0) {
            float pv[8];
#pragma unroll
            for (int i = 0; i < 8; ++i) pv[i] = __shfl_xor(v[i], 16);
            if (fq < 2) {
                const int pi = samp ? (4096 + t) : t;
                const f32x4* rp = (const f32x4*)((const float*)(ws + WS_ROPE) + (size_t)pi * 16);
                const f32x4 c0 = rp[0], c1 = rp[1], s0 = rp[2], s1 = rp[3];
                const float sg = (fq == 0) ? -1.0f : 1.0f;
#pragma unroll
                for (int i = 0; i < 4; ++i) { v[i] = v[i] * c0[i] + sg * pv[i] * s0[i]; v[4 + i] = v[4 + i] * c1[i] + sg * pv[4 + i] * s1[i]; }
            }
        }
        if (pn >= 11) {
#pragma unroll
            for (int i = 0; i < 8; ++i) v[i] = sigmoidf_(v[i]);
        }
        bf16_t* dst; int ld, cbase;
        if (pn < 9) { dst = (bf16_t*)(ws + WS_QKV); ld = 2304; cbase = pn * 256; }
        else if (pn < 11) { dst = (bf16_t*)(ws + WS_U); ld = 512; cbase = (pn - 9) * 256; }
        else { dst = (bf16_t*)(ws + WS_G); ld = 2048; cbase = (pn - 11) * 256; }
        *(u32x4*)(dst + (size_t)row * ld + cbase + cl) = pack8(v);
        if (pn >= 3 && pn < 9) {
            const int kvi = pn - 3; const int g = (kvi >= 3) ? kvi - 3 : kvi; const int kv = (kvi >= 3) ? 1 : 0;
            const int W = 128 << (2 * g);
            const size_t okp = (g == 0) ? O_KVP0 : (g == 1 ? O_KVP1 : O_KVP2);
            const size_t oks = (g == 0) ? O_KVS0 : (g == 1 ? O_KVS1 : O_KVS2);
            float* op = nullptr;
            if (samp) op = out + oks + ((size_t)((layer * 32 + b) * W + (W - 8 + t)) * 2 + kv) * 256 + cl;
            else if (t >= TP - W) op = out + okp + ((size_t)((layer * 4 + b) * W + (t - (TP - W))) * 2 + kv) * 256 + cl;
            if (op) { *(f32x4*)op = (f32x4){v[0], v[1], v[2], v[3]}; *(f32x4*)(op + 4) = (f32x4){v[4], v[5], v[6], v[7]}; }
        } else if (pn >= 9 && pn < 11) {
            float* op = nullptr; const int c = cbase + cl;
            if (samp) op = out + O_POOLS + (size_t)((layer * 32 + b) * 15 + 7 + t) * 512 + c;
            else if (t >= TP - 15) op = out + O_POOLP + (size_t)((layer * 4 + b) * 15 + (t - (TP - 15))) * 512 + c;
            if (op) { *(f32x4*)op = (f32x4){v[0], v[1], v[2], v[3]}; *(f32x4*)(op + 4) = (f32x4){v[4], v[5], v[6], v[7]}; }
        }
    }
    template <int MODE> __device__ __forceinline__ void fin(unsigned char* ws, int row, int c32, int fq, float (&v)[8], const Pre& p) const {
        const int c = c32 + 8 * fq;
        if constexpr (MODE == 0) fin_proj(ws, row, c32, fq, v, p);
        if constexpr (MODE == 1) {
            float gg[8]; unpack8(p.g, gg);
#pragma unroll
            for (int i = 0; i < 8; ++i) v[i] *= gg[i];
            *(u32x4*)((bf16_t*)(ws + WS_TMP) + (size_t)row * DM + c) = pack8(v);
        }
        if constexpr (MODE == 2) {
            float gg[8]; unpack8(p.g, gg);
            float tt[8]; unpack8(__builtin_bit_cast(u32x4, p.a), tt);
#pragma unroll
            for (int i = 0; i < 8; ++i) v[i] = tt[i] + gg[i] * v[i];
            *(u32x4*)((bf16_t*)(ws + WS_MIX) + (size_t)row * DM + c) = pack8(v);
        }
        if constexpr (MODE == 3) {
            float xh[8], xl[8]; unpack8(__builtin_bit_cast(u32x4, p.a), xh); unpack8(__builtin_bit_cast(u32x4, p.b), xl);
            float sq = 0.f;
#pragma unroll
            for (int i = 0; i < 8; ++i) { v[i] += xh[i] + xl[i]; sq += v[i] * v[i]; }
            const u32x4 hi = pack8(v);
            u32x4 lo; lo.x = bf16_lo_pair(v[0], v[1], hi.x); lo.y = bf16_lo_pair(v[2], v[3], hi.y); lo.z = bf16_lo_pair(v[4], v[5], hi.z); lo.w = bf16_lo_pair(v[6], v[7], hi.w);
            *(u32x4*)((bf16_t*)(ws + WS_XB) + (size_t)row * DM + c) = hi;
            *(u32x4*)((bf16_t*)(ws + WS_X) + (size_t)row * DM + c) = lo;
            sq += __shfl_xor(sq, 16); sq += __shfl_xor(sq, 32);
            if (fq == 0) atomicAdd((float*)(ws + WS_SS) + (size_t)ssn * NTOK + row, sq);
        }
        if constexpr (MODE == 4) {
            const float rs = __builtin_amdgcn_rsqf(p.rs * (1.0f / 1024.0f) + 1e-6f);
#pragma unroll
            for (int i = 0; i < 8; ++i) { const float a = fmaxf(v[i] * rs, 0.f); v[i] = a * a; }
            *(u32x4*)((bf16_t*)(ws + WS_H) + (size_t)row * DFF + c) = pack8(v);
        }
    }
    __device__ __forceinline__ void chunk(unsigned char* ws, int row, int c32, int fq, float (&v)[8]) const {
        const int c = c32 + 8 * fq;
        switch (mode) {
            case 0: { const Pre p = pre<0>(ws, row, c); fin<0>(ws, row, c32, fq, v, p); } break;
            case 1: { const Pre p = pre<1>(ws, row, c); fin<1>(ws, row, c32, fq, v, p); } break;
            case 2: { const Pre p = pre<2>(ws, row, c); fin<2>(ws, row, c32, fq, v, p); } break;
            case 3: { const Pre p = pre<3>(ws, row, c); fin<3>(ws, row, c32, fq, v, p); } break;
            default: { const Pre p = pre<4>(ws, row, c); fin<4>(ws, row, c32, fq, v, p); } break;
        }
    }
    template <int MODE> __device__ __forceinline__ void tile(unsigned char* ws, const f32x4 (&acc)[2][2][4][2], const Unit& u, int wr, int wc, int fr, int fq) const {
        constexpr int MB = (MODE == 2 || MODE == 3) ? 2 : 4;
#pragma unroll
        for (int ai = 0; ai < 2; ++ai)
#pragma unroll
            for (int m0 = 0; m0 < 4; m0 += MB) {
                Pre p[MB][2];
#pragma unroll
                for (int mm = 0; mm < MB; ++mm)
#pragma unroll
                    for (int bj = 0; bj < 2; ++bj) p[mm][bj] = pre<MODE>(ws, u.pm * 256 + ai * 128 + wr * 64 + (m0 + mm) * 16 + fr, u.pn * 256 + bj * 128 + wc * 32 + 8 * fq);
#pragma unroll
                for (int mm = 0; mm < MB; ++mm)
#pragma unroll
                    for (int bj = 0; bj < 2; ++bj) {
                        float v[8];
#pragma unroll
                        for (int i = 0; i < 4; ++i) { v[i] = acc[ai][bj][m0 + mm][0][i]; v[4 + i] = acc[ai][bj][m0 + mm][1][i]; }
                        fin<MODE>(ws, u.pm * 256 + ai * 128 + wr * 64 + (m0 + mm) * 16 + fr, u.pn * 256 + bj * 128 + wc * 32, fq, v, p[mm][bj]);
                    }
                asm volatile("" ::: "memory");
            }
    }
    __device__ __forceinline__ void operator()(const f32x4 (&acc)[2][2][4][2], const Unit& u, int wr, int wc, int fr, int fq) const {
        asm volatile("" : "+v"(fr), "+v"(fq));
        size_t zoff = 0; asm volatile("" : "+s"(zoff));
        unsigned char* ws = this->ws + zoff;
        switch (mode) {
            case 0: tile<0>(ws, acc, u, wr, wc, fr, fq); break;
            case 1: tile<1>(ws, acc, u, wr, wc, fr, fq); break;
            case 2: tile<2>(ws, acc, u, wr, wc, fr, fq); break;
            case 3: tile<3>(ws, acc, u, wr, wc, fr, fq); break;
            default: tile<4>(ws, acc, u, wr, wc, fr, fq); break;
        }
    }
};

__device__ __forceinline__ void skinny_gemm(LAS unsigned char* lds, const bf16_t* __restrict__ A, const bf16_t* __restrict__ Bt, int N, int K, const EpiAll& E, int first, int G) {
    using pg8::bf16x8;
    int tid = threadIdx.x; asm volatile("" : "+v"(tid));
    const int lane = tid & 63, w = __builtin_amdgcn_readfirstlane(tid >> 6), kg = lane >> 4, qn = lane & 15;
    const int nh = (N == 1024) ? 1 : 2, ksplit = 8 / nh;
    const int half = w % nh, kq = w / nh, Kq = K / ksplit, nsteps = Kq >> 5;
    size_t zoff = 0; asm volatile("" : "+s"(zoff));
    unsigned char* ws = E.ws + zoff;
    LAS float* red = (LAS float*)lds;
    const int RB = 8 / nh, units = RB * (N >> 5);
#pragma unroll 1
    for (int u = first; u < units; u += G) {
        const int rb = u % RB, c32 = (u / RB) << 5;
        const int row0 = rb * 32 * nh + half * 32;
        const bf16_t* ap = A + (size_t)(row0 + qn) * K + kq * Kq + kg * 8;
        const bf16_t* bp = Bt + (size_t)(c32 + 8 * (qn >> 2) + (qn & 3)) * K + kq * Kq + kg * 8;
        f32x4 acc[2][2];
#pragma unroll
        for (int a = 0; a < 2; ++a)
#pragma unroll
            for (int b = 0; b < 2; ++b) acc[a][b] = (f32x4){0.f, 0.f, 0.f, 0.f};
#pragma unroll 8
        for (int ks = 0; ks < nsteps; ++ks) {
            const bf16x8 x0 = *(const bf16x8*)(ap + ks * 32), x1 = *(const bf16x8*)(ap + (size_t)16 * K + ks * 32);
            const bf16x8 w0 = *(const bf16x8*)(bp + ks * 32), w1 = *(const bf16x8*)(bp + (size_t)4 * K + ks * 32);
            acc[0][0] = __builtin_amdgcn_mfma_f32_16x16x32_bf16(w0, x0, acc[0][0], 0, 0, 0);
            acc[0][1] = __builtin_amdgcn_mfma_f32_16x16x32_bf16(w1, x0, acc[0][1], 0, 0, 0);
            acc[1][0] = __builtin_amdgcn_mfma_f32_16x16x32_bf16(w0, x1, acc[1][0], 0, 0, 0);
            acc[1][1] = __builtin_amdgcn_mfma_f32_16x16x32_bf16(w1, x1, acc[1][1], 0, 0, 0);
        }
        __syncthreads();
        if (kq != 0) {
#pragma unroll
            for (int a = 0; a < 2; ++a)
#pragma unroll
                for (int b = 0; b < 2; ++b)
#pragma unroll
                    for (int i = 0; i < 4; ++i) red[(w * 16 + a * 8 + b * 4 + i) * 64 + lane] = acc[a][b][i];
        }
        __syncthreads();
        if (kq == 0) {
#pragma unroll 1
            for (int q = 1; q < ksplit; ++q)
#pragma unroll
                for (int a = 0; a < 2; ++a)
#pragma unroll
                    for (int b = 0; b < 2; ++b)
#pragma unroll
                        for (int i = 0; i < 4; ++i) acc[a][b][i] += red[((w + nh * q) * 16 + a * 8 + b * 4 + i) * 64 + lane];
#pragma unroll
            for (int a = 0; a < 2; ++a) {
                float v[8];
#pragma unroll
                for (int i = 0; i < 4; ++i) { v[i] = acc[a][0][i]; v[4 + i] = acc[a][1][i]; }
                E.chunk(ws, NTP + row0 + a * 16 + qn, c32, kg, v);
            }
        }
    }
    __syncthreads();
}

__device__ __forceinline__ void lds_wait() { asm volatile("s_waitcnt lgkmcnt(0)" ::: "memory"); }
__device__ __forceinline__ void transpose_item(const float* __restrict__ W, const float* __restrict__ gsc, int K, int N, bf16_t* __restrict__ WT, LAS float* scr, int item, int lane) {
    const int nblk = N / 64, kb = item / nblk, nb = item % nblk, k0 = 64 * kb, n0 = 64 * nb;
    f32x4 v[16];
#pragma unroll
    for (int i = 0; i < 16; ++i) v[i] = *(const f32x4*)(W + (size_t)(k0 + 4 * i + (lane >> 4)) * N + n0 + 4 * (lane & 15));
#pragma unroll
    for (int i = 0; i < 16; ++i) { const int kk = 4 * i + (lane >> 4); const float sc = gsc ? gsc[k0 + kk] : 1.0f; LAS float* d = scr + kk * 65 + 4 * (lane & 15);
        d[0] = v[i][0] * sc; d[1] = v[i][1] * sc; d[2] = v[i][2] * sc; d[3] = v[i][3] * sc; }
    lds_wait();
    const int c = lane & 7;
#pragma unroll
    for (int j = 0; j < 8; ++j) { const int n = (lane >> 3) + 8 * j; const LAS float* sp = scr + (8 * c) * 65 + n;
        u32x4 o; o.x = cvt_pk_bf16(sp[0 * 65], sp[1 * 65]); o.y = cvt_pk_bf16(sp[2 * 65], sp[3 * 65]); o.z = cvt_pk_bf16(sp[4 * 65], sp[5 * 65]); o.w = cvt_pk_bf16(sp[6 * 65], sp[7 * 65]);
        *(u32x4*)(WT + (size_t)(n0 + n) * K + k0 + 8 * c) = o; }
    lds_wait();
}

template <int L>
__device__ __forceinline__ void copy_shift(const float* __restrict__ src, float* __restrict__ dst, int layer, size_t gtid, size_t nth) {
    constexpr size_t per = (size_t)(L - 8) * 128;
    constexpr size_t total = (size_t)32 * per;
    constexpr int U = 8;
    const f32x4* s4 = (const f32x4*)src + (size_t)layer * 32 * L * 128; f32x4* d4 = (f32x4*)dst + (size_t)layer * 32 * L * 128;
    for (size_t i = gtid; i < total; i += nth * U) {
        f32x4 v[U];
#pragma unroll
        for (int u = 0; u < U; ++u) { const size_t idx = i + u * nth; const size_t ii = idx < total ? idx : 0; const size_t lb = ii / per, r = ii - lb * per;
            v[u] = __builtin_nontemporal_load(s4 + lb * (size_t)L * 128 + r + 8 * 128); }
#pragma unroll
        for (int u = 0; u < U; ++u) { const size_t idx = i + u * nth; if (idx < total) { const size_t lb = idx / per, r = idx - lb * per; __builtin_nontemporal_store(v[u], d4 + lb * (size_t)L * 128 + r); } }
    }
}

#define ATT_DOT(S, Q, KF) do { float _s = 0.f; _Pragma("unroll") for (int _i = 0; _i < 8; ++_i) _s += Q[_i] * KF[_i]; \
    _s += __shfl_xor(_s, 1); _s += __shfl_xor(_s, 2); _s += __shfl_xor(_s, 4); S = _s; } while (0)

__device__ __forceinline__ void attn_finish(float m, float l, float (&o)[8], bf16_t* dstp, int kg) {
    float M = m; M = fmaxf(M, __shfl_xor(M, 8)); M = fmaxf(M, __shfl_xor(M, 16)); M = fmaxf(M, __shfl_xor(M, 32));
    const float f = __expf(m - M); l *= f;
#pragma unroll
    for (int i = 0; i < 8; ++i) o[i] *= f;
    l += __shfl_xor(l, 8); l += __shfl_xor(l, 16); l += __shfl_xor(l, 32);
#pragma unroll
    for (int i = 0; i < 8; ++i) { o[i] += __shfl_xor(o[i], 8); o[i] += __shfl_xor(o[i], 16); o[i] += __shfl_xor(o[i], 32); }
    const float inv = 1.0f / l;
#pragma unroll
    for (int i = 0; i < 8; ++i) o[i] *= inv;
    if (kg == 0) *(u32x4*)dstp = pack8(o);
}

__device__ __forceinline__ void attn_prompt_item(const bf16_t* __restrict__ qkv, bf16_t* __restrict__ oa, int token, int h, int lane) {
    const int kg = lane >> 3, dl = lane & 7;
    const int b = token >> 12, t = token & 4095;
    const bf16_t* qrow = qkv + (size_t)token * 2304 + h * 64 + dl * 8;
    const bf16_t* kbase = qkv + (size_t)(b << 12) * 2304 + 768 + h * 64 + dl * 8;
    float m = -1e30f, l = 0.f; float o[8];
#pragma unroll
    for (int i = 0; i < 8; ++i) o[i] = 0.f;
#pragma unroll 1
    for (int g = 0; g < 3; ++g) {
        const int d = 1 << (2 * g);
        float q[8]; unpack8(*(const u32x4*)(qrow + g * 256), q);
#pragma unroll
        for (int i = 0; i < 8; ++i) q[i] *= 0.125f;
        const bf16_t* kb = kbase + g * 256;
#pragma unroll 1
        for (int it = 0; it < 16; it += 4) {
            u32x4 kr[4], vr[4]; bool val[4];
#pragma unroll
            for (int u = 0; u < 4; ++u) { const int j = (it + u) * 8 + kg; const int pos = t - j * d; val[u] = pos >= 0; const bf16_t* r = kb + (size_t)(pos < 0 ? 0 : pos) * 2304;
                kr[u] = *(const u32x4*)r; vr[u] = *(const u32x4*)(r + 768); }
            float s[4];
#pragma unroll
            for (int u = 0; u < 4; ++u) { float kf[8]; unpack8(kr[u], kf); ATT_DOT(s[u], q, kf); if (!val[u]) s[u] = -1e30f; }
            const float mb = fmaxf(fmaxf(m, fmaxf(s[0], s[1])), fmaxf(s[2], s[3]));
            const float corr = __expf(m - mb);
            l *= corr;
#pragma unroll
            for (int i = 0; i < 8; ++i) o[i] *= corr;
#pragma unroll
            for (int u = 0; u < 4; ++u) { const float p = val[u] ? __expf(s[u] - mb) : 0.f; l += p; float vf[8]; unpack8(vr[u], vf);
#pragma unroll
                for (int i = 0; i < 8; ++i) o[i] += p * vf[i]; }
            m = mb;
        }
    }
    {
        const int g = kg < 2 ? kg : 2; const int d = 1 << (2 * g);
        const int pos = t - 128 * d; const bool val = (kg < 3) && (pos >= 0);
        float q[8]; unpack8(*(const u32x4*)(qrow + g * 256), q);
        const bf16_t* r = kbase + g * 256 + (size_t)(pos < 0 ? 0 : pos) * 2304;
        float kf[8], vf[8]; unpack8(*(const u32x4*)r, kf); unpack8(*(const u32x4*)(r + 768), vf);
        float s; ATT_DOT(s, q, kf); s *= 0.125f;
        if (!val) s = -1e30f;
        const float mb = fmaxf(m, s); const float corr = __expf(m - mb); const float p = val ? __expf(s - mb) : 0.f;
        l = l * corr + p;
#pragma unroll
        for (int i = 0; i < 8; ++i) o[i] = o[i] * corr + p * vf[i];
        m = mb;
    }
    attn_finish(m, l, o, oa + (size_t)token * 256 + h * 64 + dl * 8, kg);
}

__device__ __forceinline__ void sample_kv(const bf16_t* __restrict__ newb, const float* __restrict__ cb, int W, int idx, float (&kf)[8], float (&vf)[8]) {
    if (idx >= W) { const bf16_t* r = newb + (size_t)(idx - W) * 2304; unpack8(*(const u32x4*)r, kf); unpack8(*(const u32x4*)(r + 768), vf); }
    else { const float* r = cb + (size_t)idx * 512; const f32x4 a = *(const f32x4*)r, b2 = *(const f32x4*)(r + 4), c = *(const f32x4*)(r + 256), d2 = *(const f32x4*)(r + 260);
#pragma unroll
        for (int i = 0; i < 4; ++i) { kf[i] = a[i]; kf[4 + i] = b2[i]; vf[i] = c[i]; vf[4 + i] = d2[i]; } }
}
__device__ __forceinline__ void attn_sample_sub(const bf16_t* __restrict__ qkv, const float* __restrict__ cg_, bf16_t* __restrict__ PO, float* __restrict__ LSE,
                                                int layer, int stok, int h, int g, int lane) {
    const int kg = lane >> 3, dl = lane & 7;
    const int b = stok >> 3, t = stok & 7;
    const int token = NTP + stok;
    const int d = 1 << (2 * g), W = 128 << (2 * g);
    const bf16_t* nb = qkv + (size_t)(NTP + b * 8) * 2304 + 768 + g * 256 + h * 64 + dl * 8;
    const float* cb = cg_ + (size_t)(layer * 32 + b) * W * 512 + h * 64 + dl * 8;
    float q[8]; unpack8(*(const u32x4*)(qkv + (size_t)token * 2304 + g * 256 + h * 64 + dl * 8), q);
#pragma unroll
    for (int i = 0; i < 8; ++i) q[i] *= 0.125f;
    float m = -1e30f, l = 0.f; float o[8];
#pragma unroll
    for (int i = 0; i < 8; ++i) o[i] = 0.f;
#pragma unroll 1
    for (int it = 0; it < 16; it += 8) {
        float kf[8][8], vf[8][8], s[8];
#pragma unroll
        for (int u = 0; u < 8; ++u) { const int j = (it + u) * 8 + kg; sample_kv(nb, cb, W, W + t - j * d, kf[u], vf[u]); }
        float mb = m;
#pragma unroll
        for (int u = 0; u < 8; ++u) { ATT_DOT(s[u], q, kf[u]); mb = fmaxf(mb, s[u]); }
        const float corr = __expf(m - mb);
        l *= corr;
#pragma unroll
        for (int i = 0; i < 8; ++i) o[i] *= corr;
#pragma unroll
        for (int u = 0; u < 8; ++u) { const float p = __expf(s[u] - mb); l += p;
#pragma unroll
            for (int i = 0; i < 8; ++i) o[i] += p * vf[u][i]; }
        m = mb;
    }
    {
        const bool val = kg == 0;
        float kf[8], vf[8]; sample_kv(nb, cb, W, W + t - 128 * d, kf, vf);
        float s; ATT_DOT(s, q, kf);
        if (!val) s = -1e30f;
        const float mb = fmaxf(m, s); const float corr = __expf(m - mb); const float p = val ? __expf(s - mb) : 0.f;
        l = l * corr + p;
#pragma unroll
        for (int i = 0; i < 8; ++i) o[i] = o[i] * corr + p * vf[i];
        m = mb;
    }
    float M = m; M = fmaxf(M, __shfl_xor(M, 8)); M = fmaxf(M, __shfl_xor(M, 16)); M = fmaxf(M, __shfl_xor(M, 32));
    const float f = __expf(m - M); l *= f;
#pragma unroll
    for (int i = 0; i < 8; ++i) o[i] *= f;
    l += __shfl_xor(l, 8); l += __shfl_xor(l, 16); l += __shfl_xor(l, 32);
#pragma unroll
    for (int i = 0; i < 8; ++i) { o[i] += __shfl_xor(o[i], 8); o[i] += __shfl_xor(o[i], 16); o[i] += __shfl_xor(o[i], 32); }
    const float inv = 1.0f / l;
#pragma unroll
    for (int i = 0; i < 8; ++i) o[i] *= inv;
    if (kg == 0) *(u32x4*)(PO + ((size_t)g * NTOK + token) * 256 + h * 64 + dl * 8) = pack8(o);
    if (lane == 0) LSE[((size_t)g * NTOK + token) * 4 + h] = M + __logf(l);
}

constexpr int ATT_PITCH = 144, ATT_ROWS = 272, ATT_VOFF = ATT_ROWS * ATT_PITCH;
typedef short s16x4 __attribute__((ext_vector_type(4)));
template <int OFF> __device__ __forceinline__ s16x4 tr_read(unsigned addr) { s16x4 r; asm volatile("ds_read_b64_tr_b16 %0, %1 offset:%2" : "=v"(r) : "v"(addr), "n"(OFF) : "memory"); return r; }
__device__ __forceinline__ void tr_wait8(s16x4& a, s16x4& b, s16x4& c, s16x4& d, s16x4& e, s16x4& f, s16x4& g, s16x4& h) {
    asm volatile("s_waitcnt lgkmcnt(0)" : "+v"(a), "+v"(b), "+v"(c), "+v"(d), "+v"(e), "+v"(f), "+v"(g), "+v"(h) :: "memory"); }

__device__ __forceinline__ void attn_mfma_phase(LAS unsigned char* lds, const bf16_t* __restrict__ QKV, bf16_t* __restrict__ PO, float* __restrict__ LSE, int bid, int G, int tid) {
    using pg8::bf16x8;
    const int lane = tid & 63, w = __builtin_amdgcn_readfirstlane(tid >> 6), kg = lane >> 4, qn = lane & 15;
    for (int i = tid; i < 2 * 144; i += NTHREADS) { const int kv = i / 144, rem = i - kv * 144; *(LAS u32x4*)(lds + kv * ATT_VOFF + 256 * ATT_PITCH + rem * 16) = (u32x4){0u, 0u, 0u, 0u}; }
    const unsigned vaddr = (unsigned)(uintptr_t)(lds + ATT_VOFF + (16 * w + 4 * kg + (qn >> 2)) * ATT_PITCH + (lane & 3) * 8);
    const float csc = 0.125f * 1.44269504089f;
#define ATT_DECODE(U, b_, h_, g_, r_, I0_) do { const int _bh = (U) / 96, _rest = (U) - _bh * 96; b_ = _bh >> 2; h_ = _bh & 3; \
        if (_rest < 32) { g_ = 0; r_ = 0; I0_ = 128 * _rest; } else if (_rest < 64) { g_ = 1; r_ = (_rest - 32) >> 3; I0_ = 128 * ((_rest - 32) & 7); } else { g_ = 2; r_ = (_rest - 64) >> 1; I0_ = 128 * ((_rest - 64) & 1); } } while (0)
#define ATT_FETCH(U) do { int _b, _h, _g, _r, _I0; ATT_DECODE(U, _b, _h, _g, _r, _I0); const int _d = 1 << (2 * _g); \
        _Pragma("unroll") for (int i = 0; i < 8; ++i) { const int kv = i >> 2, row = (tid >> 3) + 64 * (i & 3), ch = tid & 7; const int I = _I0 - 128 + row; \
            pf[i] = (u32x4){0u, 0u, 0u, 0u}; \
            if (I >= 0) pf[i] = *(const u32x4*)(QKV + (size_t)(_b * 4096 + _r + _d * I) * 2304 + 768 + kv * 768 + _g * 256 + _h * 64 + ch * 8); } \
        const bf16_t* _qp = QKV + ((size_t)_b * 4096 + _r + _d * (_I0 + 16 * w + qn)) * 2304 + _g * 256 + _h * 64 + kg * 8; \
        qf0 = *(const bf16x8*)_qp; qf1 = *(const bf16x8*)(_qp + 32); } while (0)
    u32x4 pf[8]; bf16x8 qf0, qf1;
    if (bid < 1536) ATT_FETCH(bid);
#pragma unroll 1
    for (int u = bid; u < 1536; u += G) {
        int b, h, g, r, I0; ATT_DECODE(u, b, h, g, r, I0);
        const int d = 1 << (2 * g);
        __syncthreads();
#pragma unroll
        for (int i = 0; i < 8; ++i) { const int kv = i >> 2, row = (tid >> 3) + 64 * (i & 3), ch = tid & 7; *(LAS u32x4*)(lds + kv * ATT_VOFF + row * ATT_PITCH + ch * 16) = pf[i]; }
        const bf16x8 q0 = qf0, q1 = qf1;
        __syncthreads();
        if (u + G < 1536) ATT_FETCH(u + G);
        const int Iq = I0 + 16 * w + qn; const size_t tokq = (size_t)b * 4096 + r + d * Iq;
        f32x4 sc[9];
        const LAS unsigned char* kb = lds + (16 * w + qn) * ATT_PITCH + kg * 16;
#pragma unroll
        for (int kt = 0; kt < 9; ++kt) { const bf16x8 k0 = *(const LAS bf16x8*)(kb + kt * 16 * ATT_PITCH), k1 = *(const LAS bf16x8*)(kb + kt * 16 * ATT_PITCH + 64);
            f32x4 z = (f32x4){0.f, 0.f, 0.f, 0.f}; z = __builtin_amdgcn_mfma_f32_16x16x32_bf16(k0, q0, z, 0, 0, 0); sc[kt] = __builtin_amdgcn_mfma_f32_16x16x32_bf16(k1, q1, z, 0, 0, 0); }
        const int jb = 128 + qn - 4 * kg, ikb = I0 - 128 + 16 * w + 4 * kg;
        float m = -1e30f;
#pragma unroll
        for (int kt = 0; kt < 9; ++kt)
#pragma unroll
            for (int i = 0; i < 4; ++i) { const int j = jb - 16 * kt - i; const bool val = (j >= 0) && (j <= 128) && (ikb + 16 * kt + i >= 0); sc[kt][i] = val ? sc[kt][i] : -1e30f; m = fmaxf(m, sc[kt][i]); }
        m = fmaxf(m, __shfl_xor(m, 16)); m = fmaxf(m, __shfl_xor(m, 32));
        const float mc = m * csc; float l = 0.f;
        unsigned pk[10][2];
#pragma unroll
        for (int kt = 0; kt < 9; ++kt) { float p[4];
#pragma unroll
            for (int i = 0; i < 4; ++i) { p[i] = (sc[kt][i] > -1e29f) ? __builtin_amdgcn_exp2f(sc[kt][i] * csc - mc) : 0.f; l += p[i]; }
            pk[kt][0] = cvt_pk_bf16(p[0], p[1]); pk[kt][1] = cvt_pk_bf16(p[2], p[3]); }
        pk[9][0] = 0u; pk[9][1] = 0u;
        l += __shfl_xor(l, 16); l += __shfl_xor(l, 32);
        f32x4 o[4];
#pragma unroll
        for (int dt = 0; dt < 4; ++dt) o[dt] = (f32x4){0.f, 0.f, 0.f, 0.f};
#define ATT_PV(KK) do { s16x4 a0 = tr_read<(KK) * 32 * ATT_PITCH + 0>(vaddr), a1 = tr_read<(KK) * 32 * ATT_PITCH + 32>(vaddr), a2 = tr_read<(KK) * 32 * ATT_PITCH + 64>(vaddr), a3 = tr_read<(KK) * 32 * ATT_PITCH + 96>(vaddr); \
            s16x4 c0 = tr_read<(KK) * 32 * ATT_PITCH + 16 * ATT_PITCH + 0>(vaddr), c1 = tr_read<(KK) * 32 * ATT_PITCH + 16 * ATT_PITCH + 32>(vaddr), c2 = tr_read<(KK) * 32 * ATT_PITCH + 16 * ATT_PITCH + 64>(vaddr), c3 = tr_read<(KK) * 32 * ATT_PITCH + 16 * ATT_PITCH + 96>(vaddr); \
            tr_wait8(a0, a1, a2, a3, c0, c1, c2, c3); \
            u32x4 pw; pw.x = pk[2 * (KK)][0]; pw.y = pk[2 * (KK)][1]; pw.z = pk[2 * (KK) + 1][0]; pw.w = pk[2 * (KK) + 1][1]; \
            const bf16x8 pf = __builtin_bit_cast(bf16x8, pw); \
            o[0] = __builtin_amdgcn_mfma_f32_16x16x32_bf16(__builtin_shufflevector(a0, c0, 0, 1, 2, 3, 4, 5, 6, 7), pf, o[0], 0, 0, 0); \
            o[1] = __builtin_amdgcn_mfma_f32_16x16x32_bf16(__builtin_shufflevector(a1, c1, 0, 1, 2, 3, 4, 5, 6, 7), pf, o[1], 0, 0, 0); \
            o[2] = __builtin_amdgcn_mfma_f32_16x16x32_bf16(__builtin_shufflevector(a2, c2, 0, 1, 2, 3, 4, 5, 6, 7), pf, o[2], 0, 0, 0); \
            o[3] = __builtin_amdgcn_mfma_f32_16x16x32_bf16(__builtin_shufflevector(a3, c3, 0, 1, 2, 3, 4, 5, 6, 7), pf, o[3], 0, 0, 0); } while (0)
        ATT_PV(0); ATT_PV(1); ATT_PV(2); ATT_PV(3); ATT_PV(4);
        const float il = 1.0f / l;
        bf16_t* op = PO + ((size_t)g * NTOK + tokq) * 256 + h * 64 + 4 * kg;
#pragma unroll
        for (int dt = 0; dt < 4; ++dt) { u32x2 wv; wv.x = cvt_pk_bf16(o[dt][0] * il, o[dt][1] * il); wv.y = cvt_pk_bf16(o[dt][2] * il, o[dt][3] * il); *(u32x2*)(op + 16 * dt) = wv; }
        if (kg == 0) LSE[((size_t)g * NTOK + tokq) * 4 + h] = m * 0.125f + __logf(l);
    }
#undef ATT_PV
#undef ATT_FETCH
#undef ATT_DECODE
}

#define XB_TMO      128
#define XB_XCNT(j)  (256  + 64 * (j))
#define XB_XSUB(j)  (1280 + 64 * (j))
#define XB_XGEN(j)  (2304 + 64 * (j))
#define XB_TOP      3328
#define XB_TOPGEN   3392
#define XCD_BAR_WORDS 3456
#define XB_SPIN_CAP (1u << 20)
__device__ __forceinline__ unsigned xb_ld(unsigned* p)              { return __hip_atomic_load(p, __ATOMIC_RELAXED, __HIP_MEMORY_SCOPE_AGENT); }
__device__ __forceinline__ unsigned xb_add(unsigned* p, unsigned v) { return __hip_atomic_fetch_add(p, v, __ATOMIC_RELAXED, __HIP_MEMORY_SCOPE_AGENT); }
__device__ __forceinline__ unsigned xb_xcc_id() { return (unsigned)__builtin_amdgcn_s_getreg((3 << 11) | 20) & 0xFu; }
#define XB_SPIN(cond, bar) do { unsigned _sp = 0; while (cond) { __builtin_amdgcn_s_sleep(1); \
    if ((++_sp & 255u) == 0u) { if (xb_ld(&(bar)[XB_TMO])) break; if (_sp > XB_SPIN_CAP) { atomicAdd(&(bar)[XB_TMO], 1u); break; } } } } while (0)
struct XcdBarrier { unsigned* bar; unsigned x; volatile LAS unsigned* st; };
__device__ __forceinline__ XcdBarrier xcd_barrier_post(unsigned* bar, volatile LAS unsigned* st) {
    XcdBarrier b; b.bar = bar; b.x = xb_xcc_id(); b.st = st;
    if (threadIdx.x == 0) (void)xb_add(&bar[XB_XCNT(b.x)], 1u);
    return b;
}
__device__ __forceinline__ void xcd_barrier_complete(unsigned* bar, unsigned x, unsigned& nloc, unsigned& nx) {
    const unsigned G = gridDim.x * gridDim.y * gridDim.z;
    unsigned sum, cnt, mine, sp = 0u;
    for (;;) {
        sum = 0u; cnt = 0u; mine = 0u;
#pragma unroll
        for (unsigned j = 0; j < 16; ++j) { const unsigned c = xb_ld(&bar[XB_XCNT(j)]); sum += c; cnt += (c > 0u) ? 1u : 0u; mine = (j == x) ? c : mine; }
        if (sum == G) break;
        __builtin_amdgcn_s_sleep(1);
        if ((++sp & 255u) == 0u) { if (xb_ld(&bar[XB_TMO])) break; if (sp > XB_SPIN_CAP) { atomicAdd(&bar[XB_TMO], 1u); break; } }
    }
    nloc = mine > 0u ? mine : 1u; nx = cnt > 0u ? cnt : 1u;
}
__device__ __forceinline__ void xcd_barrier(const XcdBarrier& b) {
    asm volatile("s_waitcnt vmcnt(0)" ::: "memory");
    __syncthreads();
    if (threadIdx.x == 0) {
        unsigned* bar = b.bar;
        __builtin_amdgcn_s_waitcnt(0);
        unsigned nloc = b.st[0], nx = b.st[1];
        if (nloc == 0u) { xcd_barrier_complete(bar, b.x, nloc, nx); b.st[0] = nloc; b.st[1] = nx; }
        const unsigned old = xb_add(&bar[XB_XSUB(b.x)], 1u);
        const unsigned gen = old / nloc;
        if (old + 1u == (gen + 1u) * nloc) {
            __builtin_amdgcn_fence(__ATOMIC_RELEASE, "agent");
            asm volatile("s_waitcnt vmcnt(0)" ::: "memory");
            const unsigned og = xb_add(&bar[XB_TOP], 1u);
            const unsigned tg = og / nx;
            if (og + 1u == (tg + 1u) * nx) xb_add(&bar[XB_TOPGEN], 1u);
            else XB_SPIN(xb_ld(&bar[XB_TOPGEN]) == tg, bar);
            __builtin_amdgcn_fence(__ATOMIC_ACQUIRE, "agent");
            xb_add(&bar[XB_XGEN(b.x)], 1u);
            asm volatile("s_waitcnt vmcnt(0)" ::: "memory");
        } else {
            XB_SPIN(xb_ld(&bar[XB_XGEN(b.x)]) == gen, bar);
            __builtin_amdgcn_fence(__ATOMIC_ACQUIRE, "agent");
            asm volatile("s_waitcnt vmcnt(0)" ::: "memory");
        }
    }
    __syncthreads();
}

template <int GP> __device__ __forceinline__ void pool_item(const bf16_t* __restrict__ UB, bf16_t* __restrict__ PB, const float* __restrict__ sp, int tb, int cl) {
    constexpr int W = 2 << GP, NR = W + 7;
    const int c = (GP * 16 + cl) * 8;
    const int token0 = tb * 8; const bool samp = token0 >= NTP; const int t0 = samp ? 0 : (token0 & 4095); const int b = (token0 - NTP) >> 3;
    u32x4 R[NR];
#pragma unroll
    for (int r = 0; r < NR; ++r) { const int dt = r - (W - 1);
        if (dt >= 0 || t0 + dt >= 0) R[r] = *(const u32x4*)(UB + (size_t)(token0 + dt) * 512 + c);
        else if (samp) { const float* q = sp + (size_t)(b * 15 + 15 + dt) * 512 + c; const f32x4 a = *(const f32x4*)q, b2 = *(const f32x4*)(q + 4);
            R[r].x = cvt_pk_bf16(a[0], a[1]); R[r].y = cvt_pk_bf16(a[2], a[3]); R[r].z = cvt_pk_bf16(b2[0], b2[1]); R[r].w = cvt_pk_bf16(b2[2], b2[3]); }
        else R[r] = (u32x4){0u, 0u, 0u, 0u}; }
#pragma unroll
    for (int j = 0; j < 8; ++j) {
        float sum[8];
#pragma unroll
        for (int k = 0; k < 8; ++k) sum[k] = 0.f;
#pragma unroll
        for (int i = 0; i < W; ++i) { float f[8]; unpack8(R[j + (W - 1) - i], f);
#pragma unroll
            for (int k = 0; k < 8; ++k) sum[k] += f[k]; }
        float ut[8]; unpack8(R[j + W - 1], ut);
        const int t = t0 + j; const float cnt = samp ? (float)W : (float)(W < t + 1 ? W : t + 1); const float ic = 1.0f / cnt;
        float p[8];
#pragma unroll
        for (int k = 0; k < 8; ++k) p[k] = sum[k] * ic - ut[k];
        *(u32x4*)(PB + (size_t)(token0 + j) * 512 + c) = pack8(p);
    }
}

__global__ void __launch_bounds__(NTHREADS, 2) fwd_megakernel(Params P) {
    extern __shared__ __attribute__((aligned(16))) unsigned char lds_raw[];
    LAS unsigned char* lds = (LAS unsigned char*)lds_raw;
    cg::grid_group grid = cg::this_grid();
    const int tid = threadIdx.x, lane = tid & 63, wave = __builtin_amdgcn_readfirstlane(tid >> 6);
    const int G = gridDim.x, bid = blockIdx.x;
    const int gw = bid * 8 + wave, NGW = G * 8;
    const size_t gtid = (size_t)bid * NTHREADS + tid, nth = (size_t)G * NTHREADS;
    unsigned char* ws = P.ws;
    bf16_t* Wt_in = (bf16_t*)(ws + WS_WIN); bf16_t* Wt_pa = (bf16_t*)(ws + WS_WPA); bf16_t* Wt_pb = (bf16_t*)(ws + WS_WPB);
    bf16_t* Wt_o = (bf16_t*)(ws + WS_WO); bf16_t* Wt_up = (bf16_t*)(ws + WS_WUP); bf16_t* Wt_dn = (bf16_t*)(ws + WS_WDN);
    bf16_t* XL = (bf16_t*)(ws + WS_X); bf16_t* XB = (bf16_t*)(ws + WS_XB); bf16_t* QKV = (bf16_t*)(ws + WS_QKV); bf16_t* UB = (bf16_t*)(ws + WS_U);
    bf16_t* GT = (bf16_t*)(ws + WS_G); bf16_t* OA = (bf16_t*)(ws + WS_OA); bf16_t* PB = (bf16_t*)(ws + WS_P); float* TMP = (float*)(ws + WS_TMP);
    bf16_t* MIX = (bf16_t*)(ws + WS_MIX); bf16_t* HID = (bf16_t*)(ws + WS_H); float* SS = (float*)(ws + WS_SS); float* ROPE = (float*)(ws + WS_ROPE);
    float* out = P.out;
    volatile LAS unsigned* bst = (volatile LAS unsigned*)(lds + LDS_BYTES - 16);
    if (tid == 0) { bst[0] = 0u; bst[1] = 0u; }
    __syncthreads();
    const XcdBarrier xb = xcd_barrier_post((unsigned*)(ws + WS_BAR), bst);

    {
        LAS float* LsT = (LAS float*)lds;
        LAS float* Ws = LsT + 128 * 128;
        for (int item = bid; item < DEPTH * 4 * 16; item += G) {
            const int l = item >> 6, g = (item >> 4) & 3, n0 = (item & 15) * 64;
            const float* lin = P.in[10] + (size_t)(l * 4 + g) * 128 * 128;
            const float* sc = P.in[11] + l * 512 + g * 128;
            const float* wpb = P.in[9] + (size_t)l * 512 * 1024 + (size_t)g * 128 * 1024;
            for (int i = tid; i < 128 * 128; i += NTHREADS) { const int c = i >> 7, d = i & 127; LsT[d * 128 + c] = lin[i] * sc[d]; }
            for (int i = tid; i < 128 * 64; i += NTHREADS) { const int d = i >> 6, n = i & 63; Ws[i] = wpb[(size_t)d * 1024 + n0 + n]; }
            __syncthreads();
            const int n = tid & 63, cgp = tid >> 6;
            float a[16];
#pragma unroll
            for (int i = 0; i < 16; ++i) a[i] = 0.f;
            for (int d = 0; d < 128; ++d) {
                const float w = Ws[d * 64 + n];
                const LAS f32x4* lp = (const LAS f32x4*)(LsT + d * 128 + cgp * 16);
#pragma unroll
                for (int q4 = 0; q4 < 4; ++q4) { const f32x4 lv = lp[q4];
#pragma unroll
                    for (int i = 0; i < 4; ++i) a[q4 * 4 + i] += lv[i] * w; }
            }
            bf16_t* op = Wt_pb + ((size_t)l * 1024 + n0 + n) * 512 + g * 128 + cgp * 16;
            u32x4 o0, o1; o0.x = cvt_pk_bf16(a[0], a[1]); o0.y = cvt_pk_bf16(a[2], a[3]); o0.z = cvt_pk_bf16(a[4], a[5]); o0.w = cvt_pk_bf16(a[6], a[7]);
            o1.x = cvt_pk_bf16(a[8], a[9]); o1.y = cvt_pk_bf16(a[10], a[11]); o1.z = cvt_pk_bf16(a[12], a[13]); o1.w = cvt_pk_bf16(a[14], a[15]);
            *(u32x4*)op = o0; *(u32x4*)(op + 8) = o1;
            __syncthreads();
        }
        {
            LAS float* scr = (LAS float*)(lds + wave * 16640);
            constexpr int I_IN = 16 * 76, I_PA = 4 * 16, I_O = 16 * 16, I_UP = 16 * 64, I_DN = 64 * 16, I_L = I_IN + I_PA + I_O + I_UP + I_DN;
            for (int it = gw; it < DEPTH * I_L; it += NGW) {
                const int l = it / I_L; int r = it - l * I_L;
                if (r < I_IN) { transpose_item(P.in[7] + (size_t)l * DM * NIN, P.in[6] + l * DM, DM, NIN, Wt_in + (size_t)l * NIN * DM, scr, r, lane); continue; } r -= I_IN;
                if (r < I_PA) { transpose_item(P.in[8] + (size_t)l * 256 * DM, nullptr, 256, DM, Wt_pa + (size_t)l * DM * 256, scr, r, lane); continue; } r -= I_PA;
                if (r < I_O) { transpose_item(P.in[12] + (size_t)l * DM * DM, nullptr, DM, DM, Wt_o + (size_t)l * DM * DM, scr, r, lane); continue; } r -= I_O;
                if (r < I_UP) { transpose_item(P.in[14] + (size_t)l * DM * DFF, P.in[13] + l * DM, DM, DFF, Wt_up + (size_t)l * DFF * DM, scr, r, lane); continue; } r -= I_UP;
                transpose_item(P.in[15] + (size_t)l * DFF * DM, nullptr, DFF, DM, Wt_dn + (size_t)l * DM * DFF, scr, r, lane);
            }
        }
        for (int row = gw; row < NTOK; row += NGW) {
            const float* src = row < NTP ? P.in[0] + (size_t)row * DM : P.in[1] + (size_t)(row - NTP) * DM;
            float s = 0.f;
#pragma unroll
            for (int j = 0; j < 4; ++j) { const f32x4 v = *(const f32x4*)(src + 4 * lane + 256 * j); s += v[0] * v[0] + v[1] * v[1] + v[2] * v[2] + v[3] * v[3];
                u32x2 w; w.x = cvt_pk_bf16(v[0], v[1]); w.y = cvt_pk_bf16(v[2], v[3]); *(u32x2*)(XB + (size_t)row * DM + 4 * lane + 256 * j) = w;
                u32x2 wl; wl.x = bf16_lo_pair(v[0], v[1], w.x); wl.y = bf16_lo_pair(v[2], v[3], w.y); *(u32x2*)(XL + (size_t)row * DM + 4 * lane + 256 * j) = wl; }
#pragma unroll
            for (int o = 1; o < 64; o <<= 1) s += __shfl_xor(s, o);
            if (lane == 0) SS[row] = s;
        }
        for (size_t i = gtid; i < 4104 * 8; i += nth) { const int pi = (int)(i >> 3), k = (int)(i & 7); const float pos = (float)(pi < 4096 ? pi : 8192 + pi - 4096);
            const float inv = powf(500000.0f, -(float)(2 * k) / 16.0f); const float ang = pos * inv; ROPE[pi * 16 + k] = cosf(ang); ROPE[pi * 16 + 8 + k] = sinf(ang); }
        for (size_t i = gtid; i < (size_t)8 * NTOK; i += nth) SS[NTOK + i] = 0.f;
        for (size_t i = gtid; i < (size_t)DEPTH * 32 * 7 * 128; i += nth) { const size_t lb = i / (7 * 128), r = i - lb * (7 * 128);
            *(f32x4*)(out + O_POOLS + lb * 15 * 512 + r * 4) = *(const f32x4*)(P.in[5] + lb * 15 * 512 + 8 * 512 + r * 4); }
    }
    grid.sync();

    pg8::StaticOrder S;
#pragma unroll 1
    for (int step = 0; step < DEPTH * 7; ++step) {
        const int layer = step / 7, st = step - layer * 7;
        if (st == 1) {
            int tid_l = threadIdx.x; asm volatile("" : "+v"(tid_l));
            const int lane = tid_l & 63, gw = bid * 8 + (tid_l >> 6);
            const size_t gtid = (size_t)bid * NTHREADS + tid_l;
            size_t zoff = 0; asm volatile("" : "+s"(zoff));
            unsigned char* wsl = ws + zoff;
            bf16_t* QKV = (bf16_t*)(wsl + WS_QKV); bf16_t* UB = (bf16_t*)(wsl + WS_U); bf16_t* OA = (bf16_t*)(wsl + WS_OA); bf16_t* PB = (bf16_t*)(wsl + WS_P);
            bf16_t* PO = (bf16_t*)(wsl + WS_TMP); float* LSE = (float*)(wsl + WS_TMP + (size_t)3 * NTOK * 256 * 2);
            for (int it = gw; it < NTS * 12; it += NGW) { const int g = it % 3, r = it / 3; attn_sample_sub(QKV, g == 0 ? P.in[2] : (g == 1 ? P.in[3] : P.in[4]), PO, LSE, layer, r >> 2, r & 3, g, lane); }
            attn_mfma_phase(lds, QKV, PO, LSE, bid, G, tid_l);
            copy_shift<128>(P.in[2], out + O_KVS0, layer, gtid, nth);
            copy_shift<512>(P.in[3], out + O_KVS1, layer, gtid, nth);
            copy_shift<2048>(P.in[4], out + O_KVS2, layer, gtid, nth);
            xcd_barrier(xb);
            for (size_t base = gtid; base < (size_t)NTOK * 32; base += nth * 4) {
                float ls[4][3]; u32x4 av[4][3];
#pragma unroll
                for (int u = 0; u < 4; ++u) { const size_t idx = base + u * nth; const size_t ii = idx < (size_t)NTOK * 32 ? idx : base; const size_t token = ii >> 5; const int c = (int)(ii & 31) * 8, h = c >> 6;
#pragma unroll
                    for (int g = 0; g < 3; ++g) { ls[u][g] = LSE[((size_t)g * NTOK + token) * 4 + h]; av[u][g] = *(const u32x4*)(PO + ((size_t)g * NTOK + token) * 256 + c); } }
#pragma unroll
                for (int u = 0; u < 4; ++u) { const size_t idx = base + u * nth;
                    if (idx < (size_t)NTOK * 32) { const size_t token = idx >> 5; const int c = (int)(idx & 31) * 8;
                        const float mx = fmaxf(ls[u][0], fmaxf(ls[u][1], ls[u][2])); float w0 = __expf(ls[u][0] - mx), w1 = __expf(ls[u][1] - mx), w2 = __expf(ls[u][2] - mx); const float iw = 1.0f / (w0 + w1 + w2); w0 *= iw; w1 *= iw; w2 *= iw;
                        float a0[8], a1[8], a2[8], o[8]; unpack8(av[u][0], a0); unpack8(av[u][1], a1); unpack8(av[u][2], a2);
#pragma unroll
                        for (int k = 0; k < 8; ++k) o[k] = w0 * a0[k] + w1 * a1[k] + w2 * a2[k];
                        *(u32x4*)(OA + token * 256 + c) = pack8(o); } }
            }
            const float* sp = P.in[5] + (size_t)layer * 32 * 15 * 512;
            for (int it = (int)gtid; it < 4 * (NTOK / 8) * 16; it += (int)nth) {
                const int cl = it & 15, q = it >> 4, g = q / (NTOK / 8), tb = q - g * (NTOK / 8);
                if (g == 0) pool_item<0>(UB, PB, sp, tb, cl); else if (g == 1) pool_item<1>(UB, PB, sp, tb, cl); else if (g == 2) pool_item<2>(UB, PB, sp, tb, cl); else pool_item<3>(UB, PB, sp, tb, cl);
            }
            xcd_barrier(xb);
            continue;
        }
        pg8::Gemm g; EpiAll E; E.ws = ws; E.out = out; E.layer = layer; E.ssi = 0; E.ssn = 0;
        const int Mg = (st == 0) ? NTOK : NTP;
        g.M = Mg;
        if (st == 0)      { g.A = XB;  g.Bt = Wt_in + (size_t)layer * NIN * DM; g.N = NIN; g.K = DM;  E.mode = 0; E.ssi = 2 * layer; }
        else if (st == 2) { g.A = OA;  g.Bt = Wt_pa + (size_t)layer * DM * 256; g.N = DM;  g.K = 256; E.mode = 1; }
        else if (st == 3) { g.A = PB;  g.Bt = Wt_pb + (size_t)layer * DM * 512; g.N = DM;  g.K = 512; E.mode = 2; }
        else if (st == 4) { g.A = MIX; g.Bt = Wt_o + (size_t)layer * DM * DM;   g.N = DM;  g.K = DM;  E.mode = 3; E.ssn = 2 * layer + 1; }
        else if (st == 5) { g.A = XB;  g.Bt = Wt_up + (size_t)layer * DFF * DM; g.N = DFF; g.K = DM;  E.mode = 4; E.ssi = 2 * layer + 1; }
        else              { g.A = HID; g.Bt = Wt_dn + (size_t)layer * DM * DFF; g.N = DM;  g.K = DFF; E.mode = 3; E.ssn = 2 * layer + 2; }
        S.init(Mg, g.N, G, bid);
        pg8::gemm_phase<EpiAll, pg8::StaticOrder, true, true>(lds, g, S, E);
        if (st != 0) skinny_gemm(lds, g.A + (size_t)NTP * g.K, g.Bt, g.N, g.K, E, G - 1 - bid, G);
        if (st != 2) xcd_barrier(xb);
    }
    {
        int tid_l = threadIdx.x; asm volatile("" : "+v"(tid_l));
        const int lane = tid_l & 63, gw = bid * 8 + (tid_l >> 6);
        size_t zoff = 0; asm volatile("" : "+s"(zoff));
        unsigned char* wsl = ws + zoff;
        const bf16_t* XL = (const bf16_t*)(wsl + WS_X); const bf16_t* XH = (const bf16_t*)(wsl + WS_XB);
        const float* fn = P.in[16]; const float* ssf = (const float*)(wsl + WS_SS) + (size_t)8 * NTOK;
        for (int row = gw; row < NTOK; row += 2 * NGW) {
            const int r2 = row + NGW; const bool ok2 = r2 < NTOK; const int rb = ok2 ? r2 : row;
            const float s0 = ssf[row], s1 = ssf[rb];
            f32x4 va[4], vb[4], gn[4];
#pragma unroll
            for (int j = 0; j < 4; ++j) { const int c = 4 * lane + 256 * j; gn[j] = *(const f32x4*)(fn + c);
                const u32x2 ah = *(const u32x2*)(XH + (size_t)row * DM + c), al = *(const u32x2*)(XL + (size_t)row * DM + c), bh = *(const u32x2*)(XH + (size_t)rb * DM + c), bl = *(const u32x2*)(XL + (size_t)rb * DM + c);
                va[j] = (f32x4){__uint_as_float(ah.x << 16) + __uint_as_float(al.x << 16), __uint_as_float(ah.x & 0xffff0000u) + __uint_as_float(al.x & 0xffff0000u), __uint_as_float(ah.y << 16) + __uint_as_float(al.y << 16), __uint_as_float(ah.y & 0xffff0000u) + __uint_as_float(al.y & 0xffff0000u)};
                vb[j] = (f32x4){__uint_as_float(bh.x << 16) + __uint_as_float(bl.x << 16), __uint_as_float(bh.x & 0xffff0000u) + __uint_as_float(bl.x & 0xffff0000u), __uint_as_float(bh.y << 16) + __uint_as_float(bl.y << 16), __uint_as_float(bh.y & 0xffff0000u) + __uint_as_float(bl.y & 0xffff0000u)}; }
            const float rs0 = rsqrtf(s0 * (1.0f / 1024.0f) + 1e-6f), rs1 = rsqrtf(s1 * (1.0f / 1024.0f) + 1e-6f);
#pragma unroll
            for (int j = 0; j < 4; ++j) { const int c = 4 * lane + 256 * j;
                *(f32x4*)(out + (size_t)row * DM + c) = (f32x4){va[j][0] * rs0 * gn[j][0], va[j][1] * rs0 * gn[j][1], va[j][2] * rs0 * gn[j][2], va[j][3] * rs0 * gn[j][3]};
                if (ok2) *(f32x4*)(out + (size_t)r2 * DM + c) = (f32x4){vb[j][0] * rs1 * gn[j][0], vb[j][1] * rs1 * gn[j][1], vb[j][2] * rs1 * gn[j][2], vb[j][3] * rs1 * gn[j][3]}; }
        }
    }
}

extern "C" void kernel_launch(void* const* d_in, const int* in_sizes, int n_in, void* d_out, int out_size, void* d_ws, size_t ws_size, hipStream_t stream) {
    static int grid_blocks = 0;
    if (grid_blocks == 0) {
        if (n_in != 17 || ws_size < WS_END) { fprintf(stderr, "kernel_launch: unexpected n_in %d / ws %zu (need %zu)\n", n_in, ws_size, (size_t)WS_END); grid_blocks = -1; return; }
        int dev = 0, cus = 0, per_cu = 0;
        (void)hipGetDevice(&dev);
        (void)hipDeviceGetAttribute(&cus, hipDeviceAttributeMultiprocessorCount, dev);
        if (hipFuncSetAttribute((const void*)fwd_megakernel, hipFuncAttributeMaxDynamicSharedMemorySize, LDS_BYTES) != hipSuccess) { fprintf(stderr, "kernel_launch: hipFuncSetAttribute failed\n"); grid_blocks = -1; return; }
        (void)hipOccupancyMaxActiveBlocksPerMultiprocessor(&per_cu, (const void*)fwd_megakernel, NTHREADS, LDS_BYTES);
        if (per_cu < 1) { fprintf(stderr, "kernel_launch: occupancy query says %d blocks/CU\n", per_cu); grid_blocks = -1; return; }
        grid_blocks = cus * 1;
    }
    if (grid_blocks < 0) return;
    if (hipMemsetAsync((unsigned char*)d_ws + WS_BAR, 0, 4096 * 4, stream) != hipSuccess) { fprintf(stderr, "kernel_launch: memset of barrier words failed\n"); return; }
    Params p{};
    for (int i = 0; i < 17; ++i) p.in[i] = (const float*)d_in[i];
    p.out = (float*)d_out; p.ws = (unsigned char*)d_ws;
    void* args[] = {&p};
    hipError_t e = hipLaunchCooperativeKernel((const void*)fwd_megakernel, dim3(grid_blocks), dim3(NTHREADS), args, LDS_BYTES, stream);
    if (e != hipSuccess) fprintf(stderr, "cooperative launch failed: %s (grid %d)\n", hipGetErrorString(e), grid_blocks);
}
```

```cpp
#include <hip/hip_runtime.h>
#include <hip/hip_cooperative_groups.h>
#include <cstdio>
#include <cstdint>
namespace cg = cooperative_groups;

namespace pg8 {
#define PG8_LAS __attribute__((address_space(3)))
typedef unsigned short bf16_t;
typedef short bf16x8 __attribute__((ext_vector_type(8)));
typedef float f32x4 __attribute__((ext_vector_type(4)));
typedef unsigned u32x4 __attribute__((ext_vector_type(4)));
typedef unsigned u32x2 __attribute__((ext_vector_type(2)));
constexpr int BM = 256, BK = 64, HALF = 128, HTB = HALF * BK * 2, STAGE_BYTES = 8 * HTB, NXCD = 8, WGM = 8;

__host__ __device__ __forceinline__ int lds_byte(int r, int c) { const int st = (r >> 4) * 2 + (c >> 5), rr = r & 15, cc = c & 31, ob = rr * 64 + cc * 2; return st * 1024 + (ob ^ (((ob >> 9) & 1) << 5)); }
__host__ __device__ __forceinline__ void stage_rc(int b, int& R, int& C) { const int st = b / 1024, sb = b % 1024, swz = sb ^ (((sb >> 9) & 1) << 5); R = (st >> 1) * 16 + swz / 64; C = (st & 1) * 32 + (swz % 64) / 2; }
__host__ __device__ __forceinline__ int perm32(int rho) { const int n = rho >> 4, i = rho & 15; return 8 * (i >> 2) + 4 * n + (i & 3); }

struct Unit { int pm, pn; };
struct Gemm { const bf16_t* A; const bf16_t* Bt; int M, N, K; };

struct StaticOrder {
    int nM, nN, nwg, G, c;
    __host__ __device__ void init(int M, int N, int G_, int c_) { nM = M / BM; nN = N / BM; nwg = nM * nN; G = G_; c = c_; }
    __host__ __device__ bool next(int i, Unit& u) const {
        const long L = (long)i * G + c; if (L >= nwg) return false;
        int wgid = (int)L; { const int q = nwg / NXCD, r = nwg % NXCD, xcd = wgid % NXCD, off = wgid / NXCD; wgid = (xcd < r ? xcd * (q + 1) : r * (q + 1) + (xcd - r) * q) + off; }
        const int nig = WGM * nN, gid = wgid / nig, fm = gid * WGM, gsz = (nM - fm) < WGM ? (nM - fm) : WGM;
        u.pm = fm + ((wgid % nig) % gsz); u.pn = (wgid % nig) / gsz; return true;
    }
    __device__ __forceinline__ void a_ready(const Unit&) const {}
    __device__ __forceinline__ void done(const Unit&) const {}
};

__device__ __forceinline__ unsigned cvt_pk_bf16(float lo, float hi) { unsigned r; asm volatile("v_cvt_pk_bf16_f32 %0, %1, %2" : "=v"(r) : "v"(lo), "v"(hi)); return r; }

template <class Epi, class Sched, bool ALIGN_EPI = false, bool SP2 = false>
__device__ __forceinline__ void gemm_phase(PG8_LAS unsigned char* lds, const Gemm g, const Sched& S, const Epi& E) {
    int tid = threadIdx.x; asm volatile("" : "+v"(tid));
    const int wid = __builtin_amdgcn_readfirstlane(tid >> 6), lane = tid & 63, wr = wid >> 2, wc = wid & 3, fr = lane & 15, fq = lane >> 4;
    const int K = g.K, nt = K / BK;
    unsigned voffA[2], voffB[2];
#pragma unroll
    for (int i = 0; i < 2; ++i) { int R, C; stage_rc(tid * 16 + i * 8192, R, C); const int Rb = Epi::PERM ? ((R & ~31) + perm32(R & 31)) : R;
        voffA[i] = (unsigned)(R * K + C) * 2u; voffB[i] = (unsigned)(Rb * K + C) * 2u; }
    const size_t kstep = (size_t)(BK * 2);
    const size_t hstep = (size_t)HALF * K * 2;
    const size_t tstep = 2 * hstep;
    const unsigned ldsw = (unsigned)wid * 1024u;
    const int aoff = lds_byte(wr * 64 + fr, fq * 8), boff = lds_byte(wc * 32 + fr, fq * 8);
#define PG8_SA(b, h) (((b) * 2 + (h)) * HTB)
#define PG8_SB(b, h) ((4 + (b) * 2 + (h)) * HTB)
#define PG8_STAGE(bufoff, gbase, voff) do { _Pragma("unroll") for (int _i = 0; _i < 2; ++_i) \
        __builtin_amdgcn_global_load_lds((const unsigned*)((const char*)(gbase) + (voff)[_i]), (PG8_LAS unsigned*)(lds + (bufoff) + ldsw + _i * 8192), 16, 0, 0); } while (0)
#define PG8_LDA(dst, b, h) do { _Pragma("unroll") for (int m = 0; m < 4; ++m) _Pragma("unroll") for (int k = 0; k < 2; ++k) dst[m][k] = *(const PG8_LAS bf16x8*)(lds + PG8_SA(b, h) + aoff + m * 2048 + k * 1024); } while (0)
#define PG8_LDB(dst, b, h) do { _Pragma("unroll") for (int n = 0; n < 2; ++n) _Pragma("unroll") for (int k = 0; k < 2; ++k) dst[n][k] = *(const PG8_LAS bf16x8*)(lds + PG8_SB(b, h) + boff + n * 2048 + k * 1024); } while (0)
#define PG8_MMA(ai, bj, At, Bt) do { __builtin_amdgcn_s_setprio(1); _Pragma("unroll") for (int m = 0; m < 4; ++m) _Pragma("unroll") for (int n = 0; n < 2; ++n) _Pragma("unroll") for (int k = 0; k < 2; ++k) \
        acc[ai][bj][m][n] = __builtin_amdgcn_mfma_f32_16x16x32_bf16(Bt[n][k], At[m][k], acc[ai][bj][m][n], 0, 0, 0); __builtin_amdgcn_s_setprio(0); } while (0)
#define PG8_WAIT_V(n) asm volatile("s_waitcnt vmcnt(" #n ")" ::: "memory")
#define PG8_WAIT_L(n) asm volatile("s_waitcnt lgkmcnt(" #n ")" ::: "memory")
#define PG8_BAR __builtin_amdgcn_s_barrier()
#define PG8_SCHED __builtin_amdgcn_sched_barrier(0)
    Unit cur, nxt; int ui = 0;
    if (!S.next(0, cur)) return;
    f32x4 acc[2][2][4][2];
#pragma unroll
    for (int a = 0; a < 2; ++a)
#pragma unroll
        for (int b = 0; b < 2; ++b)
#pragma unroll
            for (int m = 0; m < 4; ++m)
#pragma unroll
                for (int n = 0; n < 2; ++n) acc[a][b][m][n] = (f32x4){0.f, 0.f, 0.f, 0.f};
    bf16x8 At[4][2], B0[2][2], B1[2][2];
    const char* cA = (const char*)g.A + (size_t)cur.pm * tstep; const char* cB = (const char*)g.Bt + (size_t)cur.pn * tstep;
    S.a_ready(cur);
    if constexpr (SP2) {
        PG8_STAGE(PG8_SB(0, 0), cB, voffB); PG8_STAGE(PG8_SB(0, 1), cB + hstep, voffB); PG8_STAGE(PG8_SA(0, 0), cA, voffA); PG8_STAGE(PG8_SA(0, 1), cA + hstep, voffA);
        if (wr == 1) PG8_BAR;
        PG8_WAIT_V(2); PG8_BAR;
        PG8_STAGE(PG8_SB(1, 0), cB + kstep, voffB); PG8_STAGE(PG8_SA(1, 0), cA + kstep, voffA); PG8_STAGE(PG8_SB(1, 1), cB + hstep + kstep, voffB);
        PG8_WAIT_V(6); PG8_BAR;
    } else {
        PG8_STAGE(PG8_SB(0, 0), cB, voffB); PG8_STAGE(PG8_SA(0, 0), cA, voffA); PG8_STAGE(PG8_SB(0, 1), cB + hstep, voffB); PG8_STAGE(PG8_SA(0, 1), cA + hstep, voffA);
        if (wr == 1) PG8_BAR;
        PG8_WAIT_V(4); PG8_BAR;
        PG8_STAGE(PG8_SB(1, 0), cB + kstep, voffB); PG8_STAGE(PG8_SA(1, 0), cA + kstep, voffA); PG8_STAGE(PG8_SB(1, 1), cB + hstep + kstep, voffB);
        PG8_WAIT_V(6); PG8_BAR;
    }
    for (;;) {
        const bool has_next = S.next(ui + 1, nxt);
        const char* nA = has_next ? (const char*)g.A + (size_t)nxt.pm * tstep : cA; const char* nB = has_next ? (const char*)g.Bt + (size_t)nxt.pn * tstep : cB;
        for (int t = 0; t < nt; t += 2) {
            const bool last = (t == nt - 2);
            const char* a1 = cA + (size_t)(t + 1) * kstep;
            const char* a2 = last ? nA : cA + (size_t)(t + 2) * kstep; const char* b2 = last ? nB : cB + (size_t)(t + 2) * kstep;
            const char* a3 = a2 + kstep; const char* b3 = b2 + kstep;
            if (last && has_next) S.a_ready(nxt);
            if constexpr (SP2) {
            PG8_LDB(B0, 0, 0); PG8_LDB(B1, 0, 1); PG8_SCHED; PG8_LDA(At, 0, 0); PG8_STAGE(PG8_SA(1, 1), a1 + hstep, voffA);
            PG8_WAIT_V(8); PG8_WAIT_L(0); PG8_BAR; PG8_MMA(0, 0, At, B0); PG8_MMA(0, 1, At, B1); PG8_BAR; PG8_SCHED;
            PG8_LDA(At, 0, 1); PG8_STAGE(PG8_SB(0, 0), b2, voffB); PG8_STAGE(PG8_SB(0, 1), b2 + hstep, voffB); PG8_STAGE(PG8_SA(0, 0), a2, voffA);
            PG8_WAIT_V(8); PG8_WAIT_L(0); PG8_BAR; PG8_MMA(1, 0, At, B0); PG8_MMA(1, 1, At, B1); PG8_BAR; PG8_SCHED;
            PG8_LDB(B0, 1, 0); PG8_LDB(B1, 1, 1); PG8_SCHED; PG8_LDA(At, 1, 0); PG8_STAGE(PG8_SA(0, 1), a2 + hstep, voffA);
            PG8_WAIT_V(8); PG8_WAIT_L(0); PG8_BAR; PG8_MMA(0, 0, At, B0); PG8_MMA(0, 1, At, B1); PG8_BAR; PG8_SCHED;
            PG8_LDA(At, 1, 1); PG8_STAGE(PG8_SB(1, 0), b3, voffB); PG8_STAGE(PG8_SB(1, 1), b3 + hstep, voffB); PG8_STAGE(PG8_SA(1, 0), a3, voffA);
            PG8_WAIT_V(8); PG8_WAIT_L(0); PG8_BAR; PG8_MMA(1, 0, At, B0); PG8_MMA(1, 1, At, B1); PG8_BAR; PG8_SCHED;
            } else {
            PG8_LDB(B0, 0, 0); PG8_SCHED; PG8_LDA(At, 0, 0); PG8_STAGE(PG8_SA(1, 1), a1 + hstep, voffA);
            PG8_WAIT_L(8); PG8_BAR; PG8_WAIT_L(0); PG8_MMA(0, 0, At, B0); PG8_BAR; PG8_SCHED;
            PG8_LDB(B1, 0, 1); PG8_STAGE(PG8_SB(0, 0), b2, voffB);
            PG8_BAR; PG8_WAIT_L(0); PG8_MMA(0, 1, At, B1); PG8_BAR;
            PG8_LDA(At, 0, 1); PG8_STAGE(PG8_SA(0, 0), a2, voffA);
            PG8_BAR; PG8_WAIT_L(0); PG8_MMA(1, 0, At, B0); PG8_BAR; PG8_SCHED;
            PG8_STAGE(PG8_SB(0, 1), b2 + hstep, voffB);
            PG8_WAIT_V(6); PG8_BAR; PG8_MMA(1, 1, At, B1); PG8_BAR;
            PG8_LDB(B0, 1, 0); PG8_SCHED; PG8_LDA(At, 1, 0); PG8_STAGE(PG8_SA(0, 1), a2 + hstep, voffA);
            PG8_WAIT_L(8); PG8_BAR; PG8_WAIT_L(0); PG8_MMA(0, 0, At, B0); PG8_BAR; PG8_SCHED;
            PG8_LDB(B1, 1, 1); PG8_STAGE(PG8_SB(1, 0), b3, voffB);
            PG8_BAR; PG8_WAIT_L(0); PG8_MMA(0, 1, At, B1); PG8_BAR;
            PG8_LDA(At, 1, 1); PG8_STAGE(PG8_SA(1, 0), a3, voffA);
            PG8_BAR; PG8_WAIT_L(0); PG8_MMA(1, 0, At, B0); PG8_BAR; PG8_SCHED;
            PG8_STAGE(PG8_SB(1, 1), b3 + hstep, voffB);
            PG8_WAIT_V(6); PG8_BAR; PG8_MMA(1, 1, At, B1); PG8_BAR;
            }
        }
        if constexpr (ALIGN_EPI) { if (wr == 0) PG8_BAR; }
        E(acc, cur, wr, wc, fr, fq); S.done(cur);
        if (!has_next) break;
#pragma unroll
        for (int a = 0; a < 2; ++a)
#pragma unroll
            for (int b = 0; b < 2; ++b)
#pragma unroll
                for (int m = 0; m < 4; ++m)
#pragma unroll
                    for (int n = 0; n < 2; ++n) acc[a][b][m][n] = (f32x4){0.f, 0.f, 0.f, 0.f};
        cur = nxt; cA = nA; cB = nB; ++ui;
        if constexpr (ALIGN_EPI) { if (wr == 1) PG8_BAR; }
    }
    PG8_WAIT_V(0);
    if constexpr (!ALIGN_EPI) { if (wr == 0) PG8_BAR; }
    PG8_BAR;
#undef PG8_SA
#undef PG8_SB
#undef PG8_STAGE
#undef PG8_LDA
#undef PG8_LDB
#undef PG8_MMA
#undef PG8_WAIT_V
#undef PG8_WAIT_L
#undef PG8_BAR
#undef PG8_SCHED
}
}

using pg8::bf16_t; using pg8::f32x4; using pg8::u32x4; using pg8::u32x2; using pg8::Unit; using pg8::cvt_pk_bf16;
#define LAS __attribute__((address_space(3)))

constexpr int DM = 1024, TP = 4096, NTP = 16384, NTS = 256, NTOK = 16640, DEPTH = 4, NIN = 4864, DFF = 4096;
constexpr int NTHREADS = 512, LDS_BYTES = 147456;
constexpr size_t O_YP = 0, O_YS = 16777216, O_KVP0 = 17039360, O_KVP1 = 18087936, O_KVP2 = 22282240, O_POOLP = 39059456,
                 O_KVS0 = 39182336, O_KVS1 = 47570944, O_KVS2 = 81125376, O_POOLS = 215343104;
constexpr size_t WS_WIN = 0;
constexpr size_t WS_WPA = WS_WIN + (size_t)DEPTH * NIN * DM * 2;
constexpr size_t WS_WPB = WS_WPA + (size_t)DEPTH * DM * 256 * 2;
constexpr size_t WS_WO  = WS_WPB + (size_t)DEPTH * DM * 512 * 2;
constexpr size_t WS_WUP = WS_WO  + (size_t)DEPTH * DM * DM * 2;
constexpr size_t WS_WDN = WS_WUP + (size_t)DEPTH * DFF * DM * 2;
constexpr size_t WS_X   = WS_WDN + (size_t)DEPTH * DM * DFF * 2;
constexpr size_t WS_XB  = WS_X   + (size_t)NTOK * DM * 4;
constexpr size_t WS_QKV = WS_XB  + (size_t)NTOK * DM * 2;
constexpr size_t WS_U   = WS_QKV + (size_t)NTOK * 2304 * 2;
constexpr size_t WS_G   = WS_U   + (size_t)NTOK * 512 * 2;
constexpr size_t WS_OA  = WS_G   + (size_t)NTOK * 2048 * 2;
constexpr size_t WS_P   = WS_OA  + (size_t)NTOK * 256 * 2;
constexpr size_t WS_TMP = WS_P   + (size_t)NTOK * 512 * 2;
constexpr size_t WS_MIX = WS_TMP + (size_t)NTOK * DM * 4;
constexpr size_t WS_H   = WS_MIX + (size_t)NTOK * DM * 2;
constexpr size_t WS_SS  = WS_H   + (size_t)NTOK * DFF * 2;
constexpr size_t WS_ROPE = WS_SS + (size_t)9 * NTOK * 4;
constexpr size_t WS_BAR = WS_ROPE + (size_t)4104 * 16 * 4;
constexpr size_t WS_END = WS_BAR + (size_t)4096 * 4;

struct Params { const float* in[17]; float* out; unsigned char* ws; };

__device__ __forceinline__ void unpack8(const u32x4 w, float (&f)[8]) {
    f[0] = __uint_as_float(w.x << 16); f[1] = __uint_as_float(w.x & 0xffff0000u);
    f[2] = __uint_as_float(w.y << 16); f[3] = __uint_as_float(w.y & 0xffff0000u);
    f[4] = __uint_as_float(w.z << 16); f[5] = __uint_as_float(w.z & 0xffff0000u);
    f[6] = __uint_as_float(w.w << 16); f[7] = __uint_as_float(w.w & 0xffff0000u);
}
__device__ __forceinline__ u32x4 pack8(const float (&f)[8]) {
    u32x4 w; w.x = cvt_pk_bf16(f[0], f[1]); w.y = cvt_pk_bf16(f[2], f[3]); w.z = cvt_pk_bf16(f[4], f[5]); w.w = cvt_pk_bf16(f[6], f[7]); return w;
}
__device__ __forceinline__ unsigned bf16_lo_pair(float a, float b, unsigned hi) { return cvt_pk_bf16(a - __uint_as_float(hi << 16), b - __uint_as_float(hi & 0xffff0000u)); }
__device__ __forceinline__ float sigmoidf_(float x) { return __builtin_amdgcn_rcpf(1.0f + __builtin_amdgcn_exp2f(x * -1.44269504089f)); }

struct EpiAll {
    static constexpr bool PERM = true, AFTER_DRAIN = false;
    int mode, layer, ssi, ssn; unsigned char* ws; float* out;

    struct Pre { u32x4 g; f32x4 a, b; float rs; };

    template <int MODE> __device__ __forceinline__ Pre pre(unsigned char* ws, int row, int c) const {
        Pre p;
        if constexpr (MODE == 0 || MODE == 4) p.rs = ((const float*)(ws + WS_SS) + (size_t)ssi * NTOK)[row];
        if constexpr (MODE == 1) p.g = *(const u32x4*)((const bf16_t*)(ws + WS_G) + (size_t)row * 2048 + c);
        if constexpr (MODE == 2) { p.g = *(const u32x4*)((const bf16_t*)(ws + WS_G) + (size_t)row * 2048 + 1024 + c);
            p.a = __builtin_bit_cast(f32x4, *(const u32x4*)((const bf16_t*)(ws + WS_TMP) + (size_t)row * DM + c)); }
        if constexpr (MODE == 3) p.a = __builtin_bit_cast(f32x4, *(const u32x4*)((const bf16_t*)(ws + WS_XB) + (size_t)row * DM + c));
        return p;
    }
    __device__ __forceinline__ void fin_proj(unsigned char* ws, int row, int c32, int fq, float (&v)[8], const Pre& p) const {
        const int pn = c32 >> 8, cl = (c32 & 255) + 8 * fq;
        const float rs = __builtin_amdgcn_rsqf(p.rs * (1.0f / 1024.0f) + 1e-6f);
        const bool samp = row >= NTP;
        const int b = samp ? ((row - NTP) >> 3) : (row >> 12);
        const int t = samp ? (row & 7) : (row & 4095);
#pragma unroll
        for (int i = 0; i < 8; ++i) v[i] *= rs;
        if (pn < 6 && ((c32 >> 5) & 1) == 0) {
            float pv[8];
#pragma unroll
            for (int i = 0; i < 8; ++i) pv[i] = __shfl_xor(v[i], 16);
            if (fq < 2) {
                const int pi = samp ? (4096 + t) : t;
                const f32x4* rp = (const f32x4*)((const float*)(ws + WS_ROPE) + (size_t)pi * 16);
                const f32x4 c0 = rp[0], c1 = rp[1], s0 = rp[2], s1 = rp[3];
                const float sg = (fq == 0) ? -1.0f : 1.0f;
#pragma unroll
                for (int i = 0; i < 4; ++i) { v[i] = v[i] * c0[i] + sg * pv[i] * s0[i]; v[4 + i] = v[4 + i] * c1[i] + sg * pv[4 + i] * s1[i]; }
            }
        }
        if (pn >= 11) {
#pragma unroll
            for (int i = 0; i < 8; ++i) v[i] = sigmoidf_(v[i]);
        }
        bf16_t* dst; int ld, cbase;
        if (pn < 9) { dst = (bf16_t*)(ws + WS_QKV); ld = 2304; cbase = pn * 256; }
        else if (pn < 11) { dst = (bf16_t*)(ws + WS_U); ld = 512; cbase = (pn - 9) * 256; }
        else { dst = (bf16_t*)(ws + WS_G); ld = 2048; cbase = (pn - 11) * 256; }
        *(u32x4*)(dst + (size_t)row * ld + cbase + cl) = pack8(v);
        if (pn >= 3 && pn < 9) {
            const int kvi = pn - 3; const int g = (kvi >= 3) ? kvi - 3 : kvi; const int kv = (kvi >= 3) ? 1 : 0;
            const int W = 128 << (2 * g);
            const size_t okp = (g == 0) ? O_KVP0 : (g == 1 ? O_KVP1 : O_KVP2);
            const size_t oks = (g == 0) ? O_KVS0 : (g == 1 ? O_KVS1 : O_KVS2);
            float* op = nullptr;
            if (samp) op = out + oks + ((size_t)((layer * 32 + b) * W + (W - 8 + t)) * 2 + kv) * 256 + cl;
            else if (t >= TP - W) op = out + okp + ((size_t)((layer * 4 + b) * W + (t - (TP - W))) * 2 + kv) * 256 + cl;
            if (op) { *(f32x4*)op = (f32x4){v[0], v[1], v[2], v[3]}; *(f32x4*)(op + 4) = (f32x4){v[4], v[5], v[6], v[7]}; }
        } else if (pn >= 9 && pn < 11) {
            float* op = nullptr; const int c = cbase + cl;
            if (samp) op = out + O_POOLS + (size_t)((layer * 32 + b) * 15 + 7 + t) * 512 + c;
            else if (t >= TP - 15) op = out + O_POOLP + (size_t)((layer * 4 + b) * 15 + (t - (TP - 15))) * 512 + c;
            if (op) { *(f32x4*)op = (f32x4){v[0], v[1], v[2], v[3]}; *(f32x4*)(op + 4) = (f32x4){v[4], v[5], v[6], v[7]}; }
        }
    }
    template <int MODE> __device__ __forceinline__ void fin(unsigned char* ws, int row, int c32, int fq, float (&v)[8], const Pre& p) const {
        const int c = c32 + 8 * fq;
        if constexpr (MODE == 0) fin_proj(ws, row, c32, fq, v, p);
        if constexpr (MODE == 1) {
            float gg[8]; unpack8(p.g, gg);
#pragma unroll
            for (int i = 0; i < 8; ++i) v[i] *= gg[i];
            *(u32x4*)((bf16_t*)(ws + WS_TMP) + (size_t)row * DM + c) = pack8(v);
        }
        if constexpr (MODE == 2) {
            float gg[8]; unpack8(p.g, gg);
            float tt[8]; unpack8(__builtin_bit_cast(u32x4, p.a), tt);
#pragma unroll
            for (int i = 0; i < 8; ++i) v[i] = tt[i] + gg[i] * v[i];
            *(u32x4*)((bf16_t*)(ws + WS_MIX) + (size_t)row * DM + c) = pack8(v);
        }
        if constexpr (MODE == 3) {
            float xh[8]; unpack8(__builtin_bit_cast(u32x4, p.a), xh);
            float sq = 0.f;
#pragma unroll
            for (int i = 0; i < 8; ++i) { v[i] += xh[i]; sq += v[i] * v[i]; }
            *(u32x4*)((bf16_t*)(ws + WS_XB) + (size_t)row * DM + c) = pack8(v);
            sq += __shfl_xor(sq, 16); sq += __shfl_xor(sq, 32);
            if (fq == 0) atomicAdd((float*)(ws + WS_SS) + (size_t)ssn * NTOK + row, sq);
        }
        if constexpr (MODE == 4) {
            const float rs = __builtin_amdgcn_rsqf(p.rs * (1.0f / 1024.0f) + 1e-6f);
#pragma unroll
            for (int i = 0; i < 8; ++i) { const float a = fmaxf(v[i] * rs, 0.f); v[i] = a * a; }
            *(u32x4*)((bf16_t*)(ws + WS_H) + (size_t)row * DFF + c) = pack8(v);
        }
    }
    __device__ __forceinline__ void chunk(unsigned char* ws, int row, int c32, int fq, float (&v)[8]) const {
        const int c = c32 + 8 * fq;
        switch (mode) {
            case 0: { const Pre p = pre<0>(ws, row, c); fin<0>(ws, row, c32, fq, v, p); } break;
            case 1: { const Pre p = pre<1>(ws, row, c); fin<1>(ws, row, c32, fq, v, p); } break;
            case 2: { const Pre p = pre<2>(ws, row, c); fin<2>(ws, row, c32, fq, v, p); } break;
            case 3: { const Pre p = pre<3>(ws, row, c); fin<3>(ws, row, c32, fq, v, p); } break;
            default: { const Pre p = pre<4>(ws, row, c); fin<4>(ws, row, c32, fq, v, p); } break;
        }
    }
    template <int MODE> __device__ __forceinline__ void tile(unsigned char* ws, const f32x4 (&acc)[2][2][4][2], const Unit& u, int wr, int wc, int fr, int fq) const {
        constexpr int MB = (MODE == 2 || MODE == 3) ? 2 : 4;
#pragma unroll
        for (int ai = 0; ai < 2; ++ai)
#pragma unroll
            for (int m0 = 0; m0 < 4; m0 += MB) {
                Pre p[MB][2];
#pragma unroll
                for (int mm = 0; mm < MB; ++mm)
#pragma unroll
                    for (int bj = 0; bj < 2; ++bj) p[mm][bj] = pre<MODE>(ws, u.pm * 256 + ai * 128 + wr * 64 + (m0 + mm) * 16 + fr, u.pn * 256 + bj * 128 + wc * 32 + 8 * fq);
#pragma unroll
                for (int mm = 0; mm < MB; ++mm)
#pragma unroll
                    for (int bj = 0; bj < 2; ++bj) {
                        float v[8];
#pragma unroll
                        for (int i = 0; i < 4; ++i) { v[i] = acc[ai][bj][m0 + mm][0][i]; v[4 + i] = acc[ai][bj][m0 + mm][1][i]; }
                        fin<MODE>(ws, u.pm * 256 + ai * 128 + wr * 64 + (m0 + mm) * 16 + fr, u.pn * 256 + bj * 128 + wc * 32, fq, v, p[mm][bj]);
                    }
                asm volatile("" ::: "memory");
            }
    }
    __device__ __forceinline__ void operator()(const f32x4 (&acc)[2][2][4][2], const Unit& u, int wr, int wc, int fr, int fq) const {
        asm volatile("" : "+v"(fr), "+v"(fq));
        size_t zoff = 0; asm volatile("" : "+s"(zoff));
        unsigned char* ws = this->ws + zoff;
        switch (mode) {
            case 0: tile<0>(ws, acc, u, wr, wc, fr, fq); break;
            case 1: tile<1>(ws, acc, u, wr, wc, fr, fq); break;
            case 2: tile<2>(ws, acc, u, wr, wc, fr, fq); break;
            case 3: tile<3>(ws, acc, u, wr, wc, fr, fq); break;
            default: tile<4>(ws, acc, u, wr, wc, fr, fq); break;
        }
    }
};

__device__ __forceinline__ void skinny_gemm(LAS unsigned char* lds, const bf16_t* __restrict__ A, const bf16_t* __restrict__ Bt, int N, int K, const EpiAll& E, int first, int G) {
    using pg8::bf16x8;
    int tid = threadIdx.x; asm volatile("" : "+v"(tid));
    const int lane = tid & 63, w = __builtin_amdgcn_readfirstlane(tid >> 6), kg = lane >> 4, qn = lane & 15;
    const int nh = (N == 1024) ? 1 : 2, ksplit = 8 / nh;
    const int half = w % nh, kq = w / nh, Kq = K / ksplit, nsteps = Kq >> 5;
    size_t zoff = 0; asm volatile("" : "+s"(zoff));
    unsigned char* ws = E.ws + zoff;
    LAS float* red = (LAS float*)lds;
    const int RB = 8 / nh, units = RB * (N >> 5);
#pragma unroll 1
    for (int u = first; u < units; u += G) {
        const int rb = u % RB, c32 = (u / RB) << 5;
        const int row0 = rb * 32 * nh + half * 32;
        const bf16_t* ap = A + (size_t)(row0 + qn) * K + kq * Kq + kg * 8;
        const bf16_t* bp = Bt + (size_t)(c32 + 8 * (qn >> 2) + (qn & 3)) * K + kq * Kq + kg * 8;
        f32x4 acc[2][2];
#pragma unroll
        for (int a = 0; a < 2; ++a)
#pragma unroll
            for (int b = 0; b < 2; ++b) acc[a][b] = (f32x4){0.f, 0.f, 0.f, 0.f};
#pragma unroll 8
        for (int ks = 0; ks < nsteps; ++ks) {
            const bf16x8 x0 = *(const bf16x8*)(ap + ks * 32), x1 = *(const bf16x8*)(ap + (size_t)16 * K + ks * 32);
            const bf16x8 w0 = *(const bf16x8*)(bp + ks * 32), w1 = *(const bf16x8*)(bp + (size_t)4 * K + ks * 32);
            acc[0][0] = __builtin_amdgcn_mfma_f32_16x16x32_bf16(w0, x0, acc[0][0], 0, 0, 0);
            acc[0][1] = __builtin_amdgcn_mfma_f32_16x16x32_bf16(w1, x0, acc[0][1], 0, 0, 0);
            acc[1][0] = __builtin_amdgcn_mfma_f32_16x16x32_bf16(w0, x1, acc[1][0], 0, 0, 0);
            acc[1][1] = __builtin_amdgcn_mfma_f32_16x16x32_bf16(w1, x1, acc[1][1], 0, 0, 0);
        }
        __syncthreads();
        if (kq != 0) {
#pragma unroll
            for (int a = 0; a < 2; ++a)
#pragma unroll
                for (int b = 0; b < 2; ++b)
#pragma unroll
                    for (int i = 0; i < 4; ++i) red[(w * 16 + a * 8 + b * 4 + i) * 64 + lane] = acc[a][b][i];
        }
        __syncthreads();
        if (kq == 0) {
#pragma unroll 1
            for (int q = 1; q < ksplit; ++q)
#pragma unroll
                for (int a = 0; a < 2; ++a)
#pragma unroll
                    for (int b = 0; b < 2; ++b)
#pragma unroll
                        for (int i = 0; i < 4; ++i) acc[a][b][i] += red[((w + nh * q) * 16 + a * 8 + b * 4 + i) * 64 + lane];
#pragma unroll
            for (int a = 0; a < 2; ++a) {
                float v[8];
#pragma unroll
                for (int i = 0; i < 4; ++i) { v[i] = acc[a][0][i]; v[4 + i] = acc[a][1][i]; }
                E.chunk(ws, NTP + row0 + a * 16 + qn, c32, kg, v);
            }
        }
    }
    __syncthreads();
}

__device__ __forceinline__ void lds_wait() { asm volatile("s_waitcnt lgkmcnt(0)" ::: "memory"); }
__device__ __forceinline__ void transpose_item(const float* __restrict__ W, const float* __restrict__ gsc, int K, int N, bf16_t* __restrict__ WT, LAS float* scr, int item, int lane) {
    const int nblk = N / 64, kb = item / nblk, nb = item % nblk, k0 = 64 * kb, n0 = 64 * nb;
    f32x4 v[16];
#pragma unroll
    for (int i = 0; i < 16; ++i) v[i] = *(const f32x4*)(W + (size_t)(k0 + 4 * i + (lane >> 4)) * N + n0 + 4 * (lane & 15));
#pragma unroll
    for (int i = 0; i < 16; ++i) { const int kk = 4 * i + (lane >> 4); const float sc = gsc ? gsc[k0 + kk] : 1.0f; LAS float* d = scr + kk * 65 + 4 * (lane & 15);
        d[0] = v[i][0] * sc; d[1] = v[i][1] * sc; d[2] = v[i][2] * sc; d[3] = v[i][3] * sc; }
    lds_wait();
    const int c = lane & 7;
#pragma unroll
    for (int j = 0; j < 8; ++j) { const int n = (lane >> 3) + 8 * j; const LAS float* sp = scr + (8 * c) * 65 + n;
        u32x4 o; o.x = cvt_pk_bf16(sp[0 * 65], sp[1 * 65]); o.y = cvt_pk_bf16(sp[2 * 65], sp[3 * 65]); o.z = cvt_pk_bf16(sp[4 * 65], sp[5 * 65]); o.w = cvt_pk_bf16(sp[6 * 65], sp[7 * 65]);
        *(u32x4*)(WT + (size_t)(n0 + n) * K + k0 + 8 * c) = o; }
    lds_wait();
}

template <int L>
__device__ __forceinline__ void copy_shift(const float* __restrict__ src, float* __restrict__ dst, int layer, size_t gtid, size_t nth) {
    constexpr size_t per = (size_t)(L - 8) * 128;
    constexpr size_t total = (size_t)32 * per;
    constexpr int U = 8;
    const f32x4* s4 = (const f32x4*)src + (size_t)layer * 32 * L * 128; f32x4* d4 = (f32x4*)dst + (size_t)layer * 32 * L * 128;
    for (size_t i = gtid; i < total; i += nth * U) {
        f32x4 v[U];
#pragma unroll
        for (int u = 0; u < U; ++u) { const size_t idx = i + u * nth; const size_t ii = idx < total ? idx : 0; const size_t lb = ii / per, r = ii - lb * per;
            v[u] = __builtin_nontemporal_load(s4 + lb * (size_t)L * 128 + r + 8 * 128); }
#pragma unroll
        for (int u = 0; u < U; ++u) { const size_t idx = i + u * nth; if (idx < total) { const size_t lb = idx / per, r = idx - lb * per; __builtin_nontemporal_store(v[u], d4 + lb * (size_t)L * 128 + r); } }
    }
}

#define ATT_DOT(S, Q, KF) do { float _s = 0.f; _Pragma("unroll") for (int _i = 0; _i < 8; ++_i) _s += Q[_i] * KF[_i]; \
    _s += __shfl_xor(_s, 1); _s += __shfl_xor(_s, 2); _s += __shfl_xor(_s, 4); S = _s; } while (0)

__device__ __forceinline__ void attn_finish(float m, float l, float (&o)[8], bf16_t* dstp, int kg) {
    float M = m; M = fmaxf(M, __shfl_xor(M, 8)); M = fmaxf(M, __shfl_xor(M, 16)); M = fmaxf(M, __shfl_xor(M, 32));
    const float f = __expf(m - M); l *= f;
#pragma unroll
    for (int i = 0; i < 8; ++i) o[i] *= f;
    l += __shfl_xor(l, 8); l += __shfl_xor(l, 16); l += __shfl_xor(l, 32);
#pragma unroll
    for (int i = 0; i < 8; ++i) { o[i] += __shfl_xor(o[i], 8); o[i] += __shfl_xor(o[i], 16); o[i] += __shfl_xor(o[i], 32); }
    const float inv = 1.0f / l;
#pragma unroll
    for (int i = 0; i < 8; ++i) o[i] *= inv;
    if (kg == 0) *(u32x4*)dstp = pack8(o);
}

__device__ __forceinline__ void attn_prompt_item(const bf16_t* __restrict__ qkv, bf16_t* __restrict__ oa, int token, int h, int lane) {
    const int kg = lane >> 3, dl = lane & 7;
    const int b = token >> 12, t = token & 4095;
    const bf16_t* qrow = qkv + (size_t)token * 2304 + h * 64 + dl * 8;
    const bf16_t* kbase = qkv + (size_t)(b << 12) * 2304 + 768 + h * 64 + dl * 8;
    float m = -1e30f, l = 0.f; float o[8];
#pragma unroll
    for (int i = 0; i < 8; ++i) o[i] = 0.f;
#pragma unroll 1
    for (int g = 0; g < 3; ++g) {
        const int d = 1 << (2 * g);
        float q[8]; unpack8(*(const u32x4*)(qrow + g * 256), q);
#pragma unroll
        for (int i = 0; i < 8; ++i) q[i] *= 0.125f;
        const bf16_t* kb = kbase + g * 256;
#pragma unroll 1
        for (int it = 0; it < 16; it += 4) {
            u32x4 kr[4], vr[4]; bool val[4];
#pragma unroll
            for (int u = 0; u < 4; ++u) { const int j = (it + u) * 8 + kg; const int pos = t - j * d; val[u] = pos >= 0; const bf16_t* r = kb + (size_t)(pos < 0 ? 0 : pos) * 2304;
                kr[u] = *(const u32x4*)r; vr[u] = *(const u32x4*)(r + 768); }
            float s[4];
#pragma unroll
            for (int u = 0; u < 4; ++u) { float kf[8]; unpack8(kr[u], kf); ATT_DOT(s[u], q, kf); if (!val[u]) s[u] = -1e30f; }
            const float mb = fmaxf(fmaxf(m, fmaxf(s[0], s[1])), fmaxf(s[2], s[3]));
            const float corr = __expf(m - mb);
            l *= corr;
#pragma unroll
            for (int i = 0; i < 8; ++i) o[i] *= corr;
#pragma unroll
            for (int u = 0; u < 4; ++u) { const float p = val[u] ? __expf(s[u] - mb) : 0.f; l += p; float vf[8]; unpack8(vr[u], vf);
#pragma unroll
                for (int i = 0; i < 8; ++i) o[i] += p * vf[i]; }
            m = mb;
        }
    }
    {
        const int g = kg < 2 ? kg : 2; const int d = 1 << (2 * g);
        const int pos = t - 128 * d; const bool val = (kg < 3) && (pos >= 0);
        float q[8]; unpack8(*(const u32x4*)(qrow + g * 256), q);
        const bf16_t* r = kbase + g * 256 + (size_t)(pos < 0 ? 0 : pos) * 2304;
        float kf[8], vf[8]; unpack8(*(const u32x4*)r, kf); unpack8(*(const u32x4*)(r + 768), vf);
        float s; ATT_DOT(s, q, kf); s *= 0.125f;
        if (!val) s = -1e30f;
        const float mb = fmaxf(m, s); const float corr = __expf(m - mb); const float p = val ? __expf(s - mb) : 0.f;
        l = l * corr + p;
#pragma unroll
        for (int i = 0; i < 8; ++i) o[i] = o[i] * corr + p * vf[i];
        m = mb;
    }
    attn_finish(m, l, o, oa + (size_t)token * 256 + h * 64 + dl * 8, kg);
}

__device__ __forceinline__ void sample_kv(const bf16_t* __restrict__ newb, const float* __restrict__ cb, int W, int idx, float (&kf)[8], float (&vf)[8]) {
    if (idx >= W) { const bf16_t* r = newb + (size_t)(idx - W) * 2304; unpack8(*(const u32x4*)r, kf); unpack8(*(const u32x4*)(r + 768), vf); }
    else { const float* r = cb + (size_t)idx * 512; const f32x4 a = *(const f32x4*)r, b2 = *(const f32x4*)(r + 4), c = *(const f32x4*)(r + 256), d2 = *(const f32x4*)(r + 260);
#pragma unroll
        for (int i = 0; i < 4; ++i) { kf[i] = a[i]; kf[4 + i] = b2[i]; vf[i] = c[i]; vf[4 + i] = d2[i]; } }
}
__device__ __forceinline__ void attn_sample_sub(const bf16_t* __restrict__ qkv, const float* __restrict__ cg_, bf16_t* __restrict__ PO, float* __restrict__ LSE,
                                                int layer, int stok, int h, int g, int lane) {
    const int kg = lane >> 3, dl = lane & 7;
    const int b = stok >> 3, t = stok & 7;
    const int token = NTP + stok;
    const int d = 1 << (2 * g), W = 128 << (2 * g);
    const bf16_t* nb = qkv + (size_t)(NTP + b * 8) * 2304 + 768 + g * 256 + h * 64 + dl * 8;
    const float* cb = cg_ + (size_t)(layer * 32 + b) * W * 512 + h * 64 + dl * 8;
    float q[8]; unpack8(*(const u32x4*)(qkv + (size_t)token * 2304 + g * 256 + h * 64 + dl * 8), q);
#pragma unroll
    for (int i = 0; i < 8; ++i) q[i] *= 0.125f;
    float m = -1e30f, l = 0.f; float o[8];
#pragma unroll
    for (int i = 0; i < 8; ++i) o[i] = 0.f;
#pragma unroll 1
    for (int it = 0; it < 16; it += 8) {
        float kf[8][8], vf[8][8], s[8];
#pragma unroll
        for (int u = 0; u < 8; ++u) { const int j = (it + u) * 8 + kg; sample_kv(nb, cb, W, W + t - j * d, kf[u], vf[u]); }
        float mb = m;
#pragma unroll
        for (int u = 0; u < 8; ++u) { ATT_DOT(s[u], q, kf[u]); mb = fmaxf(mb, s[u]); }
        const float corr = __expf(m - mb);
        l *= corr;
#pragma unroll
        for (int i = 0; i < 8; ++i) o[i] *= corr;
#pragma unroll
        for (int u = 0; u < 8; ++u) { const float p = __expf(s[u] - mb); l += p;
#pragma unroll
            for (int i = 0; i < 8; ++i) o[i] += p * vf[u][i]; }
        m = mb;
    }
    {
        const bool val = kg == 0;
        float kf[8], vf[8]; sample_kv(nb, cb, W, W + t - 128 * d, kf, vf);
        float s; ATT_DOT(s, q, kf);
        if (!val) s = -1e30f;
        const float mb = fmaxf(m, s); const float corr = __expf(m - mb); const float p = val ? __expf(s - mb) : 0.f;
        l = l * corr + p;
#pragma unroll
        for (int i = 0; i < 8; ++i) o[i] = o[i] * corr + p * vf[i];
        m = mb;
    }
    float M = m; M = fmaxf(M, __shfl_xor(M, 8)); M = fmaxf(M, __shfl_xor(M, 16)); M = fmaxf(M, __shfl_xor(M, 32));
    const float f = __expf(m - M); l *= f;
#pragma unroll
    for (int i = 0; i < 8; ++i) o[i] *= f;
    l += __shfl_xor(l, 8); l += __shfl_xor(l, 16); l += __shfl_xor(l, 32);
#pragma unroll
    for (int i = 0; i < 8; ++i) { o[i] += __shfl_xor(o[i], 8); o[i] += __shfl_xor(o[i], 16); o[i] += __shfl_xor(o[i], 32); }
    const float inv = 1.0f / l;
#pragma unroll
    for (int i = 0; i < 8; ++i) o[i] *= inv;
    if (kg == 0) *(u32x4*)(PO + ((size_t)g * NTOK + token) * 256 + h * 64 + dl * 8) = pack8(o);
    if (lane == 0) LSE[((size_t)g * NTOK + token) * 4 + h] = M + __logf(l);
}

constexpr int ATT_PITCH = 144, ATT_ROWS = 272, ATT_VOFF = ATT_ROWS * ATT_PITCH;
typedef short s16x4 __attribute__((ext_vector_type(4)));
template <int OFF> __device__ __forceinline__ s16x4 tr_read(unsigned addr) { s16x4 r; asm volatile("ds_read_b64_tr_b16 %0, %1 offset:%2" : "=v"(r) : "v"(addr), "n"(OFF) : "memory"); return r; }
__device__ __forceinline__ void tr_wait8(s16x4& a, s16x4& b, s16x4& c, s16x4& d, s16x4& e, s16x4& f, s16x4& g, s16x4& h) {
    asm volatile("s_waitcnt lgkmcnt(0)" : "+v"(a), "+v"(b), "+v"(c), "+v"(d), "+v"(e), "+v"(f), "+v"(g), "+v"(h) :: "memory"); }

__device__ __forceinline__ void attn_mfma_phase(LAS unsigned char* lds, const bf16_t* __restrict__ QKV, bf16_t* __restrict__ PO, float* __restrict__ LSE, int bid, int G, int tid) {
    using pg8::bf16x8;
    const int lane = tid & 63, w = __builtin_amdgcn_readfirstlane(tid >> 6), kg = lane >> 4, qn = lane & 15;
    for (int i = tid; i < 2 * 144; i += NTHREADS) { const int kv = i / 144, rem = i - kv * 144; *(LAS u32x4*)(lds + kv * ATT_VOFF + 256 * ATT_PITCH + rem * 16) = (u32x4){0u, 0u, 0u, 0u}; }
    const unsigned vaddr = (unsigned)(uintptr_t)(lds + ATT_VOFF + (16 * w + 4 * kg + (qn >> 2)) * ATT_PITCH + (lane & 3) * 8);
    const float csc = 0.125f * 1.44269504089f;
#define ATT_DECODE(U, b_, h_, g_, r_, I0_) do { const int _bh = (U) / 96, _rest = (U) - _bh * 96; b_ = _bh >> 2; h_ = _bh & 3; \
        if (_rest < 32) { g_ = 0; r_ = 0; I0_ = 128 * _rest; } else if (_rest < 64) { g_ = 1; r_ = (_rest - 32) >> 3; I0_ = 128 * ((_rest - 32) & 7); } else { g_ = 2; r_ = (_rest - 64) >> 1; I0_ = 128 * ((_rest - 64) & 1); } } while (0)
#define ATT_FETCH(U) do { int _b, _h, _g, _r, _I0; ATT_DECODE(U, _b, _h, _g, _r, _I0); const int _d = 1 << (2 * _g); \
        _Pragma("unroll") for (int i = 0; i < 8; ++i) { const int kv = i >> 2, row = (tid >> 3) + 64 * (i & 3), ch = tid & 7; const int I = _I0 - 128 + row; \
            pf[i] = (u32x4){0u, 0u, 0u, 0u}; \
            if (I >= 0) pf[i] = *(const u32x4*)(QKV + (size_t)(_b * 4096 + _r + _d * I) * 2304 + 768 + kv * 768 + _g * 256 + _h * 64 + ch * 8); } \
        const bf16_t* _qp = QKV + ((size_t)_b * 4096 + _r + _d * (_I0 + 16 * w + qn)) * 2304 + _g * 256 + _h * 64 + kg * 8; \
        qf0 = *(const bf16x8*)_qp; qf1 = *(const bf16x8*)(_qp + 32); } while (0)
    u32x4 pf[8]; bf16x8 qf0, qf1;
    if (bid < 1536) ATT_FETCH(bid);
#pragma unroll 1
    for (int u = bid; u < 1536; u += G) {
        int b, h, g, r, I0; ATT_DECODE(u, b, h, g, r, I0);
        const int d = 1 << (2 * g);
        __syncthreads();
#pragma unroll
        for (int i = 0; i < 8; ++i) { const int kv = i >> 2, row = (tid >> 3) + 64 * (i & 3), ch = tid & 7; *(LAS u32x4*)(lds + kv * ATT_VOFF + row * ATT_PITCH + ch * 16) = pf[i]; }
        const bf16x8 q0 = qf0, q1 = qf1;
        __syncthreads();
        if (u + G < 1536) ATT_FETCH(u + G);
        const int Iq = I0 + 16 * w + qn; const size_t tokq = (size_t)b * 4096 + r + d * Iq;
        f32x4 sc[9];
        const LAS unsigned char* kb = lds + (16 * w + qn) * ATT_PITCH + kg * 16;
#pragma unroll
        for (int kt = 0; kt < 9; ++kt) { const bf16x8 k0 = *(const LAS bf16x8*)(kb + kt * 16 * ATT_PITCH), k1 = *(const LAS bf16x8*)(kb + kt * 16 * ATT_PITCH + 64);
            f32x4 z = (f32x4){0.f, 0.f, 0.f, 0.f}; z = __builtin_amdgcn_mfma_f32_16x16x32_bf16(k0, q0, z, 0, 0, 0); sc[kt] = __builtin_amdgcn_mfma_f32_16x16x32_bf16(k1, q1, z, 0, 0, 0); }
        const int jb = 128 + qn - 4 * kg, ikb = I0 - 128 + 16 * w + 4 * kg;
        float m = -1e30f;
#pragma unroll
        for (int kt = 0; kt < 9; ++kt)
#pragma unroll
            for (int i = 0; i < 4; ++i) { const int j = jb - 16 * kt - i; const bool val = (j >= 0) && (j <= 128) && (ikb + 16 * kt + i >= 0); sc[kt][i] = val ? sc[kt][i] : -1e30f; m = fmaxf(m, sc[kt][i]); }
        m = fmaxf(m, __shfl_xor(m, 16)); m = fmaxf(m, __shfl_xor(m, 32));
        const float mc = m * csc; float l = 0.f;
        unsigned pk[10][2];
#pragma unroll
        for (int kt = 0; kt < 9; ++kt) { float p[4];
#pragma unroll
            for (int i = 0; i < 4; ++i) { p[i] = (sc[kt][i] > -1e29f) ? __builtin_amdgcn_exp2f(sc[kt][i] * csc - mc) : 0.f; l += p[i]; }
            pk[kt][0] = cvt_pk_bf16(p[0], p[1]); pk[kt][1] = cvt_pk_bf16(p[2], p[3]); }
        pk[9][0] = 0u; pk[9][1] = 0u;
        l += __shfl_xor(l, 16); l += __shfl_xor(l, 32);
        f32x4 o[4];
#pragma unroll
        for (int dt = 0; dt < 4; ++dt) o[dt] = (f32x4){0.f, 0.f, 0.f, 0.f};
#define ATT_PV(KK) do { s16x4 a0 = tr_read<(KK) * 32 * ATT_PITCH + 0>(vaddr), a1 = tr_read<(KK) * 32 * ATT_PITCH + 32>(vaddr), a2 = tr_read<(KK) * 32 * ATT_PITCH + 64>(vaddr), a3 = tr_read<(KK) * 32 * ATT_PITCH + 96>(vaddr); \
            s16x4 c0 = tr_read<(KK) * 32 * ATT_PITCH + 16 * ATT_PITCH + 0>(vaddr), c1 = tr_read<(KK) * 32 * ATT_PITCH + 16 * ATT_PITCH + 32>(vaddr), c2 = tr_read<(KK) * 32 * ATT_PITCH + 16 * ATT_PITCH + 64>(vaddr), c3 = tr_read<(KK) * 32 * ATT_PITCH + 16 * ATT_PITCH + 96>(vaddr); \
            tr_wait8(a0, a1, a2, a3, c0, c1, c2, c3); \
            u32x4 pw; pw.x = pk[2 * (KK)][0]; pw.y = pk[2 * (KK)][1]; pw.z = pk[2 * (KK) + 1][0]; pw.w = pk[2 * (KK) + 1][1]; \
            const bf16x8 pf = __builtin_bit_cast(bf16x8, pw); \
            o[0] = __builtin_amdgcn_mfma_f32_16x16x32_bf16(__builtin_shufflevector(a0, c0, 0, 1, 2, 3, 4, 5, 6, 7), pf, o[0], 0, 0, 0); \
            o[1] = __builtin_amdgcn_mfma_f32_16x16x32_bf16(__builtin_shufflevector(a1, c1, 0, 1, 2, 3, 4, 5, 6, 7), pf, o[1], 0, 0, 0); \
            o[2] = __builtin_amdgcn_mfma_f32_16x16x32_bf16(__builtin_shufflevector(a2, c2, 0, 1, 2, 3, 4, 5, 6, 7), pf, o[2], 0, 0, 0); \
            o[3] = __builtin_amdgcn_mfma_f32_16x16x32_bf16(__builtin_shufflevector(a3, c3, 0, 1, 2, 3, 4, 5, 6, 7), pf, o[3], 0, 0, 0); } while (0)
        ATT_PV(0); ATT_PV(1); ATT_PV(2); ATT_PV(3); ATT_PV(4);
        const float il = 1.0f / l;
        bf16_t* op = PO + ((size_t)g * NTOK + tokq) * 256 + h * 64 + 4 * kg;
#pragma unroll
        for (int dt = 0; dt < 4; ++dt) { u32x2 wv; wv.x = cvt_pk_bf16(o[dt][0] * il, o[dt][1] * il); wv.y = cvt_pk_bf16(o[dt][2] * il, o[dt][3] * il); *(u32x2*)(op + 16 * dt) = wv; }
        if (kg == 0) LSE[((size_t)g * NTOK + tokq) * 4 + h] = m * 0.125f + __logf(l);
    }
#undef ATT_PV
#undef ATT_FETCH
#undef ATT_DECODE
}

#define XB_TMO      128
#define XB_XCNT(j)  (256  + 64 * (j))
#define XB_XSUB(j)  (1280 + 64 * (j))
#define XB_XGEN(j)  (2304 + 64 * (j))
#define XB_TOP      3328
#define XB_TOPGEN   3392
#define XCD_BAR_WORDS 3456
#define XB_SPIN_CAP (1u << 20)
__device__ __forceinline__ unsigned xb_ld(unsigned* p)              { return __hip_atomic_load(p, __ATOMIC_RELAXED, __HIP_MEMORY_SCOPE_AGENT); }
__device__ __forceinline__ unsigned xb_add(unsigned* p, unsigned v) { return __hip_atomic_fetch_add(p, v, __ATOMIC_RELAXED, __HIP_MEMORY_SCOPE_AGENT); }
__device__ __forceinline__ unsigned xb_xcc_id() { return (unsigned)__builtin_amdgcn_s_getreg((3 << 11) | 20) & 0xFu; }
#define XB_SPIN(cond, bar) do { unsigned _sp = 0; while (cond) { __builtin_amdgcn_s_sleep(1); \
    if ((++_sp & 255u) == 0u) { if (xb_ld(&(bar)[XB_TMO])) break; if (_sp > XB_SPIN_CAP) { atomicAdd(&(bar)[XB_TMO], 1u); break; } } } } while (0)
struct XcdBarrier { unsigned* bar; unsigned x; volatile LAS unsigned* st; };
__device__ __forceinline__ XcdBarrier xcd_barrier_post(unsigned* bar, volatile LAS unsigned* st) {
    XcdBarrier b; b.bar = bar; b.x = xb_xcc_id(); b.st = st;
    if (threadIdx.x == 0) (void)xb_add(&bar[XB_XCNT(b.x)], 1u);
    return b;
}
__device__ __forceinline__ void xcd_barrier_complete(unsigned* bar, unsigned x, unsigned& nloc, unsigned& nx) {
    const unsigned G = gridDim.x * gridDim.y * gridDim.z;
    unsigned sum, cnt, mine, sp = 0u;
    for (;;) {
        sum = 0u; cnt = 0u; mine = 0u;
#pragma unroll
        for (unsigned j = 0; j < 16; ++j) { const unsigned c = xb_ld(&bar[XB_XCNT(j)]); sum += c; cnt += (c > 0u) ? 1u : 0u; mine = (j == x) ? c : mine; }
        if (sum == G) break;
        __builtin_amdgcn_s_sleep(1);
        if ((++sp & 255u) == 0u) { if (xb_ld(&bar[XB_TMO])) break; if (sp > XB_SPIN_CAP) { atomicAdd(&bar[XB_TMO], 1u); break; } }
    }
    nloc = mine > 0u ? mine : 1u; nx = cnt > 0u ? cnt : 1u;
}
__device__ __forceinline__ void xcd_barrier(const XcdBarrier& b) {
    asm volatile("s_waitcnt vmcnt(0)" ::: "memory");
    __syncthreads();
    if (threadIdx.x == 0) {
        unsigned* bar = b.bar;
        __builtin_amdgcn_s_waitcnt(0);
        unsigned nloc = b.st[0], nx = b.st[1];
        if (nloc == 0u) { xcd_barrier_complete(bar, b.x, nloc, nx); b.st[0] = nloc; b.st[1] = nx; }
        const unsigned old = xb_add(&bar[XB_XSUB(b.x)], 1u);
        const unsigned gen = old / nloc;
        if (old + 1u == (gen + 1u) * nloc) {
            __builtin_amdgcn_fence(__ATOMIC_RELEASE, "agent");
            asm volatile("s_waitcnt vmcnt(0)" ::: "memory");
            const unsigned og = xb_add(&bar[XB_TOP], 1u);
            const unsigned tg = og / nx;
            if (og + 1u == (tg + 1u) * nx) xb_add(&bar[XB_TOPGEN], 1u);
            else XB_SPIN(xb_ld(&bar[XB_TOPGEN]) == tg, bar);
            __builtin_amdgcn_fence(__ATOMIC_ACQUIRE, "agent");
            xb_add(&bar[XB_XGEN(b.x)], 1u);
            asm volatile("s_waitcnt vmcnt(0)" ::: "memory");
        } else {
            XB_SPIN(xb_ld(&bar[XB_XGEN(b.x)]) == gen, bar);
            __builtin_amdgcn_fence(__ATOMIC_ACQUIRE, "agent");
            asm volatile("s_waitcnt vmcnt(0)" ::: "memory");
        }
    }
    __syncthreads();
}

template <int GP> __device__ __forceinline__ void pool_item(const bf16_t* __restrict__ UB, bf16_t* __restrict__ PB, const float* __restrict__ sp, int tb, int cl) {
    constexpr int W = 2 << GP, NR = W + 7;
    const int c = (GP * 16 + cl) * 8;
    const int token0 = tb * 8; const bool samp = token0 >= NTP; const int t0 = samp ? 0 : (token0 & 4095); const int b = (token0 - NTP) >> 3;
    u32x4 R[NR];
#pragma unroll
    for (int r = 0; r < NR; ++r) { const int dt = r - (W - 1);
        if (dt >= 0 || t0 + dt >= 0) R[r] = *(const u32x4*)(UB + (size_t)(token0 + dt) * 512 + c);
        else if (samp) { const float* q = sp + (size_t)(b * 15 + 15 + dt) * 512 + c; const f32x4 a = *(const f32x4*)q, b2 = *(const f32x4*)(q + 4);
            R[r].x = cvt_pk_bf16(a[0], a[1]); R[r].y = cvt_pk_bf16(a[2], a[3]); R[r].z = cvt_pk_bf16(b2[0], b2[1]); R[r].w = cvt_pk_bf16(b2[2], b2[3]); }
        else R[r] = (u32x4){0u, 0u, 0u, 0u}; }
#pragma unroll
    for (int j = 0; j < 8; ++j) {
        float sum[8];
#pragma unroll
        for (int k = 0; k < 8; ++k) sum[k] = 0.f;
#pragma unroll
        for (int i = 0; i < W; ++i) { float f[8]; unpack8(R[j + (W - 1) - i], f);
#pragma unroll
            for (int k = 0; k < 8; ++k) sum[k] += f[k]; }
        float ut[8]; unpack8(R[j + W - 1], ut);
        const int t = t0 + j; const float cnt = samp ? (float)W : (float)(W < t + 1 ? W : t + 1); const float ic = 1.0f / cnt;
        float p[8];
#pragma unroll
        for (int k = 0; k < 8; ++k) p[k] = sum[k] * ic - ut[k];
        *(u32x4*)(PB + (size_t)(token0 + j) * 512 + c) = pack8(p);
    }
}

__global__ void __launch_bounds__(NTHREADS, 2) fwd_megakernel(Params P) {
    extern __shared__ __attribute__((aligned(16))) unsigned char lds_raw[];
    LAS unsigned char* lds = (LAS unsigned char*)lds_raw;
    cg::grid_group grid = cg::this_grid();
    const int tid = threadIdx.x, lane = tid & 63, wave = __builtin_amdgcn_readfirstlane(tid >> 6);
    const int G = gridDim.x, bid = blockIdx.x;
    const int gw = bid * 8 + wave, NGW = G * 8;
    const size_t gtid = (size_t)bid * NTHREADS + tid, nth = (size_t)G * NTHREADS;
    unsigned char* ws = P.ws;
    bf16_t* Wt_in = (bf16_t*)(ws + WS_WIN); bf16_t* Wt_pa = (bf16_t*)(ws + WS_WPA); bf16_t* Wt_pb = (bf16_t*)(ws + WS_WPB);
    bf16_t* Wt_o = (bf16_t*)(ws + WS_WO); bf16_t* Wt_up = (bf16_t*)(ws + WS_WUP); bf16_t* Wt_dn = (bf16_t*)(ws + WS_WDN);
    bf16_t* XL = (bf16_t*)(ws + WS_X); bf16_t* XB = (bf16_t*)(ws + WS_XB); bf16_t* QKV = (bf16_t*)(ws + WS_QKV); bf16_t* UB = (bf16_t*)(ws + WS_U);
    bf16_t* GT = (bf16_t*)(ws + WS_G); bf16_t* OA = (bf16_t*)(ws + WS_OA); bf16_t* PB = (bf16_t*)(ws + WS_P); float* TMP = (float*)(ws + WS_TMP);
    bf16_t* MIX = (bf16_t*)(ws + WS_MIX); bf16_t* HID = (bf16_t*)(ws + WS_H); float* SS = (float*)(ws + WS_SS); float* ROPE = (float*)(ws + WS_ROPE);
    float* out = P.out;
    volatile LAS unsigned* bst = (volatile LAS unsigned*)(lds + LDS_BYTES - 16);
    if (tid == 0) { bst[0] = 0u; bst[1] = 0u; }
    __syncthreads();
    const XcdBarrier xb = xcd_barrier_post((unsigned*)(ws + WS_BAR), bst);

    {
        LAS float* LsT = (LAS float*)lds;
        LAS float* Ws = LsT + 128 * 128;
        for (int item = bid; item < DEPTH * 4 * 16; item += G) {
            const int l = item >> 6, g = (item >> 4) & 3, n0 = (item & 15) * 64;
            const float* lin = P.in[10] + (size_t)(l * 4 + g) * 128 * 128;
            const float* sc = P.in[11] + l * 512 + g * 128;
            const float* wpb = P.in[9] + (size_t)l * 512 * 1024 + (size_t)g * 128 * 1024;
            for (int i = tid; i < 128 * 128; i += NTHREADS) { const int c = i >> 7, d = i & 127; LsT[d * 128 + c] = lin[i] * sc[d]; }
            for (int i = tid; i < 128 * 64; i += NTHREADS) { const int d = i >> 6, n = i & 63; Ws[i] = wpb[(size_t)d * 1024 + n0 + n]; }
            __syncthreads();
            const int n = tid & 63, cgp = tid >> 6;
            float a[16];
#pragma unroll
            for (int i = 0; i < 16; ++i) a[i] = 0.f;
            for (int d = 0; d < 128; ++d) {
                const float w = Ws[d * 64 + n];
                const LAS f32x4* lp = (const LAS f32x4*)(LsT + d * 128 + cgp * 16);
#pragma unroll
                for (int q4 = 0; q4 < 4; ++q4) { const f32x4 lv = lp[q4];
#pragma unroll
                    for (int i = 0; i < 4; ++i) a[q4 * 4 + i] += lv[i] * w; }
            }
            bf16_t* op = Wt_pb + ((size_t)l * 1024 + n0 + n) * 512 + g * 128 + cgp * 16;
            u32x4 o0, o1; o0.x = cvt_pk_bf16(a[0], a[1]); o0.y = cvt_pk_bf16(a[2], a[3]); o0.z = cvt_pk_bf16(a[4], a[5]); o0.w = cvt_pk_bf16(a[6], a[7]);
            o1.x = cvt_pk_bf16(a[8], a[9]); o1.y = cvt_pk_bf16(a[10], a[11]); o1.z = cvt_pk_bf16(a[12], a[13]); o1.w = cvt_pk_bf16(a[14], a[15]);
            *(u32x4*)op = o0; *(u32x4*)(op + 8) = o1;
            __syncthreads();
        }
        {
            LAS float* scr = (LAS float*)(lds + wave * 16640);
            constexpr int I_IN = 16 * 76, I_PA = 4 * 16, I_O = 16 * 16, I_UP = 16 * 64, I_DN = 64 * 16, I_L = I_IN + I_PA + I_O + I_UP + I_DN;
            for (int it = gw; it < DEPTH * I_L; it += NGW) {
                const int l = it / I_L; int r = it - l * I_L;
                if (r < I_IN) { transpose_item(P.in[7] + (size_t)l * DM * NIN, P.in[6] + l * DM, DM, NIN, Wt_in + (size_t)l * NIN * DM, scr, r, lane); continue; } r -= I_IN;
                if (r < I_PA) { transpose_item(P.in[8] + (size_t)l * 256 * DM, nullptr, 256, DM, Wt_pa + (size_t)l * DM * 256, scr, r, lane); continue; } r -= I_PA;
                if (r < I_O) { transpose_item(P.in[12] + (size_t)l * DM * DM, nullptr, DM, DM, Wt_o + (size_t)l * DM * DM, scr, r, lane); continue; } r -= I_O;
                if (r < I_UP) { transpose_item(P.in[14] + (size_t)l * DM * DFF, P.in[13] + l * DM, DM, DFF, Wt_up + (size_t)l * DFF * DM, scr, r, lane); continue; } r -= I_UP;
                transpose_item(P.in[15] + (size_t)l * DFF * DM, nullptr, DFF, DM, Wt_dn + (size_t)l * DM * DFF, scr, r, lane);
            }
        }
        for (int row = gw; row < NTOK; row += NGW) {
            const float* src = row < NTP ? P.in[0] + (size_t)row * DM : P.in[1] + (size_t)(row - NTP) * DM;
            float s = 0.f;
#pragma unroll
            for (int j = 0; j < 4; ++j) { const f32x4 v = *(const f32x4*)(src + 4 * lane + 256 * j); s += v[0] * v[0] + v[1] * v[1] + v[2] * v[2] + v[3] * v[3];
                u32x2 w; w.x = cvt_pk_bf16(v[0], v[1]); w.y = cvt_pk_bf16(v[2], v[3]); *(u32x2*)(XB + (size_t)row * DM + 4 * lane + 256 * j) = w;
                }
#pragma unroll
            for (int o = 1; o < 64; o <<= 1) s += __shfl_xor(s, o);
            if (lane == 0) SS[row] = s;
        }
        for (size_t i = gtid; i < 4104 * 8; i += nth) { const int pi = (int)(i >> 3), k = (int)(i & 7); const float pos = (float)(pi < 4096 ? pi : 8192 + pi - 4096);
            const float inv = powf(500000.0f, -(float)(2 * k) / 16.0f); const float ang = pos * inv; ROPE[pi * 16 + k] = cosf(ang); ROPE[pi * 16 + 8 + k] = sinf(ang); }
        for (size_t i = gtid; i < (size_t)8 * NTOK; i += nth) SS[NTOK + i] = 0.f;
        for (size_t i = gtid; i < (size_t)DEPTH * 32 * 7 * 128; i += nth) { const size_t lb = i / (7 * 128), r = i - lb * (7 * 128);
            *(f32x4*)(out + O_POOLS + lb * 15 * 512 + r * 4) = *(const f32x4*)(P.in[5] + lb * 15 * 512 + 8 * 512 + r * 4); }
    }
    grid.sync();

    pg8::StaticOrder S;
#pragma unroll 1
    for (int step = 0; step < DEPTH * 7; ++step) {
        const int layer = step / 7, st = step - layer * 7;
        if (st == 1) {
            int tid_l = threadIdx.x; asm volatile("" : "+v"(tid_l));
            const int lane = tid_l & 63, gw = bid * 8 + (tid_l >> 6);
            const size_t gtid = (size_t)bid * NTHREADS + tid_l;
            size_t zoff = 0; asm volatile("" : "+s"(zoff));
            unsigned char* wsl = ws + zoff;
            bf16_t* QKV = (bf16_t*)(wsl + WS_QKV); bf16_t* UB = (bf16_t*)(wsl + WS_U); bf16_t* OA = (bf16_t*)(wsl + WS_OA); bf16_t* PB = (bf16_t*)(wsl + WS_P);
            bf16_t* PO = (bf16_t*)(wsl + WS_TMP); float* LSE = (float*)(wsl + WS_TMP + (size_t)3 * NTOK * 256 * 2);
            for (int it = gw; it < NTS * 12; it += NGW) { const int g = it % 3, r = it / 3; attn_sample_sub(QKV, g == 0 ? P.in[2] : (g == 1 ? P.in[3] : P.in[4]), PO, LSE, layer, r >> 2, r & 3, g, lane); }
            attn_mfma_phase(lds, QKV, PO, LSE, bid, G, tid_l);
            copy_shift<128>(P.in[2], out + O_KVS0, layer, gtid, nth);
            copy_shift<512>(P.in[3], out + O_KVS1, layer, gtid, nth);
            copy_shift<2048>(P.in[4], out + O_KVS2, layer, gtid, nth);
            xcd_barrier(xb);
            for (size_t base = gtid; base < (size_t)NTOK * 32; base += nth * 4) {
                float ls[4][3]; u32x4 av[4][3];
#pragma unroll
                for (int u = 0; u < 4; ++u) { const size_t idx = base + u * nth; const size_t ii = idx < (size_t)NTOK * 32 ? idx : base; const size_t token = ii >> 5; const int c = (int)(ii & 31) * 8, h = c >> 6;
#pragma unroll
                    for (int g = 0; g < 3; ++g) { ls[u][g] = LSE[((size_t)g * NTOK + token) * 4 + h]; av[u][g] = *(const u32x4*)(PO + ((size_t)g * NTOK + token) * 256 + c); } }
#pragma unroll
                for (int u = 0; u < 4; ++u) { const size_t idx = base + u * nth;
                    if (idx < (size_t)NTOK * 32) { const size_t token = idx >> 5; const int c = (int)(idx & 31) * 8;
                        const float mx = fmaxf(ls[u][0], fmaxf(ls[u][1], ls[u][2])); float w0 = __expf(ls[u][0] - mx), w1 = __expf(ls[u][1] - mx), w2 = __expf(ls[u][2] - mx); const float iw = 1.0f / (w0 + w1 + w2); w0 *= iw; w1 *= iw; w2 *= iw;
                        float a0[8], a1[8], a2[8], o[8]; unpack8(av[u][0], a0); unpack8(av[u][1], a1); unpack8(av[u][2], a2);
#pragma unroll
                        for (int k = 0; k < 8; ++k) o[k] = w0 * a0[k] + w1 * a1[k] + w2 * a2[k];
                        *(u32x4*)(OA + token * 256 + c) = pack8(o); } }
            }
            const float* sp = P.in[5] + (size_t)layer * 32 * 15 * 512;
            for (int it = (int)gtid; it < 4 * (NTOK / 8) * 16; it += (int)nth) {
                const int cl = it & 15, q = it >> 4, g = q / (NTOK / 8), tb = q - g * (NTOK / 8);
                if (g == 0) pool_item<0>(UB, PB, sp, tb, cl); else if (g == 1) pool_item<1>(UB, PB, sp, tb, cl); else if (g == 2) pool_item<2>(UB, PB, sp, tb, cl); else pool_item<3>(UB, PB, sp, tb, cl);
            }
            xcd_barrier(xb);
            continue;
        }
        pg8::Gemm g; EpiAll E; E.ws = ws; E.out = out; E.layer = layer; E.ssi = 0; E.ssn = 0;
        const int Mg = (st == 0) ? NTOK : NTP;
        g.M = Mg;
        if (st == 0)      { g.A = XB;  g.Bt = Wt_in + (size_t)layer * NIN * DM; g.N = NIN; g.K = DM;  E.mode = 0; E.ssi = 2 * layer; }
        else if (st == 2) { g.A = OA;  g.Bt = Wt_pa + (size_t)layer * DM * 256; g.N = DM;  g.K = 256; E.mode = 1; }
        else if (st == 3) { g.A = PB;  g.Bt = Wt_pb + (size_t)layer * DM * 512; g.N = DM;  g.K = 512; E.mode = 2; }
        else if (st == 4) { g.A = MIX; g.Bt = Wt_o + (size_t)layer * DM * DM;   g.N = DM;  g.K = DM;  E.mode = 3; E.ssn = 2 * layer + 1; }
        else if (st == 5) { g.A = XB;  g.Bt = Wt_up + (size_t)layer * DFF * DM; g.N = DFF; g.K = DM;  E.mode = 4; E.ssi = 2 * layer + 1; }
        else              { g.A = HID; g.Bt = Wt_dn + (size_t)layer * DM * DFF; g.N = DM;  g.K = DFF; E.mode = 3; E.ssn = 2 * layer + 2; }
        S.init(Mg, g.N, G, bid);
        pg8::gemm_phase<EpiAll, pg8::StaticOrder, true, true>(lds, g, S, E);
        if (st != 0) skinny_gemm(lds, g.A + (size_t)NTP * g.K, g.Bt, g.N, g.K, E, G - 1 - bid, G);
        if (st != 2) xcd_barrier(xb);
    }
    {
        int tid_l = threadIdx.x; asm volatile("" : "+v"(tid_l));
        const int lane = tid_l & 63, gw = bid * 8 + (tid_l >> 6);
        size_t zoff = 0; asm volatile("" : "+s"(zoff));
        unsigned char* wsl = ws + zoff;
        const bf16_t* XL = (const bf16_t*)(wsl + WS_X); const bf16_t* XH = (const bf16_t*)(wsl + WS_XB);
        const float* fn = P.in[16]; const float* ssf = (const float*)(wsl + WS_SS) + (size_t)8 * NTOK;
        for (int row = gw; row < NTOK; row += 2 * NGW) {
            const int r2 = row + NGW; const bool ok2 = r2 < NTOK; const int rb = ok2 ? r2 : row;
            const float s0 = ssf[row], s1 = ssf[rb];
            f32x4 va[4], vb[4], gn[4];
#pragma unroll
            for (int j = 0; j < 4; ++j) { const int c = 4 * lane + 256 * j; gn[j] = *(const f32x4*)(fn + c);
                const u32x2 ah = *(const u32x2*)(XH + (size_t)row * DM + c), bh = *(const u32x2*)(XH + (size_t)rb * DM + c);
                va[j] = (f32x4){__uint_as_float(ah.x << 16), __uint_as_float(ah.x & 0xffff0000u), __uint_as_float(ah.y << 16), __uint_as_float(ah.y & 0xffff0000u)};
                vb[j] = (f32x4){__uint_as_float(bh.x << 16), __uint_as_float(bh.x & 0xffff0000u), __uint_as_float(bh.y << 16), __uint_as_float(bh.y & 0xffff0000u)}; }
            const float rs0 = rsqrtf(s0 * (1.0f / 1024.0f) + 1e-6f), rs1 = rsqrtf(s1 * (1.0f / 1024.0f) + 1e-6f);
#pragma unroll
            for (int j = 0; j < 4; ++j) { const int c = 4 * lane + 256 * j;
                *(f32x4*)(out + (size_t)row * DM + c) = (f32x4){va[j][0] * rs0 * gn[j][0], va[j][1] * rs0 * gn[j][1], va[j][2] * rs0 * gn[j][2], va[j][3] * rs0 * gn[j][3]};
                if (ok2) *(f32x4*)(out + (size_t)r2 * DM + c) = (f32x4){vb[j][0] * rs1 * gn[j][0], vb[j][1] * rs1 * gn[j][1], vb[j][2] * rs1 * gn[j][2], vb[j][3] * rs1 * gn[j][3]}; }
        }
    }
}

extern "C" void kernel_launch(void* const* d_in, const int* in_sizes, int n_in, void* d_out, int out_size, void* d_ws, size_t ws_size, hipStream_t stream) {
    static int grid_blocks = 0;
    if (grid_blocks == 0) {
        if (n_in != 17 || ws_size < WS_END) { fprintf(stderr, "kernel_launch: unexpected n_in %d / ws %zu (need %zu)\n", n_in, ws_size, (size_t)WS_END); grid_blocks = -1; return; }
        int dev = 0, cus = 0, per_cu = 0;
        (void)hipGetDevice(&dev);
        (void)hipDeviceGetAttribute(&cus, hipDeviceAttributeMultiprocessorCount, dev);
        if (hipFuncSetAttribute((const void*)fwd_megakernel, hipFuncAttributeMaxDynamicSharedMemorySize, LDS_BYTES) != hipSuccess) { fprintf(stderr, "kernel_launch: hipFuncSetAttribute failed\n"); grid_blocks = -1; return; }
        (void)hipOccupancyMaxActiveBlocksPerMultiprocessor(&per_cu, (const void*)fwd_megakernel, NTHREADS, LDS_BYTES);
        if (per_cu < 1) { fprintf(stderr, "kernel_launch: occupancy query says %d blocks/CU\n", per_cu); grid_blocks = -1; return; }
        grid_blocks = cus * 1;
    }
    if (grid_blocks < 0) return;
    if (hipMemsetAsync((unsigned char*)d_ws + WS_BAR, 0, 4096 * 4, stream) != hipSuccess) { fprintf(stderr, "kernel_launch: memset of barrier words failed\n"); return; }
    Params p{};
    for (int i = 0; i < 17; ++i) p.in[i] = (const float*)d_in[i];
    p.out = (float*)d_out; p.ws = (unsigned char*)d_ws;
    void* args[] = {&p};
    hipError_t e = hipLaunchCooperativeKernel((const void*)fwd_megakernel, dim3(grid_blocks), dim3(NTHREADS), args, LDS_BYTES, stream);
    if (e != hipSuccess) fprintf(stderr, "cooperative launch failed: %s (grid %d)\n", hipGetErrorString(e), grid_blocks);
}
```
